# Optimizing an MI355X kernel written in HIP

```python
import math
import jax
import jax.numpy as jnp
from jax import lax
import numpy as np

D_MODEL = 1024
BATCH = 8
SEQ = 4096
DEPTH = 1

MIX_WIDTH = D_MODEL
MLSTM_WIDTH = MIX_WIDTH // 2
MLSTM_HEADS = 4
MLSTM_HEAD_DIM = MLSTM_WIDTH // MLSTM_HEADS
MLSTM_CHUNK = 128
MLSTM_M_INIT = -1e30
HYENA_WIDTH = MIX_WIDTH - MLSTM_WIDTH
HYENA_GROUPS = 4
HYENA_GROUP_DIM = HYENA_WIDTH // HYENA_GROUPS
HYENA_ORDER = 2
HYENA_DIRS = 2
HYENA_BANDS = 16
HYENA_EMB_DIM = 1 + 2 * HYENA_BANDS
HYENA_FILTER_HIDDEN = 64
HYENA_WINDOW_SHIFT = 0.05
HYENA_SLOW_DECAY = -math.log(1e-2) / 1.5
HYENA_FAST_DECAY = -math.log(1e-2) / 0.3
SHORT_CONV = 3
N_GATE_COLS = 4 * MLSTM_HEADS
PROJ_COLS = 4 * MLSTM_WIDTH + N_GATE_COLS + (HYENA_ORDER + 1) * HYENA_WIDTH
N_EXPERTS = 16
EC_CAPACITY_FACTOR = 2
EXPERT_FF = 2 * D_MODEL
RMS_EPS = 1e-6

kernel_name = 'hybrid_mlstm_hyena_ec_moe_encoder'


def rms_norm(x, g):
    xf = x.astype(jnp.float32)
    y = xf * lax.rsqrt(jnp.mean(xf * xf, axis=-1, keepdims=True) + RMS_EPS)
    return (y * g.astype(jnp.float32)).astype(x.dtype)


def centred_short_conv(u, w, b):
    S = u.shape[1]
    r = SHORT_CONV // 2
    up = jnp.pad(u, ((0, 0), (r, r), (0, 0)))
    y = b
    for j in range(SHORT_CONV):
        y = y + up[:, j:j + S] * w[j]
    return y


def mlstm_scan(q, k, v, i_pre, logf):
    B, H, S, Dh = q.shape
    nc = S // MLSTM_CHUNK
    qc = q.reshape(B, H, nc, MLSTM_CHUNK, Dh)
    kc = k.reshape(B, H, nc, MLSTM_CHUNK, Dh)
    vc = v.reshape(B, H, nc, MLSTM_CHUNK, Dh)
    ic = i_pre.reshape(B, H, nc, MLSTM_CHUNK)
    b = jnp.cumsum(logf.reshape(B, H, nc, MLSTM_CHUNK), axis=-1)
    g = b[..., -1]
    w_end = g[..., None] - b + ic
    a = jnp.max(w_end, axis=-1)
    e_end = jnp.exp(w_end - a[..., None])
    c_loc = jnp.einsum('bhcsv,bhcsk->bhcvk', vc * e_end[..., None], kc)
    n_loc = jnp.einsum('bhcs,bhcsk->bhck', e_end, kc)

    def step(carry, inp):
        c_st, n_st, m_st = carry
        g_j, a_j, c_j, n_j = inp
        m_new = jnp.maximum(g_j + m_st, a_j)
        s_prev = jnp.exp(g_j + m_st - m_new)
        s_loc = jnp.exp(a_j - m_new)
        c_new = s_prev[..., None, None] * c_st + s_loc[..., None, None] * c_j
        n_new = s_prev[..., None] * n_st + s_loc[..., None] * n_j
        return (c_new, n_new, m_new), (c_st, n_st, m_st)

    init = (jnp.zeros((B, H, Dh, Dh), q.dtype), jnp.zeros((B, H, Dh), q.dtype),
            jnp.full((B, H), MLSTM_M_INIT, q.dtype))
    xs = tuple(jnp.moveaxis(t, 2, 0) for t in (g, a, c_loc, n_loc))
    _, (c_in, n_in, m_in) = lax.scan(step, init, xs)
    c_in = jnp.moveaxis(c_in, 0, 2)
    n_in = jnp.moveaxis(n_in, 0, 2)
    m_in = jnp.moveaxis(m_in, 0, 2)

    tri = jnp.tril(jnp.ones((MLSTM_CHUNK, MLSTM_CHUNK), dtype=bool))
    log_d = jnp.where(tri, b[..., :, None] - b[..., None, :] + ic[..., None, :], -jnp.inf)
    log_inter = b + m_in[..., None]
    m_t = jnp.maximum(log_inter, jnp.max(log_d, axis=-1))
    d = jnp.exp(log_d - m_t[..., None])
    e_inter = jnp.exp(log_inter - m_t)
    s = jnp.einsum('bhctd,bhcsd->bhcts', qc, kc) * d
    num = (jnp.einsum('bhcts,bhcsd->bhctd', s, vc)
           + e_inter[..., None] * jnp.einsum('bhcvk,bhctk->bhctv', c_in, qc))
    den = jnp.sum(s, axis=-1) + e_inter * jnp.einsum('bhck,bhctk->bhct', n_in, qc)
    nrm = jnp.maximum(jnp.abs(den), jnp.exp(-m_t))
    return (num / nrm[..., None]).reshape(B, H, S, Dh)


def mlstm_mixer(q, k, v, o, gates, conv_w, conv_b, norm_g):
    B, S, _ = q.shape
    H, Dh = MLSTM_HEADS, MLSTM_HEAD_DIM
    qk = jax.nn.silu(centred_short_conv(jnp.concatenate([q, k], axis=-1), conv_w, conv_b))
    q, k = jnp.split(qk, 2, axis=-1)

    def heads(t):
        return t.reshape(B, S, H, Dh).transpose(0, 2, 1, 3).astype(jnp.float32)

    qh, kh, vh = heads(q), heads(k) * (MLSTM_HEAD_DIM ** -0.5), heads(v)
    g4 = gates.reshape(B, S, 4, H).transpose(2, 0, 3, 1).astype(jnp.float32)
    i_f, f_f, i_b, f_b = g4[0], g4[1], g4[2], g4[3]
    h_f = mlstm_scan(qh, kh, vh, i_f, jax.nn.log_sigmoid(f_f))

    def fl(t):
        return jnp.flip(t, axis=2)

    h_b = fl(mlstm_scan(fl(qh), fl(kh), fl(vh), fl(i_b), fl(jax.nn.log_sigmoid(f_b))))
    hsum = (h_f + h_b).transpose(0, 2, 1, 3)
    hn = rms_norm(hsum, norm_g.reshape(H, Dh)).reshape(B, S, MLSTM_WIDTH)
    return (jax.nn.sigmoid(o.astype(jnp.float32)) * hn).astype(o.dtype)


def hyena_filters(L, w1, b1, w2, b2, w3, freq, deltas):
    f32 = jnp.float32
    t = jnp.linspace(0.0, 1.0, L, dtype=f32)[:, None]
    w = 2.0 * math.pi * jnp.arange(L, dtype=f32)[:, None] / L
    bands = jnp.linspace(1e-4, HYENA_BANDS - 1, HYENA_BANDS, dtype=f32)[None, :]
    z = jnp.concatenate([t, jnp.cos(bands * w), -jnp.sin(bands * w)], axis=-1)
    fr = freq.astype(f32)
    hid = jnp.sin(fr * (z @ w1.astype(f32) + b1.astype(f32)))
    hid = jnp.sin(fr * (hid @ w2.astype(f32) + b2.astype(f32)))
    h = hid @ w3.astype(f32)
    window = jnp.exp(-t * jnp.abs(deltas.astype(f32))) + HYENA_WINDOW_SHIFT
    return (h * window).reshape(L, HYENA_ORDER, HYENA_DIRS, HYENA_WIDTH)


def bidir_long_conv(u, h_fwd, h_bwd, bias):
    L, C = h_fwd.shape
    two_sided = jnp.concatenate([(h_fwd[0] + h_bwd[0])[None], h_fwd[1:],
                                 jnp.zeros((1, C), jnp.float32), jnp.flip(h_bwd[1:], axis=0)], axis=0)
    k_f = jnp.fft.rfft(two_sided, n=2 * L, axis=0)
    uf = u.astype(jnp.float32)
    u_f = jnp.fft.rfft(uf, n=2 * L, axis=1)
    y = jnp.fft.irfft(u_f * k_f[None], n=2 * L, axis=1)[:, :L]
    return (y + uf * bias.astype(jnp.float32)).astype(u.dtype)


def hyena_mixer(hx, conv_w, conv_b, filt, bias, norm_g):
    B, S, _ = hx.shape
    u = centred_short_conv(hx, conv_w, conv_b)
    x1, x2, z = jnp.split(u, HYENA_ORDER + 1, axis=-1)
    z = x1 * bidir_long_conv(z, filt[:, 0, 0], filt[:, 0, 1], bias[0])
    z = x2 * bidir_long_conv(z, filt[:, 1, 0], filt[:, 1, 1], bias[1])
    zg = z.reshape(B, S, HYENA_GROUPS, HYENA_GROUP_DIM)
    return rms_norm(zg, norm_g.reshape(HYENA_GROUPS, HYENA_GROUP_DIM)).reshape(B, S, HYENA_WIDTH)


def expert_choice_moe(xn, w_router, w_gate, w_up, w_down):
    B, T, D = xn.shape
    cap = EC_CAPACITY_FACTOR * T // N_EXPERTS
    aff = jax.nn.softmax((xn @ w_router).astype(jnp.float32), axis=-1)
    g, idx = lax.top_k(jnp.swapaxes(aff, 1, 2), cap)
    bidx = jnp.arange(B)[:, None, None]
    xs = xn[bidx, idx]
    hid = jax.nn.silu(jnp.einsum('becd,edf->becf', xs, w_gate)) * jnp.einsum('becd,edf->becf', xs, w_up)
    y = jnp.einsum('becf,efd->becd', hid, w_down) * g[..., None].astype(xn.dtype)
    return jnp.zeros_like(xn).at[bidx, idx].add(y)


def setup_inputs(seed: int = 0) -> dict:
    key = jax.random.key(seed)
    ks = jax.random.split(key, 32)
    f32 = jnp.float32
    D, L = D_MODEL, DEPTH

    def nrm(k, shape, scale):
        return jax.random.normal(k, shape, f32) * scale

    gate_off = 4 * MLSTM_WIDTH
    H = MLSTM_HEADS
    f_bias = jnp.linspace(3.0, 6.0, H, dtype=f32)
    b_in = nrm(ks[5], (L, PROJ_COLS), 0.02)
    b_in = b_in.at[:, gate_off + H:gate_off + 2 * H].add(f_bias)
    b_in = b_in.at[:, gate_off + 3 * H:gate_off + 4 * H].add(f_bias)
    n_filt = HYENA_ORDER * HYENA_DIRS * HYENA_WIDTH
    base_delta = jnp.tile(jnp.linspace(HYENA_SLOW_DECAY, HYENA_FAST_DECAY, HYENA_WIDTH, dtype=f32),
                          HYENA_ORDER * HYENA_DIRS)
    return {
        'x': nrm(ks[0], (BATCH, SEQ, D), 1.0),
        'c': nrm(ks[1], (BATCH, D), 1.0),
        'w_ada': nrm(ks[2], (L, D, 6 * D), 0.5 * D ** -0.5),
        'b_ada': nrm(ks[3], (L, 6 * D), 0.02),
        'g_mix': 1.0 + nrm(ks[4], (L, D), 0.02),
        'w_in': nrm(ks[6], (L, D, PROJ_COLS), D ** -0.5),
        'b_in': b_in,
        'conv_qk_w': nrm(ks[7], (L, SHORT_CONV, 2 * MLSTM_WIDTH), SHORT_CONV ** -0.5),
        'conv_qk_b': nrm(ks[8], (L, 2 * MLSTM_WIDTH), 0.02),
        'mlstm_norm_g': 1.0 + nrm(ks[9], (L, MLSTM_WIDTH), 0.02),
        'conv_hy_w': nrm(ks[10], (L, SHORT_CONV, (HYENA_ORDER + 1) * HYENA_WIDTH), SHORT_CONV ** -0.5),
        'conv_hy_b': nrm(ks[11], (L, (HYENA_ORDER + 1) * HYENA_WIDTH), 0.02),
        'hy_w1': nrm(ks[12], (L, HYENA_EMB_DIM, HYENA_FILTER_HIDDEN), HYENA_EMB_DIM ** -0.5),
        'hy_b1': nrm(ks[13], (L, HYENA_FILTER_HIDDEN), 0.1),
        'hy_w2': nrm(ks[14], (L, HYENA_FILTER_HIDDEN, HYENA_FILTER_HIDDEN), HYENA_FILTER_HIDDEN ** -0.5),
        'hy_b2': nrm(ks[15], (L, HYENA_FILTER_HIDDEN), 0.1),
        'hy_w3': nrm(ks[16], (L, HYENA_FILTER_HIDDEN, n_filt), 0.1 * HYENA_FILTER_HIDDEN ** -0.5),
        'hy_freq': 1.0 + nrm(ks[17], (L, HYENA_FILTER_HIDDEN), 0.02),
        'hy_deltas': base_delta[None] * (1.0 + nrm(ks[18], (L, n_filt), 0.02)),
        'hy_bias': nrm(ks[19], (L, HYENA_ORDER, HYENA_WIDTH), 0.1),
        'hyena_norm_g': 1.0 + nrm(ks[20], (L, HYENA_WIDTH), 0.02),
        'w_out': nrm(ks[21], (L, MIX_WIDTH, D), MIX_WIDTH ** -0.5),
        'g_ffn': 1.0 + nrm(ks[22], (L, D), 0.02),
        'w_router': nrm(ks[23], (L, D, N_EXPERTS), D ** -0.5),
        'w_gate': nrm(ks[24], (L, N_EXPERTS, D, EXPERT_FF), D ** -0.5),
        'w_up': nrm(ks[25], (L, N_EXPERTS, D, EXPERT_FF), D ** -0.5),
        'w_down': nrm(ks[26], (L, N_EXPERTS, EXPERT_FF, D), EXPERT_FF ** -0.5),
        'g_final': 1.0 + nrm(ks[27], (D,), 0.02),
    }


def reference(x, c, w_ada, b_ada, g_mix, w_in, b_in, conv_qk_w, conv_qk_b, mlstm_norm_g,
              conv_hy_w, conv_hy_b, hy_w1, hy_b1, hy_w2, hy_b2, hy_w3, hy_freq, hy_deltas, hy_bias,
              hyena_norm_g, w_out, g_ffn, w_router, w_gate, w_up, w_down, g_final):
    W = MLSTM_WIDTH
    split_pts = [W, 2 * W, 3 * W, 4 * W, 4 * W + N_GATE_COLS]
    seq_len = x.shape[1]
    for l in range(DEPTH):
        mod = (c @ w_ada[l] + b_ada[l])[:, None, :]
        sh1, sc1, gt1, sh2, sc2, gt2 = jnp.split(mod, 6, axis=-1)
        h = rms_norm(x, g_mix[l]) * (1 + sc1) + sh1
        p = h @ w_in[l] + b_in[l]
        q, k, v, o, gates, hx = jnp.split(p, split_pts, axis=-1)
        y_m = mlstm_mixer(q, k, v, o, gates, conv_qk_w[l], conv_qk_b[l], mlstm_norm_g[l])
        filt = hyena_filters(seq_len, hy_w1[l], hy_b1[l], hy_w2[l], hy_b2[l], hy_w3[l], hy_freq[l], hy_deltas[l])
        y_h = hyena_mixer(hx, conv_hy_w[l], conv_hy_b[l], filt, hy_bias[l], hyena_norm_g[l])
        mixed = jnp.concatenate([y_m, y_h], axis=-1) @ w_out[l]
        x = x + gt1 * mixed
        hf = rms_norm(x, g_ffn[l]) * (1 + sc2) + sh2
        x = x + gt2 * expert_choice_moe(hf, w_router[l], w_gate[l], w_up[l], w_down[l])
    return rms_norm(x, g_final)
```

```cpp
#include <hip/hip_runtime.h>
#include <cstdio>
#include <cstdint>
#define N_LAUNCHES 13
namespace pg8 {
#define PG8_LAS __attribute__((address_space(3)))
typedef unsigned short bf16_t;
typedef short bf16x8 __attribute__((ext_vector_type(8)));
typedef float f32x4 __attribute__((ext_vector_type(4)));
typedef unsigned u32x4 __attribute__((ext_vector_type(4)));
constexpr int BM = 256, BK = 64, HALF = 128, HTB = HALF * BK * 2  , STAGE_BYTES = 8 * HTB, NXCD = 8, WGM = 8;

__host__ __device__ __forceinline__ int lds_byte(int r, int c) { const int st = (r >> 4) * 2 + (c >> 5), rr = r & 15, cc = c & 31, ob = rr * 64 + cc * 2; return st * 1024 + (ob ^ (((ob >> 9) & 1) << 5)); }
__host__ __device__ __forceinline__ void stage_rc(int b, int& R, int& C) { const int st = b / 1024, sb = b % 1024, swz = sb ^ (((sb >> 9) & 1) << 5); R = (st >> 1) * 16 + swz / 64; C = (st & 1) * 32 + (swz % 64) / 2; }
__host__ __device__ __forceinline__ int perm32(int rho) { const int n = rho >> 4, i = rho & 15; return 8 * (i >> 2) + 4 * n + (i & 3); }

struct Unit { int pm, pn; };
struct Gemm { const bf16_t* A; const bf16_t* Bt; int M, N, K; };

struct StaticOrder {
    int nM, nN, nwg, G, c;
    __host__ __device__ void init(int M, int N, int G_, int c_) { nM = M / BM; nN = N / BM; nwg = nM * nN; G = G_; c = c_; }
    __host__ __device__ bool next(int i, Unit& u) const {
        const long L = (long)i * G + c; if (L >= nwg) return false;
        int wgid = (int)L; { const int q = nwg / NXCD, r = nwg % NXCD, xcd = wgid % NXCD, off = wgid / NXCD; wgid = (xcd < r ? xcd * (q + 1) : r * (q + 1) + (xcd - r) * q) + off; }
        const int nig = WGM * nN, gid = wgid / nig, fm = gid * WGM, gsz = (nM - fm) < WGM ? (nM - fm) : WGM;
        u.pm = fm + ((wgid % nig) % gsz); u.pn = (wgid % nig) / gsz; return true;
    }
    __device__ __forceinline__ void a_ready(const Unit&) const {}
    __device__ __forceinline__ void done(const Unit&) const {}
};

__device__ __forceinline__ unsigned cvt_pk_bf16(float lo, float hi) { unsigned r; asm volatile("v_cvt_pk_bf16_f32 %0, %1, %2" : "=v"(r) : "v"(lo), "v"(hi)); return r; }
typedef float f32x2 __attribute__((ext_vector_type(2)));
__device__ __forceinline__ f32x2 gelu_pk(f32x2 v) {
    const f32x2 av = __builtin_elementwise_abs(v), d = av * 0.2316418882f + 1.0f;
    f32x2 t; t.x = __builtin_amdgcn_rcpf(d.x); t.y = __builtin_amdgcn_rcpf(d.y);
    f32x2 q = t * 0.5307027145f + (-0.7265760135f); q = q * t + 0.7107068705f; q = q * t + (-0.142248368f); q = q * t + 0.127414796f; q = q * t;
    const f32x2 s = (v * v) * (-0.72134752044f);
    f32x2 e; e.x = __builtin_amdgcn_exp2f(s.x); e.y = __builtin_amdgcn_exp2f(s.y);
    const f32x2 m = v * (q * e), r = v - m;
    f32x2 o; o.x = v.x < 0.f ? m.x : r.x; o.y = v.y < 0.f ? m.y : r.y; return o;
}

template <int ACT  > struct EpiBf16 {
    static constexpr bool PERM = true, AFTER_DRAIN = false; static_assert(ACT == 0 || ACT == 1, "EpiBf16: ACT is 0 (none) or 1 (gelu_pk)");
    bf16_t* O; int ldc; const float* bias; int split_cols; size_t split_stride; float scale0;
    __device__ __forceinline__ void operator()(const f32x4 (&acc)[2][2][4][2], const Unit& u, int wr, int wc, int fr, int fq) const {
        const int row0 = u.pm * BM + wr * 64 + fr; int colt = u.pn * BM; bf16_t* base = O;
        float sc = 1.f; if (split_cols) { const int t = colt / split_cols; base += (size_t)t * split_stride; colt -= t * split_cols; if (t == 0) sc = scale0; }
        const int col0 = colt + wc * 32 + 8 * fq, bcol0 = u.pn * BM + wc * 32 + 8 * fq;
        f32x4 bv[2][2];
#pragma unroll
        for (int bj = 0; bj < 2; ++bj)
#pragma unroll
            for (int n = 0; n < 2; ++n) bv[bj][n] = bias ? *(const f32x4*)(bias + bcol0 + bj * HALF + 4 * n) : (f32x4){0.f, 0.f, 0.f, 0.f};
#pragma unroll
        for (int ai = 0; ai < 2; ++ai)
#pragma unroll
            for (int m = 0; m < 4; ++m) { bf16_t* rowp = base + (size_t)(row0 + ai * HALF + m * 16) * ldc + col0;
#pragma unroll
                for (int bj = 0; bj < 2; ++bj) { f32x4 v0 = acc[ai][bj][m][0] + bv[bj][0], v1 = acc[ai][bj][m][1] + bv[bj][1];
                    if (ACT == 1) { f32x2 a = gelu_pk((f32x2){v0[0], v0[1]}), b = gelu_pk((f32x2){v0[2], v0[3]}), c = gelu_pk((f32x2){v1[0], v1[1]}), d = gelu_pk((f32x2){v1[2], v1[3]});
                        v0 = (f32x4){a.x, a.y, b.x, b.y}; v1 = (f32x4){c.x, c.y, d.x, d.y}; }
                    v0 = v0 * sc; v1 = v1 * sc; u32x4 w; w.x = cvt_pk_bf16(v0[0], v0[1]); w.y = cvt_pk_bf16(v0[2], v0[3]); w.z = cvt_pk_bf16(v1[0], v1[1]); w.w = cvt_pk_bf16(v1[2], v1[3]);
                    *(u32x4*)(rowp + bj * HALF) = w; } }
    }
};


template <class Epi, class Sched, bool ALIGN_EPI = false, bool SP2 = false>
__device__ __forceinline__ void gemm_phase(PG8_LAS unsigned char* lds, const Gemm g, const Sched& S, const Epi& E) {
    const int tid = threadIdx.x, wid = __builtin_amdgcn_readfirstlane(tid >> 6), lane = tid & 63, wr = wid >> 2, wc = wid & 3, fr = lane & 15, fq = lane >> 4;
    const int K = g.K, nt = K / BK;
    unsigned voffA[2], voffB[2];
#pragma unroll
    for (int i = 0; i < 2; ++i) { int R, C; stage_rc(tid * 16 + i * 8192, R, C); const int Rb = Epi::PERM ? ((R & ~31) + perm32(R & 31)) : R;
        voffA[i] = (unsigned)(R * K + C) * 2u; voffB[i] = (unsigned)(Rb * K + C) * 2u; }
    const size_t kstep = (size_t)(BK * 2);
    const size_t hstep = (size_t)HALF * K * 2;
    const size_t tstep = 2 * hstep;
    const unsigned ldsw = (unsigned)wid * 1024u;
    const int aoff = lds_byte(wr * 64 + fr, fq * 8), boff = lds_byte(wc * 32 + fr, fq * 8);
#define PG8_SA(b, h) (((b) * 2 + (h)) * HTB)
#define PG8_SB(b, h) ((4 + (b) * 2 + (h)) * HTB)
#define PG8_STAGE(bufoff, gbase, voff) do { _Pragma("unroll") for (int _i = 0; _i < 2; ++_i) \
        __builtin_amdgcn_global_load_lds((const unsigned*)((const char*)(gbase) + (voff)[_i]), (PG8_LAS unsigned*)(lds + (bufoff) + ldsw + _i * 8192), 16, 0, 0); } while (0)
#define PG8_LDA(dst, b, h) do { _Pragma("unroll") for (int m = 0; m < 4; ++m) _Pragma("unroll") for (int k = 0; k < 2; ++k) dst[m][k] = *(const PG8_LAS bf16x8*)(lds + PG8_SA(b, h) + aoff + m * 2048 + k * 1024); } while (0)
#define PG8_LDB(dst, b, h) do { _Pragma("unroll") for (int n = 0; n < 2; ++n) _Pragma("unroll") for (int k = 0; k < 2; ++k) dst[n][k] = *(const PG8_LAS bf16x8*)(lds + PG8_SB(b, h) + boff + n * 2048 + k * 1024); } while (0)
#define PG8_MMA(ai, bj, At, Bt) do { __builtin_amdgcn_s_setprio(1); _Pragma("unroll") for (int m = 0; m < 4; ++m) _Pragma("unroll") for (int n = 0; n < 2; ++n) _Pragma("unroll") for (int k = 0; k < 2; ++k) \
        acc[ai][bj][m][n] = __builtin_amdgcn_mfma_f32_16x16x32_bf16(Bt[n][k], At[m][k], acc[ai][bj][m][n], 0, 0, 0); __builtin_amdgcn_s_setprio(0); } while (0)
#define PG8_WAIT_V(n) asm volatile("s_waitcnt vmcnt(" #n ")" ::: "memory")
#define PG8_WAIT_L(n) asm volatile("s_waitcnt lgkmcnt(" #n ")" ::: "memory")
#define PG8_BAR __builtin_amdgcn_s_barrier()
#define PG8_SCHED __builtin_amdgcn_sched_barrier(0)
    Unit cur, nxt; int ui = 0;
    if (!S.next(0, cur)) return;
    f32x4 acc[2][2][4][2];
#pragma unroll
    for (int a = 0; a < 2; ++a)
#pragma unroll
        for (int b = 0; b < 2; ++b)
#pragma unroll
            for (int m = 0; m < 4; ++m)
#pragma unroll
                for (int n = 0; n < 2; ++n) acc[a][b][m][n] = (f32x4){0.f, 0.f, 0.f, 0.f};
    bf16x8 At[4][2], B0[2][2], B1[2][2];
    const char* cA = (const char*)g.A + (size_t)cur.pm * tstep; const char* cB = (const char*)g.Bt + (size_t)cur.pn * tstep;
    S.a_ready(cur);
    if constexpr (SP2) {
        PG8_STAGE(PG8_SB(0, 0), cB, voffB); PG8_STAGE(PG8_SB(0, 1), cB + hstep, voffB); PG8_STAGE(PG8_SA(0, 0), cA, voffA); PG8_STAGE(PG8_SA(0, 1), cA + hstep, voffA);
        if (wr == 1) PG8_BAR;
        PG8_WAIT_V(2); PG8_BAR;
        PG8_STAGE(PG8_SB(1, 0), cB + kstep, voffB); PG8_STAGE(PG8_SA(1, 0), cA + kstep, voffA); PG8_STAGE(PG8_SB(1, 1), cB + hstep + kstep, voffB);
        PG8_WAIT_V(6); PG8_BAR;
    } else {
        PG8_STAGE(PG8_SB(0, 0), cB, voffB); PG8_STAGE(PG8_SA(0, 0), cA, voffA); PG8_STAGE(PG8_SB(0, 1), cB + hstep, voffB); PG8_STAGE(PG8_SA(0, 1), cA + hstep, voffA);
        if (wr == 1) PG8_BAR;
        PG8_WAIT_V(4); PG8_BAR;
        PG8_STAGE(PG8_SB(1, 0), cB + kstep, voffB); PG8_STAGE(PG8_SA(1, 0), cA + kstep, voffA); PG8_STAGE(PG8_SB(1, 1), cB + hstep + kstep, voffB);
        PG8_WAIT_V(6); PG8_BAR;
    }
    for (;;) {
        const bool has_next = S.next(ui + 1, nxt);
        const char* nA = has_next ? (const char*)g.A + (size_t)nxt.pm * tstep : cA; const char* nB = has_next ? (const char*)g.Bt + (size_t)nxt.pn * tstep : cB;
        for (int t = 0; t < nt; t += 2) {
            const bool last = (t == nt - 2);
            const char* a1 = cA + (size_t)(t + 1) * kstep;
            const char* a2 = last ? nA : cA + (size_t)(t + 2) * kstep; const char* b2 = last ? nB : cB + (size_t)(t + 2) * kstep;
            const char* a3 = a2 + kstep; const char* b3 = b2 + kstep;
            if (last && has_next) S.a_ready(nxt);
            if constexpr (SP2) {
            PG8_LDB(B0, 0, 0); PG8_LDB(B1, 0, 1); PG8_SCHED; PG8_LDA(At, 0, 0); PG8_STAGE(PG8_SA(1, 1), a1 + hstep, voffA);
            PG8_WAIT_V(8); PG8_WAIT_L(0); PG8_BAR; PG8_MMA(0, 0, At, B0); PG8_MMA(0, 1, At, B1); PG8_BAR; PG8_SCHED;
            PG8_LDA(At, 0, 1); PG8_STAGE(PG8_SB(0, 0), b2, voffB); PG8_STAGE(PG8_SB(0, 1), b2 + hstep, voffB); PG8_STAGE(PG8_SA(0, 0), a2, voffA);
            PG8_WAIT_V(8); PG8_WAIT_L(0); PG8_BAR; PG8_MMA(1, 0, At, B0); PG8_MMA(1, 1, At, B1); PG8_BAR; PG8_SCHED;
            PG8_LDB(B0, 1, 0); PG8_LDB(B1, 1, 1); PG8_SCHED; PG8_LDA(At, 1, 0); PG8_STAGE(PG8_SA(0, 1), a2 + hstep, voffA);
            PG8_WAIT_V(8); PG8_WAIT_L(0); PG8_BAR; PG8_MMA(0, 0, At, B0); PG8_MMA(0, 1, At, B1); PG8_BAR; PG8_SCHED;
            PG8_LDA(At, 1, 1); PG8_STAGE(PG8_SB(1, 0), b3, voffB); PG8_STAGE(PG8_SB(1, 1), b3 + hstep, voffB); PG8_STAGE(PG8_SA(1, 0), a3, voffA);
            PG8_WAIT_V(8); PG8_WAIT_L(0); PG8_BAR; PG8_MMA(1, 0, At, B0); PG8_MMA(1, 1, At, B1); PG8_BAR; PG8_SCHED;
            } else {
            PG8_LDB(B0, 0, 0); PG8_SCHED; PG8_LDA(At, 0, 0); PG8_STAGE(PG8_SA(1, 1), a1 + hstep, voffA);
            PG8_WAIT_L(8); PG8_BAR; PG8_WAIT_L(0); PG8_MMA(0, 0, At, B0); PG8_BAR; PG8_SCHED;
            PG8_LDB(B1, 0, 1); PG8_STAGE(PG8_SB(0, 0), b2, voffB);
            PG8_BAR; PG8_WAIT_L(0); PG8_MMA(0, 1, At, B1); PG8_BAR;
            PG8_LDA(At, 0, 1); PG8_STAGE(PG8_SA(0, 0), a2, voffA);
            PG8_BAR; PG8_WAIT_L(0); PG8_MMA(1, 0, At, B0); PG8_BAR; PG8_SCHED;
            PG8_STAGE(PG8_SB(0, 1), b2 + hstep, voffB);
            PG8_WAIT_V(6); PG8_BAR; PG8_MMA(1, 1, At, B1); PG8_BAR;
            PG8_LDB(B0, 1, 0); PG8_SCHED; PG8_LDA(At, 1, 0); PG8_STAGE(PG8_SA(0, 1), a2 + hstep, voffA);
            PG8_WAIT_L(8); PG8_BAR; PG8_WAIT_L(0); PG8_MMA(0, 0, At, B0); PG8_BAR; PG8_SCHED;
            PG8_LDB(B1, 1, 1); PG8_STAGE(PG8_SB(1, 0), b3, voffB);
            PG8_BAR; PG8_WAIT_L(0); PG8_MMA(0, 1, At, B1); PG8_BAR;
            PG8_LDA(At, 1, 1); PG8_STAGE(PG8_SA(1, 0), a3, voffA);
            PG8_BAR; PG8_WAIT_L(0); PG8_MMA(1, 0, At, B0); PG8_BAR; PG8_SCHED;
            PG8_STAGE(PG8_SB(1, 1), b3 + hstep, voffB);
            PG8_WAIT_V(6); PG8_BAR; PG8_MMA(1, 1, At, B1); PG8_BAR;
            }
        }
        if constexpr (ALIGN_EPI) { if (wr == 0) PG8_BAR; }
        if constexpr (!Epi::AFTER_DRAIN) { E(acc, cur, wr, wc, fr, fq); S.done(cur); }
        if (!has_next) break;
#pragma unroll
        for (int a = 0; a < 2; ++a)
#pragma unroll
            for (int b = 0; b < 2; ++b)
#pragma unroll
                for (int m = 0; m < 4; ++m)
#pragma unroll
                    for (int n = 0; n < 2; ++n) acc[a][b][m][n] = (f32x4){0.f, 0.f, 0.f, 0.f};
        cur = nxt; cA = nA; cB = nB; ++ui;
        if constexpr (ALIGN_EPI) { if (wr == 1) PG8_BAR; }
    }
    PG8_WAIT_V(0);
    if constexpr (!ALIGN_EPI) { if (wr == 0) PG8_BAR; }
    PG8_BAR;
    if constexpr (Epi::AFTER_DRAIN) { E.fused(acc, cur, wr, wc, fr, fq, lds, wid, lane); S.done(cur); }
#undef PG8_SA
#undef PG8_SB
#undef PG8_STAGE
#undef PG8_LDA
#undef PG8_LDB
#undef PG8_MMA
#undef PG8_WAIT_V
#undef PG8_WAIT_L
#undef PG8_BAR
#undef PG8_SCHED
}
}
constexpr int NB = 8, SEQ = 4096, DM = 1024, MTOK = NB * SEQ;
constexpr int NPROJ = 3584;
constexpr int PCOLS_IN = 3600;
constexpr int NEXP = 16, CAP = 512, FFD = 2048, NSLOT = NEXP * NB * CAP;
constexpr float RMS_EPS = 1e-6f;
#ifndef N_LAUNCHES
#define N_LAUNCHES 1
#endif
constexpr int N_PHASES = 13;

constexpr size_t MiB = 1u << 20;
constexpr size_t WS_CTL = 0, CTL_ZERO_BYTES = 64 * 1024;
constexpr size_t WS_MOD = 1 * MiB;
constexpr size_t WS_BIN2 = 1 * MiB + 512 * 1024;
constexpr size_t WS_HID2 = 2 * MiB;
constexpr size_t WS_GATES = 3 * MiB;
constexpr size_t WS_AFF = 5 * MiB;
constexpr size_t WS_IDX = 7 * MiB, WS_GSEL = 7 * MiB + 256 * 1024;
constexpr size_t WS_INV = 8 * MiB;
constexpr size_t WS_WOUT = 12 * MiB;
constexpr size_t WS_WIN = 14 * MiB;
constexpr size_t WS_P = 24 * MiB;
constexpr size_t WS_H = 248 * MiB;
constexpr size_t WS_UT = 312 * MiB;
constexpr size_t WS_HM = 408 * MiB;
constexpr size_t WS_ZT = 472 * MiB;
constexpr size_t WS_KSP = 504 * MiB;
constexpr size_t WS_WGU = 24 * MiB;
constexpr size_t WS_XS = 152 * MiB;
constexpr size_t WS_HID = 280 * MiB;
constexpr size_t WS_HF = 280 * MiB;
constexpr size_t WS_WD = 152 * MiB;
constexpr size_t WS_YS = 24 * MiB;
constexpr size_t WS_END = 536 * MiB;

constexpr int RING_BYTES = 131072;
constexpr int MISC_OFF = RING_BYTES;
constexpr int LDS_BYTES = 147456;

#define GAS __attribute__((address_space(1)))
#define LAS __attribute__((address_space(3)))
#define DI __device__ __forceinline__
typedef unsigned short bf16;
typedef unsigned v4u __attribute__((ext_vector_type(4)));
typedef unsigned v2u __attribute__((ext_vector_type(2)));
typedef float f32x4 __attribute__((ext_vector_type(4)));
typedef GAS unsigned gu32;
#define LDS_WAIT() asm volatile("s_waitcnt lgkmcnt(0)" ::: "memory")
DI float bf2f(unsigned b) { return __uint_as_float(b << 16); }
DI float bflo(unsigned w) { return __uint_as_float(w << 16); }
DI float bfhi(unsigned w) { return __uint_as_float(w & 0xffff0000u); }
DI unsigned f2bf(float f) { unsigned u = __float_as_uint(f); return (u + 0x7fffu + ((u >> 16) & 1u)) >> 16; }
DI unsigned pk2(float lo, float hi) { return f2bf(lo) | (f2bf(hi) << 16); }
DI float wave_sum(float v) {
#pragma unroll
    for (int o = 1; o < 64; o <<= 1) v += __shfl_xor(v, o);
    return v;
}
DI float sigmoidf_(float x) { return 1.f / (1.f + __expf(-x)); }

namespace pg8 {
struct MoeOrderA {
    int G, c;
    __device__ bool next(int i, Unit& u) const {
        const long L = (long)i * G + c; if (L >= 4096) return false;
        const int e = (int)(L >> 8), r = (int)(L & 255), x = r & 7, j = r >> 3;
        u.pm = e * 16 + 4 * (x >> 1) + (j >> 3); u.pn = e * 16 + 8 * (x & 1) + (j & 7); return true;
    }
    __device__ __forceinline__ void a_ready(const Unit&) const {}
    __device__ __forceinline__ void done(const Unit&) const {}
};
struct MoeOrderB {
    int G, c;
    __device__ bool next(int i, Unit& u) const {
        const long L = (long)i * G + c; if (L >= 1024) return false;
        const int r = (int)(L & 255), e = (int)(L >> 8) * 4 + ((r & 7) >> 1), idx = ((r & 1) << 5) | (r >> 3);
        u.pm = e * 16 + (idx >> 2); u.pn = e * 4 + (idx & 3); return true;
    }
    __device__ __forceinline__ void a_ready(const Unit&) const {}
    __device__ __forceinline__ void done(const Unit&) const {}
};
struct EpiSwiGLU {
    static constexpr bool PERM = true, AFTER_DRAIN = false;
    bf16_t* O;
    __device__ __forceinline__ void operator()(const f32x4 (&acc)[2][2][4][2], const Unit& u, int wr, int wc, int fr, int fq) const {
        const int row0 = u.pm * BM + wr * 64 + fr, col0 = (u.pn & 15) * 128 + wc * 32 + 8 * fq;
#pragma unroll
        for (int ai = 0; ai < 2; ++ai)
#pragma unroll
            for (int m = 0; m < 4; ++m) {
                bf16_t* rowp = O + (size_t)(row0 + ai * HALF + m * 16) * 2048 + col0;
                float h[8];
#pragma unroll
                for (int n = 0; n < 2; ++n)
#pragma unroll
                    for (int i = 0; i < 4; ++i) { const float g = acc[ai][0][m][n][i], up = acc[ai][1][m][n][i]; h[4 * n + i] = g * __builtin_amdgcn_rcpf(1.f + __expf(-g)) * up; }
                u32x4 w; w.x = cvt_pk_bf16(h[0], h[1]); w.y = cvt_pk_bf16(h[2], h[3]); w.z = cvt_pk_bf16(h[4], h[5]); w.w = cvt_pk_bf16(h[6], h[7]);
                *(u32x4*)rowp = w;
            }
    }
};
struct EpiYs {
    static constexpr bool PERM = true, AFTER_DRAIN = false;
    bf16_t* O;
    __device__ __forceinline__ void operator()(const f32x4 (&acc)[2][2][4][2], const Unit& u, int wr, int wc, int fr, int fq) const {
        const int row0 = u.pm * BM + wr * 64 + fr, col0 = (u.pn & 3) * BM + wc * 32 + 8 * fq;
#pragma unroll
        for (int ai = 0; ai < 2; ++ai)
#pragma unroll
            for (int m = 0; m < 4; ++m) {
                bf16_t* rowp = O + (size_t)(row0 + ai * HALF + m * 16) * 1024 + col0;
#pragma unroll
                for (int bj = 0; bj < 2; ++bj) { const f32x4 v0 = acc[ai][bj][m][0], v1 = acc[ai][bj][m][1];
                    u32x4 w; w.x = cvt_pk_bf16(v0[0], v0[1]); w.y = cvt_pk_bf16(v0[2], v0[3]); w.z = cvt_pk_bf16(v1[0], v1[1]); w.w = cvt_pk_bf16(v1[2], v1[3]);
                    *(u32x4*)(rowp + bj * HALF) = w; }
            }
    }
};
struct EpiRes {
    static constexpr bool PERM = false, AFTER_DRAIN = false;
    const float* X; float* C; const float* mod;
    __device__ __forceinline__ void operator()(const f32x4 (&acc)[2][2][4][2], const Unit& u, int wr, int wc, int fr, int fq) const {
        const int row0 = u.pm * BM + wr * 64 + fr, col0 = u.pn * BM + wc * 32 + 4 * fq;
        const float* gp = mod + (size_t)((u.pm * BM) >> 12) * 6144 + 2048 + col0;
        f32x4 gv[2][2];
#pragma unroll
        for (int bj = 0; bj < 2; ++bj)
#pragma unroll
            for (int n = 0; n < 2; ++n) gv[bj][n] = *(const f32x4*)(gp + bj * HALF + n * 16);
#pragma unroll
        for (int ai = 0; ai < 2; ++ai)
#pragma unroll
            for (int m = 0; m < 4; ++m) { const size_t off = (size_t)(row0 + ai * HALF + m * 16) * 1024 + col0;
#pragma unroll
                for (int bj = 0; bj < 2; ++bj)
#pragma unroll
                    for (int n = 0; n < 2; ++n) { const f32x4 xv = *(const f32x4*)(X + off + bj * HALF + n * 16); *(f32x4*)(C + off + bj * HALF + n * 16) = xv + gv[bj][n] * acc[ai][bj][m][n]; } }
    }
};
}
#define XB_TMO      128
#define XB_XCNT(j)  (256  + 64 * (j))
#define XB_XSUB(j)  (1280 + 64 * (j))
#define XB_XGEN(j)  (2304 + 64 * (j))
#define XB_TOP      3328
#define XB_TOPGEN   3392
#define XCD_BAR_WORDS 3456
#define XB_SPIN_CAP (1u << 18)

__device__ __forceinline__ unsigned xb_ld(unsigned* p)              { return __hip_atomic_load(p, __ATOMIC_RELAXED, __HIP_MEMORY_SCOPE_AGENT); }
__device__ __forceinline__ unsigned xb_add(unsigned* p, unsigned v) { return __hip_atomic_fetch_add(p, v, __ATOMIC_RELAXED, __HIP_MEMORY_SCOPE_AGENT); }
__device__ __forceinline__ unsigned xb_xcc_id() { return (unsigned)__builtin_amdgcn_s_getreg((3 << 11) | 20) & 0xFu; }
#define XB_SPIN(cond, bar) do { unsigned _sp = 0; while (cond) { __builtin_amdgcn_s_sleep(1); \
    if ((++_sp & 255u) == 0u) { if (xb_ld(&(bar)[XB_TMO])) break; if (_sp > XB_SPIN_CAP) { atomicAdd(&(bar)[XB_TMO], 1u); break; } } } } while (0)

struct XcdBarrier {
    unsigned* bar; unsigned x;
    volatile LAS unsigned* st;
};

__device__ __forceinline__ XcdBarrier xcd_barrier_post(unsigned* bar, volatile LAS unsigned* st) {
    XcdBarrier b; b.bar = bar; b.x = xb_xcc_id(); b.st = st;
    if (threadIdx.x == 0) (void)xb_add(&bar[XB_XCNT(b.x)], 1u);
    return b;
}
__device__ __forceinline__ void xcd_barrier_complete(unsigned* bar, unsigned x, unsigned& nloc, unsigned& nx) {
    const unsigned G = gridDim.x * gridDim.y * gridDim.z;
    unsigned sum, cnt, mine, sp = 0u;
    for (;;) {
        sum = 0u; cnt = 0u; mine = 0u;
#pragma unroll
        for (unsigned j = 0; j < 16; ++j) { const unsigned c = xb_ld(&bar[XB_XCNT(j)]); sum += c; cnt += (c > 0u) ? 1u : 0u; mine = (j == x) ? c : mine; }
        if (sum == G) break;
        __builtin_amdgcn_s_sleep(1);
        if ((++sp & 255u) == 0u) { if (xb_ld(&bar[XB_TMO])) break; if (sp > XB_SPIN_CAP) { atomicAdd(&bar[XB_TMO], 1u); break; } }
    }
    nloc = mine > 0u ? mine : 1u; nx = cnt > 0u ? cnt : 1u;
}

__device__ __forceinline__ void xcd_barrier(const XcdBarrier& b) {
    asm volatile("s_waitcnt vmcnt(0)" ::: "memory");
    __syncthreads();
    if (threadIdx.x == 0) {
        unsigned* bar = b.bar;
        __builtin_amdgcn_s_waitcnt(0);
        unsigned nloc = b.st[0], nx = b.st[1];
        if (nloc == 0u) { xcd_barrier_complete(bar, b.x, nloc, nx); b.st[0] = nloc; b.st[1] = nx; }
        const unsigned old = xb_add(&bar[XB_XSUB(b.x)], 1u);
        const unsigned gen = old / nloc;
        if (old + 1u == (gen + 1u) * nloc) {
            __builtin_amdgcn_fence(__ATOMIC_RELEASE, "agent");
            asm volatile("s_waitcnt vmcnt(0)" ::: "memory");
            const unsigned og = xb_add(&bar[XB_TOP], 1u);
            const unsigned tg = og / nx;
            if (og + 1u == (tg + 1u) * nx) xb_add(&bar[XB_TOPGEN], 1u);
            else XB_SPIN(xb_ld(&bar[XB_TOPGEN]) == tg, bar);
            __builtin_amdgcn_fence(__ATOMIC_ACQUIRE, "agent");
            xb_add(&bar[XB_XGEN(b.x)], 1u);
            asm volatile("s_waitcnt vmcnt(0)" ::: "memory");
        } else {
            XB_SPIN(xb_ld(&bar[XB_XGEN(b.x)]) == gen, bar);
            __builtin_amdgcn_fence(__ATOMIC_ACQUIRE, "agent");
            asm volatile("s_waitcnt vmcnt(0)" ::: "memory");
        }
    }
    __syncthreads();
}
#define HD __host__ __device__ __forceinline__
typedef float cf2 __attribute__((ext_vector_type(2)));
#define MK2(a, b) ((cf2){(a), (b)})
HD cf2 c_add(cf2 a, cf2 b) { return MK2(a.x + b.x, a.y + b.y); }
HD cf2 c_sub(cf2 a, cf2 b) { return MK2(a.x - b.x, a.y - b.y); }
HD cf2 c_mul(cf2 a, cf2 b) { return MK2(a.x * b.x - a.y * b.y, a.x * b.y + a.y * b.x); }
HD cf2 c_mulc(cf2 a, cf2 b) { return MK2(a.x * b.x + a.y * b.y, a.y * b.x - a.x * b.y); }
HD int fphys(int i) { return i + (i >> 4); }
constexpr int FFT_XSLOTS = 8192 + 512;

#define W16_C1 0.92387953251128674f
#define W16_S1 0.38268343236508977f
#define W16_H  0.70710678118654752f
template <int J> HD cf2 mul_w16(cf2 d) {
    if constexpr (J == 0) return d;
    else if constexpr (J == 1) return c_mul(d, MK2(W16_C1, -W16_S1));
    else if constexpr (J == 2) return MK2((d.x + d.y) * W16_H, (d.y - d.x) * W16_H);
    else if constexpr (J == 3) return c_mul(d, MK2(W16_S1, -W16_C1));
    else if constexpr (J == 4) return MK2(d.y, -d.x);
    else if constexpr (J == 5) return c_mul(d, MK2(-W16_S1, -W16_C1));
    else if constexpr (J == 6) return MK2((d.y - d.x) * W16_H, -(d.x + d.y) * W16_H);
    else return c_mul(d, MK2(-W16_C1, -W16_S1));
}
HD void dft16(cf2 (&v)[16]) {
#define BF(i, j, TWJ) { const cf2 a_ = v[i], b_ = v[j]; v[i] = c_add(a_, b_); v[j] = mul_w16<TWJ>(c_sub(a_, b_)); }
    BF(0, 8, 0) BF(1, 9, 1) BF(2, 10, 2) BF(3, 11, 3) BF(4, 12, 4) BF(5, 13, 5) BF(6, 14, 6) BF(7, 15, 7)
    BF(0, 4, 0) BF(1, 5, 2) BF(2, 6, 4) BF(3, 7, 6)   BF(8, 12, 0) BF(9, 13, 2) BF(10, 14, 4) BF(11, 15, 6)
    BF(0, 2, 0) BF(1, 3, 4)  BF(4, 6, 0) BF(5, 7, 4)  BF(8, 10, 0) BF(9, 11, 4)  BF(12, 14, 0) BF(13, 15, 4)
    BF(0, 1, 0) BF(2, 3, 0) BF(4, 5, 0) BF(6, 7, 0) BF(8, 9, 0) BF(10, 11, 0) BF(12, 13, 0) BF(14, 15, 0)
#undef BF
#define SW(i, j) { const cf2 t_ = v[i]; v[i] = v[j]; v[j] = t_; }
    SW(1, 8) SW(2, 4) SW(3, 12) SW(5, 10) SW(7, 14) SW(11, 13)
#undef SW
}
HD void idft16(cf2 (&v)[16]) {
#pragma unroll
    for (int i = 0; i < 16; ++i) v[i] = MK2(v[i].y, v[i].x);
    dft16(v);
#pragma unroll
    for (int i = 0; i < 16; ++i) v[i] = MK2(v[i].y, v[i].x);
}
HD void c_powers(cf2 t, cf2 (&pw)[16]) {
    pw[0] = MK2(1.f, 0.f); pw[1] = t;
#pragma unroll
    for (int r = 2; r < 16; ++r) pw[r] = (r & 1) ? c_mul(pw[r - 1], t) : c_mul(pw[r >> 1], pw[r >> 1]);
}
HD cf2 w32_const(int k) {
    constexpr float C[16] = {1.f, 0.98078528040323043f, 0.92387953251128674f, 0.83146961230254524f, 0.70710678118654752f, 0.55557023301960218f, 0.38268343236508977f, 0.19509032201612825f,
                             0.f, -0.19509032201612825f, -0.38268343236508977f, -0.55557023301960218f, -0.70710678118654752f, -0.83146961230254524f, -0.92387953251128674f, -0.98078528040323043f};
    constexpr float S[16] = {0.f, 0.19509032201612825f, 0.38268343236508977f, 0.55557023301960218f, 0.70710678118654752f, 0.83146961230254524f, 0.92387953251128674f, 0.98078528040323043f,
                             1.f, 0.98078528040323043f, 0.92387953251128674f, 0.83146961230254524f, 0.70710678118654752f, 0.55557023301960218f, 0.38268343236508977f, 0.19509032201612825f};
    return MK2(C[k], -S[k]);
}
template <class XP, class TP> HD void fft_passA_fwd(int tid, const cf2 (&a)[16], const cf2 (&b)[16], XP X, TP TW4, TP TW8) {
    const int H = tid >> 8, lo = tid & 255;
    cf2 v[16];
    if (H == 0) {
#pragma unroll
        for (int k = 0; k < 16; ++k) v[k] = c_add(a[k], b[k]);
    } else {
        const cf2 t8 = TW8[lo];
#pragma unroll
        for (int k = 0; k < 16; ++k) v[k] = c_mul(c_sub(a[k], b[k]), c_mul(t8, w32_const(k)));
    }
    dft16(v);
    cf2 pw[16]; c_powers(TW4[lo], pw);
#pragma unroll
    for (int r = 0; r < 16; ++r) X[fphys(H * 4096 + r * 256 + lo)] = c_mul(v[r], pw[r]);
}
template <class XP, class TP> HD void fft_passB_fwd(int tid, XP X, TP TW4) {
    const int H = tid >> 8, hi = (tid >> 4) & 15, lo = tid & 15, base = H * 4096 + hi * 256 + lo;
    cf2 v[16];
#pragma unroll
    for (int k = 0; k < 16; ++k) v[k] = X[fphys(base + k * 16)];
    dft16(v);
    cf2 pw[16]; c_powers(TW4[16 * lo], pw);
#pragma unroll
    for (int r = 0; r < 16; ++r) X[fphys(base + r * 16)] = c_mul(v[r], pw[r]);
}
template <class XP> HD void fft_passC_fwd(int tid, XP X, cf2 (&v)[16]) {
    const int p0 = 17 * tid;
#pragma unroll
    for (int k = 0; k < 16; ++k) v[k] = X[p0 + k];
    dft16(v);
}
template <class XP> HD void fft_passC_inv(int tid, XP X, cf2 (&v)[16]) {
    const int p0 = 17 * tid;
    idft16(v);
#pragma unroll
    for (int k = 0; k < 16; ++k) X[p0 + k] = v[k];
}
template <class XP, class TP> HD void fft_passB_inv(int tid, XP X, TP TW4) {
    const int H = tid >> 8, hi = (tid >> 4) & 15, lo = tid & 15, base = H * 4096 + hi * 256 + lo;
    cf2 v[16], pw[16]; c_powers(TW4[16 * lo], pw);
#pragma unroll
    for (int r = 0; r < 16; ++r) v[r] = c_mulc(X[fphys(base + r * 16)], pw[r]);
    idft16(v);
#pragma unroll
    for (int k = 0; k < 16; ++k) X[fphys(base + k * 16)] = v[k];
}
template <class XP, class TP> HD void fft_passA_inv(int tid, XP X, TP TW4, TP TW8, cf2 (&u)[16]) {
    const int H = tid >> 8, lo = tid & 255;
    cf2 pw[16]; c_powers(TW4[lo], pw);
#pragma unroll
    for (int r = 0; r < 16; ++r) u[r] = c_mulc(X[fphys(H * 4096 + r * 256 + lo)], pw[r]);
    idft16(u);
    if (H == 1) {
        const cf2 t8 = TW8[lo];
#pragma unroll
        for (int k = 0; k < 16; ++k) u[k] = c_mulc(u[k], c_mul(t8, w32_const(k)));
    }
}
struct Args { const float* in[28]; float* out; unsigned char* ws; int ph_lo, ph_hi; };
struct Frame {
    LAS unsigned char* lds;
    int tid, lane, wave, G, blk;
    const struct Args* a;
};
#define IN_X 0
#define IN_C 1
#define IN_WADA 2
#define IN_BADA 3
#define IN_GMIX 4
#define IN_WIN 5
#define IN_BIN 6
#define IN_CQKW 7
#define IN_CQKB 8
#define IN_MNG 9
#define IN_CHYW 10
#define IN_CHYB 11
#define IN_HW1 12
#define IN_HB1 13
#define IN_HW2 14
#define IN_HB2 15
#define IN_HW3 16
#define IN_HFREQ 17
#define IN_HDELTA 18
#define IN_HBIAS 19
#define IN_HNG 20
#define IN_WOUT 21
#define IN_GFFN 22
#define IN_WROUTER 23
#define IN_WGATE 24
#define IN_WUP 25
#define IN_WDOWN 26
#define IN_GFINAL 27

DI void transpose_item(const float* src, int ldsrc, bf16* dst, int lddst, LAS float* scr, int lane) {
#pragma unroll 8
    for (int i = 0; i < 32; ++i) { const int kk = 2 * i + (lane >> 5); scr[kk * 33 + (lane & 31)] = src[(size_t)kk * ldsrc + (lane & 31)]; }
    LDS_WAIT(); asm volatile("" ::: "memory");
    const int c = lane & 7;
#pragma unroll
    for (int j = 0; j < 4; ++j) { const int n = (lane >> 3) + 8 * j; const LAS float* s = scr + (8 * c) * 33 + n;
        v4u o; o.x = pk2(s[0 * 33], s[1 * 33]); o.y = pk2(s[2 * 33], s[3 * 33]); o.z = pk2(s[4 * 33], s[5 * 33]); o.w = pk2(s[6 * 33], s[7 * 33]);
        *(v4u*)(dst + (size_t)n * lddst + 8 * c) = o; }
    LDS_WAIT(); asm volatile("" ::: "memory");
}
DI float reduce16(const float (&acc)[16], int lane) {
    float r8[8], r4[4], r2[2], r1;
    { const bool up = (lane & 32) != 0;
#pragma unroll
      for (int i = 0; i < 8; ++i) { const float mine = up ? acc[8 + i] : acc[i], other = up ? acc[i] : acc[8 + i]; r8[i] = mine + __shfl_xor(other, 32); } }
    { const bool up = (lane & 16) != 0;
#pragma unroll
      for (int i = 0; i < 4; ++i) { const float mine = up ? r8[4 + i] : r8[i], other = up ? r8[i] : r8[4 + i]; r4[i] = mine + __shfl_xor(other, 16); } }
    { const bool up = (lane & 8) != 0;
#pragma unroll
      for (int i = 0; i < 2; ++i) { const float mine = up ? r4[2 + i] : r4[i], other = up ? r4[i] : r4[2 + i]; r2[i] = mine + __shfl_xor(other, 8); } }
    { const bool up = (lane & 4) != 0; const float mine = up ? r2[1] : r2[0], other = up ? r2[0] : r2[1]; r1 = mine + __shfl_xor(other, 4); }
    r1 += __shfl_xor(r1, 1); r1 += __shfl_xor(r1, 2);
    return r1;
}
DI int reduce16_index(int lane) { return ((lane >> 5) & 1) * 8 + ((lane >> 4) & 1) * 4 + ((lane >> 3) & 1) * 2 + ((lane >> 2) & 1); }

DI void p0_prologue(Frame& F) {
    unsigned char* ws = F.a->ws;
    LAS float* scr = (LAS float*)(F.lds + F.wave * 16384);
    const int gw = F.blk * 8 + F.wave, NGW = F.G * 8, lane = F.lane;
    bf16* WIN = (bf16*)(ws + WS_WIN); bf16* WOUT = (bf16*)(ws + WS_WOUT);
    for (int it = gw; it < 1792 + 512; it += NGW) {
        if (it < 1792) { const int kb = it / 112, nb = it % 112, n0 = 32 * nb, k0 = 64 * kb, sc = n0 + (n0 >= 2048 ? 16 : 0);
            transpose_item(F.a->in[IN_WIN] + (size_t)k0 * PCOLS_IN + sc, PCOLS_IN, WIN + (size_t)n0 * 1024 + k0, 1024, scr, lane); }
        else { const int r = it - 1792, kb = r / 32, nb = r % 32, n0 = 32 * nb, k0 = 64 * kb;
            transpose_item(F.a->in[IN_WOUT] + (size_t)k0 * 1024 + n0, 1024, WOUT + (size_t)n0 * 1024 + k0, 1024, scr, lane); }
    }
    {
        float* HID2 = (float*)(ws + WS_HID2);
        const float* w1 = F.a->in[IN_HW1]; const float* w2 = F.a->in[IN_HW2];
        const float fr = F.a->in[IN_HFREQ][lane], b1 = F.a->in[IN_HB1][lane], b2 = F.a->in[IN_HB2][lane];
        for (int t = gw; t < SEQ; t += NGW) {
            float a1 = b1 + ((float)t * (1.f / 4095.f)) * w1[lane];
#pragma unroll 4
            for (int i = 0; i < 16; ++i) {
                const float band = 1e-4f + (float)i * ((15.f - 1e-4f) / 15.f);
                const float rev = band * (float)t * (1.f / 4096.f);
                const float fx = rev - floorf(rev);
                float sn, cs; sincospif(2.f * fx, &sn, &cs);
                a1 += cs * w1[(1 + i) * 64 + lane] - sn * w1[(17 + i) * 64 + lane];
            }
            const float h1 = sinf(fr * a1);
            float a2 = b2;
#pragma unroll 8
            for (int i = 0; i < 64; ++i) a2 += __shfl(h1, i) * w2[i * 64 + lane];
            HID2[t * 64 + lane] = sinf(fr * a2);
        }
    }
    { float* BIN2 = (float*)(ws + WS_BIN2); for (int n = F.blk * 512 + F.tid; n < NPROJ; n += F.G * 512) BIN2[n] = F.a->in[IN_BIN][n + (n >= 2048 ? 16 : 0)]; }
    __syncthreads();
    {
        LAS float* red = (LAS float*)F.lds; float* MOD = (float*)(ws + WS_MOD);
        const float* wada = F.a->in[IN_WADA]; const float* cvec = F.a->in[IN_C];
        for (int it = F.blk; it < 96; it += F.G) {
            const int col = 64 * it + lane; float acc[8];
#pragma unroll
            for (int b = 0; b < 8; ++b) acc[b] = 0.f;
            for (int k = F.wave * 128; k < F.wave * 128 + 128; ++k) { const float wv = wada[(size_t)k * 6144 + col];
#pragma unroll
                for (int b = 0; b < 8; ++b) acc[b] += cvec[b * 1024 + k] * wv; }
#pragma unroll
            for (int b = 0; b < 8; ++b) red[(F.wave * 8 + b) * 64 + lane] = acc[b];
            __syncthreads();
            { const int b = F.tid >> 6; float s = F.a->in[IN_BADA][col];
#pragma unroll
              for (int w = 0; w < 8; ++w) s += red[(w * 8 + b) * 64 + lane];
              MOD[b * 6144 + col] = s; }
            __syncthreads();
        }
    }
}

template <bool SECOND> DI void p_norm(Frame& F) {
    unsigned char* ws = F.a->ws; const int lane = F.lane;
    LAS float* Wt = (LAS float*)F.lds;
    for (int i = F.tid; i < 16384; i += 512) { const int k = i >> 4, g = i & 15; Wt[g * 1024 + k] = SECOND ? F.a->in[IN_WROUTER][k * 16 + g] : F.a->in[IN_WIN][(size_t)k * PCOLS_IN + 2048 + g]; }
    __syncthreads();
    const float* xin = SECOND ? (const float*)F.a->out : F.a->in[IN_X];
    const float* gvec = SECOND ? F.a->in[IN_GFFN] : F.a->in[IN_GMIX];
    const float* MOD = (const float*)(ws + WS_MOD);
    bf16* HO = (bf16*)(ws + (SECOND ? WS_HF : WS_H));
    const int gw = F.blk * 8 + F.wave, NGW = F.G * 8;
    for (int row = gw; row < MTOK; row += NGW) {
        const int b = row >> 12;
        const f32x4* xr = (const f32x4*)(xin + (size_t)row * 1024) + lane;
        f32x4 v[4]; float ss = 0.f;
#pragma unroll
        for (int j = 0; j < 4; ++j) { v[j] = xr[64 * j]; ss += (v[j].x * v[j].x + v[j].y * v[j].y) + (v[j].z * v[j].z + v[j].w * v[j].w); }
        const float rstd = rsqrtf(wave_sum(ss) * (1.f / 1024.f) + RMS_EPS);
        const float* mb = MOD + b * 6144 + (SECOND ? 3072 : 0);
#pragma unroll
        for (int j = 0; j < 4; ++j) { const int col = 256 * j + 4 * lane;
            const f32x4 g = *(const f32x4*)(gvec + col), sh = *(const f32x4*)(mb + col), sc = *(const f32x4*)(mb + 1024 + col);
            v[j] = v[j] * rstd * g * (sc + 1.f) + sh; }
        unsigned long long* o8 = (unsigned long long*)(HO + (size_t)row * 1024) + lane;
#pragma unroll
        for (int j = 0; j < 4; ++j) o8[64 * j] = (unsigned long long)pk2(v[j].x, v[j].y) | ((unsigned long long)pk2(v[j].z, v[j].w) << 32);
        float acc[16];
#pragma unroll
        for (int g = 0; g < 16; ++g) { float a = 0.f;
            if ((g & 3) == 0) asm volatile("" ::: "memory");
#pragma unroll
            for (int j = 0; j < 4; ++j) { const f32x4 w = *(const LAS f32x4*)(Wt + g * 1024 + 256 * j + 4 * lane); a += (v[j].x * w.x + v[j].y * w.y) + (v[j].z * w.z + v[j].w * w.w); }
            acc[g] = a; }
        const float val = reduce16(acc, lane); const int gi = reduce16_index(lane);
        if (!SECOND) { if ((lane & 3) == 0) ((float*)(ws + WS_GATES))[(size_t)row * 16 + gi] = val + F.a->in[IN_BIN][2048 + gi]; }
        else {
            float mx = val;
#pragma unroll
            for (int o = 4; o < 64; o <<= 1) mx = fmaxf(mx, __shfl_xor(mx, o));
            const float ex = __expf(val - mx); float sm = ex;
#pragma unroll
            for (int o = 4; o < 64; o <<= 1) sm += __shfl_xor(sm, o);
            if ((lane & 3) == 0) ((float*)(ws + WS_AFF))[((size_t)b * 16 + gi) * SEQ + (row & 4095)] = ex / sm;
        }
    }
}

DI void p3_prep(Frame& F) {
    unsigned char* ws = F.a->ws;
    const bf16* P = (const bf16*)(ws + WS_P);
    {
        bf16* QK = (bf16*)(ws + WS_H);
        const float* cw = F.a->in[IN_CQKW]; const float* cb = F.a->in[IN_CQKB];
        const int nthr = F.G * 512;
        for (int i = F.blk * 512 + F.tid; i < MTOK * 128; i += nthr) {
            const int token = i >> 7, cg = i & 127, t = token & 4095, c0 = 8 * cg;
            const bf16* p0 = P + (size_t)token * NPROJ + c0;
            const v4u cur = *(const v4u*)p0;
            v4u prv = (v4u){0u, 0u, 0u, 0u}, nxt = (v4u){0u, 0u, 0u, 0u};
            if (t > 0) prv = *(const v4u*)(p0 - NPROJ);
            if (t < SEQ - 1) nxt = *(const v4u*)(p0 + NPROJ);
            const float scale = (c0 >= 512) ? 0.08838834764831845f : 1.f;
            float o[8];
#pragma unroll
            for (int e = 0; e < 8; ++e) {
                const unsigned wp = prv[e >> 1], wc = cur[e >> 1], wn = nxt[e >> 1];
                const float xp = (e & 1) ? bfhi(wp) : bflo(wp), xc = (e & 1) ? bfhi(wc) : bflo(wc), xn = (e & 1) ? bfhi(wn) : bflo(wn);
                const int c = c0 + e;
                const float val = cb[c] + cw[c] * xp + cw[1024 + c] * xc + cw[2048 + c] * xn;
                o[e] = val * sigmoidf_(val) * scale;
            }
            v4u w; w.x = pk2(o[0], o[1]); w.y = pk2(o[2], o[3]); w.z = pk2(o[4], o[5]); w.w = pk2(o[6], o[7]);
            *(v4u*)(QK + (size_t)token * 1024 + c0) = w;
        }
    }
    {
        bf16* UT = (bf16*)(ws + WS_UT);
        LAS bf16* tile = (LAS bf16*)F.lds;
        const float* cw = F.a->in[IN_CHYW]; const float* cb = F.a->in[IN_CHYB];
        for (int u = F.blk; u < 4 * 64 * 24; u += F.G) {
            const int cgq = u % 24, tt = (u / 24) & 63, p = u / (24 * 64);
            for (int it = F.tid; it < 1024; it += 512) {
                const int cg8 = it & 7, tl = (it >> 3) & 63, bs = it >> 9;
                const int t = tt * 64 + tl, token = (2 * p + bs) * SEQ + t, hxc = cgq * 64 + cg8 * 8;
                const bf16* p0 = P + (size_t)token * NPROJ + 2048 + hxc;
                const v4u cur = *(const v4u*)p0;
                v4u prv = (v4u){0u, 0u, 0u, 0u}, nxt = (v4u){0u, 0u, 0u, 0u};
                if (t > 0) prv = *(const v4u*)(p0 - NPROJ);
                if (t < SEQ - 1) nxt = *(const v4u*)(p0 + NPROJ);
#pragma unroll
                for (int e = 0; e < 8; ++e) {
                    const unsigned wp = prv[e >> 1], wc = cur[e >> 1], wn = nxt[e >> 1];
                    const float xp = (e & 1) ? bfhi(wp) : bflo(wp), xc = (e & 1) ? bfhi(wc) : bflo(wc), xn = (e & 1) ? bfhi(wn) : bflo(wn);
                    const int c = hxc + e;
                    const float val = cb[c] + cw[c] * xp + cw[1536 + c] * xc + cw[3072 + c] * xn;
                    tile[((cg8 * 8 + e) * 64 + tl) * 2 + bs] = (bf16)f2bf(val);
                }
            }
            __syncthreads();
            for (int pc = F.tid; pc < 1024; pc += 512) {
                const int cl = pc >> 4, q = pc & 15, hxc = cgq * 64 + cl, part = hxc >> 9, c = hxc & 511;
                const v4u v = *(const LAS v4u*)(tile + cl * 128 + q * 8);
                *(v4u*)(UT + ((((size_t)part * 4 + p) * 512 + c) * SEQ + tt * 64) * 2 + q * 8) = v;
            }
            __syncthreads();
        }
    }
}

DI void p4_mlstm_seq(Frame& F) {
    unsigned char* ws = F.a->ws;
    constexpr int TB = 32;
    LAS float* qs = (LAS float*)F.lds; LAS float* ks = qs + TB * 128; LAS float* vs = ks + TB * 128; LAS float* ob = vs + TB * 128;
    LAS float* gi = ob + TB * 128; LAS float* gl = gi + TB;
    const bf16* QK = (const bf16*)(ws + WS_H); const bf16* P = (const bf16*)(ws + WS_P); const float* GATES = (const float*)(ws + WS_GATES);
    bf16* HM = (bf16*)(ws + WS_HM);
    const int tid = F.tid, v = tid >> 2, kq = tid & 3;
    for (int it = F.blk; it < 64; it += F.G) {
        const int b = it >> 3, h = (it >> 1) & 3, dir = it & 1;
        float C[32], n[32]; float m = -1e30f;
#pragma unroll
        for (int j = 0; j < 32; ++j) { C[j] = 0.f; n[j] = 0.f; }
        for (int tau0 = 0; tau0 < SEQ; tau0 += TB) {
#pragma unroll
            for (int r = 0; r < 3; ++r) {
                const int st = tid >> 4, ch = tid & 15, tau = tau0 + st, token = b * SEQ + (dir ? SEQ - 1 - tau : tau);
                const bf16* src = (r == 0) ? QK + (size_t)token * 1024 + h * 128 : (r == 1) ? QK + (size_t)token * 1024 + 512 + h * 128 : P + (size_t)token * NPROJ + 1024 + h * 128;
                const v4u w = *(const v4u*)(src + ch * 8);
                LAS float* d = ((r == 0) ? qs : (r == 1) ? ks : vs) + st * 128 + ch * 8;
                *(LAS f32x4*)d = (f32x4){bflo(w.x), bfhi(w.x), bflo(w.y), bfhi(w.y)};
                *(LAS f32x4*)(d + 4) = (f32x4){bflo(w.z), bfhi(w.z), bflo(w.w), bfhi(w.w)};
            }
            if (tid < TB) { const int tau = tau0 + tid, token = b * SEQ + (dir ? SEQ - 1 - tau : tau);
                const float ip = GATES[(size_t)token * 16 + 8 * dir + h], fp = GATES[(size_t)token * 16 + 8 * dir + 4 + h];
                gi[tid] = ip; gl[tid] = fminf(fp, 0.f) - log1pf(__expf(-fabsf(fp))); }
            __syncthreads();
            for (int s = 0; s < TB; ++s) {
                const float is = gi[s], lf = gl[s];
                const float mn = fmaxf(lf + m, is), fpr = __expf(lf + m - mn), ipr = __expf(is - mn); m = mn;
                const float iv = ipr * vs[s * 128 + v];
                float hv = 0.f, dn = 0.f;
#pragma unroll
                for (int j4 = 0; j4 < 8; ++j4) {
                    const f32x4 kk = *(const LAS f32x4*)(ks + s * 128 + 32 * kq + 4 * j4), qq = *(const LAS f32x4*)(qs + s * 128 + 32 * kq + 4 * j4);
#pragma unroll
                    for (int e = 0; e < 4; ++e) { const int j = 4 * j4 + e;
                        C[j] = fmaf(iv, kk[e], fpr * C[j]); n[j] = fmaf(ipr, kk[e], fpr * n[j]);
                        hv = fmaf(C[j], qq[e], hv); dn = fmaf(n[j], qq[e], dn); }
                }
                hv += __shfl_xor(hv, 1); hv += __shfl_xor(hv, 2); dn += __shfl_xor(dn, 1); dn += __shfl_xor(dn, 2);
                if (kq == 0) ob[s * 128 + v] = hv / fmaxf(fabsf(dn), __expf(-m));
            }
            __syncthreads();
            { const int st = tid >> 4, ch = tid & 15, tau = tau0 + st, token = b * SEQ + (dir ? SEQ - 1 - tau : tau);
              const f32x4 a = *(const LAS f32x4*)(ob + st * 128 + ch * 8), c2 = *(const LAS f32x4*)(ob + st * 128 + ch * 8 + 4);
              v4u w; w.x = pk2(a.x, a.y); w.y = pk2(a.z, a.w); w.z = pk2(c2.x, c2.y); w.w = pk2(c2.z, c2.w);
              *(v4u*)(HM + ((size_t)dir * MTOK + token) * 512 + h * 128 + ch * 8) = w; }
            __syncthreads();
        }
    }
}

#define LAUNDER(x) asm volatile("" : "+v"(x))
DI float filt_tap(const float* HID2, const LAS float* w3s, int t, float adelta) {
    const f32x4* hr = (const f32x4*)(HID2 + (size_t)t * 64); float s = 0.f;
#pragma unroll
    for (int i = 0; i < 16; ++i) { const f32x4 hh = hr[i]; s += (hh.x * w3s[4 * i] + hh.y * w3s[4 * i + 1]) + (hh.z * w3s[4 * i + 2] + hh.w * w3s[4 * i + 3]); }
    return s * (__expf(-(float)t * (1.f / 4095.f) * adelta) + 0.05f);
}
template <int HH> DI void hy_finalize(const cf2 (&u)[16], LAS cf2* X, LAS cf2* Z1, const unsigned* Uz, const unsigned* Ux1, const unsigned* Ux2, unsigned* zt, int lo_, int o, float bias) {
#pragma unroll
    for (int j = 0; j < 8; ++j) {
        const int t = (8 * HH + j) * 256 + lo_;
        const cf2 mine = u[8 * HH + j];
        const cf2 oth = X[fphys((HH ? 0 : 4096) + t)];
        const cf2 y = MK2(mine.x + oth.x, mine.y + oth.y);
        if (o == 0) { const unsigned wz = Uz[t], w1 = Ux1[t];
            Z1[t] = MK2(bflo(w1) * (y.x + bias * bflo(wz)), bfhi(w1) * (y.y + bias * bfhi(wz))); }
        else { const unsigned w2 = Ux2[t]; const cf2 z1 = Z1[t];
            zt[t] = pk2(bflo(w2) * (y.x + bias * z1.x), bfhi(w2) * (y.y + bias * z1.y)); }
    }
}
DI void p4_hyena(Frame& F) {
    unsigned char* ws = F.a->ws; const int tid = F.tid, H = tid >> 8, lo = tid & 255;
    LAS cf2* X = (LAS cf2*)F.lds;
    LAS cf2* Z1 = (LAS cf2*)(F.lds + 69632);
    LAS cf2* TW4 = (LAS cf2*)(F.lds + 102400); LAS cf2* TW8 = TW4 + 256;
    LAS float* W3S = (LAS float*)(F.lds + 106496);
    const float* HID2 = (const float*)(ws + WS_HID2);
    cf2* KG = (cf2*)(ws + WS_KSP) + (size_t)F.blk * 16384;
    const unsigned* UT = (const unsigned*)(ws + WS_UT); unsigned* ZT = (unsigned*)(ws + WS_ZT);
    if (tid < 256) { float sn, cs; sincospif((float)tid * (1.f / 2048.f), &sn, &cs); TW4[tid] = MK2(cs, -sn); sincospif((float)tid * (1.f / 4096.f), &sn, &cs); TW8[tid] = MK2(cs, -sn); }
    __syncthreads();
    LAS float* TS = (LAS float*)Z1;
    for (int c = F.blk; c < 512; c += F.G) {
        for (int o = 0; o < 2; ++o) {
            if (tid < 128) { const int d = tid >> 6, j = tid & 63; W3S[tid] = F.a->in[IN_HW3][(size_t)j * 2048 + (o * 2 + d) * 512 + c]; }
            __syncthreads();
            const float adf = fabsf(F.a->in[IN_HDELTA][(o * 2) * 512 + c]), adb = fabsf(F.a->in[IN_HDELTA][(o * 2 + 1) * 512 + c]);
#pragma unroll 1
            for (int n = tid; n < 8192; n += 512) {
                float val;
                if (n < SEQ) { val = filt_tap(HID2, W3S, n, adf); if (n == 0) val += filt_tap(HID2, W3S + 64, 0, adb); }
                else if (n == SEQ) val = 0.f;
                else val = filt_tap(HID2, W3S + 64, 2 * SEQ - n, adb);
                TS[n] = val;
            }
            __syncthreads();
            {
                int tl = tid; LAUNDER(tl); const int lo_ = tl & 255;
                cf2 a[16], b[16];
#pragma unroll
                for (int k = 0; k < 16; ++k) { a[k] = MK2(TS[k * 256 + lo_], 0.f); b[k] = MK2(TS[SEQ + k * 256 + lo_], 0.f); }
                fft_passA_fwd(tl, a, b, X, TW4, TW8);
            }
            __syncthreads();
            { int tl = tid; LAUNDER(tl); fft_passB_fwd(tl, X, TW4); }
            __syncthreads();
            { int tl = tid; LAUNDER(tl); cf2 v[16]; fft_passC_fwd(tl, X, v);
              cf2* kg = KG + o * 8192 + tl;
#pragma unroll
              for (int r = 0; r < 16; ++r) kg[r * 512] = MK2(v[r].x * (1.f / 8192.f), v[r].y * (1.f / 8192.f)); }
            __syncthreads();
        }
        const float bias0 = F.a->in[IN_HBIAS][c], bias1 = F.a->in[IN_HBIAS][512 + c];
#pragma unroll 1
        for (int p = 0; p < 4; ++p) {
            const unsigned* Ux1 = UT + (((size_t)0 * 4 + p) * 512 + c) * SEQ; const unsigned* Ux2 = UT + (((size_t)1 * 4 + p) * 512 + c) * SEQ; const unsigned* Uz = UT + (((size_t)2 * 4 + p) * 512 + c) * SEQ;
#pragma unroll 1
            for (int o = 0; o < 2; ++o) {
                { int tl = tid; LAUNDER(tl); const int lo_ = tl & 255;
                    cf2 a[16], b[16];
#pragma unroll
                    for (int k = 0; k < 16; ++k) {
                        if (o == 0) { const unsigned w = Uz[k * 256 + lo_]; a[k] = MK2(bflo(w), bfhi(w)); } else a[k] = Z1[k * 256 + lo_];
                        b[k] = MK2(0.f, 0.f); }
                    fft_passA_fwd(tl, a, b, X, TW4, TW8);
                }
                __syncthreads();
                { int tl = tid; LAUNDER(tl); fft_passB_fwd(tl, X, TW4); }
                __syncthreads();
                { int tl = tid; LAUNDER(tl); cf2 v[16]; fft_passC_fwd(tl, X, v);
                  const cf2* kg = KG + o * 8192 + tl;
#pragma unroll
                  for (int r = 0; r < 16; ++r) v[r] = c_mul(v[r], kg[r * 512]);
                  fft_passC_inv(tl, X, v); }
                __syncthreads();
                { int tl = tid; LAUNDER(tl); fft_passB_inv(tl, X, TW4); }
                __syncthreads();
                {
                    int tl = tid; LAUNDER(tl); const int H_ = tl >> 8, lo_ = tl & 255;
                    cf2 u[16]; fft_passA_inv(tl, X, TW4, TW8, u);
                    if (H_ == 0) {
#pragma unroll
                        for (int k = 8; k < 16; ++k) X[fphys(k * 256 + lo_)] = u[k];
                    } else {
#pragma unroll
                        for (int k = 0; k < 8; ++k) X[fphys(4096 + k * 256 + lo_)] = u[k];
                    }
                    __syncthreads();
                    const float bias = (o == 0) ? bias0 : bias1;
                    if (H_ == 0) hy_finalize<0>(u, X, Z1, Uz, Ux1, Ux2, ZT + ((size_t)p * 512 + c) * SEQ, lo_, o, bias);
                    else hy_finalize<1>(u, X, Z1, Uz, Ux1, Ux2, ZT + ((size_t)p * 512 + c) * SEQ, lo_, o, bias);
                }
                __syncthreads();
            }
        }
    }
}

DI void p5_post(Frame& F) {
    unsigned char* ws = F.a->ws; const int lane = F.lane;
    bf16* Y = (bf16*)(ws + WS_H); const bf16* P = (const bf16*)(ws + WS_P); const bf16* HM = (const bf16*)(ws + WS_HM);
    {
        const int gw = F.blk * 8 + F.wave, NGW = F.G * 8;
        const f32x4 g0 = *(const f32x4*)(F.a->in[IN_MNG] + 8 * lane), g1 = *(const f32x4*)(F.a->in[IN_MNG] + 8 * lane + 4);
        for (int row = gw; row < MTOK; row += NGW) {
            const v4u a = *(const v4u*)(HM + (size_t)row * 512 + 8 * lane), bq = *(const v4u*)(HM + ((size_t)MTOK + row) * 512 + 8 * lane);
            const v4u ov = *(const v4u*)(P + (size_t)row * NPROJ + 1536 + 8 * lane);
            float hsum[8], og[8];
#pragma unroll
            for (int e = 0; e < 4; ++e) { hsum[2 * e] = bflo(a[e]) + bflo(bq[e]); hsum[2 * e + 1] = bfhi(a[e]) + bfhi(bq[e]); og[2 * e] = bflo(ov[e]); og[2 * e + 1] = bfhi(ov[e]); }
            float ss = 0.f;
#pragma unroll
            for (int e = 0; e < 8; ++e) ss += hsum[e] * hsum[e];
            ss += __shfl_xor(ss, 1); ss += __shfl_xor(ss, 2); ss += __shfl_xor(ss, 4); ss += __shfl_xor(ss, 8);
            const float rstd = rsqrtf(ss * (1.f / 128.f) + RMS_EPS);
            const float gg[8] = {g0.x, g0.y, g0.z, g0.w, g1.x, g1.y, g1.z, g1.w};
            float o[8];
#pragma unroll
            for (int e = 0; e < 8; ++e) o[e] = sigmoidf_(og[e]) * hsum[e] * rstd * gg[e];
            v4u w; w.x = pk2(o[0], o[1]); w.y = pk2(o[2], o[3]); w.z = pk2(o[4], o[5]); w.w = pk2(o[6], o[7]);
            *(v4u*)(Y + (size_t)row * 1024 + 8 * lane) = w;
        }
    }
    {
        const bf16* ZT = (const bf16*)(ws + WS_ZT);
        LAS bf16* tile = (LAS bf16*)F.lds;
        const f32x4 g0 = *(const f32x4*)(F.a->in[IN_HNG] + 8 * lane), g1 = *(const f32x4*)(F.a->in[IN_HNG] + 8 * lane + 4);
        const float gg[8] = {g0.x, g0.y, g0.z, g0.w, g1.x, g1.y, g1.z, g1.w};
        __syncthreads();
        for (int u = F.blk; u < 4 * 128; u += F.G) {
            const int p = u >> 7, tt = u & 127;
            for (int pc = F.tid; pc < 4096; pc += 512) {
                const int c = pc >> 3, q = pc & 7;
                const v4u v = *(const v4u*)(ZT + (((size_t)p * 512 + c) * SEQ + tt * 32) * 2 + q * 8);
#pragma unroll
                for (int i = 0; i < 4; ++i) { tile[((4 * q + i) * 2 + 0) * 520 + c] = (bf16)(v[i] & 0xffffu); tile[((4 * q + i) * 2 + 1) * 520 + c] = (bf16)(v[i] >> 16); }
            }
            __syncthreads();
#pragma unroll 2
            for (int rr = 0; rr < 8; ++rr) {
                const int row = F.wave * 8 + rr, t = row >> 1, bs = row & 1, token = (2 * p + bs) * SEQ + tt * 32 + t;
                const v4u v = *(const LAS v4u*)(tile + row * 520 + 8 * lane);
                float z[8];
#pragma unroll
                for (int e = 0; e < 4; ++e) { z[2 * e] = bflo(v[e]); z[2 * e + 1] = bfhi(v[e]); }
                float ss = 0.f;
#pragma unroll
                for (int e = 0; e < 8; ++e) ss += z[e] * z[e];
                ss += __shfl_xor(ss, 1); ss += __shfl_xor(ss, 2); ss += __shfl_xor(ss, 4); ss += __shfl_xor(ss, 8);
                const float rstd = rsqrtf(ss * (1.f / 128.f) + RMS_EPS);
                v4u w; w.x = pk2(z[0] * rstd * gg[0], z[1] * rstd * gg[1]); w.y = pk2(z[2] * rstd * gg[2], z[3] * rstd * gg[3]);
                w.z = pk2(z[4] * rstd * gg[4], z[5] * rstd * gg[5]); w.w = pk2(z[6] * rstd * gg[6], z[7] * rstd * gg[7]);
                *(v4u*)(Y + (size_t)token * 1024 + 512 + 8 * lane) = w;
            }
            __syncthreads();
        }
    }
}

DI void conv_wgu(Frame& F) {
    LAS float* scr = (LAS float*)(F.lds + F.wave * 16384); bf16* WGU = (bf16*)(F.a->ws + WS_WGU);
    const int gw = F.blk * 8 + F.wave, NGW = F.G * 8;
    for (int it = gw; it < 16 * 16 * 128; it += NGW) {
        const int nb = it & 127, kb = (it >> 7) & 15, e = it >> 11, n0 = 32 * nb, k0 = 64 * kb, j = n0 >> 8, r = n0 & 255, f0 = 128 * j + (r & 127);
        const float* W = (r < 128 ? F.a->in[IN_WGATE] : F.a->in[IN_WUP]) + (size_t)e * 1024 * 2048;
        transpose_item(W + (size_t)k0 * 2048 + f0, 2048, WGU + ((size_t)e * 4096 + n0) * 1024 + k0, 1024, scr, F.lane);
    }
}
DI void conv_wd(Frame& F) {
    LAS float* scr = (LAS float*)(F.lds + F.wave * 16384); bf16* WD = (bf16*)(F.a->ws + WS_WD);
    const int gw = F.blk * 8 + F.wave, NGW = F.G * 8;
    for (int it = gw; it < 16 * 32 * 32; it += NGW) {
        const int nb = it & 31, kb = (it >> 5) & 31, e = it >> 10, n0 = 32 * nb, k0 = 64 * kb;
        transpose_item(F.a->in[IN_WDOWN] + (size_t)e * 2048 * 1024 + (size_t)k0 * 1024 + n0, 1024, WD + ((size_t)e * 1024 + n0) * 2048 + k0, 2048, scr, F.lane);
    }
}

DI void p8_topk(Frame& F) {
    unsigned char* ws = F.a->ws; const int tid = F.tid, lane = F.lane, wave = F.wave;
    LAS unsigned* hist = (LAS unsigned*)F.lds;
    LAS unsigned* wtot = hist + 256;
    LAS unsigned* ctl = wtot + 8;
    LAS int* sel = (LAS int*)(ctl + 8);
    const float* AFF = (const float*)(ws + WS_AFF); const bf16* HF = (const bf16*)(ws + WS_HF); bf16* XS = (bf16*)(ws + WS_XS);
    int* IDX = (int*)(ws + WS_IDX); float* GSEL = (float*)(ws + WS_GSEL); int* INV = (int*)(ws + WS_INV);
    for (int it = F.blk; it < NB * NEXP; it += F.G) {
        const int b = it >> 4, e = it & 15;
        unsigned k8[8];
        { const v4u a = *(const v4u*)(AFF + (size_t)it * SEQ + 8 * tid), c2 = *(const v4u*)(AFF + (size_t)it * SEQ + 8 * tid + 4);
          k8[0] = a.x; k8[1] = a.y; k8[2] = a.z; k8[3] = a.w; k8[4] = c2.x; k8[5] = c2.y; k8[6] = c2.z; k8[7] = c2.w; }
        unsigned prefix = 0u, need = CAP;
#pragma unroll 1
        for (int pass = 0; pass < 4; ++pass) {
            const int shift = 24 - 8 * pass; const unsigned mask = pass ? (0xffffffffu << (shift + 8)) : 0u;
            if (tid < 256) hist[tid] = 0u;
            __syncthreads();
#pragma unroll
            for (int i = 0; i < 8; ++i) if ((k8[i] & mask) == prefix) atomicAdd((unsigned*)(hist + ((k8[i] >> shift) & 255u)), 1u);
            __syncthreads();
            if (wave == 0) {
                const unsigned h0 = hist[4 * lane], h1 = hist[4 * lane + 1], h2 = hist[4 * lane + 2], h3 = hist[4 * lane + 3], s = h0 + h1 + h2 + h3;
                unsigned suf = s;
#pragma unroll
                for (int o = 1; o < 64; o <<= 1) { const unsigned t = __shfl_down(suf, o); if (lane + o < 64) suf += t; }
                const unsigned above = suf - s;
                if (above < need && need <= suf) {
                    unsigned rem = need - above; int bin;
                    if (h3 >= rem) bin = 3; else { rem -= h3; if (h2 >= rem) bin = 2; else { rem -= h2; if (h1 >= rem) bin = 1; else { rem -= h1; bin = 0; } } }
                    ctl[0] = prefix | ((unsigned)(4 * lane + bin) << shift); ctl[1] = rem;
                }
            }
            __syncthreads();
            prefix = ctl[0]; need = ctl[1];
        }
        const unsigned T = prefix;
        unsigned cg = 0u, ce = 0u;
#pragma unroll
        for (int i = 0; i < 8; ++i) { cg += (k8[i] > T) ? 1u : 0u; ce += (k8[i] == T) ? 1u : 0u; }
        const unsigned pack = cg | (ce << 16);
        unsigned inc = pack;
#pragma unroll
        for (int o = 1; o < 64; o <<= 1) { const unsigned t = __shfl_up(inc, o); if (lane >= o) inc += t; }
        if (lane == 63) wtot[wave] = inc;
        __syncthreads();
        unsigned woff = 0u;
#pragma unroll
        for (int w = 0; w < 8; ++w) woff += (w < wave) ? wtot[w] : 0u;
        const unsigned exc = woff + inc - pack;
        unsigned gtb = exc & 0xffffu, eqb = exc >> 16;
#pragma unroll
        for (int i = 0; i < 8; ++i) {
            const int idx = 8 * tid + i; const bool isgt = k8[i] > T, iseq = k8[i] == T, selc = isgt || (iseq && eqb < need);
            const int slot = (int)(gtb + (eqb < need ? eqb : need));
            if (selc) { sel[slot] = idx; IDX[it * CAP + slot] = idx; GSEL[it * CAP + slot] = __uint_as_float(k8[i]); }
            INV[((size_t)b * SEQ + idx) * 16 + e] = selc ? slot : -1;
            gtb += isgt ? 1u : 0u; eqb += iseq ? 1u : 0u;
        }
        __syncthreads();
        for (int s = wave; s < CAP; s += 8) {
            const int row = sel[s];
            const v4u* src = (const v4u*)(HF + ((size_t)b * SEQ + row) * 1024); v4u* dst = (v4u*)(XS + (((size_t)e * NB + b) * CAP + s) * 1024);
            const v4u x0 = src[lane], x1 = src[lane + 64]; dst[lane] = x0; dst[lane + 64] = x1;
        }
        __syncthreads();
    }
}

DI void p12_final(Frame& F) {
    unsigned char* ws = F.a->ws; const int lane = F.lane;
    const int* INV = (const int*)(ws + WS_INV); const float* GSEL = (const float*)(ws + WS_GSEL); const bf16* YS = (const bf16*)(ws + WS_YS); const float* MOD = (const float*)(ws + WS_MOD);
    const int gw = F.blk * 8 + F.wave, NGW = F.G * 8;
    for (int row = gw; row < MTOK; row += NGW) {
        const int b = row >> 12;
        f32x4* xr = (f32x4*)(F.a->out + (size_t)row * 1024) + lane;
        f32x4 v[4], acc[4];
#pragma unroll
        for (int j = 0; j < 4; ++j) { v[j] = xr[64 * j]; acc[j] = (f32x4){0.f, 0.f, 0.f, 0.f}; }
        const int myslot = INV[(size_t)row * 16 + (lane & 15)];
#pragma unroll 1
        for (int e = 0; e < 16; ++e) {
            const int s = __shfl(myslot, e);
            if (s >= 0) {
                const float g = GSEL[((size_t)b * 16 + e) * CAP + s];
                const v2u* yr = (const v2u*)(YS + (((size_t)e * NB + b) * CAP + s) * 1024) + lane;
#pragma unroll
                for (int j = 0; j < 4; ++j) { const v2u w = yr[64 * j]; acc[j] += (f32x4){bflo(w.x), bfhi(w.x), bflo(w.y), bfhi(w.y)} * g; }
            }
        }
        float ss = 0.f;
#pragma unroll
        for (int j = 0; j < 4; ++j) { const f32x4 gt = *(const f32x4*)(MOD + b * 6144 + 5120 + 256 * j + 4 * lane); v[j] = v[j] + gt * acc[j]; ss += (v[j].x * v[j].x + v[j].y * v[j].y) + (v[j].z * v[j].z + v[j].w * v[j].w); }
        const float rstd = rsqrtf(wave_sum(ss) * (1.f / 1024.f) + RMS_EPS);
#pragma unroll
        for (int j = 0; j < 4; ++j) { const f32x4 g = *(const f32x4*)(F.a->in[IN_GFINAL] + 256 * j + 4 * lane); xr[64 * j] = v[j] * rstd * g; }
    }
}

__global__ void __launch_bounds__(512, 2) fwd_kernel(Args args) {
    extern __shared__ __attribute__((aligned(16))) unsigned char lds[];
    Frame F;
    F.lds = (LAS unsigned char*)lds;
    F.tid = threadIdx.x; F.lane = F.tid & 63; F.wave = __builtin_amdgcn_readfirstlane(F.tid >> 6);
    F.G = gridDim.x; F.blk = blockIdx.x;
    F.a = &args;
    volatile LAS unsigned* MISC = (volatile LAS unsigned*)(F.lds + MISC_OFF);
    if (F.tid < 64) MISC[F.tid] = 0u;
    __syncthreads();
    XcdBarrier bar; bar.bar = (unsigned*)(F.a->ws + WS_CTL); bar.x = 0; bar.st = nullptr;
    if (N_LAUNCHES == 1) bar = xcd_barrier_post((unsigned*)(F.a->ws + WS_CTL), MISC + 8);
    const int lo = args.ph_lo, hi = args.ph_hi;
#define IN(k) (lo <= (k) && (k) < hi)
#define SEAM(k) do { if (IN(k) && IN((k) + 1)) xcd_barrier(bar); } while (0)
    unsigned char* ws = F.a->ws;
    if (IN(0)) { p0_prologue(F); } SEAM(0);
    if (IN(1)) { p_norm<false>(F); } SEAM(1);
    if (IN(2)) {
        pg8::Gemm g{(const pg8::bf16_t*)(ws + WS_H), (const pg8::bf16_t*)(ws + WS_WIN), MTOK, NPROJ, DM}; pg8::StaticOrder S; S.init(MTOK, NPROJ, F.G, F.blk);
        pg8::EpiBf16<0> E{(pg8::bf16_t*)(ws + WS_P), NPROJ, (const float*)(ws + WS_BIN2), 0, 0, 1.f};
        pg8::gemm_phase<pg8::EpiBf16<0>, pg8::StaticOrder, true, true>(F.lds, g, S, E);
    } SEAM(2);
    if (IN(3)) { p3_prep(F); } SEAM(3);
    if (IN(4)) { p4_hyena(F); __syncthreads(); p4_mlstm_seq(F); } SEAM(4);
    if (IN(5)) { p5_post(F); } SEAM(5);
    if (IN(6)) {
        pg8::Gemm g{(const pg8::bf16_t*)(ws + WS_H), (const pg8::bf16_t*)(ws + WS_WOUT), MTOK, DM, DM}; pg8::StaticOrder S; S.init(MTOK, DM, F.G, F.blk);
        pg8::EpiRes E{F.a->in[IN_X], F.a->out, (const float*)(ws + WS_MOD)};
        pg8::gemm_phase<pg8::EpiRes, pg8::StaticOrder, true, true>(F.lds, g, S, E);
    } SEAM(6);
    if (IN(7)) { p_norm<true>(F); __syncthreads(); conv_wgu(F); } SEAM(7);
    if (IN(8)) { p8_topk(F); } SEAM(8);
    if (IN(9)) {
        pg8::Gemm g{(const pg8::bf16_t*)(ws + WS_XS), (const pg8::bf16_t*)(ws + WS_WGU), NSLOT, NEXP * 4096, DM}; pg8::MoeOrderA S{F.G, F.blk};
        pg8::EpiSwiGLU E{(pg8::bf16_t*)(ws + WS_HID)};
        pg8::gemm_phase<pg8::EpiSwiGLU, pg8::MoeOrderA, true, true>(F.lds, g, S, E);
    } SEAM(9);
    if (IN(10)) { conv_wd(F); } SEAM(10);
    if (IN(11)) {
        pg8::Gemm g{(const pg8::bf16_t*)(ws + WS_HID), (const pg8::bf16_t*)(ws + WS_WD), NSLOT, NEXP * 1024, FFD}; pg8::MoeOrderB S{F.G, F.blk};
        pg8::EpiYs E{(pg8::bf16_t*)(ws + WS_YS)};
        pg8::gemm_phase<pg8::EpiYs, pg8::MoeOrderB, true, true>(F.lds, g, S, E);
    } SEAM(11);
    if (IN(12)) { p12_final(F); }
#undef IN
#undef SEAM
}

extern "C" void kernel_launch(void* const* d_in, const int* in_sizes, int n_in, void* d_out, int out_size, void* d_ws, size_t ws_size, hipStream_t stream) {
    static int grid = 0;
    if (grid == 0) {
        if (n_in != 28 || out_size != MTOK * DM || ws_size < WS_END) { fprintf(stderr, "kernel_launch: unexpected shapes (n_in %d, out %d, ws %zu < %zu)\n", n_in, out_size, ws_size, (size_t)WS_END); grid = -1; return; }
        int dev = 0, cus = 0;
        if (hipGetDevice(&dev) != hipSuccess || hipDeviceGetAttribute(&cus, hipDeviceAttributeMultiprocessorCount, dev) != hipSuccess) { grid = -1; return; }
        if (hipFuncSetAttribute((const void*)fwd_kernel, hipFuncAttributeMaxDynamicSharedMemorySize, LDS_BYTES) != hipSuccess) { fprintf(stderr, "kernel_launch: hipFuncSetAttribute failed\n"); grid = -1; return; }
        int per_cu = 0;
        if (hipOccupancyMaxActiveBlocksPerMultiprocessor(&per_cu, (const void*)fwd_kernel, 512, LDS_BYTES) != hipSuccess || per_cu < 1) fprintf(stderr, "kernel_launch: occupancy query reports %d\n", per_cu);
        (void)hipGetLastError();
        grid = cus > 256 ? 256 : cus;
    }
    if (grid < 0) return;
    (void)hipMemsetAsync((char*)d_ws + WS_CTL, 0, CTL_ZERO_BYTES, stream);
    Args a{};
    for (int i = 0; i < 28; ++i) a.in[i] = (const float*)d_in[i];
    a.out = (float*)d_out; a.ws = (unsigned char*)d_ws;
    if (N_LAUNCHES == 1) { a.ph_lo = 0; a.ph_hi = N_PHASES; hipLaunchKernelGGL(fwd_kernel, dim3(grid), dim3(512), LDS_BYTES, stream, a); }
    else for (int p = 0; p < N_PHASES; ++p) { a.ph_lo = p; a.ph_hi = p + 1; hipLaunchKernelGGL(fwd_kernel, dim3(grid), dim3(512), LDS_BYTES, stream, a); }
}
```

```cpp
#include <hip/hip_runtime.h>
#include <cstdio>
#include <cstdint>
#define N_LAUNCHES 1
namespace pg8 {
#define PG8_LAS __attribute__((address_space(3)))
typedef unsigned short bf16_t;
typedef short bf16x8 __attribute__((ext_vector_type(8)));
typedef float f32x4 __attribute__((ext_vector_type(4)));
typedef unsigned u32x4 __attribute__((ext_vector_type(4)));
constexpr int BM = 256, BK = 64, HALF = 128, HTB = HALF * BK * 2  , STAGE_BYTES = 8 * HTB, NXCD = 8, WGM = 8;

__host__ __device__ __forceinline__ int lds_byte(int r, int c) { const int st = (r >> 4) * 2 + (c >> 5), rr = r & 15, cc = c & 31, ob = rr * 64 + cc * 2; return st * 1024 + (ob ^ (((ob >> 9) & 1) << 5)); }
__host__ __device__ __forceinline__ void stage_rc(int b, int& R, int& C) { const int st = b / 1024, sb = b % 1024, swz = sb ^ (((sb >> 9) & 1) << 5); R = (st >> 1) * 16 + swz / 64; C = (st & 1) * 32 + (swz % 64) / 2; }
__host__ __device__ __forceinline__ int perm32(int rho) { const int n = rho >> 4, i = rho & 15; return 8 * (i >> 2) + 4 * n + (i & 3); }

struct Unit { int pm, pn; };
struct Gemm { const bf16_t* A; const bf16_t* Bt; int M, N, K; };

struct StaticOrder {
    int nM, nN, nwg, G, c;
    __host__ __device__ void init(int M, int N, int G_, int c_) { nM = M / BM; nN = N / BM; nwg = nM * nN; G = G_; c = c_; }
    __host__ __device__ bool next(int i, Unit& u) const {
        const long L = (long)i * G + c; if (L >= nwg) return false;
        int wgid = (int)L; { const int q = nwg / NXCD, r = nwg % NXCD, xcd = wgid % NXCD, off = wgid / NXCD; wgid = (xcd < r ? xcd * (q + 1) : r * (q + 1) + (xcd - r) * q) + off; }
        const int nig = WGM * nN, gid = wgid / nig, fm = gid * WGM, gsz = (nM - fm) < WGM ? (nM - fm) : WGM;
        u.pm = fm + ((wgid % nig) % gsz); u.pn = (wgid % nig) / gsz; return true;
    }
    __device__ __forceinline__ void a_ready(const Unit&) const {}
    __device__ __forceinline__ void done(const Unit&) const {}
};

__device__ __forceinline__ unsigned cvt_pk_bf16(float lo, float hi) { unsigned r; asm volatile("v_cvt_pk_bf16_f32 %0, %1, %2" : "=v"(r) : "v"(lo), "v"(hi)); return r; }
typedef float f32x2 __attribute__((ext_vector_type(2)));
__device__ __forceinline__ f32x2 gelu_pk(f32x2 v) {
    const f32x2 av = __builtin_elementwise_abs(v), d = av * 0.2316418882f + 1.0f;
    f32x2 t; t.x = __builtin_amdgcn_rcpf(d.x); t.y = __builtin_amdgcn_rcpf(d.y);
    f32x2 q = t * 0.5307027145f + (-0.7265760135f); q = q * t + 0.7107068705f; q = q * t + (-0.142248368f); q = q * t + 0.127414796f; q = q * t;
    const f32x2 s = (v * v) * (-0.72134752044f);
    f32x2 e; e.x = __builtin_amdgcn_exp2f(s.x); e.y = __builtin_amdgcn_exp2f(s.y);
    const f32x2 m = v * (q * e), r = v - m;
    f32x2 o; o.x = v.x < 0.f ? m.x : r.x; o.y = v.y < 0.f ? m.y : r.y; return o;
}

template <int ACT  > struct EpiBf16 {
    static constexpr bool PERM = true, AFTER_DRAIN = false; static_assert(ACT == 0 || ACT == 1, "EpiBf16: ACT is 0 (none) or 1 (gelu_pk)");
    bf16_t* O; int ldc; const float* bias; int split_cols; size_t split_stride; float scale0;
    __device__ __forceinline__ void operator()(const f32x4 (&acc)[2][2][4][2], const Unit& u, int wr, int wc, int fr, int fq) const {
        const int row0 = u.pm * BM + wr * 64 + fr; int colt = u.pn * BM; bf16_t* base = O;
        float sc = 1.f; if (split_cols) { const int t = colt / split_cols; base += (size_t)t * split_stride; colt -= t * split_cols; if (t == 0) sc = scale0; }
        const int col0 = colt + wc * 32 + 8 * fq, bcol0 = u.pn * BM + wc * 32 + 8 * fq;
        f32x4 bv[2][2];
#pragma unroll
        for (int bj = 0; bj < 2; ++bj)
#pragma unroll
            for (int n = 0; n < 2; ++n) bv[bj][n] = bias ? *(const f32x4*)(bias + bcol0 + bj * HALF + 4 * n) : (f32x4){0.f, 0.f, 0.f, 0.f};
#pragma unroll
        for (int ai = 0; ai < 2; ++ai)
#pragma unroll
            for (int m = 0; m < 4; ++m) { bf16_t* rowp = base + (size_t)(row0 + ai * HALF + m * 16) * ldc + col0;
#pragma unroll
                for (int bj = 0; bj < 2; ++bj) { f32x4 v0 = acc[ai][bj][m][0] + bv[bj][0], v1 = acc[ai][bj][m][1] + bv[bj][1];
                    if (ACT == 1) { f32x2 a = gelu_pk((f32x2){v0[0], v0[1]}), b = gelu_pk((f32x2){v0[2], v0[3]}), c = gelu_pk((f32x2){v1[0], v1[1]}), d = gelu_pk((f32x2){v1[2], v1[3]});
                        v0 = (f32x4){a.x, a.y, b.x, b.y}; v1 = (f32x4){c.x, c.y, d.x, d.y}; }
                    v0 = v0 * sc; v1 = v1 * sc; u32x4 w; w.x = cvt_pk_bf16(v0[0], v0[1]); w.y = cvt_pk_bf16(v0[2], v0[3]); w.z = cvt_pk_bf16(v1[0], v1[1]); w.w = cvt_pk_bf16(v1[2], v1[3]);
                    *(u32x4*)(rowp + bj * HALF) = w; } }
    }
};


template <class Epi, class Sched, bool ALIGN_EPI = false, bool SP2 = false>
__device__ __forceinline__ void gemm_phase(PG8_LAS unsigned char* lds, const Gemm g, const Sched& S, const Epi& E) {
    const int tid = threadIdx.x, wid = __builtin_amdgcn_readfirstlane(tid >> 6), lane = tid & 63, wr = wid >> 2, wc = wid & 3, fr = lane & 15, fq = lane >> 4;
    const int K = g.K, nt = K / BK;
    unsigned voffA[2], voffB[2];
#pragma unroll
    for (int i = 0; i < 2; ++i) { int R, C; stage_rc(tid * 16 + i * 8192, R, C); const int Rb = Epi::PERM ? ((R & ~31) + perm32(R & 31)) : R;
        voffA[i] = (unsigned)(R * K + C) * 2u; voffB[i] = (unsigned)(Rb * K + C) * 2u; }
    const size_t kstep = (size_t)(BK * 2);
    const size_t hstep = (size_t)HALF * K * 2;
    const size_t tstep = 2 * hstep;
    const unsigned ldsw = (unsigned)wid * 1024u;
    const int aoff = lds_byte(wr * 64 + fr, fq * 8), boff = lds_byte(wc * 32 + fr, fq * 8);
#define PG8_SA(b, h) (((b) * 2 + (h)) * HTB)
#define PG8_SB(b, h) ((4 + (b) * 2 + (h)) * HTB)
#define PG8_STAGE(bufoff, gbase, voff) do { _Pragma("unroll") for (int _i = 0; _i < 2; ++_i) \
        __builtin_amdgcn_global_load_lds((const unsigned*)((const char*)(gbase) + (voff)[_i]), (PG8_LAS unsigned*)(lds + (bufoff) + ldsw + _i * 8192), 16, 0, 0); } while (0)
#define PG8_LDA(dst, b, h) do { _Pragma("unroll") for (int m = 0; m < 4; ++m) _Pragma("unroll") for (int k = 0; k < 2; ++k) dst[m][k] = *(const PG8_LAS bf16x8*)(lds + PG8_SA(b, h) + aoff + m * 2048 + k * 1024); } while (0)
#define PG8_LDB(dst, b, h) do { _Pragma("unroll") for (int n = 0; n < 2; ++n) _Pragma("unroll") for (int k = 0; k < 2; ++k) dst[n][k] = *(const PG8_LAS bf16x8*)(lds + PG8_SB(b, h) + boff + n * 2048 + k * 1024); } while (0)
#define PG8_MMA(ai, bj, At, Bt) do { __builtin_amdgcn_s_setprio(1); _Pragma("unroll") for (int m = 0; m < 4; ++m) _Pragma("unroll") for (int n = 0; n < 2; ++n) _Pragma("unroll") for (int k = 0; k < 2; ++k) \
        acc[ai][bj][m][n] = __builtin_amdgcn_mfma_f32_16x16x32_bf16(Bt[n][k], At[m][k], acc[ai][bj][m][n], 0, 0, 0); __builtin_amdgcn_s_setprio(0); } while (0)
#define PG8_WAIT_V(n) asm volatile("s_waitcnt vmcnt(" #n ")" ::: "memory")
#define PG8_WAIT_L(n) asm volatile("s_waitcnt lgkmcnt(" #n ")" ::: "memory")
#define PG8_BAR __builtin_amdgcn_s_barrier()
#define PG8_SCHED __builtin_amdgcn_sched_barrier(0)
    Unit cur, nxt; int ui = 0;
    if (!S.next(0, cur)) return;
    f32x4 acc[2][2][4][2];
#pragma unroll
    for (int a = 0; a < 2; ++a)
#pragma unroll
        for (int b = 0; b < 2; ++b)
#pragma unroll
            for (int m = 0; m < 4; ++m)
#pragma unroll
                for (int n = 0; n < 2; ++n) acc[a][b][m][n] = (f32x4){0.f, 0.f, 0.f, 0.f};
    bf16x8 At[4][2], B0[2][2], B1[2][2];
    const char* cA = (const char*)g.A + (size_t)cur.pm * tstep; const char* cB = (const char*)g.Bt + (size_t)cur.pn * tstep;
    S.a_ready(cur);
    if constexpr (SP2) {
        PG8_STAGE(PG8_SB(0, 0), cB, voffB); PG8_STAGE(PG8_SB(0, 1), cB + hstep, voffB); PG8_STAGE(PG8_SA(0, 0), cA, voffA); PG8_STAGE(PG8_SA(0, 1), cA + hstep, voffA);
        if (wr == 1) PG8_BAR;
        PG8_WAIT_V(2); PG8_BAR;
        PG8_STAGE(PG8_SB(1, 0), cB + kstep, voffB); PG8_STAGE(PG8_SA(1, 0), cA + kstep, voffA); PG8_STAGE(PG8_SB(1, 1), cB + hstep + kstep, voffB);
        PG8_WAIT_V(6); PG8_BAR;
    } else {
        PG8_STAGE(PG8_SB(0, 0), cB, voffB); PG8_STAGE(PG8_SA(0, 0), cA, voffA); PG8_STAGE(PG8_SB(0, 1), cB + hstep, voffB); PG8_STAGE(PG8_SA(0, 1), cA + hstep, voffA);
        if (wr == 1) PG8_BAR;
        PG8_WAIT_V(4); PG8_BAR;
        PG8_STAGE(PG8_SB(1, 0), cB + kstep, voffB); PG8_STAGE(PG8_SA(1, 0), cA + kstep, voffA); PG8_STAGE(PG8_SB(1, 1), cB + hstep + kstep, voffB);
        PG8_WAIT_V(6); PG8_BAR;
    }
    for (;;) {
        const bool has_next = S.next(ui + 1, nxt);
        const char* nA = has_next ? (const char*)g.A + (size_t)nxt.pm * tstep : cA; const char* nB = has_next ? (const char*)g.Bt + (size_t)nxt.pn * tstep : cB;
        for (int t = 0; t < nt; t += 2) {
            const bool last = (t == nt - 2);
            const char* a1 = cA + (size_t)(t + 1) * kstep;
            const char* a2 = last ? nA : cA + (size_t)(t + 2) * kstep; const char* b2 = last ? nB : cB + (size_t)(t + 2) * kstep;
            const char* a3 = a2 + kstep; const char* b3 = b2 + kstep;
            if (last && has_next) S.a_ready(nxt);
            if constexpr (SP2) {
            PG8_LDB(B0, 0, 0); PG8_LDB(B1, 0, 1); PG8_SCHED; PG8_LDA(At, 0, 0); PG8_STAGE(PG8_SA(1, 1), a1 + hstep, voffA);
            PG8_WAIT_V(8); PG8_WAIT_L(0); PG8_BAR; PG8_MMA(0, 0, At, B0); PG8_MMA(0, 1, At, B1); PG8_BAR; PG8_SCHED;
            PG8_LDA(At, 0, 1); PG8_STAGE(PG8_SB(0, 0), b2, voffB); PG8_STAGE(PG8_SB(0, 1), b2 + hstep, voffB); PG8_STAGE(PG8_SA(0, 0), a2, voffA);
            PG8_WAIT_V(8); PG8_WAIT_L(0); PG8_BAR; PG8_MMA(1, 0, At, B0); PG8_MMA(1, 1, At, B1); PG8_BAR; PG8_SCHED;
            PG8_LDB(B0, 1, 0); PG8_LDB(B1, 1, 1); PG8_SCHED; PG8_LDA(At, 1, 0); PG8_STAGE(PG8_SA(0, 1), a2 + hstep, voffA);
            PG8_WAIT_V(8); PG8_WAIT_L(0); PG8_BAR; PG8_MMA(0, 0, At, B0); PG8_MMA(0, 1, At, B1); PG8_BAR; PG8_SCHED;
            PG8_LDA(At, 1, 1); PG8_STAGE(PG8_SB(1, 0), b3, voffB); PG8_STAGE(PG8_SB(1, 1), b3 + hstep, voffB); PG8_STAGE(PG8_SA(1, 0), a3, voffA);
            PG8_WAIT_V(8); PG8_WAIT_L(0); PG8_BAR; PG8_MMA(1, 0, At, B0); PG8_MMA(1, 1, At, B1); PG8_BAR; PG8_SCHED;
            } else {
            PG8_LDB(B0, 0, 0); PG8_SCHED; PG8_LDA(At, 0, 0); PG8_STAGE(PG8_SA(1, 1), a1 + hstep, voffA);
            PG8_WAIT_L(8); PG8_BAR; PG8_WAIT_L(0); PG8_MMA(0, 0, At, B0); PG8_BAR; PG8_SCHED;
            PG8_LDB(B1, 0, 1); PG8_STAGE(PG8_SB(0, 0), b2, voffB);
            PG8_BAR; PG8_WAIT_L(0); PG8_MMA(0, 1, At, B1); PG8_BAR;
            PG8_LDA(At, 0, 1); PG8_STAGE(PG8_SA(0, 0), a2, voffA);
            PG8_BAR; PG8_WAIT_L(0); PG8_MMA(1, 0, At, B0); PG8_BAR; PG8_SCHED;
            PG8_STAGE(PG8_SB(0, 1), b2 + hstep, voffB);
            PG8_WAIT_V(6); PG8_BAR; PG8_MMA(1, 1, At, B1); PG8_BAR;
            PG8_LDB(B0, 1, 0); PG8_SCHED; PG8_LDA(At, 1, 0); PG8_STAGE(PG8_SA(0, 1), a2 + hstep, voffA);
            PG8_WAIT_L(8); PG8_BAR; PG8_WAIT_L(0); PG8_MMA(0, 0, At, B0); PG8_BAR; PG8_SCHED;
            PG8_LDB(B1, 1, 1); PG8_STAGE(PG8_SB(1, 0), b3, voffB);
            PG8_BAR; PG8_WAIT_L(0); PG8_MMA(0, 1, At, B1); PG8_BAR;
            PG8_LDA(At, 1, 1); PG8_STAGE(PG8_SA(1, 0), a3, voffA);
            PG8_BAR; PG8_WAIT_L(0); PG8_MMA(1, 0, At, B0); PG8_BAR; PG8_SCHED;
            PG8_STAGE(PG8_SB(1, 1), b3 + hstep, voffB);
            PG8_WAIT_V(6); PG8_BAR; PG8_MMA(1, 1, At, B1); PG8_BAR;
            }
        }
        if constexpr (ALIGN_EPI) { if (wr == 0) PG8_BAR; }
        if constexpr (!Epi::AFTER_DRAIN) { E(acc, cur, wr, wc, fr, fq); S.done(cur); }
        if (!has_next) break;
#pragma unroll
        for (int a = 0; a < 2; ++a)
#pragma unroll
            for (int b = 0; b < 2; ++b)
#pragma unroll
                for (int m = 0; m < 4; ++m)
#pragma unroll
                    for (int n = 0; n < 2; ++n) acc[a][b][m][n] = (f32x4){0.f, 0.f, 0.f, 0.f};
        cur = nxt; cA = nA; cB = nB; ++ui;
        if constexpr (ALIGN_EPI) { if (wr == 1) PG8_BAR; }
    }
    PG8_WAIT_V(0);
    if constexpr (!ALIGN_EPI) { if (wr == 0) PG8_BAR; }
    PG8_BAR;
    if constexpr (Epi::AFTER_DRAIN) { E.fused(acc, cur, wr, wc, fr, fq, lds, wid, lane); S.done(cur); }
#undef PG8_SA
#undef PG8_SB
#undef PG8_STAGE
#undef PG8_LDA
#undef PG8_LDB
#undef PG8_MMA
#undef PG8_WAIT_V
#undef PG8_WAIT_L
#undef PG8_BAR
#undef PG8_SCHED
}
}
constexpr int NB = 8, SEQ = 4096, DM = 1024, MTOK = NB * SEQ;
constexpr int NPROJ = 3584;
constexpr int PCOLS_IN = 3600;
constexpr int NEXP = 16, CAP = 512, FFD = 2048, NSLOT = NEXP * NB * CAP;
constexpr float RMS_EPS = 1e-6f;
#ifndef N_LAUNCHES
#define N_LAUNCHES 1
#endif
constexpr int N_PHASES = 13;

constexpr size_t MiB = 1u << 20;
constexpr size_t WS_CTL = 0, CTL_ZERO_BYTES = 64 * 1024;
constexpr size_t WS_MOD = 1 * MiB;
constexpr size_t WS_BIN2 = 1 * MiB + 512 * 1024;
constexpr size_t WS_HID2 = 2 * MiB;
constexpr size_t WS_GATES = 3 * MiB;
constexpr size_t WS_AFF = 5 * MiB;
constexpr size_t WS_IDX = 7 * MiB, WS_GSEL = 7 * MiB + 256 * 1024;
constexpr size_t WS_INV = 8 * MiB;
constexpr size_t WS_WOUT = 12 * MiB;
constexpr size_t WS_WIN = 14 * MiB;
constexpr size_t WS_P = 24 * MiB;
constexpr size_t WS_H = 248 * MiB;
constexpr size_t WS_UT = 312 * MiB;
constexpr size_t WS_HM = 408 * MiB;
constexpr size_t WS_ZT = 472 * MiB;
constexpr size_t WS_KSP = 504 * MiB;
constexpr size_t WS_WGU = 24 * MiB;
constexpr size_t WS_XS = 152 * MiB;
constexpr size_t WS_HID = 280 * MiB;
constexpr size_t WS_HF = 280 * MiB;
constexpr size_t WS_WD = 152 * MiB;
constexpr size_t WS_YS = 24 * MiB;
constexpr size_t WS_END = 536 * MiB;

constexpr int RING_BYTES = 131072;
constexpr int MISC_OFF = RING_BYTES;
constexpr int LDS_BYTES = 147456;

#define GAS __attribute__((address_space(1)))
#define LAS __attribute__((address_space(3)))
#define DI __device__ __forceinline__
typedef unsigned short bf16;
typedef unsigned v4u __attribute__((ext_vector_type(4)));
typedef unsigned v2u __attribute__((ext_vector_type(2)));
typedef float f32x4 __attribute__((ext_vector_type(4)));
typedef GAS unsigned gu32;
#define LDS_WAIT() asm volatile("s_waitcnt lgkmcnt(0)" ::: "memory")
DI float bf2f(unsigned b) { return __uint_as_float(b << 16); }
DI float bflo(unsigned w) { return __uint_as_float(w << 16); }
DI float bfhi(unsigned w) { return __uint_as_float(w & 0xffff0000u); }
DI unsigned f2bf(float f) { unsigned u = __float_as_uint(f); return (u + 0x7fffu + ((u >> 16) & 1u)) >> 16; }
DI unsigned pk2(float lo, float hi) { return f2bf(lo) | (f2bf(hi) << 16); }
DI float wave_sum(float v) {
#pragma unroll
    for (int o = 1; o < 64; o <<= 1) v += __shfl_xor(v, o);
    return v;
}
DI float sigmoidf_(float x) { return 1.f / (1.f + __expf(-x)); }

namespace pg8 {
struct MoeOrderA {
    int G, c;
    __device__ bool next(int i, Unit& u) const {
        const long L = (long)i * G + c; if (L >= 4096) return false;
        const int e = (int)(L >> 8), r = (int)(L & 255), x = r & 7, j = r >> 3;
        u.pm = e * 16 + 4 * (x >> 1) + (j >> 3); u.pn = e * 16 + 8 * (x & 1) + (j & 7); return true;
    }
    __device__ __forceinline__ void a_ready(const Unit&) const {}
    __device__ __forceinline__ void done(const Unit&) const {}
};
struct MoeOrderB {
    int G, c;
    __device__ bool next(int i, Unit& u) const {
        const long L = (long)i * G + c; if (L >= 1024) return false;
        const int r = (int)(L & 255), e = (int)(L >> 8) * 4 + ((r & 7) >> 1), idx = ((r & 1) << 5) | (r >> 3);
        u.pm = e * 16 + (idx >> 2); u.pn = e * 4 + (idx & 3); return true;
    }
    __device__ __forceinline__ void a_ready(const Unit&) const {}
    __device__ __forceinline__ void done(const Unit&) const {}
};
struct EpiSwiGLU {
    static constexpr bool PERM = true, AFTER_DRAIN = false;
    bf16_t* O;
    __device__ __forceinline__ void operator()(const f32x4 (&acc)[2][2][4][2], const Unit& u, int wr, int wc, int fr, int fq) const {
        const int row0 = u.pm * BM + wr * 64 + fr, col0 = (u.pn & 15) * 128 + wc * 32 + 8 * fq;
#pragma unroll
        for (int ai = 0; ai < 2; ++ai)
#pragma unroll
            for (int m = 0; m < 4; ++m) {
                bf16_t* rowp = O + (size_t)(row0 + ai * HALF + m * 16) * 2048 + col0;
                float h[8];
#pragma unroll
                for (int n = 0; n < 2; ++n)
#pragma unroll
                    for (int i = 0; i < 4; ++i) { const float g = acc[ai][0][m][n][i], up = acc[ai][1][m][n][i]; h[4 * n + i] = g * __builtin_amdgcn_rcpf(1.f + __expf(-g)) * up; }
                u32x4 w; w.x = cvt_pk_bf16(h[0], h[1]); w.y = cvt_pk_bf16(h[2], h[3]); w.z = cvt_pk_bf16(h[4], h[5]); w.w = cvt_pk_bf16(h[6], h[7]);
                *(u32x4*)rowp = w;
            }
    }
};
struct EpiYs {
    static constexpr bool PERM = true, AFTER_DRAIN = false;
    bf16_t* O;
    __device__ __forceinline__ void operator()(const f32x4 (&acc)[2][2][4][2], const Unit& u, int wr, int wc, int fr, int fq) const {
        const int row0 = u.pm * BM + wr * 64 + fr, col0 = (u.pn & 3) * BM + wc * 32 + 8 * fq;
#pragma unroll
        for (int ai = 0; ai < 2; ++ai)
#pragma unroll
            for (int m = 0; m < 4; ++m) {
                bf16_t* rowp = O + (size_t)(row0 + ai * HALF + m * 16) * 1024 + col0;
#pragma unroll
                for (int bj = 0; bj < 2; ++bj) { const f32x4 v0 = acc[ai][bj][m][0], v1 = acc[ai][bj][m][1];
                    u32x4 w; w.x = cvt_pk_bf16(v0[0], v0[1]); w.y = cvt_pk_bf16(v0[2], v0[3]); w.z = cvt_pk_bf16(v1[0], v1[1]); w.w = cvt_pk_bf16(v1[2], v1[3]);
                    *(u32x4*)(rowp + bj * HALF) = w; }
            }
    }
};
struct EpiRes {
    static constexpr bool PERM = false, AFTER_DRAIN = false;
    const float* X; float* C; const float* mod;
    __device__ __forceinline__ void operator()(const f32x4 (&acc)[2][2][4][2], const Unit& u, int wr, int wc, int fr, int fq) const {
        const int row0 = u.pm * BM + wr * 64 + fr, col0 = u.pn * BM + wc * 32 + 4 * fq;
        const float* gp = mod + (size_t)((u.pm * BM) >> 12) * 6144 + 2048 + col0;
        f32x4 gv[2][2];
#pragma unroll
        for (int bj = 0; bj < 2; ++bj)
#pragma unroll
            for (int n = 0; n < 2; ++n) gv[bj][n] = *(const f32x4*)(gp + bj * HALF + n * 16);
#pragma unroll
        for (int ai = 0; ai < 2; ++ai)
#pragma unroll
            for (int m = 0; m < 4; ++m) { const size_t off = (size_t)(row0 + ai * HALF + m * 16) * 1024 + col0;
#pragma unroll
                for (int bj = 0; bj < 2; ++bj)
#pragma unroll
                    for (int n = 0; n < 2; ++n) { const f32x4 xv = *(const f32x4*)(X + off + bj * HALF + n * 16); *(f32x4*)(C + off + bj * HALF + n * 16) = xv + gv[bj][n] * acc[ai][bj][m][n]; } }
    }
};
}
#define XB_TMO      128
#define XB_XCNT(j)  (256  + 64 * (j))
#define XB_XSUB(j)  (1280 + 64 * (j))
#define XB_XGEN(j)  (2304 + 64 * (j))
#define XB_TOP      3328
#define XB_TOPGEN   3392
#define XCD_BAR_WORDS 3456
#define XB_SPIN_CAP (1u << 18)

__device__ __forceinline__ unsigned xb_ld(unsigned* p)              { return __hip_atomic_load(p, __ATOMIC_RELAXED, __HIP_MEMORY_SCOPE_AGENT); }
__device__ __forceinline__ unsigned xb_add(unsigned* p, unsigned v) { return __hip_atomic_fetch_add(p, v, __ATOMIC_RELAXED, __HIP_MEMORY_SCOPE_AGENT); }
__device__ __forceinline__ unsigned xb_xcc_id() { return (unsigned)__builtin_amdgcn_s_getreg((3 << 11) | 20) & 0xFu; }
#define XB_SPIN(cond, bar) do { unsigned _sp = 0; while (cond) { __builtin_amdgcn_s_sleep(1); \
    if ((++_sp & 255u) == 0u) { if (xb_ld(&(bar)[XB_TMO])) break; if (_sp > XB_SPIN_CAP) { atomicAdd(&(bar)[XB_TMO], 1u); break; } } } } while (0)

struct XcdBarrier {
    unsigned* bar; unsigned x;
    volatile LAS unsigned* st;
};

__device__ __forceinline__ XcdBarrier xcd_barrier_post(unsigned* bar, volatile LAS unsigned* st) {
    XcdBarrier b; b.bar = bar; b.x = xb_xcc_id(); b.st = st;
    if (threadIdx.x == 0) (void)xb_add(&bar[XB_XCNT(b.x)], 1u);
    return b;
}
__device__ __forceinline__ void xcd_barrier_complete(unsigned* bar, unsigned x, unsigned& nloc, unsigned& nx) {
    const unsigned G = gridDim.x * gridDim.y * gridDim.z;
    unsigned sum, cnt, mine, sp = 0u;
    for (;;) {
        sum = 0u; cnt = 0u; mine = 0u;
#pragma unroll
        for (unsigned j = 0; j < 16; ++j) { const unsigned c = xb_ld(&bar[XB_XCNT(j)]); sum += c; cnt += (c > 0u) ? 1u : 0u; mine = (j == x) ? c : mine; }
        if (sum == G) break;
        __builtin_amdgcn_s_sleep(1);
        if ((++sp & 255u) == 0u) { if (xb_ld(&bar[XB_TMO])) break; if (sp > XB_SPIN_CAP) { atomicAdd(&bar[XB_TMO], 1u); break; } }
    }
    nloc = mine > 0u ? mine : 1u; nx = cnt > 0u ? cnt : 1u;
}

__device__ __forceinline__ void xcd_barrier(const XcdBarrier& b) {
    asm volatile("s_waitcnt vmcnt(0)" ::: "memory");
    __syncthreads();
    if (threadIdx.x == 0) {
        unsigned* bar = b.bar;
        __builtin_amdgcn_s_waitcnt(0);
        unsigned nloc = b.st[0], nx = b.st[1];
        if (nloc == 0u) { xcd_barrier_complete(bar, b.x, nloc, nx); b.st[0] = nloc; b.st[1] = nx; }
        const unsigned old = xb_add(&bar[XB_XSUB(b.x)], 1u);
        const unsigned gen = old / nloc;
        if (old + 1u == (gen + 1u) * nloc) {
            __builtin_amdgcn_fence(__ATOMIC_RELEASE, "agent");
            asm volatile("s_waitcnt vmcnt(0)" ::: "memory");
            const unsigned og = xb_add(&bar[XB_TOP], 1u);
            const unsigned tg = og / nx;
            if (og + 1u == (tg + 1u) * nx) xb_add(&bar[XB_TOPGEN], 1u);
            else XB_SPIN(xb_ld(&bar[XB_TOPGEN]) == tg, bar);
            __builtin_amdgcn_fence(__ATOMIC_ACQUIRE, "agent");
            xb_add(&bar[XB_XGEN(b.x)], 1u);
            asm volatile("s_waitcnt vmcnt(0)" ::: "memory");
        } else {
            XB_SPIN(xb_ld(&bar[XB_XGEN(b.x)]) == gen, bar);
            __builtin_amdgcn_fence(__ATOMIC_ACQUIRE, "agent");
            asm volatile("s_waitcnt vmcnt(0)" ::: "memory");
        }
    }
    __syncthreads();
}
#define HD __host__ __device__ __forceinline__
typedef float cf2 __attribute__((ext_vector_type(2)));
#define MK2(a, b) ((cf2){(a), (b)})
HD cf2 c_add(cf2 a, cf2 b) { return MK2(a.x + b.x, a.y + b.y); }
HD cf2 c_sub(cf2 a, cf2 b) { return MK2(a.x - b.x, a.y - b.y); }
HD cf2 c_mul(cf2 a, cf2 b) { return MK2(a.x * b.x - a.y * b.y, a.x * b.y + a.y * b.x); }
HD cf2 c_mulc(cf2 a, cf2 b) { return MK2(a.x * b.x + a.y * b.y, a.y * b.x - a.x * b.y); }
HD int fphys(int i) { return i + (i >> 4); }
constexpr int FFT_XSLOTS = 8192 + 512;

#define W16_C1 0.92387953251128674f
#define W16_S1 0.38268343236508977f
#define W16_H  0.70710678118654752f
template <int J> HD cf2 mul_w16(cf2 d) {
    if constexpr (J == 0) return d;
    else if constexpr (J == 1) return c_mul(d, MK2(W16_C1, -W16_S1));
    else if constexpr (J == 2) return MK2((d.x + d.y) * W16_H, (d.y - d.x) * W16_H);
    else if constexpr (J == 3) return c_mul(d, MK2(W16_S1, -W16_C1));
    else if constexpr (J == 4) return MK2(d.y, -d.x);
    else if constexpr (J == 5) return c_mul(d, MK2(-W16_S1, -W16_C1));
    else if constexpr (J == 6) return MK2((d.y - d.x) * W16_H, -(d.x + d.y) * W16_H);
    else return c_mul(d, MK2(-W16_C1, -W16_S1));
}
HD void dft16(cf2 (&v)[16]) {
#define BF(i, j, TWJ) { const cf2 a_ = v[i], b_ = v[j]; v[i] = c_add(a_, b_); v[j] = mul_w16<TWJ>(c_sub(a_, b_)); }
    BF(0, 8, 0) BF(1, 9, 1) BF(2, 10, 2) BF(3, 11, 3) BF(4, 12, 4) BF(5, 13, 5) BF(6, 14, 6) BF(7, 15, 7)
    BF(0, 4, 0) BF(1, 5, 2) BF(2, 6, 4) BF(3, 7, 6)   BF(8, 12, 0) BF(9, 13, 2) BF(10, 14, 4) BF(11, 15, 6)
    BF(0, 2, 0) BF(1, 3, 4)  BF(4, 6, 0) BF(5, 7, 4)  BF(8, 10, 0) BF(9, 11, 4)  BF(12, 14, 0) BF(13, 15, 4)
    BF(0, 1, 0) BF(2, 3, 0) BF(4, 5, 0) BF(6, 7, 0) BF(8, 9, 0) BF(10, 11, 0) BF(12, 13, 0) BF(14, 15, 0)
#undef BF
#define SW(i, j) { const cf2 t_ = v[i]; v[i] = v[j]; v[j] = t_; }
    SW(1, 8) SW(2, 4) SW(3, 12) SW(5, 10) SW(7, 14) SW(11, 13)
#undef SW
}
HD void idft16(cf2 (&v)[16]) {
#pragma unroll
    for (int i = 0; i < 16; ++i) v[i] = MK2(v[i].y, v[i].x);
    dft16(v);
#pragma unroll
    for (int i = 0; i < 16; ++i) v[i] = MK2(v[i].y, v[i].x);
}
HD void c_powers(cf2 t, cf2 (&pw)[16]) {
    pw[0] = MK2(1.f, 0.f); pw[1] = t;
#pragma unroll
    for (int r = 2; r < 16; ++r) pw[r] = (r & 1) ? c_mul(pw[r - 1], t) : c_mul(pw[r >> 1], pw[r >> 1]);
}
HD cf2 w32_const(int k) {
    constexpr float C[16] = {1.f, 0.98078528040323043f, 0.92387953251128674f, 0.83146961230254524f, 0.70710678118654752f, 0.55557023301960218f, 0.38268343236508977f, 0.19509032201612825f,
                             0.f, -0.19509032201612825f, -0.38268343236508977f, -0.55557023301960218f, -0.70710678118654752f, -0.83146961230254524f, -0.92387953251128674f, -0.98078528040323043f};
    constexpr float S[16] = {0.f, 0.19509032201612825f, 0.38268343236508977f, 0.55557023301960218f, 0.70710678118654752f, 0.83146961230254524f, 0.92387953251128674f, 0.98078528040323043f,
                             1.f, 0.98078528040323043f, 0.92387953251128674f, 0.83146961230254524f, 0.70710678118654752f, 0.55557023301960218f, 0.38268343236508977f, 0.19509032201612825f};
    return MK2(C[k], -S[k]);
}
template <class XP, class TP> HD void fft_passA_fwd(int tid, const cf2 (&a)[16], const cf2 (&b)[16], XP X, TP TW4, TP TW8) {
    const int H = tid >> 8, lo = tid & 255;
    cf2 v[16];
    if (H == 0) {
#pragma unroll
        for (int k = 0; k < 16; ++k) v[k] = c_add(a[k], b[k]);
    } else {
        const cf2 t8 = TW8[lo];
#pragma unroll
        for (int k = 0; k < 16; ++k) v[k] = c_mul(c_sub(a[k], b[k]), c_mul(t8, w32_const(k)));
    }
    dft16(v);
    cf2 pw[16]; c_powers(TW4[lo], pw);
#pragma unroll
    for (int r = 0; r < 16; ++r) X[fphys(H * 4096 + r * 256 + lo)] = c_mul(v[r], pw[r]);
}
template <class XP, class TP> HD void fft_passB_fwd(int tid, XP X, TP TW4) {
    const int H = tid >> 8, hi = (tid >> 4) & 15, lo = tid & 15, base = H * 4096 + hi * 256 + lo;
    cf2 v[16];
#pragma unroll
    for (int k = 0; k < 16; ++k) v[k] = X[fphys(base + k * 16)];
    dft16(v);
    cf2 pw[16]; c_powers(TW4[16 * lo], pw);
#pragma unroll
    for (int r = 0; r < 16; ++r) X[fphys(base + r * 16)] = c_mul(v[r], pw[r]);
}
template <class XP> HD void fft_passC_fwd(int tid, XP X, cf2 (&v)[16]) {
    const int p0 = 17 * tid;
#pragma unroll
    for (int k = 0; k < 16; ++k) v[k] = X[p0 + k];
    dft16(v);
}
template <class XP> HD void fft_passC_inv(int tid, XP X, cf2 (&v)[16]) {
    const int p0 = 17 * tid;
    idft16(v);
#pragma unroll
    for (int k = 0; k < 16; ++k) X[p0 + k] = v[k];
}
template <class XP, class TP> HD void fft_passB_inv(int tid, XP X, TP TW4) {
    const int H = tid >> 8, hi = (tid >> 4) & 15, lo = tid & 15, base = H * 4096 + hi * 256 + lo;
    cf2 v[16], pw[16]; c_powers(TW4[16 * lo], pw);
#pragma unroll
    for (int r = 0; r < 16; ++r) v[r] = c_mulc(X[fphys(base + r * 16)], pw[r]);
    idft16(v);
#pragma unroll
    for (int k = 0; k < 16; ++k) X[fphys(base + k * 16)] = v[k];
}
template <class XP, class TP> HD void fft_passA_inv(int tid, XP X, TP TW4, TP TW8, cf2 (&u)[16]) {
    const int H = tid >> 8, lo = tid & 255;
    cf2 pw[16]; c_powers(TW4[lo], pw);
#pragma unroll
    for (int r = 0; r < 16; ++r) u[r] = c_mulc(X[fphys(H * 4096 + r * 256 + lo)], pw[r]);
    idft16(u);
    if (H == 1) {
        const cf2 t8 = TW8[lo];
#pragma unroll
        for (int k = 0; k < 16; ++k) u[k] = c_mulc(u[k], c_mul(t8, w32_const(k)));
    }
}
struct Args { const float* in[28]; float* out; unsigned char* ws; int ph_lo, ph_hi; };
struct Frame {
    LAS unsigned char* lds;
    int tid, lane, wave, G, blk;
    const struct Args* a;
};
#define IN_X 0
#define IN_C 1
#define IN_WADA 2
#define IN_BADA 3
#define IN_GMIX 4
#define IN_WIN 5
#define IN_BIN 6
#define IN_CQKW 7
#define IN_CQKB 8
#define IN_MNG 9
#define IN_CHYW 10
#define IN_CHYB 11
#define IN_HW1 12
#define IN_HB1 13
#define IN_HW2 14
#define IN_HB2 15
#define IN_HW3 16
#define IN_HFREQ 17
#define IN_HDELTA 18
#define IN_HBIAS 19
#define IN_HNG 20
#define IN_WOUT 21
#define IN_GFFN 22
#define IN_WROUTER 23
#define IN_WGATE 24
#define IN_WUP 25
#define IN_WDOWN 26
#define IN_GFINAL 27

DI void transpose_item(const float* src, int ldsrc, bf16* dst, int lddst, LAS float* scr, int lane) {
#pragma unroll 8
    for (int i = 0; i < 32; ++i) { const int kk = 2 * i + (lane >> 5); scr[kk * 33 + (lane & 31)] = src[(size_t)kk * ldsrc + (lane & 31)]; }
    LDS_WAIT(); asm volatile("" ::: "memory");
    const int c = lane & 7;
#pragma unroll
    for (int j = 0; j < 4; ++j) { const int n = (lane >> 3) + 8 * j; const LAS float* s = scr + (8 * c) * 33 + n;
        v4u o; o.x = pk2(s[0 * 33], s[1 * 33]); o.y = pk2(s[2 * 33], s[3 * 33]); o.z = pk2(s[4 * 33], s[5 * 33]); o.w = pk2(s[6 * 33], s[7 * 33]);
        *(v4u*)(dst + (size_t)n * lddst + 8 * c) = o; }
    LDS_WAIT(); asm volatile("" ::: "memory");
}
DI float reduce16(const float (&acc)[16], int lane) {
    float r8[8], r4[4], r2[2], r1;
    { const bool up = (lane & 32) != 0;
#pragma unroll
      for (int i = 0; i < 8; ++i) { const float mine = up ? acc[8 + i] : acc[i], other = up ? acc[i] : acc[8 + i]; r8[i] = mine + __shfl_xor(other, 32); } }
    { const bool up = (lane & 16) != 0;
#pragma unroll
      for (int i = 0; i < 4; ++i) { const float mine = up ? r8[4 + i] : r8[i], other = up ? r8[i] : r8[4 + i]; r4[i] = mine + __shfl_xor(other, 16); } }
    { const bool up = (lane & 8) != 0;
#pragma unroll
      for (int i = 0; i < 2; ++i) { const float mine = up ? r4[2 + i] : r4[i], other = up ? r4[i] : r4[2 + i]; r2[i] = mine + __shfl_xor(other, 8); } }
    { const bool up = (lane & 4) != 0; const float mine = up ? r2[1] : r2[0], other = up ? r2[0] : r2[1]; r1 = mine + __shfl_xor(other, 4); }
    r1 += __shfl_xor(r1, 1); r1 += __shfl_xor(r1, 2);
    return r1;
}
DI int reduce16_index(int lane) { return ((lane >> 5) & 1) * 8 + ((lane >> 4) & 1) * 4 + ((lane >> 3) & 1) * 2 + ((lane >> 2) & 1); }

DI void p0_prologue(Frame& F) {
    unsigned char* ws = F.a->ws;
    LAS float* scr = (LAS float*)(F.lds + F.wave * 16384);
    const int gw = F.blk * 8 + F.wave, NGW = F.G * 8, lane = F.lane;
    bf16* WIN = (bf16*)(ws + WS_WIN); bf16* WOUT = (bf16*)(ws + WS_WOUT);
    for (int it = gw; it < 1792 + 512; it += NGW) {
        if (it < 1792) { const int kb = it / 112, nb = it % 112, n0 = 32 * nb, k0 = 64 * kb, sc = n0 + (n0 >= 2048 ? 16 : 0);
            transpose_item(F.a->in[IN_WIN] + (size_t)k0 * PCOLS_IN + sc, PCOLS_IN, WIN + (size_t)n0 * 1024 + k0, 1024, scr, lane); }
        else { const int r = it - 1792, kb = r / 32, nb = r % 32, n0 = 32 * nb, k0 = 64 * kb;
            transpose_item(F.a->in[IN_WOUT] + (size_t)k0 * 1024 + n0, 1024, WOUT + (size_t)n0 * 1024 + k0, 1024, scr, lane); }
    }
    {
        float* HID2 = (float*)(ws + WS_HID2);
        const float* w1 = F.a->in[IN_HW1]; const float* w2 = F.a->in[IN_HW2];
        const float fr = F.a->in[IN_HFREQ][lane], b1 = F.a->in[IN_HB1][lane], b2 = F.a->in[IN_HB2][lane];
        for (int t = gw; t < SEQ; t += NGW) {
            float a1 = b1 + ((float)t * (1.f / 4095.f)) * w1[lane];
#pragma unroll 4
            for (int i = 0; i < 16; ++i) {
                const float band = 1e-4f + (float)i * ((15.f - 1e-4f) / 15.f);
                const float rev = band * (float)t * (1.f / 4096.f);
                const float fx = rev - floorf(rev);
                float sn, cs; sincospif(2.f * fx, &sn, &cs);
                a1 += cs * w1[(1 + i) * 64 + lane] - sn * w1[(17 + i) * 64 + lane];
            }
            const float h1 = sinf(fr * a1);
            float a2 = b2;
#pragma unroll 8
            for (int i = 0; i < 64; ++i) a2 += __shfl(h1, i) * w2[i * 64 + lane];
            HID2[t * 64 + lane] = sinf(fr * a2);
        }
    }
    { float* BIN2 = (float*)(ws + WS_BIN2); for (int n = F.blk * 512 + F.tid; n < NPROJ; n += F.G * 512) BIN2[n] = F.a->in[IN_BIN][n + (n >= 2048 ? 16 : 0)]; }
    __syncthreads();
    {
        LAS float* red = (LAS float*)F.lds; float* MOD = (float*)(ws + WS_MOD);
        const float* wada = F.a->in[IN_WADA]; const float* cvec = F.a->in[IN_C];
        for (int it = F.blk; it < 96; it += F.G) {
            const int col = 64 * it + lane; float acc[8];
#pragma unroll
            for (int b = 0; b < 8; ++b) acc[b] = 0.f;
            for (int k = F.wave * 128; k < F.wave * 128 + 128; ++k) { const float wv = wada[(size_t)k * 6144 + col];
#pragma unroll
                for (int b = 0; b < 8; ++b) acc[b] += cvec[b * 1024 + k] * wv; }
#pragma unroll
            for (int b = 0; b < 8; ++b) red[(F.wave * 8 + b) * 64 + lane] = acc[b];
            __syncthreads();
            { const int b = F.tid >> 6; float s = F.a->in[IN_BADA][col];
#pragma unroll
              for (int w = 0; w < 8; ++w) s += red[(w * 8 + b) * 64 + lane];
              MOD[b * 6144 + col] = s; }
            __syncthreads();
        }
    }
}

template <bool SECOND> DI void p_norm(Frame& F) {
    unsigned char* ws = F.a->ws; const int lane = F.lane;
    LAS float* Wt = (LAS float*)F.lds;
    for (int i = F.tid; i < 16384; i += 512) { const int k = i >> 4, g = i & 15; Wt[g * 1024 + k] = SECOND ? F.a->in[IN_WROUTER][k * 16 + g] : F.a->in[IN_WIN][(size_t)k * PCOLS_IN + 2048 + g]; }
    __syncthreads();
    const float* xin = SECOND ? (const float*)F.a->out : F.a->in[IN_X];
    const float* gvec = SECOND ? F.a->in[IN_GFFN] : F.a->in[IN_GMIX];
    const float* MOD = (const float*)(ws + WS_MOD);
    bf16* HO = (bf16*)(ws + (SECOND ? WS_HF : WS_H));
    const int gw = F.blk * 8 + F.wave, NGW = F.G * 8;
    for (int row = gw; row < MTOK; row += NGW) {
        const int b = row >> 12;
        const f32x4* xr = (const f32x4*)(xin + (size_t)row * 1024) + lane;
        f32x4 v[4]; float ss = 0.f;
#pragma unroll
        for (int j = 0; j < 4; ++j) { v[j] = xr[64 * j]; ss += (v[j].x * v[j].x + v[j].y * v[j].y) + (v[j].z * v[j].z + v[j].w * v[j].w); }
        const float rstd = rsqrtf(wave_sum(ss) * (1.f / 1024.f) + RMS_EPS);
        const float* mb = MOD + b * 6144 + (SECOND ? 3072 : 0);
#pragma unroll
        for (int j = 0; j < 4; ++j) { const int col = 256 * j + 4 * lane;
            const f32x4 g = *(const f32x4*)(gvec + col), sh = *(const f32x4*)(mb + col), sc = *(const f32x4*)(mb + 1024 + col);
            v[j] = v[j] * rstd * g * (sc + 1.f) + sh; }
        unsigned long long* o8 = (unsigned long long*)(HO + (size_t)row * 1024) + lane;
#pragma unroll
        for (int j = 0; j < 4; ++j) o8[64 * j] = (unsigned long long)pk2(v[j].x, v[j].y) | ((unsigned long long)pk2(v[j].z, v[j].w) << 32);
        float acc[16];
#pragma unroll
        for (int g = 0; g < 16; ++g) { float a = 0.f;
            if ((g & 3) == 0) asm volatile("" ::: "memory");
#pragma unroll
            for (int j = 0; j < 4; ++j) { const f32x4 w = *(const LAS f32x4*)(Wt + g * 1024 + 256 * j + 4 * lane); a += (v[j].x * w.x + v[j].y * w.y) + (v[j].z * w.z + v[j].w * w.w); }
            acc[g] = a; }
        const float val = reduce16(acc, lane); const int gi = reduce16_index(lane);
        if (!SECOND) { if ((lane & 3) == 0) ((float*)(ws + WS_GATES))[(size_t)row * 16 + gi] = val + F.a->in[IN_BIN][2048 + gi]; }
        else {
            float mx = val;
#pragma unroll
            for (int o = 4; o < 64; o <<= 1) mx = fmaxf(mx, __shfl_xor(mx, o));
            const float ex = __expf(val - mx); float sm = ex;
#pragma unroll
            for (int o = 4; o < 64; o <<= 1) sm += __shfl_xor(sm, o);
            if ((lane & 3) == 0) ((float*)(ws + WS_AFF))[((size_t)b * 16 + gi) * SEQ + (row & 4095)] = ex / sm;
        }
    }
}

DI void p3_prep(Frame& F) {
    unsigned char* ws = F.a->ws;
    const bf16* P = (const bf16*)(ws + WS_P);
    {
        bf16* QK = (bf16*)(ws + WS_H);
        const float* cw = F.a->in[IN_CQKW]; const float* cb = F.a->in[IN_CQKB];
        const int nthr = F.G * 512;
        for (int i = F.blk * 512 + F.tid; i < MTOK * 128; i += nthr) {
            const int token = i >> 7, cg = i & 127, t = token & 4095, c0 = 8 * cg;
            const bf16* p0 = P + (size_t)token * NPROJ + c0;
            const v4u cur = *(const v4u*)p0;
            v4u prv = (v4u){0u, 0u, 0u, 0u}, nxt = (v4u){0u, 0u, 0u, 0u};
            if (t > 0) prv = *(const v4u*)(p0 - NPROJ);
            if (t < SEQ - 1) nxt = *(const v4u*)(p0 + NPROJ);
            const float scale = (c0 >= 512) ? 0.08838834764831845f : 1.f;
            float o[8];
#pragma unroll
            for (int e = 0; e < 8; ++e) {
                const unsigned wp = prv[e >> 1], wc = cur[e >> 1], wn = nxt[e >> 1];
                const float xp = (e & 1) ? bfhi(wp) : bflo(wp), xc = (e & 1) ? bfhi(wc) : bflo(wc), xn = (e & 1) ? bfhi(wn) : bflo(wn);
                const int c = c0 + e;
                const float val = cb[c] + cw[c] * xp + cw[1024 + c] * xc + cw[2048 + c] * xn;
                o[e] = val * sigmoidf_(val) * scale;
            }
            v4u w; w.x = pk2(o[0], o[1]); w.y = pk2(o[2], o[3]); w.z = pk2(o[4], o[5]); w.w = pk2(o[6], o[7]);
            *(v4u*)(QK + (size_t)token * 1024 + c0) = w;
        }
    }
    {
        bf16* UT = (bf16*)(ws + WS_UT);
        LAS bf16* tile = (LAS bf16*)F.lds;
        const float* cw = F.a->in[IN_CHYW]; const float* cb = F.a->in[IN_CHYB];
        for (int u = F.blk; u < 4 * 64 * 24; u += F.G) {
            const int cgq = u % 24, tt = (u / 24) & 63, p = u / (24 * 64);
            for (int it = F.tid; it < 1024; it += 512) {
                const int cg8 = it & 7, tl = (it >> 3) & 63, bs = it >> 9;
                const int t = tt * 64 + tl, token = (2 * p + bs) * SEQ + t, hxc = cgq * 64 + cg8 * 8;
                const bf16* p0 = P + (size_t)token * NPROJ + 2048 + hxc;
                const v4u cur = *(const v4u*)p0;
                v4u prv = (v4u){0u, 0u, 0u, 0u}, nxt = (v4u){0u, 0u, 0u, 0u};
                if (t > 0) prv = *(const v4u*)(p0 - NPROJ);
                if (t < SEQ - 1) nxt = *(const v4u*)(p0 + NPROJ);
#pragma unroll
                for (int e = 0; e < 8; ++e) {
                    const unsigned wp = prv[e >> 1], wc = cur[e >> 1], wn = nxt[e >> 1];
                    const float xp = (e & 1) ? bfhi(wp) : bflo(wp), xc = (e & 1) ? bfhi(wc) : bflo(wc), xn = (e & 1) ? bfhi(wn) : bflo(wn);
                    const int c = hxc + e;
                    const float val = cb[c] + cw[c] * xp + cw[1536 + c] * xc + cw[3072 + c] * xn;
                    tile[((cg8 * 8 + e) * 64 + tl) * 2 + bs] = (bf16)f2bf(val);
                }
            }
            __syncthreads();
            for (int pc = F.tid; pc < 1024; pc += 512) {
                const int cl = pc >> 4, q = pc & 15, hxc = cgq * 64 + cl, part = hxc >> 9, c = hxc & 511;
                const v4u v = *(const LAS v4u*)(tile + cl * 128 + q * 8);
                *(v4u*)(UT + ((((size_t)part * 4 + p) * 512 + c) * SEQ + tt * 64) * 2 + q * 8) = v;
            }
            __syncthreads();
        }
    }
}

DI void p4_mlstm_seq(Frame& F) {
    unsigned char* ws = F.a->ws;
    constexpr int TB = 32;
    LAS float* qs = (LAS float*)F.lds; LAS float* ks = qs + TB * 128; LAS float* vs = ks + TB * 128; LAS float* ob = vs + TB * 128;
    LAS float* gi = ob + TB * 128; LAS float* gl = gi + TB;
    const bf16* QK = (const bf16*)(ws + WS_H); const bf16* P = (const bf16*)(ws + WS_P); const float* GATES = (const float*)(ws + WS_GATES);
    bf16* HM = (bf16*)(ws + WS_HM);
    const int tid = F.tid, v = tid >> 2, kq = tid & 3;
    for (int it = F.blk; it < 64; it += F.G) {
        const int b = it >> 3, h = (it >> 1) & 3, dir = it & 1;
        float C[32], n[32]; float m = -1e30f;
#pragma unroll
        for (int j = 0; j < 32; ++j) { C[j] = 0.f; n[j] = 0.f; }
        for (int tau0 = 0; tau0 < SEQ; tau0 += TB) {
#pragma unroll
            for (int r = 0; r < 3; ++r) {
                const int st = tid >> 4, ch = tid & 15, tau = tau0 + st, token = b * SEQ + (dir ? SEQ - 1 - tau : tau);
                const bf16* src = (r == 0) ? QK + (size_t)token * 1024 + h * 128 : (r == 1) ? QK + (size_t)token * 1024 + 512 + h * 128 : P + (size_t)token * NPROJ + 1024 + h * 128;
                const v4u w = *(const v4u*)(src + ch * 8);
                LAS float* d = ((r == 0) ? qs : (r == 1) ? ks : vs) + st * 128 + ch * 8;
                *(LAS f32x4*)d = (f32x4){bflo(w.x), bfhi(w.x), bflo(w.y), bfhi(w.y)};
                *(LAS f32x4*)(d + 4) = (f32x4){bflo(w.z), bfhi(w.z), bflo(w.w), bfhi(w.w)};
            }
            if (tid < TB) { const int tau = tau0 + tid, token = b * SEQ + (dir ? SEQ - 1 - tau : tau);
                const float ip = GATES[(size_t)token * 16 + 8 * dir + h], fp = GATES[(size_t)token * 16 + 8 * dir + 4 + h];
                gi[tid] = ip; gl[tid] = fminf(fp, 0.f) - log1pf(__expf(-fabsf(fp))); }
            __syncthreads();
            for (int s = 0; s < TB; ++s) {
                const float is = gi[s], lf = gl[s];
                const float mn = fmaxf(lf + m, is), fpr = __expf(lf + m - mn), ipr = __expf(is - mn); m = mn;
                const float iv = ipr * vs[s * 128 + v];
                float hv = 0.f, dn = 0.f;
#pragma unroll
                for (int j4 = 0; j4 < 8; ++j4) {
                    const f32x4 kk = *(const LAS f32x4*)(ks + s * 128 + 32 * kq + 4 * j4), qq = *(const LAS f32x4*)(qs + s * 128 + 32 * kq + 4 * j4);
#pragma unroll
                    for (int e = 0; e < 4; ++e) { const int j = 4 * j4 + e;
                        C[j] = fmaf(iv, kk[e], fpr * C[j]); n[j] = fmaf(ipr, kk[e], fpr * n[j]);
                        hv = fmaf(C[j], qq[e], hv); dn = fmaf(n[j], qq[e], dn); }
                }
                hv += __shfl_xor(hv, 1); hv += __shfl_xor(hv, 2); dn += __shfl_xor(dn, 1); dn += __shfl_xor(dn, 2);
                if (kq == 0) ob[s * 128 + v] = hv / fmaxf(fabsf(dn), __expf(-m));
            }
            __syncthreads();
            { const int st = tid >> 4, ch = tid & 15, tau = tau0 + st, token = b * SEQ + (dir ? SEQ - 1 - tau : tau);
              const f32x4 a = *(const LAS f32x4*)(ob + st * 128 + ch * 8), c2 = *(const LAS f32x4*)(ob + st * 128 + ch * 8 + 4);
              v4u w; w.x = pk2(a.x, a.y); w.y = pk2(a.z, a.w); w.z = pk2(c2.x, c2.y); w.w = pk2(c2.z, c2.w);
              *(v4u*)(HM + ((size_t)dir * MTOK + token) * 512 + h * 128 + ch * 8) = w; }
            __syncthreads();
        }
    }
}

#define LAUNDER(x) asm volatile("" : "+v"(x))
DI float filt_tap(const float* HID2, const LAS float* w3s, int t, float adelta) {
    const f32x4* hr = (const f32x4*)(HID2 + (size_t)t * 64); float s = 0.f;
#pragma unroll
    for (int i = 0; i < 16; ++i) { const f32x4 hh = hr[i]; s += (hh.x * w3s[4 * i] + hh.y * w3s[4 * i + 1]) + (hh.z * w3s[4 * i + 2] + hh.w * w3s[4 * i + 3]); }
    return s * (__expf(-(float)t * (1.f / 4095.f) * adelta) + 0.05f);
}
template <int HH> DI void hy_finalize(const cf2 (&u)[16], LAS cf2* X, LAS cf2* Z1, const unsigned* Uz, const unsigned* Ux1, const unsigned* Ux2, unsigned* zt, int lo_, int o, float bias) {
#pragma unroll
    for (int j = 0; j < 8; ++j) {
        const int t = (8 * HH + j) * 256 + lo_;
        const cf2 mine = u[8 * HH + j];
        const cf2 oth = X[fphys((HH ? 0 : 4096) + t)];
        const cf2 y = MK2(mine.x + oth.x, mine.y + oth.y);
        if (o == 0) { const unsigned wz = Uz[t], w1 = Ux1[t];
            Z1[t] = MK2(bflo(w1) * (y.x + bias * bflo(wz)), bfhi(w1) * (y.y + bias * bfhi(wz))); }
        else { const unsigned w2 = Ux2[t]; const cf2 z1 = Z1[t];
            zt[t] = pk2(bflo(w2) * (y.x + bias * z1.x), bfhi(w2) * (y.y + bias * z1.y)); }
    }
}
DI void p4_hyena(Frame& F) {
    unsigned char* ws = F.a->ws; const int tid = F.tid, H = tid >> 8, lo = tid & 255;
    LAS cf2* X = (LAS cf2*)F.lds;
    LAS cf2* Z1 = (LAS cf2*)(F.lds + 69632);
    LAS cf2* TW4 = (LAS cf2*)(F.lds + 102400); LAS cf2* TW8 = TW4 + 256;
    LAS float* W3S = (LAS float*)(F.lds + 106496);
    const float* HID2 = (const float*)(ws + WS_HID2);
    cf2* KG = (cf2*)(ws + WS_KSP) + (size_t)F.blk * 16384;
    const unsigned* UT = (const unsigned*)(ws + WS_UT); unsigned* ZT = (unsigned*)(ws + WS_ZT);
    if (tid < 256) { float sn, cs; sincospif((float)tid * (1.f / 2048.f), &sn, &cs); TW4[tid] = MK2(cs, -sn); sincospif((float)tid * (1.f / 4096.f), &sn, &cs); TW8[tid] = MK2(cs, -sn); }
    __syncthreads();
    LAS float* TS = (LAS float*)Z1;
    for (int c = F.blk; c < 512; c += F.G) {
        for (int o = 0; o < 2; ++o) {
            if (tid < 128) { const int d = tid >> 6, j = tid & 63; W3S[tid] = F.a->in[IN_HW3][(size_t)j * 2048 + (o * 2 + d) * 512 + c]; }
            __syncthreads();
            const float adf = fabsf(F.a->in[IN_HDELTA][(o * 2) * 512 + c]), adb = fabsf(F.a->in[IN_HDELTA][(o * 2 + 1) * 512 + c]);
#pragma unroll 1
            for (int n = tid; n < 8192; n += 512) {
                float val;
                if (n < SEQ) { val = filt_tap(HID2, W3S, n, adf); if (n == 0) val += filt_tap(HID2, W3S + 64, 0, adb); }
                else if (n == SEQ) val = 0.f;
                else val = filt_tap(HID2, W3S + 64, 2 * SEQ - n, adb);
                TS[n] = val;
            }
            __syncthreads();
            {
                int tl = tid; LAUNDER(tl); const int lo_ = tl & 255;
                cf2 a[16], b[16];
#pragma unroll
                for (int k = 0; k < 16; ++k) { a[k] = MK2(TS[k * 256 + lo_], 0.f); b[k] = MK2(TS[SEQ + k * 256 + lo_], 0.f); }
                fft_passA_fwd(tl, a, b, X, TW4, TW8);
            }
            __syncthreads();
            { int tl = tid; LAUNDER(tl); fft_passB_fwd(tl, X, TW4); }
            __syncthreads();
            { int tl = tid; LAUNDER(tl); cf2 v[16]; fft_passC_fwd(tl, X, v);
              cf2* kg = KG + o * 8192 + tl;
#pragma unroll
              for (int r = 0; r < 16; ++r) kg[r * 512] = MK2(v[r].x * (1.f / 8192.f), v[r].y * (1.f / 8192.f)); }
            __syncthreads();
        }
        const float bias0 = F.a->in[IN_HBIAS][c], bias1 = F.a->in[IN_HBIAS][512 + c];
#pragma unroll 1
        for (int p = 0; p < 4; ++p) {
            const unsigned* Ux1 = UT + (((size_t)0 * 4 + p) * 512 + c) * SEQ; const unsigned* Ux2 = UT + (((size_t)1 * 4 + p) * 512 + c) * SEQ; const unsigned* Uz = UT + (((size_t)2 * 4 + p) * 512 + c) * SEQ;
#pragma unroll 1
            for (int o = 0; o < 2; ++o) {
                { int tl = tid; LAUNDER(tl); const int lo_ = tl & 255;
                    cf2 a[16], b[16];
#pragma unroll
                    for (int k = 0; k < 16; ++k) {
                        if (o == 0) { const unsigned w = Uz[k * 256 + lo_]; a[k] = MK2(bflo(w), bfhi(w)); } else a[k] = Z1[k * 256 + lo_];
                        b[k] = MK2(0.f, 0.f); }
                    fft_passA_fwd(tl, a, b, X, TW4, TW8);
                }
                __syncthreads();
                { int tl = tid; LAUNDER(tl); fft_passB_fwd(tl, X, TW4); }
                __syncthreads();
                { int tl = tid; LAUNDER(tl); cf2 v[16]; fft_passC_fwd(tl, X, v);
                  const cf2* kg = KG + o * 8192 + tl;
#pragma unroll
                  for (int r = 0; r < 16; ++r) v[r] = c_mul(v[r], kg[r * 512]);
                  fft_passC_inv(tl, X, v); }
                __syncthreads();
                { int tl = tid; LAUNDER(tl); fft_passB_inv(tl, X, TW4); }
                __syncthreads();
                {
                    int tl = tid; LAUNDER(tl); const int H_ = tl >> 8, lo_ = tl & 255;
                    cf2 u[16]; fft_passA_inv(tl, X, TW4, TW8, u);
                    if (H_ == 0) {
#pragma unroll
                        for (int k = 8; k < 16; ++k) X[fphys(k * 256 + lo_)] = u[k];
                    } else {
#pragma unroll
                        for (int k = 0; k < 8; ++k) X[fphys(4096 + k * 256 + lo_)] = u[k];
                    }
                    __syncthreads();
                    const float bias = (o == 0) ? bias0 : bias1;
                    if (H_ == 0) hy_finalize<0>(u, X, Z1, Uz, Ux1, Ux2, ZT + ((size_t)p * 512 + c) * SEQ, lo_, o, bias);
                    else hy_finalize<1>(u, X, Z1, Uz, Ux1, Ux2, ZT + ((size_t)p * 512 + c) * SEQ, lo_, o, bias);
                }
                __syncthreads();
            }
        }
    }
}

DI void p5_post(Frame& F) {
    unsigned char* ws = F.a->ws; const int lane = F.lane;
    bf16* Y = (bf16*)(ws + WS_H); const bf16* P = (const bf16*)(ws + WS_P); const bf16* HM = (const bf16*)(ws + WS_HM);
    {
        const int gw = F.blk * 8 + F.wave, NGW = F.G * 8;
        const f32x4 g0 = *(const f32x4*)(F.a->in[IN_MNG] + 8 * lane), g1 = *(const f32x4*)(F.a->in[IN_MNG] + 8 * lane + 4);
        for (int row = gw; row < MTOK; row += NGW) {
            const v4u a = *(const v4u*)(HM + (size_t)row * 512 + 8 * lane), bq = *(const v4u*)(HM + ((size_t)MTOK + row) * 512 + 8 * lane);
            const v4u ov = *(const v4u*)(P + (size_t)row * NPROJ + 1536 + 8 * lane);
            float hsum[8], og[8];
#pragma unroll
            for (int e = 0; e < 4; ++e) { hsum[2 * e] = bflo(a[e]) + bflo(bq[e]); hsum[2 * e + 1] = bfhi(a[e]) + bfhi(bq[e]); og[2 * e] = bflo(ov[e]); og[2 * e + 1] = bfhi(ov[e]); }
            float ss = 0.f;
#pragma unroll
            for (int e = 0; e < 8; ++e) ss += hsum[e] * hsum[e];
            ss += __shfl_xor(ss, 1); ss += __shfl_xor(ss, 2); ss += __shfl_xor(ss, 4); ss += __shfl_xor(ss, 8);
            const float rstd = rsqrtf(ss * (1.f / 128.f) + RMS_EPS);
            const float gg[8] = {g0.x, g0.y, g0.z, g0.w, g1.x, g1.y, g1.z, g1.w};
            float o[8];
#pragma unroll
            for (int e = 0; e < 8; ++e) o[e] = sigmoidf_(og[e]) * hsum[e] * rstd * gg[e];
            v4u w; w.x = pk2(o[0], o[1]); w.y = pk2(o[2], o[3]); w.z = pk2(o[4], o[5]); w.w = pk2(o[6], o[7]);
            *(v4u*)(Y + (size_t)row * 1024 + 8 * lane) = w;
        }
    }
    {
        const bf16* ZT = (const bf16*)(ws + WS_ZT);
        LAS bf16* tile = (LAS bf16*)F.lds;
        const f32x4 g0 = *(const f32x4*)(F.a->in[IN_HNG] + 8 * lane), g1 = *(const f32x4*)(F.a->in[IN_HNG] + 8 * lane + 4);
        const float gg[8] = {g0.x, g0.y, g0.z, g0.w, g1.x, g1.y, g1.z, g1.w};
        __syncthreads();
        for (int u = F.blk; u < 4 * 128; u += F.G) {
            const int p = u >> 7, tt = u & 127;
            for (int pc = F.tid; pc < 4096; pc += 512) {
                const int c = pc >> 3, q = pc & 7;
                const v4u v = *(const v4u*)(ZT + (((size_t)p * 512 + c) * SEQ + tt * 32) * 2 + q * 8);
#pragma unroll
                for (int i = 0; i < 4; ++i) { tile[((4 * q + i) * 2 + 0) * 520 + c] = (bf16)(v[i] & 0xffffu); tile[((4 * q + i) * 2 + 1) * 520 + c] = (bf16)(v[i] >> 16); }
            }
            __syncthreads();
#pragma unroll 2
            for (int rr = 0; rr < 8; ++rr) {
                const int row = F.wave * 8 + rr, t = row >> 1, bs = row & 1, token = (2 * p + bs) * SEQ + tt * 32 + t;
                const v4u v = *(const LAS v4u*)(tile + row * 520 + 8 * lane);
                float z[8];
#pragma unroll
                for (int e = 0; e < 4; ++e) { z[2 * e] = bflo(v[e]); z[2 * e + 1] = bfhi(v[e]); }
                float ss = 0.f;
#pragma unroll
                for (int e = 0; e < 8; ++e) ss += z[e] * z[e];
                ss += __shfl_xor(ss, 1); ss += __shfl_xor(ss, 2); ss += __shfl_xor(ss, 4); ss += __shfl_xor(ss, 8);
                const float rstd = rsqrtf(ss * (1.f / 128.f) + RMS_EPS);
                v4u w; w.x = pk2(z[0] * rstd * gg[0], z[1] * rstd * gg[1]); w.y = pk2(z[2] * rstd * gg[2], z[3] * rstd * gg[3]);
                w.z = pk2(z[4] * rstd * gg[4], z[5] * rstd * gg[5]); w.w = pk2(z[6] * rstd * gg[6], z[7] * rstd * gg[7]);
                *(v4u*)(Y + (size_t)token * 1024 + 512 + 8 * lane) = w;
            }
            __syncthreads();
        }
    }
}

DI void conv_wgu(Frame& F) {
    LAS float* scr = (LAS float*)(F.lds + F.wave * 16384); bf16* WGU = (bf16*)(F.a->ws + WS_WGU);
    const int gw = F.blk * 8 + F.wave, NGW = F.G * 8;
    for (int it = gw; it < 16 * 16 * 128; it += NGW) {
        const int nb = it & 127, kb = (it >> 7) & 15, e = it >> 11, n0 = 32 * nb, k0 = 64 * kb, j = n0 >> 8, r = n0 & 255, f0 = 128 * j + (r & 127);
        const float* W = (r < 128 ? F.a->in[IN_WGATE] : F.a->in[IN_WUP]) + (size_t)e * 1024 * 2048;
        transpose_item(W + (size_t)k0 * 2048 + f0, 2048, WGU + ((size_t)e * 4096 + n0) * 1024 + k0, 1024, scr, F.lane);
    }
}
DI void conv_wd(Frame& F) {
    LAS float* scr = (LAS float*)(F.lds + F.wave * 16384); bf16* WD = (bf16*)(F.a->ws + WS_WD);
    const int gw = F.blk * 8 + F.wave, NGW = F.G * 8;
    for (int it = gw; it < 16 * 32 * 32; it += NGW) {
        const int nb = it & 31, kb = (it >> 5) & 31, e = it >> 10, n0 = 32 * nb, k0 = 64 * kb;
        transpose_item(F.a->in[IN_WDOWN] + (size_t)e * 2048 * 1024 + (size_t)k0 * 1024 + n0, 1024, WD + ((size_t)e * 1024 + n0) * 2048 + k0, 2048, scr, F.lane);
    }
}

DI void p8_topk(Frame& F) {
    unsigned char* ws = F.a->ws; const int tid = F.tid, lane = F.lane, wave = F.wave;
    LAS unsigned* hist = (LAS unsigned*)F.lds;
    LAS unsigned* wtot = hist + 256;
    LAS unsigned* ctl = wtot + 8;
    LAS int* sel = (LAS int*)(ctl + 8);
    const float* AFF = (const float*)(ws + WS_AFF); const bf16* HF = (const bf16*)(ws + WS_HF); bf16* XS = (bf16*)(ws + WS_XS);
    int* IDX = (int*)(ws + WS_IDX); float* GSEL = (float*)(ws + WS_GSEL); int* INV = (int*)(ws + WS_INV);
    for (int it = F.blk; it < NB * NEXP; it += F.G) {
        const int b = it >> 4, e = it & 15;
        unsigned k8[8];
        { const v4u a = *(const v4u*)(AFF + (size_t)it * SEQ + 8 * tid), c2 = *(const v4u*)(AFF + (size_t)it * SEQ + 8 * tid + 4);
          k8[0] = a.x; k8[1] = a.y; k8[2] = a.z; k8[3] = a.w; k8[4] = c2.x; k8[5] = c2.y; k8[6] = c2.z; k8[7] = c2.w; }
        unsigned prefix = 0u, need = CAP;
#pragma unroll 1
        for (int pass = 0; pass < 4; ++pass) {
            const int shift = 24 - 8 * pass; const unsigned mask = pass ? (0xffffffffu << (shift + 8)) : 0u;
            if (tid < 256) hist[tid] = 0u;
            __syncthreads();
#pragma unroll
            for (int i = 0; i < 8; ++i) if ((k8[i] & mask) == prefix) atomicAdd((unsigned*)(hist + ((k8[i] >> shift) & 255u)), 1u);
            __syncthreads();
            if (wave == 0) {
                const unsigned h0 = hist[4 * lane], h1 = hist[4 * lane + 1], h2 = hist[4 * lane + 2], h3 = hist[4 * lane + 3], s = h0 + h1 + h2 + h3;
                unsigned suf = s;
#pragma unroll
                for (int o = 1; o < 64; o <<= 1) { const unsigned t = __shfl_down(suf, o); if (lane + o < 64) suf += t; }
                const unsigned above = suf - s;
                if (above < need && need <= suf) {
                    unsigned rem = need - above; int bin;
                    if (h3 >= rem) bin = 3; else { rem -= h3; if (h2 >= rem) bin = 2; else { rem -= h2; if (h1 >= rem) bin = 1; else { rem -= h1; bin = 0; } } }
                    ctl[0] = prefix | ((unsigned)(4 * lane + bin) << shift); ctl[1] = rem;
                }
            }
            __syncthreads();
            prefix = ctl[0]; need = ctl[1];
        }
        const unsigned T = prefix;
        unsigned cg = 0u, ce = 0u;
#pragma unroll
        for (int i = 0; i < 8; ++i) { cg += (k8[i] > T) ? 1u : 0u; ce += (k8[i] == T) ? 1u : 0u; }
        const unsigned pack = cg | (ce << 16);
        unsigned inc = pack;
#pragma unroll
        for (int o = 1; o < 64; o <<= 1) { const unsigned t = __shfl_up(inc, o); if (lane >= o) inc += t; }
        if (lane == 63) wtot[wave] = inc;
        __syncthreads();
        unsigned woff = 0u;
#pragma unroll
        for (int w = 0; w < 8; ++w) woff += (w < wave) ? wtot[w] : 0u;
        const unsigned exc = woff + inc - pack;
        unsigned gtb = exc & 0xffffu, eqb = exc >> 16;
#pragma unroll
        for (int i = 0; i < 8; ++i) {
            const int idx = 8 * tid + i; const bool isgt = k8[i] > T, iseq = k8[i] == T, selc = isgt || (iseq && eqb < need);
            const int slot = (int)(gtb + (eqb < need ? eqb : need));
            if (selc) { sel[slot] = idx; IDX[it * CAP + slot] = idx; GSEL[it * CAP + slot] = __uint_as_float(k8[i]); }
            INV[((size_t)b * SEQ + idx) * 16 + e] = selc ? slot : -1;
            gtb += isgt ? 1u : 0u; eqb += iseq ? 1u : 0u;
        }
        __syncthreads();
        for (int s = wave; s < CAP; s += 8) {
            const int row = sel[s];
            const v4u* src = (const v4u*)(HF + ((size_t)b * SEQ + row) * 1024); v4u* dst = (v4u*)(XS + (((size_t)e * NB + b) * CAP + s) * 1024);
            const v4u x0 = src[lane], x1 = src[lane + 64]; dst[lane] = x0; dst[lane + 64] = x1;
        }
        __syncthreads();
    }
}

DI void p12_final(Frame& F) {
    unsigned char* ws = F.a->ws; const int lane = F.lane;
    const int* INV = (const int*)(ws + WS_INV); const float* GSEL = (const float*)(ws + WS_GSEL); const bf16* YS = (const bf16*)(ws + WS_YS); const float* MOD = (const float*)(ws + WS_MOD);
    const int gw = F.blk * 8 + F.wave, NGW = F.G * 8;
    for (int row = gw; row < MTOK; row += NGW) {
        const int b = row >> 12;
        f32x4* xr = (f32x4*)(F.a->out + (size_t)row * 1024) + lane;
        f32x4 v[4], acc[4];
#pragma unroll
        for (int j = 0; j < 4; ++j) { v[j] = xr[64 * j]; acc[j] = (f32x4){0.f, 0.f, 0.f, 0.f}; }
        const int myslot = INV[(size_t)row * 16 + (lane & 15)];
#pragma unroll 1
        for (int e = 0; e < 16; ++e) {
            const int s = __shfl(myslot, e);
            if (s >= 0) {
                const float g = GSEL[((size_t)b * 16 + e) * CAP + s];
                const v2u* yr = (const v2u*)(YS + (((size_t)e * NB + b) * CAP + s) * 1024) + lane;
#pragma unroll
                for (int j = 0; j < 4; ++j) { const v2u w = yr[64 * j]; acc[j] += (f32x4){bflo(w.x), bfhi(w.x), bflo(w.y), bfhi(w.y)} * g; }
            }
        }
        float ss = 0.f;
#pragma unroll
        for (int j = 0; j < 4; ++j) { const f32x4 gt = *(const f32x4*)(MOD + b * 6144 + 5120 + 256 * j + 4 * lane); v[j] = v[j] + gt * acc[j]; ss += (v[j].x * v[j].x + v[j].y * v[j].y) + (v[j].z * v[j].z + v[j].w * v[j].w); }
        const float rstd = rsqrtf(wave_sum(ss) * (1.f / 1024.f) + RMS_EPS);
#pragma unroll
        for (int j = 0; j < 4; ++j) { const f32x4 g = *(const f32x4*)(F.a->in[IN_GFINAL] + 256 * j + 4 * lane); xr[64 * j] = v[j] * rstd * g; }
    }
}

__global__ void __launch_bounds__(512, 2) fwd_kernel(Args args) {
    extern __shared__ __attribute__((aligned(16))) unsigned char lds[];
    Frame F;
    F.lds = (LAS unsigned char*)lds;
    F.tid = threadIdx.x; F.lane = F.tid & 63; F.wave = __builtin_amdgcn_readfirstlane(F.tid >> 6);
    F.G = gridDim.x; F.blk = blockIdx.x;
    F.a = &args;
    volatile LAS unsigned* MISC = (volatile LAS unsigned*)(F.lds + MISC_OFF);
    if (F.tid < 64) MISC[F.tid] = 0u;
    __syncthreads();
    XcdBarrier bar; bar.bar = (unsigned*)(F.a->ws + WS_CTL); bar.x = 0; bar.st = nullptr;
    if (N_LAUNCHES == 1) bar = xcd_barrier_post((unsigned*)(F.a->ws + WS_CTL), MISC + 8);
    const int lo = args.ph_lo, hi = args.ph_hi;
#define IN(k) (lo <= (k) && (k) < hi)
#define SEAM(k) do { if (IN(k) && IN((k) + 1)) xcd_barrier(bar); } while (0)
    unsigned char* ws = F.a->ws;
    if (IN(0)) { p0_prologue(F); } SEAM(0);
    if (IN(1)) { p_norm<false>(F); } SEAM(1);
    if (IN(2)) {
        pg8::Gemm g{(const pg8::bf16_t*)(ws + WS_H), (const pg8::bf16_t*)(ws + WS_WIN), MTOK, NPROJ, DM}; pg8::StaticOrder S; S.init(MTOK, NPROJ, F.G, F.blk);
        pg8::EpiBf16<0> E{(pg8::bf16_t*)(ws + WS_P), NPROJ, (const float*)(ws + WS_BIN2), 0, 0, 1.f};
        pg8::gemm_phase<pg8::EpiBf16<0>, pg8::StaticOrder, true, true>(F.lds, g, S, E);
    } SEAM(2);
    if (IN(3)) { p3_prep(F); } SEAM(3);
    if (IN(4)) { p4_hyena(F); __syncthreads(); p4_mlstm_seq(F); } SEAM(4);
    if (IN(5)) { p5_post(F); } SEAM(5);
    if (IN(6)) {
        pg8::Gemm g{(const pg8::bf16_t*)(ws + WS_H), (const pg8::bf16_t*)(ws + WS_WOUT), MTOK, DM, DM}; pg8::StaticOrder S; S.init(MTOK, DM, F.G, F.blk);
        pg8::EpiRes E{F.a->in[IN_X], F.a->out, (const float*)(ws + WS_MOD)};
        pg8::gemm_phase<pg8::EpiRes, pg8::StaticOrder, true, true>(F.lds, g, S, E);
    } SEAM(6);
    if (IN(7)) { p_norm<true>(F); __syncthreads(); conv_wgu(F); } SEAM(7);
    if (IN(8)) { p8_topk(F); } SEAM(8);
    if (IN(9)) {
        pg8::Gemm g{(const pg8::bf16_t*)(ws + WS_XS), (const pg8::bf16_t*)(ws + WS_WGU), NSLOT, NEXP * 4096, DM}; pg8::MoeOrderA S{F.G, F.blk};
        pg8::EpiSwiGLU E{(pg8::bf16_t*)(ws + WS_HID)};
        pg8::gemm_phase<pg8::EpiSwiGLU, pg8::MoeOrderA, true, true>(F.lds, g, S, E);
    } SEAM(9);
    if (IN(10)) { conv_wd(F); } SEAM(10);
    if (IN(11)) {
        pg8::Gemm g{(const pg8::bf16_t*)(ws + WS_HID), (const pg8::bf16_t*)(ws + WS_WD), NSLOT, NEXP * 1024, FFD}; pg8::MoeOrderB S{F.G, F.blk};
        pg8::EpiYs E{(pg8::bf16_t*)(ws + WS_YS)};
        pg8::gemm_phase<pg8::EpiYs, pg8::MoeOrderB, true, true>(F.lds, g, S, E);
    } SEAM(11);
    if (IN(12)) { p12_final(F); }
#undef IN
#undef SEAM
}

extern "C" void kernel_launch(void* const* d_in, const int* in_sizes, int n_in, void* d_out, int out_size, void* d_ws, size_t ws_size, hipStream_t stream) {
    static int grid = 0;
    if (grid == 0) {
        if (n_in != 28 || out_size != MTOK * DM || ws_size < WS_END) { fprintf(stderr, "kernel_launch: unexpected shapes (n_in %d, out %d, ws %zu < %zu)\n", n_in, out_size, ws_size, (size_t)WS_END); grid = -1; return; }
        int dev = 0, cus = 0;
        if (hipGetDevice(&dev) != hipSuccess || hipDeviceGetAttribute(&cus, hipDeviceAttributeMultiprocessorCount, dev) != hipSuccess) { grid = -1; return; }
        if (hipFuncSetAttribute((const void*)fwd_kernel, hipFuncAttributeMaxDynamicSharedMemorySize, LDS_BYTES) != hipSuccess) { fprintf(stderr, "kernel_launch: hipFuncSetAttribute failed\n"); grid = -1; return; }
        int per_cu = 0;
        if (hipOccupancyMaxActiveBlocksPerMultiprocessor(&per_cu, (const void*)fwd_kernel, 512, LDS_BYTES) != hipSuccess || per_cu < 1) fprintf(stderr, "kernel_launch: occupancy query reports %d\n", per_cu);
        (void)hipGetLastError();
        grid = cus > 256 ? 256 : cus;
    }
    if (grid < 0) return;
    (void)hipMemsetAsync((char*)d_ws + WS_CTL, 0, CTL_ZERO_BYTES, stream);
    Args a{};
    for (int i = 0; i < 28; ++i) a.in[i] = (const float*)d_in[i];
    a.out = (float*)d_out; a.ws = (unsigned char*)d_ws;
    if (N_LAUNCHES == 1) { a.ph_lo = 0; a.ph_hi = N_PHASES; hipLaunchKernelGGL(fwd_kernel, dim3(grid), dim3(512), LDS_BYTES, stream, a); }
    else for (int p = 0; p < N_PHASES; ++p) { a.ph_lo = p; a.ph_hi = p + 1; hipLaunchKernelGGL(fwd_kernel, dim3(grid), dim3(512), LDS_BYTES, stream, a); }
}
```

```cpp
#include <hip/hip_runtime.h>
#include <cstdio>
#include <cstdint>
#define N_LAUNCHES 1
namespace pg8 {
#define PG8_LAS __attribute__((address_space(3)))
typedef unsigned short bf16_t;
typedef short bf16x8 __attribute__((ext_vector_type(8)));
typedef float f32x4 __attribute__((ext_vector_type(4)));
typedef unsigned u32x4 __attribute__((ext_vector_type(4)));
constexpr int BM = 256, BK = 64, HALF = 128, HTB = HALF * BK * 2  , STAGE_BYTES = 8 * HTB, NXCD = 8, WGM = 8;

__host__ __device__ __forceinline__ int lds_byte(int r, int c) { const int st = (r >> 4) * 2 + (c >> 5), rr = r & 15, cc = c & 31, ob = rr * 64 + cc * 2; return st * 1024 + (ob ^ (((ob >> 9) & 1) << 5)); }
__host__ __device__ __forceinline__ void stage_rc(int b, int& R, int& C) { const int st = b / 1024, sb = b % 1024, swz = sb ^ (((sb >> 9) & 1) << 5); R = (st >> 1) * 16 + swz / 64; C = (st & 1) * 32 + (swz % 64) / 2; }
__host__ __device__ __forceinline__ int perm32(int rho) { const int n = rho >> 4, i = rho & 15; return 8 * (i >> 2) + 4 * n + (i & 3); }

struct Unit { int pm, pn; };
struct Gemm { const bf16_t* A; const bf16_t* Bt; int M, N, K; };

struct StaticOrder {
    int nM, nN, nwg, G, c;
    __host__ __device__ void init(int M, int N, int G_, int c_) { nM = M / BM; nN = N / BM; nwg = nM * nN; G = G_; c = c_; }
    __host__ __device__ bool next(int i, Unit& u) const {
        const long L = (long)i * G + c; if (L >= nwg) return false;
        int wgid = (int)L; { const int q = nwg / NXCD, r = nwg % NXCD, xcd = wgid % NXCD, off = wgid / NXCD; wgid = (xcd < r ? xcd * (q + 1) : r * (q + 1) + (xcd - r) * q) + off; }
        const int nig = WGM * nN, gid = wgid / nig, fm = gid * WGM, gsz = (nM - fm) < WGM ? (nM - fm) : WGM;
        u.pm = fm + ((wgid % nig) % gsz); u.pn = (wgid % nig) / gsz; return true;
    }
    __device__ __forceinline__ void a_ready(const Unit&) const {}
    __device__ __forceinline__ void done(const Unit&) const {}
};

__device__ __forceinline__ unsigned cvt_pk_bf16(float lo, float hi) { unsigned r; asm volatile("v_cvt_pk_bf16_f32 %0, %1, %2" : "=v"(r) : "v"(lo), "v"(hi)); return r; }
typedef float f32x2 __attribute__((ext_vector_type(2)));
__device__ __forceinline__ f32x2 gelu_pk(f32x2 v) {
    const f32x2 av = __builtin_elementwise_abs(v), d = av * 0.2316418882f + 1.0f;
    f32x2 t; t.x = __builtin_amdgcn_rcpf(d.x); t.y = __builtin_amdgcn_rcpf(d.y);
    f32x2 q = t * 0.5307027145f + (-0.7265760135f); q = q * t + 0.7107068705f; q = q * t + (-0.142248368f); q = q * t + 0.127414796f; q = q * t;
    const f32x2 s = (v * v) * (-0.72134752044f);
    f32x2 e; e.x = __builtin_amdgcn_exp2f(s.x); e.y = __builtin_amdgcn_exp2f(s.y);
    const f32x2 m = v * (q * e), r = v - m;
    f32x2 o; o.x = v.x < 0.f ? m.x : r.x; o.y = v.y < 0.f ? m.y : r.y; return o;
}

template <int ACT  > struct EpiBf16 {
    static constexpr bool PERM = true, AFTER_DRAIN = false; static_assert(ACT == 0 || ACT == 1, "EpiBf16: ACT is 0 (none) or 1 (gelu_pk)");
    bf16_t* O; int ldc; const float* bias; int split_cols; size_t split_stride; float scale0;
    __device__ __forceinline__ void operator()(const f32x4 (&acc)[2][2][4][2], const Unit& u, int wr, int wc, int fr, int fq) const {
        const int row0 = u.pm * BM + wr * 64 + fr; int colt = u.pn * BM; bf16_t* base = O;
        float sc = 1.f; if (split_cols) { const int t = colt / split_cols; base += (size_t)t * split_stride; colt -= t * split_cols; if (t == 0) sc = scale0; }
        const int col0 = colt + wc * 32 + 8 * fq, bcol0 = u.pn * BM + wc * 32 + 8 * fq;
        f32x4 bv[2][2];
#pragma unroll
        for (int bj = 0; bj < 2; ++bj)
#pragma unroll
            for (int n = 0; n < 2; ++n) bv[bj][n] = bias ? *(const f32x4*)(bias + bcol0 + bj * HALF + 4 * n) : (f32x4){0.f, 0.f, 0.f, 0.f};
#pragma unroll
        for (int ai = 0; ai < 2; ++ai)
#pragma unroll
            for (int m = 0; m < 4; ++m) { bf16_t* rowp = base + (size_t)(row0 + ai * HALF + m * 16) * ldc + col0;
#pragma unroll
                for (int bj = 0; bj < 2; ++bj) { f32x4 v0 = acc[ai][bj][m][0] + bv[bj][0], v1 = acc[ai][bj][m][1] + bv[bj][1];
                    if (ACT == 1) { f32x2 a = gelu_pk((f32x2){v0[0], v0[1]}), b = gelu_pk((f32x2){v0[2], v0[3]}), c = gelu_pk((f32x2){v1[0], v1[1]}), d = gelu_pk((f32x2){v1[2], v1[3]});
                        v0 = (f32x4){a.x, a.y, b.x, b.y}; v1 = (f32x4){c.x, c.y, d.x, d.y}; }
                    v0 = v0 * sc; v1 = v1 * sc; u32x4 w; w.x = cvt_pk_bf16(v0[0], v0[1]); w.y = cvt_pk_bf16(v0[2], v0[3]); w.z = cvt_pk_bf16(v1[0], v1[1]); w.w = cvt_pk_bf16(v1[2], v1[3]);
                    *(u32x4*)(rowp + bj * HALF) = w; } }
    }
};


template <class Epi, class Sched, bool ALIGN_EPI = false, bool SP2 = false>
__device__ __forceinline__ void gemm_phase(PG8_LAS unsigned char* lds, const Gemm g, const Sched& S, const Epi& E) {
    const int tid = threadIdx.x, wid = __builtin_amdgcn_readfirstlane(tid >> 6), lane = tid & 63, wr = wid >> 2, wc = wid & 3, fr = lane & 15, fq = lane >> 4;
    const int K = g.K, nt = K / BK;
    unsigned voffA[2], voffB[2];
#pragma unroll
    for (int i = 0; i < 2; ++i) { int R, C; stage_rc(tid * 16 + i * 8192, R, C); const int Rb = Epi::PERM ? ((R & ~31) + perm32(R & 31)) : R;
        voffA[i] = (unsigned)(R * K + C) * 2u; voffB[i] = (unsigned)(Rb * K + C) * 2u; }
    const size_t kstep = (size_t)(BK * 2);
    const size_t hstep = (size_t)HALF * K * 2;
    const size_t tstep = 2 * hstep;
    const unsigned ldsw = (unsigned)wid * 1024u;
    const int aoff = lds_byte(wr * 64 + fr, fq * 8), boff = lds_byte(wc * 32 + fr, fq * 8);
#define PG8_SA(b, h) (((b) * 2 + (h)) * HTB)
#define PG8_SB(b, h) ((4 + (b) * 2 + (h)) * HTB)
#define PG8_STAGE(bufoff, gbase, voff) do { _Pragma("unroll") for (int _i = 0; _i < 2; ++_i) \
        __builtin_amdgcn_global_load_lds((const unsigned*)((const char*)(gbase) + (voff)[_i]), (PG8_LAS unsigned*)(lds + (bufoff) + ldsw + _i * 8192), 16, 0, 0); } while (0)
#define PG8_LDA(dst, b, h) do { _Pragma("unroll") for (int m = 0; m < 4; ++m) _Pragma("unroll") for (int k = 0; k < 2; ++k) dst[m][k] = *(const PG8_LAS bf16x8*)(lds + PG8_SA(b, h) + aoff + m * 2048 + k * 1024); } while (0)
#define PG8_LDB(dst, b, h) do { _Pragma("unroll") for (int n = 0; n < 2; ++n) _Pragma("unroll") for (int k = 0; k < 2; ++k) dst[n][k] = *(const PG8_LAS bf16x8*)(lds + PG8_SB(b, h) + boff + n * 2048 + k * 1024); } while (0)
#define PG8_MMA(ai, bj, At, Bt) do { __builtin_amdgcn_s_setprio(1); _Pragma("unroll") for (int m = 0; m < 4; ++m) _Pragma("unroll") for (int n = 0; n < 2; ++n) _Pragma("unroll") for (int k = 0; k < 2; ++k) \
        acc[ai][bj][m][n] = __builtin_amdgcn_mfma_f32_16x16x32_bf16(Bt[n][k], At[m][k], acc[ai][bj][m][n], 0, 0, 0); __builtin_amdgcn_s_setprio(0); } while (0)
#define PG8_WAIT_V(n) asm volatile("s_waitcnt vmcnt(" #n ")" ::: "memory")
#define PG8_WAIT_L(n) asm volatile("s_waitcnt lgkmcnt(" #n ")" ::: "memory")
#define PG8_BAR __builtin_amdgcn_s_barrier()
#define PG8_SCHED __builtin_amdgcn_sched_barrier(0)
    Unit cur, nxt; int ui = 0;
    if (!S.next(0, cur)) return;
    f32x4 acc[2][2][4][2];
#pragma unroll
    for (int a = 0; a < 2; ++a)
#pragma unroll
        for (int b = 0; b < 2; ++b)
#pragma unroll
            for (int m = 0; m < 4; ++m)
#pragma unroll
                for (int n = 0; n < 2; ++n) acc[a][b][m][n] = (f32x4){0.f, 0.f, 0.f, 0.f};
    bf16x8 At[4][2], B0[2][2], B1[2][2];
    const char* cA = (const char*)g.A + (size_t)cur.pm * tstep; const char* cB = (const char*)g.Bt + (size_t)cur.pn * tstep;
    S.a_ready(cur);
    if constexpr (SP2) {
        PG8_STAGE(PG8_SB(0, 0), cB, voffB); PG8_STAGE(PG8_SB(0, 1), cB + hstep, voffB); PG8_STAGE(PG8_SA(0, 0), cA, voffA); PG8_STAGE(PG8_SA(0, 1), cA + hstep, voffA);
        if (wr == 1) PG8_BAR;
        PG8_WAIT_V(2); PG8_BAR;
        PG8_STAGE(PG8_SB(1, 0), cB + kstep, voffB); PG8_STAGE(PG8_SA(1, 0), cA + kstep, voffA); PG8_STAGE(PG8_SB(1, 1), cB + hstep + kstep, voffB);
        PG8_WAIT_V(6); PG8_BAR;
    } else {
        PG8_STAGE(PG8_SB(0, 0), cB, voffB); PG8_STAGE(PG8_SA(0, 0), cA, voffA); PG8_STAGE(PG8_SB(0, 1), cB + hstep, voffB); PG8_STAGE(PG8_SA(0, 1), cA + hstep, voffA);
        if (wr == 1) PG8_BAR;
        PG8_WAIT_V(4); PG8_BAR;
        PG8_STAGE(PG8_SB(1, 0), cB + kstep, voffB); PG8_STAGE(PG8_SA(1, 0), cA + kstep, voffA); PG8_STAGE(PG8_SB(1, 1), cB + hstep + kstep, voffB);
        PG8_WAIT_V(6); PG8_BAR;
    }
    for (;;) {
        const bool has_next = S.next(ui + 1, nxt);
        const char* nA = has_next ? (const char*)g.A + (size_t)nxt.pm * tstep : cA; const char* nB = has_next ? (const char*)g.Bt + (size_t)nxt.pn * tstep : cB;
        for (int t = 0; t < nt; t += 2) {
            const bool last = (t == nt - 2);
            const char* a1 = cA + (size_t)(t + 1) * kstep;
            const char* a2 = last ? nA : cA + (size_t)(t + 2) * kstep; const char* b2 = last ? nB : cB + (size_t)(t + 2) * kstep;
            const char* a3 = a2 + kstep; const char* b3 = b2 + kstep;
            if (last && has_next) S.a_ready(nxt);
            if constexpr (SP2) {
            PG8_LDB(B0, 0, 0); PG8_LDB(B1, 0, 1); PG8_SCHED; PG8_LDA(At, 0, 0); PG8_STAGE(PG8_SA(1, 1), a1 + hstep, voffA);
            PG8_WAIT_V(8); PG8_WAIT_L(0); PG8_BAR; PG8_MMA(0, 0, At, B0); PG8_MMA(0, 1, At, B1); PG8_BAR; PG8_SCHED;
            PG8_LDA(At, 0, 1); PG8_STAGE(PG8_SB(0, 0), b2, voffB); PG8_STAGE(PG8_SB(0, 1), b2 + hstep, voffB); PG8_STAGE(PG8_SA(0, 0), a2, voffA);
            PG8_WAIT_V(8); PG8_WAIT_L(0); PG8_BAR; PG8_MMA(1, 0, At, B0); PG8_MMA(1, 1, At, B1); PG8_BAR; PG8_SCHED;
            PG8_LDB(B0, 1, 0); PG8_LDB(B1, 1, 1); PG8_SCHED; PG8_LDA(At, 1, 0); PG8_STAGE(PG8_SA(0, 1), a2 + hstep, voffA);
            PG8_WAIT_V(8); PG8_WAIT_L(0); PG8_BAR; PG8_MMA(0, 0, At, B0); PG8_MMA(0, 1, At, B1); PG8_BAR; PG8_SCHED;
            PG8_LDA(At, 1, 1); PG8_STAGE(PG8_SB(1, 0), b3, voffB); PG8_STAGE(PG8_SB(1, 1), b3 + hstep, voffB); PG8_STAGE(PG8_SA(1, 0), a3, voffA);
            PG8_WAIT_V(8); PG8_WAIT_L(0); PG8_BAR; PG8_MMA(1, 0, At, B0); PG8_MMA(1, 1, At, B1); PG8_BAR; PG8_SCHED;
            } else {
            PG8_LDB(B0, 0, 0); PG8_SCHED; PG8_LDA(At, 0, 0); PG8_STAGE(PG8_SA(1, 1), a1 + hstep, voffA);
            PG8_WAIT_L(8); PG8_BAR; PG8_WAIT_L(0); PG8_MMA(0, 0, At, B0); PG8_BAR; PG8_SCHED;
            PG8_LDB(B1, 0, 1); PG8_STAGE(PG8_SB(0, 0), b2, voffB);
            PG8_BAR; PG8_WAIT_L(0); PG8_MMA(0, 1, At, B1); PG8_BAR;
            PG8_LDA(At, 0, 1); PG8_STAGE(PG8_SA(0, 0), a2, voffA);
            PG8_BAR; PG8_WAIT_L(0); PG8_MMA(1, 0, At, B0); PG8_BAR; PG8_SCHED;
            PG8_STAGE(PG8_SB(0, 1), b2 + hstep, voffB);
            PG8_WAIT_V(6); PG8_BAR; PG8_MMA(1, 1, At, B1); PG8_BAR;
            PG8_LDB(B0, 1, 0); PG8_SCHED; PG8_LDA(At, 1, 0); PG8_STAGE(PG8_SA(0, 1), a2 + hstep, voffA);
            PG8_WAIT_L(8); PG8_BAR; PG8_WAIT_L(0); PG8_MMA(0, 0, At, B0); PG8_BAR; PG8_SCHED;
            PG8_LDB(B1, 1, 1); PG8_STAGE(PG8_SB(1, 0), b3, voffB);
            PG8_BAR; PG8_WAIT_L(0); PG8_MMA(0, 1, At, B1); PG8_BAR;
            PG8_LDA(At, 1, 1); PG8_STAGE(PG8_SA(1, 0), a3, voffA);
            PG8_BAR; PG8_WAIT_L(0); PG8_MMA(1, 0, At, B0); PG8_BAR; PG8_SCHED;
            PG8_STAGE(PG8_SB(1, 1), b3 + hstep, voffB);
            PG8_WAIT_V(6); PG8_BAR; PG8_MMA(1, 1, At, B1); PG8_BAR;
            }
        }
        if constexpr (ALIGN_EPI) { if (wr == 0) PG8_BAR; }
        if constexpr (!Epi::AFTER_DRAIN) { E(acc, cur, wr, wc, fr, fq); S.done(cur); }
        if (!has_next) break;
#pragma unroll
        for (int a = 0; a < 2; ++a)
#pragma unroll
            for (int b = 0; b < 2; ++b)
#pragma unroll
                for (int m = 0; m < 4; ++m)
#pragma unroll
                    for (int n = 0; n < 2; ++n) acc[a][b][m][n] = (f32x4){0.f, 0.f, 0.f, 0.f};
        cur = nxt; cA = nA; cB = nB; ++ui;
        if constexpr (ALIGN_EPI) { if (wr == 1) PG8_BAR; }
    }
    PG8_WAIT_V(0);
    if constexpr (!ALIGN_EPI) { if (wr == 0) PG8_BAR; }
    PG8_BAR;
    if constexpr (Epi::AFTER_DRAIN) { E.fused(acc, cur, wr, wc, fr, fq, lds, wid, lane); S.done(cur); }
#undef PG8_SA
#undef PG8_SB
#undef PG8_STAGE
#undef PG8_LDA
#undef PG8_LDB
#undef PG8_MMA
#undef PG8_WAIT_V
#undef PG8_WAIT_L
#undef PG8_BAR
#undef PG8_SCHED
}
}
constexpr int NB = 8, SEQ = 4096, DM = 1024, MTOK = NB * SEQ;
constexpr int NPROJ = 3584;
constexpr int PCOLS_IN = 3600;
constexpr int NEXP = 16, CAP = 512, FFD = 2048, NSLOT = NEXP * NB * CAP;
constexpr float RMS_EPS = 1e-6f;
#ifndef N_LAUNCHES
#define N_LAUNCHES 1
#endif
constexpr int N_PHASES = 13;

constexpr size_t MiB = 1u << 20;
constexpr size_t WS_CTL = 0, CTL_ZERO_BYTES = 64 * 1024;
constexpr size_t WS_MOD = 1 * MiB;
constexpr size_t WS_BIN2 = 1 * MiB + 512 * 1024;
constexpr size_t WS_HID2 = 2 * MiB;
constexpr size_t WS_GATES = 3 * MiB;
constexpr size_t WS_AFF = 5 * MiB;
constexpr size_t WS_IDX = 7 * MiB, WS_GSEL = 7 * MiB + 256 * 1024;
constexpr size_t WS_INV = 8 * MiB;
constexpr size_t WS_WOUT = 12 * MiB;
constexpr size_t WS_WIN = 14 * MiB;
constexpr size_t WS_P = 24 * MiB;
constexpr size_t WS_H = 248 * MiB;
constexpr size_t WS_UT = 312 * MiB;
constexpr size_t WS_HM = 408 * MiB;
constexpr size_t WS_ZT = 472 * MiB;
constexpr size_t WS_KSP = 504 * MiB;
constexpr size_t WS_WGU = 24 * MiB;
constexpr size_t WS_XS = 152 * MiB;
constexpr size_t WS_HID = 280 * MiB;
constexpr size_t WS_HF = 280 * MiB;
constexpr size_t WS_WD = 152 * MiB;
constexpr size_t WS_YS = 24 * MiB;
constexpr size_t WS_END = 536 * MiB;

constexpr int RING_BYTES = 131072;
constexpr int MISC_OFF = RING_BYTES;
constexpr int LDS_BYTES = 147456;

#define GAS __attribute__((address_space(1)))
#define LAS __attribute__((address_space(3)))
#define DI __device__ __forceinline__
typedef unsigned short bf16;
typedef unsigned v4u __attribute__((ext_vector_type(4)));
typedef unsigned v2u __attribute__((ext_vector_type(2)));
typedef float f32x4 __attribute__((ext_vector_type(4)));
typedef GAS unsigned gu32;
#define LDS_WAIT() asm volatile("s_waitcnt lgkmcnt(0)" ::: "memory")
DI float bf2f(unsigned b) { return __uint_as_float(b << 16); }
DI float bflo(unsigned w) { return __uint_as_float(w << 16); }
DI float bfhi(unsigned w) { return __uint_as_float(w & 0xffff0000u); }
DI unsigned f2bf(float f) { unsigned u = __float_as_uint(f); return (u + 0x7fffu + ((u >> 16) & 1u)) >> 16; }
DI unsigned pk2(float lo, float hi) { return f2bf(lo) | (f2bf(hi) << 16); }
DI float wave_sum(float v) {
#pragma unroll
    for (int o = 1; o < 64; o <<= 1) v += __shfl_xor(v, o);
    return v;
}
DI float sigmoidf_(float x) { return 1.f / (1.f + __expf(-x)); }

namespace pg8 {
struct MoeOrderA {
    int G, c;
    __device__ bool next(int i, Unit& u) const {
        const long L = (long)i * G + c; if (L >= 4096) return false;
        const int e = (int)(L >> 8), r = (int)(L & 255), x = r & 7, j = r >> 3;
        u.pm = e * 16 + 4 * (x >> 1) + (j >> 3); u.pn = e * 16 + 8 * (x & 1) + (j & 7); return true;
    }
    __device__ __forceinline__ void a_ready(const Unit&) const {}
    __device__ __forceinline__ void done(const Unit&) const {}
};
struct MoeOrderB {
    int G, c;
    __device__ bool next(int i, Unit& u) const {
        const long L = (long)i * G + c; if (L >= 1024) return false;
        const int r = (int)(L & 255), e = (int)(L >> 8) * 4 + ((r & 7) >> 1), idx = ((r & 1) << 5) | (r >> 3);
        u.pm = e * 16 + (idx >> 2); u.pn = e * 4 + (idx & 3); return true;
    }
    __device__ __forceinline__ void a_ready(const Unit&) const {}
    __device__ __forceinline__ void done(const Unit&) const {}
};
struct EpiSwiGLU {
    static constexpr bool PERM = true, AFTER_DRAIN = false;
    bf16_t* O;
    __device__ __forceinline__ void operator()(const f32x4 (&acc)[2][2][4][2], const Unit& u, int wr, int wc, int fr, int fq) const {
        const int row0 = u.pm * BM + wr * 64 + fr, col0 = (u.pn & 15) * 128 + wc * 32 + 8 * fq;
#pragma unroll
        for (int ai = 0; ai < 2; ++ai)
#pragma unroll
            for (int m = 0; m < 4; ++m) {
                bf16_t* rowp = O + (size_t)(row0 + ai * HALF + m * 16) * 2048 + col0;
                float h[8];
#pragma unroll
                for (int n = 0; n < 2; ++n)
#pragma unroll
                    for (int i = 0; i < 4; ++i) { const float g = acc[ai][0][m][n][i], up = acc[ai][1][m][n][i]; h[4 * n + i] = g * __builtin_amdgcn_rcpf(1.f + __expf(-g)) * up; }
                u32x4 w; w.x = cvt_pk_bf16(h[0], h[1]); w.y = cvt_pk_bf16(h[2], h[3]); w.z = cvt_pk_bf16(h[4], h[5]); w.w = cvt_pk_bf16(h[6], h[7]);
                *(u32x4*)rowp = w;
            }
    }
};
struct EpiYs {
    static constexpr bool PERM = true, AFTER_DRAIN = false;
    bf16_t* O;
    __device__ __forceinline__ void operator()(const f32x4 (&acc)[2][2][4][2], const Unit& u, int wr, int wc, int fr, int fq) const {
        const int row0 = u.pm * BM + wr * 64 + fr, col0 = (u.pn & 3) * BM + wc * 32 + 8 * fq;
#pragma unroll
        for (int ai = 0; ai < 2; ++ai)
#pragma unroll
            for (int m = 0; m < 4; ++m) {
                bf16_t* rowp = O + (size_t)(row0 + ai * HALF + m * 16) * 1024 + col0;
#pragma unroll
                for (int bj = 0; bj < 2; ++bj) { const f32x4 v0 = acc[ai][bj][m][0], v1 = acc[ai][bj][m][1];
                    u32x4 w; w.x = cvt_pk_bf16(v0[0], v0[1]); w.y = cvt_pk_bf16(v0[2], v0[3]); w.z = cvt_pk_bf16(v1[0], v1[1]); w.w = cvt_pk_bf16(v1[2], v1[3]);
                    *(u32x4*)(rowp + bj * HALF) = w; }
            }
    }
};
struct EpiRes {
    static constexpr bool PERM = false, AFTER_DRAIN = false;
    const float* X; float* C; const float* mod;
    __device__ __forceinline__ void operator()(const f32x4 (&acc)[2][2][4][2], const Unit& u, int wr, int wc, int fr, int fq) const {
        const int row0 = u.pm * BM + wr * 64 + fr, col0 = u.pn * BM + wc * 32 + 4 * fq;
        const float* gp = mod + (size_t)((u.pm * BM) >> 12) * 6144 + 2048 + col0;
        f32x4 gv[2][2];
#pragma unroll
        for (int bj = 0; bj < 2; ++bj)
#pragma unroll
            for (int n = 0; n < 2; ++n) gv[bj][n] = *(const f32x4*)(gp + bj * HALF + n * 16);
#pragma unroll
        for (int ai = 0; ai < 2; ++ai)
#pragma unroll
            for (int m = 0; m < 4; ++m) { const size_t off = (size_t)(row0 + ai * HALF + m * 16) * 1024 + col0;
#pragma unroll
                for (int bj = 0; bj < 2; ++bj)
#pragma unroll
                    for (int n = 0; n < 2; ++n) { const f32x4 xv = *(const f32x4*)(X + off + bj * HALF + n * 16); *(f32x4*)(C + off + bj * HALF + n * 16) = xv + gv[bj][n] * acc[ai][bj][m][n]; } }
    }
};
}
#define XB_TMO      128
#define XB_XCNT(j)  (256  + 64 * (j))
#define XB_XSUB(j)  (1280 + 64 * (j))
#define XB_XGEN(j)  (2304 + 64 * (j))
#define XB_TOP      3328
#define XB_TOPGEN   3392
#define XCD_BAR_WORDS 3456
#define XB_SPIN_CAP (1u << 18)

__device__ __forceinline__ unsigned xb_ld(unsigned* p)              { return __hip_atomic_load(p, __ATOMIC_RELAXED, __HIP_MEMORY_SCOPE_AGENT); }
__device__ __forceinline__ unsigned xb_add(unsigned* p, unsigned v) { return __hip_atomic_fetch_add(p, v, __ATOMIC_RELAXED, __HIP_MEMORY_SCOPE_AGENT); }
__device__ __forceinline__ unsigned xb_xcc_id() { return (unsigned)__builtin_amdgcn_s_getreg((3 << 11) | 20) & 0xFu; }
#define XB_SPIN(cond, bar) do { unsigned _sp = 0; while (cond) { __builtin_amdgcn_s_sleep(1); \
    if ((++_sp & 255u) == 0u) { if (xb_ld(&(bar)[XB_TMO])) break; if (_sp > XB_SPIN_CAP) { atomicAdd(&(bar)[XB_TMO], 1u); break; } } } } while (0)

struct XcdBarrier {
    unsigned* bar; unsigned x;
    volatile LAS unsigned* st;
};

__device__ __forceinline__ XcdBarrier xcd_barrier_post(unsigned* bar, volatile LAS unsigned* st) {
    XcdBarrier b; b.bar = bar; b.x = xb_xcc_id(); b.st = st;
    if (threadIdx.x == 0) (void)xb_add(&bar[XB_XCNT(b.x)], 1u);
    return b;
}
__device__ __forceinline__ void xcd_barrier_complete(unsigned* bar, unsigned x, unsigned& nloc, unsigned& nx) {
    const unsigned G = gridDim.x * gridDim.y * gridDim.z;
    unsigned sum, cnt, mine, sp = 0u;
    for (;;) {
        sum = 0u; cnt = 0u; mine = 0u;
#pragma unroll
        for (unsigned j = 0; j < 16; ++j) { const unsigned c = xb_ld(&bar[XB_XCNT(j)]); sum += c; cnt += (c > 0u) ? 1u : 0u; mine = (j == x) ? c : mine; }
        if (sum == G) break;
        __builtin_amdgcn_s_sleep(1);
        if ((++sp & 255u) == 0u) { if (xb_ld(&bar[XB_TMO])) break; if (sp > XB_SPIN_CAP) { atomicAdd(&bar[XB_TMO], 1u); break; } }
    }
    nloc = mine > 0u ? mine : 1u; nx = cnt > 0u ? cnt : 1u;
}

__device__ __forceinline__ void xcd_barrier(const XcdBarrier& b) {
    asm volatile("s_waitcnt vmcnt(0)" ::: "memory");
    __syncthreads();
    if (threadIdx.x == 0) {
        unsigned* bar = b.bar;
        __builtin_amdgcn_s_waitcnt(0);
        unsigned nloc = b.st[0], nx = b.st[1];
        if (nloc == 0u) { xcd_barrier_complete(bar, b.x, nloc, nx); b.st[0] = nloc; b.st[1] = nx; }
        const unsigned old = xb_add(&bar[XB_XSUB(b.x)], 1u);
        const unsigned gen = old / nloc;
        if (old + 1u == (gen + 1u) * nloc) {
            __builtin_amdgcn_fence(__ATOMIC_RELEASE, "agent");
            asm volatile("s_waitcnt vmcnt(0)" ::: "memory");
            const unsigned og = xb_add(&bar[XB_TOP], 1u);
            const unsigned tg = og / nx;
            if (og + 1u == (tg + 1u) * nx) xb_add(&bar[XB_TOPGEN], 1u);
            else XB_SPIN(xb_ld(&bar[XB_TOPGEN]) == tg, bar);
            __builtin_amdgcn_fence(__ATOMIC_ACQUIRE, "agent");
            xb_add(&bar[XB_XGEN(b.x)], 1u);
            asm volatile("s_waitcnt vmcnt(0)" ::: "memory");
        } else {
            XB_SPIN(xb_ld(&bar[XB_XGEN(b.x)]) == gen, bar);
            __builtin_amdgcn_fence(__ATOMIC_ACQUIRE, "agent");
            asm volatile("s_waitcnt vmcnt(0)" ::: "memory");
        }
    }
    __syncthreads();
}
#define HD __host__ __device__ __forceinline__
typedef float cf2 __attribute__((ext_vector_type(2)));
#define MK2(a, b) ((cf2){(a), (b)})
HD cf2 c_add(cf2 a, cf2 b) { return MK2(a.x + b.x, a.y + b.y); }
HD cf2 c_sub(cf2 a, cf2 b) { return MK2(a.x - b.x, a.y - b.y); }
HD cf2 c_mul(cf2 a, cf2 b) { return MK2(a.x * b.x - a.y * b.y, a.x * b.y + a.y * b.x); }
HD cf2 c_mulc(cf2 a, cf2 b) { return MK2(a.x * b.x + a.y * b.y, a.y * b.x - a.x * b.y); }
HD int fphys(int i) { return i + (i >> 4); }
constexpr int FFT_XSLOTS = 8192 + 512;

#define W16_C1 0.92387953251128674f
#define W16_S1 0.38268343236508977f
#define W16_H  0.70710678118654752f
template <int J> HD cf2 mul_w16(cf2 d) {
    if constexpr (J == 0) return d;
    else if constexpr (J == 1) return c_mul(d, MK2(W16_C1, -W16_S1));
    else if constexpr (J == 2) return MK2((d.x + d.y) * W16_H, (d.y - d.x) * W16_H);
    else if constexpr (J == 3) return c_mul(d, MK2(W16_S1, -W16_C1));
    else if constexpr (J == 4) return MK2(d.y, -d.x);
    else if constexpr (J == 5) return c_mul(d, MK2(-W16_S1, -W16_C1));
    else if constexpr (J == 6) return MK2((d.y - d.x) * W16_H, -(d.x + d.y) * W16_H);
    else return c_mul(d, MK2(-W16_C1, -W16_S1));
}
HD void dft16(cf2 (&v)[16]) {
#define BF(i, j, TWJ) { const cf2 a_ = v[i], b_ = v[j]; v[i] = c_add(a_, b_); v[j] = mul_w16<TWJ>(c_sub(a_, b_)); }
    BF(0, 8, 0) BF(1, 9, 1) BF(2, 10, 2) BF(3, 11, 3) BF(4, 12, 4) BF(5, 13, 5) BF(6, 14, 6) BF(7, 15, 7)
    BF(0, 4, 0) BF(1, 5, 2) BF(2, 6, 4) BF(3, 7, 6)   BF(8, 12, 0) BF(9, 13, 2) BF(10, 14, 4) BF(11, 15, 6)
    BF(0, 2, 0) BF(1, 3, 4)  BF(4, 6, 0) BF(5, 7, 4)  BF(8, 10, 0) BF(9, 11, 4)  BF(12, 14, 0) BF(13, 15, 4)
    BF(0, 1, 0) BF(2, 3, 0) BF(4, 5, 0) BF(6, 7, 0) BF(8, 9, 0) BF(10, 11, 0) BF(12, 13, 0) BF(14, 15, 0)
#undef BF
#define SW(i, j) { const cf2 t_ = v[i]; v[i] = v[j]; v[j] = t_; }
    SW(1, 8) SW(2, 4) SW(3, 12) SW(5, 10) SW(7, 14) SW(11, 13)
#undef SW
}
HD void idft16(cf2 (&v)[16]) {
#pragma unroll
    for (int i = 0; i < 16; ++i) v[i] = MK2(v[i].y, v[i].x);
    dft16(v);
#pragma unroll
    for (int i = 0; i < 16; ++i) v[i] = MK2(v[i].y, v[i].x);
}
HD void c_powers(cf2 t, cf2 (&pw)[16]) {
    pw[0] = MK2(1.f, 0.f); pw[1] = t;
#pragma unroll
    for (int r = 2; r < 16; ++r) pw[r] = (r & 1) ? c_mul(pw[r - 1], t) : c_mul(pw[r >> 1], pw[r >> 1]);
}
HD cf2 w32_const(int k) {
    constexpr float C[16] = {1.f, 0.98078528040323043f, 0.92387953251128674f, 0.83146961230254524f, 0.70710678118654752f, 0.55557023301960218f, 0.38268343236508977f, 0.19509032201612825f,
                             0.f, -0.19509032201612825f, -0.38268343236508977f, -0.55557023301960218f, -0.70710678118654752f, -0.83146961230254524f, -0.92387953251128674f, -0.98078528040323043f};
    constexpr float S[16] = {0.f, 0.19509032201612825f, 0.38268343236508977f, 0.55557023301960218f, 0.70710678118654752f, 0.83146961230254524f, 0.92387953251128674f, 0.98078528040323043f,
                             1.f, 0.98078528040323043f, 0.92387953251128674f, 0.83146961230254524f, 0.70710678118654752f, 0.55557023301960218f, 0.38268343236508977f, 0.19509032201612825f};
    return MK2(C[k], -S[k]);
}
template <class XP, class TP> HD void fft_passA_fwd(int tid, const cf2 (&a)[16], const cf2 (&b)[16], XP X, TP TW4, TP TW8) {
    const int H = tid >> 8, lo = tid & 255;
    cf2 v[16];
    if (H == 0) {
#pragma unroll
        for (int k = 0; k < 16; ++k) v[k] = c_add(a[k], b[k]);
    } else {
        const cf2 t8 = TW8[lo];
#pragma unroll
        for (int k = 0; k < 16; ++k) v[k] = c_mul(c_sub(a[k], b[k]), c_mul(t8, w32_const(k)));
    }
    dft16(v);
    cf2 pw[16]; c_powers(TW4[lo], pw);
#pragma unroll
    for (int r = 0; r < 16; ++r) X[fphys(H * 4096 + r * 256 + lo)] = c_mul(v[r], pw[r]);
}
template <class XP, class TP> HD void fft_passB_fwd(int tid, XP X, TP TW4) {
    const int H = tid >> 8, hi = (tid >> 4) & 15, lo = tid & 15, base = H * 4096 + hi * 256 + lo;
    cf2 v[16];
#pragma unroll
    for (int k = 0; k < 16; ++k) v[k] = X[fphys(base + k * 16)];
    dft16(v);
    cf2 pw[16]; c_powers(TW4[16 * lo], pw);
#pragma unroll
    for (int r = 0; r < 16; ++r) X[fphys(base + r * 16)] = c_mul(v[r], pw[r]);
}
template <class XP> HD void fft_passC_fwd(int tid, XP X, cf2 (&v)[16]) {
    const int p0 = 17 * tid;
#pragma unroll
    for (int k = 0; k < 16; ++k) v[k] = X[p0 + k];
    dft16(v);
}
template <class XP> HD void fft_passC_inv(int tid, XP X, cf2 (&v)[16]) {
    const int p0 = 17 * tid;
    idft16(v);
#pragma unroll
    for (int k = 0; k < 16; ++k) X[p0 + k] = v[k];
}
template <class XP, class TP> HD void fft_passB_inv(int tid, XP X, TP TW4) {
    const int H = tid >> 8, hi = (tid >> 4) & 15, lo = tid & 15, base = H * 4096 + hi * 256 + lo;
    cf2 v[16], pw[16]; c_powers(TW4[16 * lo], pw);
#pragma unroll
    for (int r = 0; r < 16; ++r) v[r] = c_mulc(X[fphys(base + r * 16)], pw[r]);
    idft16(v);
#pragma unroll
    for (int k = 0; k < 16; ++k) X[fphys(base + k * 16)] = v[k];
}
template <class XP, class TP> HD void fft_passA_inv(int tid, XP X, TP TW4, TP TW8, cf2 (&u)[16]) {
    const int H = tid >> 8, lo = tid & 255;
    cf2 pw[16]; c_powers(TW4[lo], pw);
#pragma unroll
    for (int r = 0; r < 16; ++r) u[r] = c_mulc(X[fphys(H * 4096 + r * 256 + lo)], pw[r]);
    idft16(u);
    if (H == 1) {
        const cf2 t8 = TW8[lo];
#pragma unroll
        for (int k = 0; k < 16; ++k) u[k] = c_mulc(u[k], c_mul(t8, w32_const(k)));
    }
}
struct Args { const float* in[28]; float* out; unsigned char* ws; int ph_lo, ph_hi; };
struct Frame {
    LAS unsigned char* lds;
    int tid, lane, wave, G, blk;
    const struct Args* a;
};
#define IN_X 0
#define IN_C 1
#define IN_WADA 2
#define IN_BADA 3
#define IN_GMIX 4
#define IN_WIN 5
#define IN_BIN 6
#define IN_CQKW 7
#define IN_CQKB 8
#define IN_MNG 9
#define IN_CHYW 10
#define IN_CHYB 11
#define IN_HW1 12
#define IN_HB1 13
#define IN_HW2 14
#define IN_HB2 15
#define IN_HW3 16
#define IN_HFREQ 17
#define IN_HDELTA 18
#define IN_HBIAS 19
#define IN_HNG 20
#define IN_WOUT 21
#define IN_GFFN 22
#define IN_WROUTER 23
#define IN_WGATE 24
#define IN_WUP 25
#define IN_WDOWN 26
#define IN_GFINAL 27

DI void transpose_item(const float* src, int ldsrc, bf16* dst, int lddst, LAS float* scr, int lane) {
#pragma unroll 8
    for (int i = 0; i < 32; ++i) { const int kk = 2 * i + (lane >> 5); scr[kk * 33 + (lane & 31)] = src[(size_t)kk * ldsrc + (lane & 31)]; }
    LDS_WAIT(); asm volatile("" ::: "memory");
    const int c = lane & 7;
#pragma unroll
    for (int j = 0; j < 4; ++j) { const int n = (lane >> 3) + 8 * j; const LAS float* s = scr + (8 * c) * 33 + n;
        v4u o; o.x = pk2(s[0 * 33], s[1 * 33]); o.y = pk2(s[2 * 33], s[3 * 33]); o.z = pk2(s[4 * 33], s[5 * 33]); o.w = pk2(s[6 * 33], s[7 * 33]);
        *(v4u*)(dst + (size_t)n * lddst + 8 * c) = o; }
    LDS_WAIT(); asm volatile("" ::: "memory");
}
DI float reduce16(const float (&acc)[16], int lane) {
    float r8[8], r4[4], r2[2], r1;
    { const bool up = (lane & 32) != 0;
#pragma unroll
      for (int i = 0; i < 8; ++i) { const float mine = up ? acc[8 + i] : acc[i], other = up ? acc[i] : acc[8 + i]; r8[i] = mine + __shfl_xor(other, 32); } }
    { const bool up = (lane & 16) != 0;
#pragma unroll
      for (int i = 0; i < 4; ++i) { const float mine = up ? r8[4 + i] : r8[i], other = up ? r8[i] : r8[4 + i]; r4[i] = mine + __shfl_xor(other, 16); } }
    { const bool up = (lane & 8) != 0;
#pragma unroll
      for (int i = 0; i < 2; ++i) { const float mine = up ? r4[2 + i] : r4[i], other = up ? r4[i] : r4[2 + i]; r2[i] = mine + __shfl_xor(other, 8); } }
    { const bool up = (lane & 4) != 0; const float mine = up ? r2[1] : r2[0], other = up ? r2[0] : r2[1]; r1 = mine + __shfl_xor(other, 4); }
    r1 += __shfl_xor(r1, 1); r1 += __shfl_xor(r1, 2);
    return r1;
}
DI int reduce16_index(int lane) { return ((lane >> 5) & 1) * 8 + ((lane >> 4) & 1) * 4 + ((lane >> 3) & 1) * 2 + ((lane >> 2) & 1); }

DI void p0_prologue(Frame& F) {
    unsigned char* ws = F.a->ws;
    LAS float* scr = (LAS float*)(F.lds + F.wave * 16384);
    const int gw = F.blk * 8 + F.wave, NGW = F.G * 8, lane = F.lane;
    bf16* WIN = (bf16*)(ws + WS_WIN); bf16* WOUT = (bf16*)(ws + WS_WOUT);
    for (int it = gw; it < 1792 + 512; it += NGW) {
        if (it < 1792) { const int kb = it / 112, nb = it % 112, n0 = 32 * nb, k0 = 64 * kb, sc = n0 + (n0 >= 2048 ? 16 : 0);
            transpose_item(F.a->in[IN_WIN] + (size_t)k0 * PCOLS_IN + sc, PCOLS_IN, WIN + (size_t)n0 * 1024 + k0, 1024, scr, lane); }
        else { const int r = it - 1792, kb = r / 32, nb = r % 32, n0 = 32 * nb, k0 = 64 * kb;
            transpose_item(F.a->in[IN_WOUT] + (size_t)k0 * 1024 + n0, 1024, WOUT + (size_t)n0 * 1024 + k0, 1024, scr, lane); }
    }
    {
        float* HID2 = (float*)(ws + WS_HID2);
        const float* w1 = F.a->in[IN_HW1]; const float* w2 = F.a->in[IN_HW2];
        const float fr = F.a->in[IN_HFREQ][lane], b1 = F.a->in[IN_HB1][lane], b2 = F.a->in[IN_HB2][lane];
        for (int t = gw; t < SEQ; t += NGW) {
            float a1 = b1 + ((float)t * (1.f / 4095.f)) * w1[lane];
#pragma unroll 4
            for (int i = 0; i < 16; ++i) {
                const float band = 1e-4f + (float)i * ((15.f - 1e-4f) / 15.f);
                const float rev = band * (float)t * (1.f / 4096.f);
                const float fx = rev - floorf(rev);
                float sn, cs; sincospif(2.f * fx, &sn, &cs);
                a1 += cs * w1[(1 + i) * 64 + lane] - sn * w1[(17 + i) * 64 + lane];
            }
            const float h1 = sinf(fr * a1);
            float a2 = b2;
#pragma unroll 8
            for (int i = 0; i < 64; ++i) a2 += __shfl(h1, i) * w2[i * 64 + lane];
            HID2[t * 64 + lane] = sinf(fr * a2);
        }
    }
    { float* BIN2 = (float*)(ws + WS_BIN2); for (int n = F.blk * 512 + F.tid; n < NPROJ; n += F.G * 512) BIN2[n] = F.a->in[IN_BIN][n + (n >= 2048 ? 16 : 0)]; }
    __syncthreads();
    {
        LAS float* red = (LAS float*)F.lds; float* MOD = (float*)(ws + WS_MOD);
        const float* wada = F.a->in[IN_WADA]; const float* cvec = F.a->in[IN_C];
        for (int it = F.blk; it < 96; it += F.G) {
            const int col = 64 * it + lane; float acc[8];
#pragma unroll
            for (int b = 0; b < 8; ++b) acc[b] = 0.f;
            for (int k = F.wave * 128; k < F.wave * 128 + 128; ++k) { const float wv = wada[(size_t)k * 6144 + col];
#pragma unroll
                for (int b = 0; b < 8; ++b) acc[b] += cvec[b * 1024 + k] * wv; }
#pragma unroll
            for (int b = 0; b < 8; ++b) red[(F.wave * 8 + b) * 64 + lane] = acc[b];
            __syncthreads();
            { const int b = F.tid >> 6; float s = F.a->in[IN_BADA][col];
#pragma unroll
              for (int w = 0; w < 8; ++w) s += red[(w * 8 + b) * 64 + lane];
              MOD[b * 6144 + col] = s; }
            __syncthreads();
        }
    }
}

template <bool SECOND> DI void p_norm(Frame& F) {
    unsigned char* ws = F.a->ws; const int lane = F.lane;
    LAS float* Wt = (LAS float*)F.lds;
    for (int i = F.tid; i < 16384; i += 512) { const int k = i >> 4, g = i & 15; Wt[g * 1024 + k] = SECOND ? F.a->in[IN_WROUTER][k * 16 + g] : F.a->in[IN_WIN][(size_t)k * PCOLS_IN + 2048 + g]; }
    __syncthreads();
    const float* xin = SECOND ? (const float*)F.a->out : F.a->in[IN_X];
    const float* gvec = SECOND ? F.a->in[IN_GFFN] : F.a->in[IN_GMIX];
    const float* MOD = (const float*)(ws + WS_MOD);
    bf16* HO = (bf16*)(ws + (SECOND ? WS_HF : WS_H));
    const int gw = F.blk * 8 + F.wave, NGW = F.G * 8;
    for (int row = gw; row < MTOK; row += NGW) {
        const int b = row >> 12;
        const f32x4* xr = (const f32x4*)(xin + (size_t)row * 1024) + lane;
        f32x4 v[4]; float ss = 0.f;
#pragma unroll
        for (int j = 0; j < 4; ++j) { v[j] = xr[64 * j]; ss += (v[j].x * v[j].x + v[j].y * v[j].y) + (v[j].z * v[j].z + v[j].w * v[j].w); }
        const float rstd = rsqrtf(wave_sum(ss) * (1.f / 1024.f) + RMS_EPS);
        const float* mb = MOD + b * 6144 + (SECOND ? 3072 : 0);
#pragma unroll
        for (int j = 0; j < 4; ++j) { const int col = 256 * j + 4 * lane;
            const f32x4 g = *(const f32x4*)(gvec + col), sh = *(const f32x4*)(mb + col), sc = *(const f32x4*)(mb + 1024 + col);
            v[j] = v[j] * rstd * g * (sc + 1.f) + sh; }
        unsigned long long* o8 = (unsigned long long*)(HO + (size_t)row * 1024) + lane;
#pragma unroll
        for (int j = 0; j < 4; ++j) o8[64 * j] = (unsigned long long)pk2(v[j].x, v[j].y) | ((unsigned long long)pk2(v[j].z, v[j].w) << 32);
        float acc[16];
#pragma unroll
        for (int g = 0; g < 16; ++g) { float a = 0.f;
            if ((g & 3) == 0) asm volatile("" ::: "memory");
#pragma unroll
            for (int j = 0; j < 4; ++j) { const f32x4 w = *(const LAS f32x4*)(Wt + g * 1024 + 256 * j + 4 * lane); a += (v[j].x * w.x + v[j].y * w.y) + (v[j].z * w.z + v[j].w * w.w); }
            acc[g] = a; }
        const float val = reduce16(acc, lane); const int gi = reduce16_index(lane);
        if (!SECOND) { if ((lane & 3) == 0) ((float*)(ws + WS_GATES))[(size_t)row * 16 + gi] = val + F.a->in[IN_BIN][2048 + gi]; }
        else {
            float mx = val;
#pragma unroll
            for (int o = 4; o < 64; o <<= 1) mx = fmaxf(mx, __shfl_xor(mx, o));
            const float ex = __expf(val - mx); float sm = ex;
#pragma unroll
            for (int o = 4; o < 64; o <<= 1) sm += __shfl_xor(sm, o);
            if ((lane & 3) == 0) ((float*)(ws + WS_AFF))[((size_t)b * 16 + gi) * SEQ + (row & 4095)] = ex / sm;
        }
    }
}

DI void p3_prep(Frame& F) {
    unsigned char* ws = F.a->ws;
    const bf16* P = (const bf16*)(ws + WS_P);
    {
        bf16* QK = (bf16*)(ws + WS_H);
        const float* cw = F.a->in[IN_CQKW]; const float* cb = F.a->in[IN_CQKB];
        const int nthr = F.G * 512;
        for (int i = F.blk * 512 + F.tid; i < MTOK * 128; i += nthr) {
            const int token = i >> 7, cg = i & 127, t = token & 4095, c0 = 8 * cg;
            const bf16* p0 = P + (size_t)token * NPROJ + c0;
            const v4u cur = *(const v4u*)p0;
            v4u prv = (v4u){0u, 0u, 0u, 0u}, nxt = (v4u){0u, 0u, 0u, 0u};
            if (t > 0) prv = *(const v4u*)(p0 - NPROJ);
            if (t < SEQ - 1) nxt = *(const v4u*)(p0 + NPROJ);
            const float scale = (c0 >= 512) ? 0.08838834764831845f : 1.f;
            float o[8];
#pragma unroll
            for (int e = 0; e < 8; ++e) {
                const unsigned wp = prv[e >> 1], wc = cur[e >> 1], wn = nxt[e >> 1];
                const float xp = (e & 1) ? bfhi(wp) : bflo(wp), xc = (e & 1) ? bfhi(wc) : bflo(wc), xn = (e & 1) ? bfhi(wn) : bflo(wn);
                const int c = c0 + e;
                const float val = cb[c] + cw[c] * xp + cw[1024 + c] * xc + cw[2048 + c] * xn;
                o[e] = val * sigmoidf_(val) * scale;
            }
            v4u w; w.x = pk2(o[0], o[1]); w.y = pk2(o[2], o[3]); w.z = pk2(o[4], o[5]); w.w = pk2(o[6], o[7]);
            *(v4u*)(QK + (size_t)token * 1024 + c0) = w;
        }
    }
    {
        bf16* UT = (bf16*)(ws + WS_UT);
        LAS bf16* tile = (LAS bf16*)F.lds;
        const float* cw = F.a->in[IN_CHYW]; const float* cb = F.a->in[IN_CHYB];
        for (int u = F.blk; u < 4 * 64 * 24; u += F.G) {
            const int cgq = u % 24, tt = (u / 24) & 63, p = u / (24 * 64);
            for (int it = F.tid; it < 1024; it += 512) {
                const int cg8 = it & 7, tl = (it >> 3) & 63, bs = it >> 9;
                const int t = tt * 64 + tl, token = (2 * p + bs) * SEQ + t, hxc = cgq * 64 + cg8 * 8;
                const bf16* p0 = P + (size_t)token * NPROJ + 2048 + hxc;
                const v4u cur = *(const v4u*)p0;
                v4u prv = (v4u){0u, 0u, 0u, 0u}, nxt = (v4u){0u, 0u, 0u, 0u};
                if (t > 0) prv = *(const v4u*)(p0 - NPROJ);
                if (t < SEQ - 1) nxt = *(const v4u*)(p0 + NPROJ);
#pragma unroll
                for (int e = 0; e < 8; ++e) {
                    const unsigned wp = prv[e >> 1], wc = cur[e >> 1], wn = nxt[e >> 1];
                    const float xp = (e & 1) ? bfhi(wp) : bflo(wp), xc = (e & 1) ? bfhi(wc) : bflo(wc), xn = (e & 1) ? bfhi(wn) : bflo(wn);
                    const int c = hxc + e;
                    const float val = cb[c] + cw[c] * xp + cw[1536 + c] * xc + cw[3072 + c] * xn;
                    tile[((cg8 * 8 + e) * 64 + tl) * 2 + bs] = (bf16)f2bf(val);
                }
            }
            __syncthreads();
            for (int pc = F.tid; pc < 1024; pc += 512) {
                const int cl = pc >> 4, q = pc & 15, hxc = cgq * 64 + cl, part = hxc >> 9, c = hxc & 511;
                const v4u v = *(const LAS v4u*)(tile + cl * 128 + q * 8);
                *(v4u*)(UT + ((((size_t)part * 4 + p) * 512 + c) * SEQ + tt * 64) * 2 + q * 8) = v;
            }
            __syncthreads();
        }
    }
}

DI void p4_mlstm_seq(Frame& F) {
    unsigned char* ws = F.a->ws;
    constexpr int TB = 32;
    LAS float* qs = (LAS float*)F.lds; LAS float* ks = qs + TB * 128; LAS float* vs = ks + TB * 128; LAS float* ob = vs + TB * 128;
    LAS float* gi = ob + TB * 128; LAS float* gl = gi + TB;
    const bf16* QK = (const bf16*)(ws + WS_H); const bf16* P = (const bf16*)(ws + WS_P); const float* GATES = (const float*)(ws + WS_GATES);
    bf16* HM = (bf16*)(ws + WS_HM);
    const int tid = F.tid, v = tid >> 2, kq = tid & 3;
    for (int it = F.blk; it < 64; it += F.G) {
        const int b = it >> 3, h = (it >> 1) & 3, dir = it & 1;
        float C[32], n[32]; float m = -1e30f;
#pragma unroll
        for (int j = 0; j < 32; ++j) { C[j] = 0.f; n[j] = 0.f; }
        for (int tau0 = 0; tau0 < SEQ; tau0 += TB) {
#pragma unroll
            for (int r = 0; r < 3; ++r) {
                const int st = tid >> 4, ch = tid & 15, tau = tau0 + st, token = b * SEQ + (dir ? SEQ - 1 - tau : tau);
                const bf16* src = (r == 0) ? QK + (size_t)token * 1024 + h * 128 : (r == 1) ? QK + (size_t)token * 1024 + 512 + h * 128 : P + (size_t)token * NPROJ + 1024 + h * 128;
                const v4u w = *(const v4u*)(src + ch * 8);
                LAS float* d = ((r == 0) ? qs : (r == 1) ? ks : vs) + st * 128 + ch * 8;
                *(LAS f32x4*)d = (f32x4){bflo(w.x), bfhi(w.x), bflo(w.y), bfhi(w.y)};
                *(LAS f32x4*)(d + 4) = (f32x4){bflo(w.z), bfhi(w.z), bflo(w.w), bfhi(w.w)};
            }
            if (tid < TB) { const int tau = tau0 + tid, token = b * SEQ + (dir ? SEQ - 1 - tau : tau);
                const float ip = GATES[(size_t)token * 16 + 8 * dir + h], fp = GATES[(size_t)token * 16 + 8 * dir + 4 + h];
                gi[tid] = ip; gl[tid] = fminf(fp, 0.f) - log1pf(__expf(-fabsf(fp))); }
            __syncthreads();
            for (int s = 0; s < TB; ++s) {
                const float is = gi[s], lf = gl[s];
                const float mn = fmaxf(lf + m, is), fpr = __expf(lf + m - mn), ipr = __expf(is - mn); m = mn;
                const float iv = ipr * vs[s * 128 + v];
                float hv = 0.f, dn = 0.f;
#pragma unroll
                for (int j4 = 0; j4 < 8; ++j4) {
                    const f32x4 kk = *(const LAS f32x4*)(ks + s * 128 + 32 * kq + 4 * j4), qq = *(const LAS f32x4*)(qs + s * 128 + 32 * kq + 4 * j4);
#pragma unroll
                    for (int e = 0; e < 4; ++e) { const int j = 4 * j4 + e;
                        C[j] = fmaf(iv, kk[e], fpr * C[j]); n[j] = fmaf(ipr, kk[e], fpr * n[j]);
                        hv = fmaf(C[j], qq[e], hv); dn = fmaf(n[j], qq[e], dn); }
                }
                hv += __shfl_xor(hv, 1); hv += __shfl_xor(hv, 2); dn += __shfl_xor(dn, 1); dn += __shfl_xor(dn, 2);
                if (kq == 0) ob[s * 128 + v] = hv / fmaxf(fabsf(dn), __expf(-m));
            }
            __syncthreads();
            { const int st = tid >> 4, ch = tid & 15, tau = tau0 + st, token = b * SEQ + (dir ? SEQ - 1 - tau : tau);
              const f32x4 a = *(const LAS f32x4*)(ob + st * 128 + ch * 8), c2 = *(const LAS f32x4*)(ob + st * 128 + ch * 8 + 4);
              v4u w; w.x = pk2(a.x, a.y); w.y = pk2(a.z, a.w); w.z = pk2(c2.x, c2.y); w.w = pk2(c2.z, c2.w);
              *(v4u*)(HM + ((size_t)dir * MTOK + token) * 512 + h * 128 + ch * 8) = w; }
            __syncthreads();
        }
    }
}

#define LAUNDER(x) asm volatile("" : "+v"(x))
DI float filt_tap(const float* HID2, const LAS float* w3s, int t, float adelta) {
    const f32x4* hr = (const f32x4*)(HID2 + (size_t)t * 64); float s = 0.f;
#pragma unroll
    for (int i = 0; i < 16; ++i) { const f32x4 hh = hr[i]; s += (hh.x * w3s[4 * i] + hh.y * w3s[4 * i + 1]) + (hh.z * w3s[4 * i + 2] + hh.w * w3s[4 * i + 3]); }
    return s * (__expf(-(float)t * (1.f / 4095.f) * adelta) + 0.05f);
}
template <int HH> DI void hy_finalize(const cf2 (&u)[16], LAS cf2* X, LAS cf2* Z1, const unsigned* Uz, const unsigned* Ux1, const unsigned* Ux2, unsigned* zt, int lo_, int o, float bias) {
#pragma unroll
    for (int j = 0; j < 8; ++j) {
        const int t = (8 * HH + j) * 256 + lo_;
        const cf2 mine = u[8 * HH + j];
        const cf2 oth = X[fphys((HH ? 0 : 4096) + t)];
        const cf2 y = MK2(mine.x + oth.x, mine.y + oth.y);
        if (o == 0) { const unsigned wz = Uz[t], w1 = Ux1[t];
            Z1[t] = MK2(bflo(w1) * (y.x + bias * bflo(wz)), bfhi(w1) * (y.y + bias * bfhi(wz))); }
        else { const unsigned w2 = Ux2[t]; const cf2 z1 = Z1[t];
            zt[t] = pk2(bflo(w2) * (y.x + bias * z1.x), bfhi(w2) * (y.y + bias * z1.y)); }
    }
}
DI void p4_hyena(Frame& F) {
    unsigned char* ws = F.a->ws; const int tid = F.tid, H = tid >> 8, lo = tid & 255;
    LAS cf2* X = (LAS cf2*)F.lds;
    LAS cf2* Z1 = (LAS cf2*)(F.lds + 69632);
    LAS cf2* TW4 = (LAS cf2*)(F.lds + 102400); LAS cf2* TW8 = TW4 + 256;
    LAS float* W3S = (LAS float*)(F.lds + 106496);
    const float* HID2 = (const float*)(ws + WS_HID2);
    cf2* KG = (cf2*)(ws + WS_KSP) + (size_t)F.blk * 16384;
    const unsigned* UT = (const unsigned*)(ws + WS_UT); unsigned* ZT = (unsigned*)(ws + WS_ZT);
    if (tid < 256) { float sn, cs; sincospif((float)tid * (1.f / 2048.f), &sn, &cs); TW4[tid] = MK2(cs, -sn); sincospif((float)tid * (1.f / 4096.f), &sn, &cs); TW8[tid] = MK2(cs, -sn); }
    __syncthreads();
    LAS float* TS = (LAS float*)Z1;
    for (int c = F.blk; c < 512; c += F.G) {
        for (int o = 0; o < 2; ++o) {
            if (tid < 128) { const int d = tid >> 6, j = tid & 63; W3S[tid] = F.a->in[IN_HW3][(size_t)j * 2048 + (o * 2 + d) * 512 + c]; }
            __syncthreads();
            const float adf = fabsf(F.a->in[IN_HDELTA][(o * 2) * 512 + c]), adb = fabsf(F.a->in[IN_HDELTA][(o * 2 + 1) * 512 + c]);
#pragma unroll 1
            for (int n = tid; n < 8192; n += 512) {
                float val;
                if (n < SEQ) { val = filt_tap(HID2, W3S, n, adf); if (n == 0) val += filt_tap(HID2, W3S + 64, 0, adb); }
                else if (n == SEQ) val = 0.f;
                else val = filt_tap(HID2, W3S + 64, 2 * SEQ - n, adb);
                TS[n] = val;
            }
            __syncthreads();
            {
                int tl = tid; LAUNDER(tl); const int lo_ = tl & 255;
                cf2 a[16], b[16];
#pragma unroll
                for (int k = 0; k < 16; ++k) { a[k] = MK2(TS[k * 256 + lo_], 0.f); b[k] = MK2(TS[SEQ + k * 256 + lo_], 0.f); }
                fft_passA_fwd(tl, a, b, X, TW4, TW8);
            }
            __syncthreads();
            { int tl = tid; LAUNDER(tl); fft_passB_fwd(tl, X, TW4); }
            __syncthreads();
            { int tl = tid; LAUNDER(tl); cf2 v[16]; fft_passC_fwd(tl, X, v);
              cf2* kg = KG + o * 8192 + tl;
#pragma unroll
              for (int r = 0; r < 16; ++r) kg[r * 512] = MK2(v[r].x * (1.f / 8192.f), v[r].y * (1.f / 8192.f)); }
            __syncthreads();
        }
        const float bias0 = F.a->in[IN_HBIAS][c], bias1 = F.a->in[IN_HBIAS][512 + c];
#pragma unroll 1
        for (int p = 0; p < 4; ++p) {
            const unsigned* Ux1 = UT + (((size_t)0 * 4 + p) * 512 + c) * SEQ; const unsigned* Ux2 = UT + (((size_t)1 * 4 + p) * 512 + c) * SEQ; const unsigned* Uz = UT + (((size_t)2 * 4 + p) * 512 + c) * SEQ;
#pragma unroll 1
            for (int o = 0; o < 2; ++o) {
                { int tl = tid; LAUNDER(tl); const int lo_ = tl & 255;
                    cf2 a[16], b[16];
#pragma unroll
                    for (int k = 0; k < 16; ++k) {
                        if (o == 0) { const unsigned w = Uz[k * 256 + lo_]; a[k] = MK2(bflo(w), bfhi(w)); } else a[k] = Z1[k * 256 + lo_];
                        b[k] = MK2(0.f, 0.f); }
                    fft_passA_fwd(tl, a, b, X, TW4, TW8);
                }
                __syncthreads();
                { int tl = tid; LAUNDER(tl); fft_passB_fwd(tl, X, TW4); }
                __syncthreads();
                { int tl = tid; LAUNDER(tl); cf2 v[16]; fft_passC_fwd(tl, X, v);
                  const cf2* kg = KG + o * 8192 + tl;
#pragma unroll
                  for (int r = 0; r < 16; ++r) v[r] = c_mul(v[r], kg[r * 512]);
                  fft_passC_inv(tl, X, v); }
                __syncthreads();
                { int tl = tid; LAUNDER(tl); fft_passB_inv(tl, X, TW4); }
                __syncthreads();
                {
                    int tl = tid; LAUNDER(tl); const int H_ = tl >> 8, lo_ = tl & 255;
                    cf2 u[16]; fft_passA_inv(tl, X, TW4, TW8, u);
                    if (H_ == 0) {
#pragma unroll
                        for (int k = 8; k < 16; ++k) X[fphys(k * 256 + lo_)] = u[k];
                    } else {
#pragma unroll
                        for (int k = 0; k < 8; ++k) X[fphys(4096 + k * 256 + lo_)] = u[k];
                    }
                    __syncthreads();
                    const float bias = (o == 0) ? bias0 : bias1;
                    if (H_ == 0) hy_finalize<0>(u, X, Z1, Uz, Ux1, Ux2, ZT + ((size_t)p * 512 + c) * SEQ, lo_, o, bias);
                    else hy_finalize<1>(u, X, Z1, Uz, Ux1, Ux2, ZT + ((size_t)p * 512 + c) * SEQ, lo_, o, bias);
                }
                __syncthreads();
            }
        }
    }
}

DI void p5_post(Frame& F) {
    unsigned char* ws = F.a->ws; const int lane = F.lane;
    bf16* Y = (bf16*)(ws + WS_H); const bf16* P = (const bf16*)(ws + WS_P); const bf16* HM = (const bf16*)(ws + WS_HM);
    {
        const int gw = F.blk * 8 + F.wave, NGW = F.G * 8;
        const f32x4 g0 = *(const f32x4*)(F.a->in[IN_MNG] + 8 * lane), g1 = *(const f32x4*)(F.a->in[IN_MNG] + 8 * lane + 4);
        for (int row = gw; row < MTOK; row += NGW) {
            const v4u a = *(const v4u*)(HM + (size_t)row * 512 + 8 * lane), bq = *(const v4u*)(HM + ((size_t)MTOK + row) * 512 + 8 * lane);
            const v4u ov = *(const v4u*)(P + (size_t)row * NPROJ + 1536 + 8 * lane);
            float hsum[8], og[8];
#pragma unroll
            for (int e = 0; e < 4; ++e) { hsum[2 * e] = bflo(a[e]) + bflo(bq[e]); hsum[2 * e + 1] = bfhi(a[e]) + bfhi(bq[e]); og[2 * e] = bflo(ov[e]); og[2 * e + 1] = bfhi(ov[e]); }
            float ss = 0.f;
#pragma unroll
            for (int e = 0; e < 8; ++e) ss += hsum[e] * hsum[e];
            ss += __shfl_xor(ss, 1); ss += __shfl_xor(ss, 2); ss += __shfl_xor(ss, 4); ss += __shfl_xor(ss, 8);
            const float rstd = rsqrtf(ss * (1.f / 128.f) + RMS_EPS);
            const float gg[8] = {g0.x, g0.y, g0.z, g0.w, g1.x, g1.y, g1.z, g1.w};
            float o[8];
#pragma unroll
            for (int e = 0; e < 8; ++e) o[e] = sigmoidf_(og[e]) * hsum[e] * rstd * gg[e];
            v4u w; w.x = pk2(o[0], o[1]); w.y = pk2(o[2], o[3]); w.z = pk2(o[4], o[5]); w.w = pk2(o[6], o[7]);
            *(v4u*)(Y + (size_t)row * 1024 + 8 * lane) = w;
        }
    }
    {
        const bf16* ZT = (const bf16*)(ws + WS_ZT);
        LAS bf16* tile = (LAS bf16*)F.lds;
        const f32x4 g0 = *(const f32x4*)(F.a->in[IN_HNG] + 8 * lane), g1 = *(const f32x4*)(F.a->in[IN_HNG] + 8 * lane + 4);
        const float gg[8] = {g0.x, g0.y, g0.z, g0.w, g1.x, g1.y, g1.z, g1.w};
        __syncthreads();
        for (int u = F.blk; u < 4 * 128; u += F.G) {
            const int p = u >> 7, tt = u & 127;
            for (int pc = F.tid; pc < 4096; pc += 512) {
                const int c = pc >> 3, q = pc & 7;
                const v4u v = *(const v4u*)(ZT + (((size_t)p * 512 + c) * SEQ + tt * 32) * 2 + q * 8);
#pragma unroll
                for (int i = 0; i < 4; ++i) { tile[((4 * q + i) * 2 + 0) * 520 + c] = (bf16)(v[i] & 0xffffu); tile[((4 * q + i) * 2 + 1) * 520 + c] = (bf16)(v[i] >> 16); }
            }
            __syncthreads();
#pragma unroll 2
            for (int rr = 0; rr < 8; ++rr) {
                const int row = F.wave * 8 + rr, t = row >> 1, bs = row & 1, token = (2 * p + bs) * SEQ + tt * 32 + t;
                const v4u v = *(const LAS v4u*)(tile + row * 520 + 8 * lane);
                float z[8];
#pragma unroll
                for (int e = 0; e < 4; ++e) { z[2 * e] = bflo(v[e]); z[2 * e + 1] = bfhi(v[e]); }
                float ss = 0.f;
#pragma unroll
                for (int e = 0; e < 8; ++e) ss += z[e] * z[e];
                ss += __shfl_xor(ss, 1); ss += __shfl_xor(ss, 2); ss += __shfl_xor(ss, 4); ss += __shfl_xor(ss, 8);
                const float rstd = rsqrtf(ss * (1.f / 128.f) + RMS_EPS);
                v4u w; w.x = pk2(z[0] * rstd * gg[0], z[1] * rstd * gg[1]); w.y = pk2(z[2] * rstd * gg[2], z[3] * rstd * gg[3]);
                w.z = pk2(z[4] * rstd * gg[4], z[5] * rstd * gg[5]); w.w = pk2(z[6] * rstd * gg[6], z[7] * rstd * gg[7]);
                *(v4u*)(Y + (size_t)token * 1024 + 512 + 8 * lane) = w;
            }
            __syncthreads();
        }
    }
}

DI void conv_wgu(Frame& F) {
    LAS float* scr = (LAS float*)(F.lds + F.wave * 16384); bf16* WGU = (bf16*)(F.a->ws + WS_WGU);
    const int gw = F.blk * 8 + F.wave, NGW = F.G * 8;
    for (int it = gw; it < 16 * 16 * 128; it += NGW) {
        const int nb = it & 127, kb = (it >> 7) & 15, e = it >> 11, n0 = 32 * nb, k0 = 64 * kb, j = n0 >> 8, r = n0 & 255, f0 = 128 * j + (r & 127);
        const float* W = (r < 128 ? F.a->in[IN_WGATE] : F.a->in[IN_WUP]) + (size_t)e * 1024 * 2048;
        transpose_item(W + (size_t)k0 * 2048 + f0, 2048, WGU + ((size_t)e * 4096 + n0) * 1024 + k0, 1024, scr, F.lane);
    }
}
DI void conv_wd(Frame& F) {
    LAS float* scr = (LAS float*)(F.lds + F.wave * 16384); bf16* WD = (bf16*)(F.a->ws + WS_WD);
    const int gw = F.blk * 8 + F.wave, NGW = F.G * 8;
    for (int it = gw; it < 16 * 32 * 32; it += NGW) {
        const int nb = it & 31, kb = (it >> 5) & 31, e = it >> 10, n0 = 32 * nb, k0 = 64 * kb;
        transpose_item(F.a->in[IN_WDOWN] + (size_t)e * 2048 * 1024 + (size_t)k0 * 1024 + n0, 1024, WD + ((size_t)e * 1024 + n0) * 2048 + k0, 2048, scr, F.lane);
    }
}

DI void p8_topk(Frame& F) {
    unsigned char* ws = F.a->ws; const int tid = F.tid, lane = F.lane, wave = F.wave;
    LAS unsigned* hist = (LAS unsigned*)F.lds;
    LAS unsigned* wtot = hist + 256;
    LAS unsigned* ctl = wtot + 8;
    LAS int* sel = (LAS int*)(ctl + 8);
    const float* AFF = (const float*)(ws + WS_AFF); const bf16* HF = (const bf16*)(ws + WS_HF); bf16* XS = (bf16*)(ws + WS_XS);
    int* IDX = (int*)(ws + WS_IDX); float* GSEL = (float*)(ws + WS_GSEL); int* INV = (int*)(ws + WS_INV);
    for (int it = F.blk; it < NB * NEXP; it += F.G) {
        const int b = it >> 4, e = it & 15;
        unsigned k8[8];
        { const v4u a = *(const v4u*)(AFF + (size_t)it * SEQ + 8 * tid), c2 = *(const v4u*)(AFF + (size_t)it * SEQ + 8 * tid + 4);
          k8[0] = a.x; k8[1] = a.y; k8[2] = a.z; k8[3] = a.w; k8[4] = c2.x; k8[5] = c2.y; k8[6] = c2.z; k8[7] = c2.w; }
        unsigned prefix = 0u, need = CAP;
#pragma unroll 1
        for (int pass = 0; pass < 4; ++pass) {
            const int shift = 24 - 8 * pass; const unsigned mask = pass ? (0xffffffffu << (shift + 8)) : 0u;
            if (tid < 256) hist[tid] = 0u;
            __syncthreads();
#pragma unroll
            for (int i = 0; i < 8; ++i) if ((k8[i] & mask) == prefix) atomicAdd((unsigned*)(hist + ((k8[i] >> shift) & 255u)), 1u);
            __syncthreads();
            if (wave == 0) {
                const unsigned h0 = hist[4 * lane], h1 = hist[4 * lane + 1], h2 = hist[4 * lane + 2], h3 = hist[4 * lane + 3], s = h0 + h1 + h2 + h3;
                unsigned suf = s;
#pragma unroll
                for (int o = 1; o < 64; o <<= 1) { const unsigned t = __shfl_down(suf, o); if (lane + o < 64) suf += t; }
                const unsigned above = suf - s;
                if (above < need && need <= suf) {
                    unsigned rem = need - above; int bin;
                    if (h3 >= rem) bin = 3; else { rem -= h3; if (h2 >= rem) bin = 2; else { rem -= h2; if (h1 >= rem) bin = 1; else { rem -= h1; bin = 0; } } }
                    ctl[0] = prefix | ((unsigned)(4 * lane + bin) << shift); ctl[1] = rem;
                }
            }
            __syncthreads();
            prefix = ctl[0]; need = ctl[1];
        }
        const unsigned T = prefix;
        unsigned cg = 0u, ce = 0u;
#pragma unroll
        for (int i = 0; i < 8; ++i) { cg += (k8[i] > T) ? 1u : 0u; ce += (k8[i] == T) ? 1u : 0u; }
        const unsigned pack = cg | (ce << 16);
        unsigned inc = pack;
#pragma unroll
        for (int o = 1; o < 64; o <<= 1) { const unsigned t = __shfl_up(inc, o); if (lane >= o) inc += t; }
        if (lane == 63) wtot[wave] = inc;
        __syncthreads();
        unsigned woff = 0u;
#pragma unroll
        for (int w = 0; w < 8; ++w) woff += (w < wave) ? wtot[w] : 0u;
        const unsigned exc = woff + inc - pack;
        unsigned gtb = exc & 0xffffu, eqb = exc >> 16;
#pragma unroll
        for (int i = 0; i < 8; ++i) {
            const int idx = 8 * tid + i; const bool isgt = k8[i] > T, iseq = k8[i] == T, selc = isgt || (iseq && eqb < need);
            const int slot = (int)(gtb + (eqb < need ? eqb : need));
            if (selc) { sel[slot] = idx; IDX[it * CAP + slot] = idx; GSEL[it * CAP + slot] = __uint_as_float(k8[i]); }
            INV[((size_t)b * SEQ + idx) * 16 + e] = selc ? slot : -1;
            gtb += isgt ? 1u : 0u; eqb += iseq ? 1u : 0u;
        }
        __syncthreads();
        for (int s = wave; s < CAP; s += 8) {
            const int row = sel[s];
            const v4u* src = (const v4u*)(HF + ((size_t)b * SEQ + row) * 1024); v4u* dst = (v4u*)(XS + (((size_t)e * NB + b) * CAP + s) * 1024);
            const v4u x0 = src[lane], x1 = src[lane + 64]; dst[lane] = x0; dst[lane + 64] = x1;
        }
        __syncthreads();
    }
}

DI void p12_final(Frame& F) {
    unsigned char* ws = F.a->ws; const int lane = F.lane;
    const int* INV = (const int*)(ws + WS_INV); const float* GSEL = (const float*)(ws + WS_GSEL); const bf16* YS = (const bf16*)(ws + WS_YS); const float* MOD = (const float*)(ws + WS_MOD);
    const int gw = F.blk * 8 + F.wave, NGW = F.G * 8;
    for (int row = gw; row < MTOK; row += NGW) {
        const int b = row >> 12;
        f32x4* xr = (f32x4*)(F.a->out + (size_t)row * 1024) + lane;
        f32x4 v[4], acc[4];
#pragma unroll
        for (int j = 0; j < 4; ++j) { v[j] = xr[64 * j]; acc[j] = (f32x4){0.f, 0.f, 0.f, 0.f}; }
        const int myslot = INV[(size_t)row * 16 + (lane & 15)];
#pragma unroll 1
        for (int e = 0; e < 16; ++e) {
            const int s = __shfl(myslot, e);
            if (s >= 0) {
                const float g = GSEL[((size_t)b * 16 + e) * CAP + s];
                const v2u* yr = (const v2u*)(YS + (((size_t)e * NB + b) * CAP + s) * 1024) + lane;
#pragma unroll
                for (int j = 0; j < 4; ++j) { const v2u w = yr[64 * j]; acc[j] += (f32x4){bflo(w.x), bfhi(w.x), bflo(w.y), bfhi(w.y)} * g; }
            }
        }
        float ss = 0.f;
#pragma unroll
        for (int j = 0; j < 4; ++j) { const f32x4 gt = *(const f32x4*)(MOD + b * 6144 + 5120 + 256 * j + 4 * lane); v[j] = v[j] + gt * acc[j]; ss += (v[j].x * v[j].x + v[j].y * v[j].y) + (v[j].z * v[j].z + v[j].w * v[j].w); }
        const float rstd = rsqrtf(wave_sum(ss) * (1.f / 1024.f) + RMS_EPS);
#pragma unroll
        for (int j = 0; j < 4; ++j) { const f32x4 g = *(const f32x4*)(F.a->in[IN_GFINAL] + 256 * j + 4 * lane); xr[64 * j] = v[j] * rstd * g; }
    }
}

typedef short bf16x8_t __attribute__((ext_vector_type(8)));
DI unsigned offb(unsigned row, unsigned ch) { return 256u * row + 16u * (ch ^ (((row & 3u) << 2) | ((row >> 2) & 3u))); }
DI bf16x8_t tr_read2(unsigned a0, unsigned a1) {
    v2u lo, hi;
    asm volatile("ds_read_b64_tr_b16 %0, %2\n\tds_read_b64_tr_b16 %1, %3\n\ts_waitcnt lgkmcnt(0)" : "=&v"(lo), "=&v"(hi) : "v"(a0), "v"(a1) : "memory");
    const v4u w = (v4u){lo.x, lo.y, hi.x, hi.y};
    return __builtin_bit_cast(bf16x8_t, w);
}
DI bf16x8_t lds_frag(const LAS unsigned char* p) { return *(const LAS bf16x8_t*)p; }
#define MFMA16(a, b, c) __builtin_amdgcn_mfma_f32_16x16x32_bf16((a), (b), (c), 0, 0, 0)
constexpr int ML_QT = 0, ML_KT = 32768, ML_VT = 65536, ML_VE = 81920, ML_CB = 98304, ML_OUT = 110592, ML_SC = 118784, ML_SCSZ = 2688;
DI void p4_mlstm_mfma(Frame& F) {
    unsigned char* ws = F.a->ws; LAS unsigned char* L = F.lds;
    const bf16* QK = (const bf16*)(ws + WS_H); const bf16* P = (const bf16*)(ws + WS_P); const float* GATES = (const float*)(ws + WS_GATES);
    bf16* HM = (bf16*)(ws + WS_HM);
    const int tid = F.tid, lane = F.lane, wave = F.wave, fr = lane & 15, fq = lane >> 4, q4 = fr >> 2, p4 = fr & 3;
    const int tb = (wave < 4) ? wave : 11 - wave;
    const unsigned ldsb = (unsigned)(uintptr_t)L;
    for (int it = F.blk; it < 256; it += F.G) {
        const int vs = it & 3, dir = (it >> 2) & 1, h = (it >> 3) & 3, b = it >> 5;
        __syncthreads();
        for (int i = tid; i < 12288 / 16; i += 512) *(LAS v4u*)(L + ML_CB + 16 * i) = (v4u){0u, 0u, 0u, 0u};
        if (tid < 256) { const int row = tid >> 1, hf = tid & 1;
            *(LAS v4u*)(L + ML_VT + row * 128 + 64 + 16 * hf) = (v4u){hf ? 0u : 0x3F80u, 0u, 0u, 0u};
            *(LAS v4u*)(L + ML_VE + row * 128 + 64 + 16 * hf) = (v4u){0u, 0u, 0u, 0u}; }
        f32x4 Cacc[3];
#pragma unroll
        for (int vt = 0; vt < 3; ++vt) Cacc[vt] = (f32x4){0.f, 0.f, 0.f, 0.f};
        float m_in = -1e30f;
        float gpre[4] = {0.f, 0.f, 0.f, 0.f};
        v4u rq[4], rk[4], rv;
        auto load_gates = [&](int cj) {
#pragma unroll
            for (int e = 0; e < 2; ++e) { const int tg = cj * 128 + 2 * lane + e, token = b * SEQ + (dir ? SEQ - 1 - tg : tg);
                gpre[2 * e] = GATES[(size_t)token * 16 + 8 * dir + h]; gpre[2 * e + 1] = GATES[(size_t)token * 16 + 8 * dir + 4 + h]; }
        };
        auto scan = [&](int cj) {
            LAS float* SC = (LAS float*)(L + ML_SC + (cj & 1) * ML_SCSZ);
            const float lf0 = fminf(gpre[1], 0.f) - log1pf(__expf(-fabsf(gpre[1]))), lf1 = fminf(gpre[3], 0.f) - log1pf(__expf(-fabsf(gpre[3])));
            float inc = lf0 + lf1;
#pragma unroll
            for (int o = 1; o < 64; o <<= 1) { const float t = __shfl_up(inc, o); if (lane >= o) inc += t; }
            const float b1 = inc, b0 = inc - lf1, u0 = gpre[0] - b0, u1 = gpre[2] - b1;
            float imx = fmaxf(u0, u1);
#pragma unroll
            for (int o = 1; o < 64; o <<= 1) { const float t = __shfl_up(imx, o); if (lane >= o) imx = fmaxf(imx, t); }
            float exm = __shfl_up(imx, 1); if (lane == 0) exm = -3.0e38f;
            const float M0 = fmaxf(m_in, fmaxf(exm, u0)), M1 = fmaxf(m_in, imx);
            const float g = __shfl(b1, 63), Ml = __shfl(M1, 63);
            SC[2 * lane] = u0; SC[2 * lane + 1] = u1;
            SC[128 + 2 * lane] = M0; SC[128 + 2 * lane + 1] = M1;
            SC[256 + 2 * lane] = __expf(m_in - M0); SC[256 + 2 * lane + 1] = __expf(m_in - M1);
            SC[384 + 2 * lane] = __expf(-(b0 + M0)); SC[384 + 2 * lane + 1] = __expf(-(b1 + M1));
            SC[512 + 2 * lane] = __expf(u0 - Ml); SC[512 + 2 * lane + 1] = __expf(u1 - Ml);
            if (lane == 0) SC[640] = __expf(m_in - Ml);
            m_in = g + Ml;
        };
        auto load_tiles = [&](int cj) {
#pragma unroll
            for (int i = 0; i < 4; ++i) { const int id = tid + 512 * i, row = id >> 4, ch = id & 15, tg = cj * 128 + row, token = b * SEQ + (dir ? SEQ - 1 - tg : tg);
                rq[i] = *(const v4u*)(QK + (size_t)token * 1024 + h * 128 + 8 * ch); rk[i] = *(const v4u*)(QK + (size_t)token * 1024 + 512 + h * 128 + 8 * ch); }
            { const int row = tid >> 2, pc = tid & 3, tg = cj * 128 + row, token = b * SEQ + (dir ? SEQ - 1 - tg : tg);
              rv = *(const v4u*)(P + (size_t)token * NPROJ + 1024 + h * 128 + 32 * vs + 8 * pc); }
        };
        auto store_tiles = [&](int cj) {
            const LAS float* SC = (const LAS float*)(L + ML_SC + (cj & 1) * ML_SCSZ);
#pragma unroll
            for (int i = 0; i < 4; ++i) { const int id = tid + 512 * i, row = id >> 4, ch = id & 15;
                *(LAS v4u*)(L + ML_QT + offb(row, ch)) = rq[i]; *(LAS v4u*)(L + ML_KT + offb(row, ch)) = rk[i]; }
            { const int row = tid >> 2, pc = tid & 3; const float e = SC[512 + row];
              *(LAS v4u*)(L + ML_VT + row * 128 + 16 * pc) = rv;
              v4u w; w.x = pk2(bflo(rv.x) * e, bfhi(rv.x) * e); w.y = pk2(bflo(rv.y) * e, bfhi(rv.y) * e); w.z = pk2(bflo(rv.z) * e, bfhi(rv.z) * e); w.w = pk2(bflo(rv.w) * e, bfhi(rv.w) * e);
              *(LAS v4u*)(L + ML_VE + row * 128 + 16 * pc) = w;
              if (pc == 0) *(LAS bf16*)(L + ML_VE + row * 128 + 64) = (bf16)f2bf(e); }
        };
        if (wave == 0) { load_gates(0); scan(0); load_gates(1); }
        load_tiles(0);
        __syncthreads();
        store_tiles(0);
        __syncthreads();
#pragma unroll 1
        for (int cj = 0; cj < 32; ++cj) {
            const LAS float* SC = (const LAS float*)(L + ML_SC + (cj & 1) * ML_SCSZ);
            if (cj + 1 < 32) { if (wave == 0) { scan(cj + 1); if (cj + 2 < 32) load_gates(cj + 2); } load_tiles(cj + 1); }
            bf16x8_t qf[4];
#pragma unroll
            for (int ks = 0; ks < 4; ++ks) qf[ks] = lds_frag(L + ML_QT + offb(16 * tb + fr, 4 * ks + fq));
            f32x4 accO[3];
#pragma unroll
            for (int vt = 0; vt < 3; ++vt) { accO[vt] = (f32x4){0.f, 0.f, 0.f, 0.f};
#pragma unroll
                for (int ks = 0; ks < 4; ++ks) accO[vt] = MFMA16(qf[ks], lds_frag(L + ML_CB + offb(16 * vt + fr, 4 * ks + fq)), accO[vt]); }
            { const f32x4 ei = *(const LAS f32x4*)(SC + 256 + 16 * tb + 4 * fq);
#pragma unroll
              for (int vt = 0; vt < 3; ++vt) accO[vt] = accO[vt] * ei; }
            const float mrow_t = SC[128 + 16 * tb + fr];
            for (int ks2 = 0; ks2 <= (tb >> 1); ++ks2) {
                f32x4 st[2];
#pragma unroll
                for (int hh = 0; hh < 2; ++hh) {
                    const int sb = 2 * ks2 + hh;
                    st[hh] = (f32x4){0.f, 0.f, 0.f, 0.f};
                    if (sb <= tb) {
                        f32x4 acc = (f32x4){0.f, 0.f, 0.f, 0.f};
#pragma unroll
                        for (int kd = 0; kd < 4; ++kd) acc = MFMA16(lds_frag(L + ML_KT + offb(16 * sb + fr, 4 * kd + fq)), qf[kd], acc);
                        const f32x4 us = *(const LAS f32x4*)(SC + 16 * sb + 4 * fq);
#pragma unroll
                        for (int r = 0; r < 4; ++r) { const float val = acc[r] * __expf(us[r] - mrow_t); st[hh][r] = (16 * sb + 4 * fq + r <= 16 * tb + fr) ? val : 0.f; }
                    }
                }
                v4u sw; sw.x = pk2(st[0][0], st[0][1]); sw.y = pk2(st[0][2], st[0][3]); sw.z = pk2(st[1][0], st[1][1]); sw.w = pk2(st[1][2], st[1][3]);
                const bf16x8_t sp = __builtin_bit_cast(bf16x8_t, sw);
                const unsigned va = ldsb + ML_VT + (32 * ks2 + 4 * fq + q4) * 128 + 8 * p4;
#pragma unroll
                for (int vt = 0; vt < 3; ++vt) accO[vt] = MFMA16(sp, tr_read2(va + 32 * vt, va + 32 * vt + 16 * 128), accO[vt]);
            }
            { const f32x4 enm = *(const LAS f32x4*)(SC + 384 + 16 * tb + 4 * fq);
#pragma unroll
              for (int r = 0; r < 4; ++r) { const float den = __shfl(accO[2][r], lane & 48), inv = 1.f / fmaxf(fabsf(den), enm[r]);
                  const int t = 16 * tb + 4 * fq + r;
                  *(LAS bf16*)(L + ML_OUT + t * 64 + 2 * fr) = (bf16)f2bf(accO[0][r] * inv); *(LAS bf16*)(L + ML_OUT + t * 64 + 32 + 2 * fr) = (bf16)f2bf(accO[1][r] * inv); } }
            { const float sp = SC[640];
#pragma unroll
              for (int vt = 0; vt < 3; ++vt) Cacc[vt] = Cacc[vt] * sp; }
#pragma unroll
            for (int ks = 0; ks < 4; ++ks) {
                const unsigned r0 = 32 * ks + 8 * fq + q4;
                const bf16x8_t kb = tr_read2(ldsb + ML_KT + offb(r0, 2 * wave + (p4 >> 1)) + 8 * (p4 & 1), ldsb + ML_KT + offb(r0 + 4, 2 * wave + (p4 >> 1)) + 8 * (p4 & 1));
                const unsigned ea = ldsb + ML_VE + r0 * 128 + 8 * p4;
#pragma unroll
                for (int vt = 0; vt < 3; ++vt) Cacc[vt] = MFMA16(tr_read2(ea + 32 * vt, ea + 32 * vt + 4 * 128), kb, Cacc[vt]);
            }
            __syncthreads();
#pragma unroll
            for (int vt = 0; vt < 3; ++vt)
#pragma unroll
                for (int r = 0; r < 4; ++r) { const int v = 16 * vt + 4 * fq + r, d = 16 * wave + fr;
                    *(LAS bf16*)(L + ML_CB + offb(v, d >> 3) + 2 * (d & 7)) = (bf16)f2bf(Cacc[vt][r]); }
            { const int row = tid >> 2, pc = tid & 3, tg = cj * 128 + row, token = b * SEQ + (dir ? SEQ - 1 - tg : tg);
              *(v4u*)(HM + ((size_t)dir * MTOK + token) * 512 + h * 128 + 32 * vs + 8 * pc) = *(const LAS v4u*)(L + ML_OUT + row * 64 + 16 * pc); }
            if (cj + 1 < 32) store_tiles(cj + 1);
            __syncthreads();
        }
    }
}
__global__ void __launch_bounds__(512, 2) fwd_kernel(Args args) {
    extern __shared__ __attribute__((aligned(16))) unsigned char lds[];
    Frame F;
    F.lds = (LAS unsigned char*)lds;
    F.tid = threadIdx.x; F.lane = F.tid & 63; F.wave = __builtin_amdgcn_readfirstlane(F.tid >> 6);
    F.G = gridDim.x; F.blk = blockIdx.x;
    F.a = &args;
    volatile LAS unsigned* MISC = (volatile LAS unsigned*)(F.lds + MISC_OFF);
    if (F.tid < 64) MISC[F.tid] = 0u;
    __syncthreads();
    XcdBarrier bar; bar.bar = (unsigned*)(F.a->ws + WS_CTL); bar.x = 0; bar.st = nullptr;
    if (N_LAUNCHES == 1) bar = xcd_barrier_post((unsigned*)(F.a->ws + WS_CTL), MISC + 8);
    const int lo = args.ph_lo, hi = args.ph_hi;
#define IN(k) (lo <= (k) && (k) < hi)
#define SEAM(k) do { if (IN(k) && IN((k) + 1)) xcd_barrier(bar); } while (0)
    unsigned char* ws = F.a->ws;
    if (IN(0)) { p0_prologue(F); } SEAM(0);
    if (IN(1)) { p_norm<false>(F); } SEAM(1);
    if (IN(2)) {
        pg8::Gemm g{(const pg8::bf16_t*)(ws + WS_H), (const pg8::bf16_t*)(ws + WS_WIN), MTOK, NPROJ, DM}; pg8::StaticOrder S; S.init(MTOK, NPROJ, F.G, F.blk);
        pg8::EpiBf16<0> E{(pg8::bf16_t*)(ws + WS_P), NPROJ, (const float*)(ws + WS_BIN2), 0, 0, 1.f};
        pg8::gemm_phase<pg8::EpiBf16<0>, pg8::StaticOrder, true, true>(F.lds, g, S, E);
    } SEAM(2);
    if (IN(3)) { p3_prep(F); } SEAM(3);
    if (IN(4)) { p4_hyena(F); __syncthreads(); p4_mlstm_mfma(F); } SEAM(4);
    if (IN(5)) { p5_post(F); } SEAM(5);
    if (IN(6)) {
        pg8::Gemm g{(const pg8::bf16_t*)(ws + WS_H), (const pg8::bf16_t*)(ws + WS_WOUT), MTOK, DM, DM}; pg8::StaticOrder S; S.init(MTOK, DM, F.G, F.blk);
        pg8::EpiRes E{F.a->in[IN_X], F.a->out, (const float*)(ws + WS_MOD)};
        pg8::gemm_phase<pg8::EpiRes, pg8::StaticOrder, true, true>(F.lds, g, S, E);
    } SEAM(6);
    if (IN(7)) { p_norm<true>(F); __syncthreads(); conv_wgu(F); } SEAM(7);
    if (IN(8)) { p8_topk(F); } SEAM(8);
    if (IN(9)) {
        pg8::Gemm g{(const pg8::bf16_t*)(ws + WS_XS), (const pg8::bf16_t*)(ws + WS_WGU), NSLOT, NEXP * 4096, DM}; pg8::MoeOrderA S{F.G, F.blk};
        pg8::EpiSwiGLU E{(pg8::bf16_t*)(ws + WS_HID)};
        pg8::gemm_phase<pg8::EpiSwiGLU, pg8::MoeOrderA, true, true>(F.lds, g, S, E);
    } SEAM(9);
    if (IN(10)) { conv_wd(F); } SEAM(10);
    if (IN(11)) {
        pg8::Gemm g{(const pg8::bf16_t*)(ws + WS_HID), (const pg8::bf16_t*)(ws + WS_WD), NSLOT, NEXP * 1024, FFD}; pg8::MoeOrderB S{F.G, F.blk};
        pg8::EpiYs E{(pg8::bf16_t*)(ws + WS_YS)};
        pg8::gemm_phase<pg8::EpiYs, pg8::MoeOrderB, true, true>(F.lds, g, S, E);
    } SEAM(11);
    if (IN(12)) { p12_final(F); }
#undef IN
#undef SEAM
}

extern "C" void kernel_launch(void* const* d_in, const int* in_sizes, int n_in, void* d_out, int out_size, void* d_ws, size_t ws_size, hipStream_t stream) {
    static int grid = 0;
    if (grid == 0) {
        if (n_in != 28 || out_size != MTOK * DM || ws_size < WS_END) { fprintf(stderr, "kernel_launch: unexpected shapes (n_in %d, out %d, ws %zu < %zu)\n", n_in, out_size, ws_size, (size_t)WS_END); grid = -1; return; }
        int dev = 0, cus = 0;
        if (hipGetDevice(&dev) != hipSuccess || hipDeviceGetAttribute(&cus, hipDeviceAttributeMultiprocessorCount, dev) != hipSuccess) { grid = -1; return; }
        if (hipFuncSetAttribute((const void*)fwd_kernel, hipFuncAttributeMaxDynamicSharedMemorySize, LDS_BYTES) != hipSuccess) { fprintf(stderr, "kernel_launch: hipFuncSetAttribute failed\n"); grid = -1; return; }
        int per_cu = 0;
        if (hipOccupancyMaxActiveBlocksPerMultiprocessor(&per_cu, (const void*)fwd_kernel, 512, LDS_BYTES) != hipSuccess || per_cu < 1) fprintf(stderr, "kernel_launch: occupancy query reports %d\n", per_cu);
        (void)hipGetLastError();
        grid = cus > 256 ? 256 : cus;
    }
    if (grid < 0) return;
    (void)hipMemsetAsync((char*)d_ws + WS_CTL, 0, CTL_ZERO_BYTES, stream);
    Args a{};
    for (int i = 0; i < 28; ++i) a.in[i] = (const float*)d_in[i];
    a.out = (float*)d_out; a.ws = (unsigned char*)d_ws;
    if (N_LAUNCHES == 1) { a.ph_lo = 0; a.ph_hi = N_PHASES; hipLaunchKernelGGL(fwd_kernel, dim3(grid), dim3(512), LDS_BYTES, stream, a); }
    else for (int p = 0; p < N_PHASES; ++p) { a.ph_lo = p; a.ph_hi = p + 1; hipLaunchKernelGGL(fwd_kernel, dim3(grid), dim3(512), LDS_BYTES, stream, a); }
}
```

```cpp
#include <hip/hip_runtime.h>
#include <cstdio>
#include <cstdint>
#define N_LAUNCHES 1
namespace pg8 {
#define PG8_LAS __attribute__((address_space(3)))
typedef unsigned short bf16_t;
typedef short bf16x8 __attribute__((ext_vector_type(8)));
typedef float f32x4 __attribute__((ext_vector_type(4)));
typedef unsigned u32x4 __attribute__((ext_vector_type(4)));
constexpr int BM = 256, BK = 64, HALF = 128, HTB = HALF * BK * 2  , STAGE_BYTES = 8 * HTB, NXCD = 8, WGM = 8;

__host__ __device__ __forceinline__ int lds_byte(int r, int c) { const int st = (r >> 4) * 2 + (c >> 5), rr = r & 15, cc = c & 31, ob = rr * 64 + cc * 2; return st * 1024 + (ob ^ (((ob >> 9) & 1) << 5)); }
__host__ __device__ __forceinline__ void stage_rc(int b, int& R, int& C) { const int st = b / 1024, sb = b % 1024, swz = sb ^ (((sb >> 9) & 1) << 5); R = (st >> 1) * 16 + swz / 64; C = (st & 1) * 32 + (swz % 64) / 2; }
__host__ __device__ __forceinline__ int perm32(int rho) { const int n = rho >> 4, i = rho & 15; return 8 * (i >> 2) + 4 * n + (i & 3); }

struct Unit { int pm, pn; };
struct Gemm { const bf16_t* A; const bf16_t* Bt; int M, N, K; };

struct StaticOrder {
    int nM, nN, nwg, G, c;
    __host__ __device__ void init(int M, int N, int G_, int c_) { nM = M / BM; nN = N / BM; nwg = nM * nN; G = G_; c = c_; }
    __host__ __device__ bool next(int i, Unit& u) const {
        const long L = (long)i * G + c; if (L >= nwg) return false;
        int wgid = (int)L; { const int q = nwg / NXCD, r = nwg % NXCD, xcd = wgid % NXCD, off = wgid / NXCD; wgid = (xcd < r ? xcd * (q + 1) : r * (q + 1) + (xcd - r) * q) + off; }
        const int nig = WGM * nN, gid = wgid / nig, fm = gid * WGM, gsz = (nM - fm) < WGM ? (nM - fm) : WGM;
        u.pm = fm + ((wgid % nig) % gsz); u.pn = (wgid % nig) / gsz; return true;
    }
    __device__ __forceinline__ void a_ready(const Unit&) const {}
    __device__ __forceinline__ void done(const Unit&) const {}
};

__device__ __forceinline__ unsigned cvt_pk_bf16(float lo, float hi) { unsigned r; asm volatile("v_cvt_pk_bf16_f32 %0, %1, %2" : "=v"(r) : "v"(lo), "v"(hi)); return r; }
typedef float f32x2 __attribute__((ext_vector_type(2)));
__device__ __forceinline__ f32x2 gelu_pk(f32x2 v) {
    const f32x2 av = __builtin_elementwise_abs(v), d = av * 0.2316418882f + 1.0f;
    f32x2 t; t.x = __builtin_amdgcn_rcpf(d.x); t.y = __builtin_amdgcn_rcpf(d.y);
    f32x2 q = t * 0.5307027145f + (-0.7265760135f); q = q * t + 0.7107068705f; q = q * t + (-0.142248368f); q = q * t + 0.127414796f; q = q * t;
    const f32x2 s = (v * v) * (-0.72134752044f);
    f32x2 e; e.x = __builtin_amdgcn_exp2f(s.x); e.y = __builtin_amdgcn_exp2f(s.y);
    const f32x2 m = v * (q * e), r = v - m;
    f32x2 o; o.x = v.x < 0.f ? m.x : r.x; o.y = v.y < 0.f ? m.y : r.y; return o;
}

template <int ACT  > struct EpiBf16 {
    static constexpr bool PERM = true, AFTER_DRAIN = false; static_assert(ACT == 0 || ACT == 1, "EpiBf16: ACT is 0 (none) or 1 (gelu_pk)");
    bf16_t* O; int ldc; const float* bias; int split_cols; size_t split_stride; float scale0;
    __device__ __forceinline__ void operator()(const f32x4 (&acc)[2][2][4][2], const Unit& u, int wr, int wc, int fr, int fq) const {
        const int row0 = u.pm * BM + wr * 64 + fr; int colt = u.pn * BM; bf16_t* base = O;
        float sc = 1.f; if (split_cols) { const int t = colt / split_cols; base += (size_t)t * split_stride; colt -= t * split_cols; if (t == 0) sc = scale0; }
        const int col0 = colt + wc * 32 + 8 * fq, bcol0 = u.pn * BM + wc * 32 + 8 * fq;
        f32x4 bv[2][2];
#pragma unroll
        for (int bj = 0; bj < 2; ++bj)
#pragma unroll
            for (int n = 0; n < 2; ++n) bv[bj][n] = bias ? *(const f32x4*)(bias + bcol0 + bj * HALF + 4 * n) : (f32x4){0.f, 0.f, 0.f, 0.f};
#pragma unroll
        for (int ai = 0; ai < 2; ++ai)
#pragma unroll
            for (int m = 0; m < 4; ++m) { bf16_t* rowp = base + (size_t)(row0 + ai * HALF + m * 16) * ldc + col0;
#pragma unroll
                for (int bj = 0; bj < 2; ++bj) { f32x4 v0 = acc[ai][bj][m][0] + bv[bj][0], v1 = acc[ai][bj][m][1] + bv[bj][1];
                    if (ACT == 1) { f32x2 a = gelu_pk((f32x2){v0[0], v0[1]}), b = gelu_pk((f32x2){v0[2], v0[3]}), c = gelu_pk((f32x2){v1[0], v1[1]}), d = gelu_pk((f32x2){v1[2], v1[3]});
                        v0 = (f32x4){a.x, a.y, b.x, b.y}; v1 = (f32x4){c.x, c.y, d.x, d.y}; }
                    v0 = v0 * sc; v1 = v1 * sc; u32x4 w; w.x = cvt_pk_bf16(v0[0], v0[1]); w.y = cvt_pk_bf16(v0[2], v0[3]); w.z = cvt_pk_bf16(v1[0], v1[1]); w.w = cvt_pk_bf16(v1[2], v1[3]);
                    *(u32x4*)(rowp + bj * HALF) = w; } }
    }
};


template <class Epi, class Sched, bool ALIGN_EPI = false, bool SP2 = false>
__device__ __forceinline__ void gemm_phase(PG8_LAS unsigned char* lds, const Gemm g, const Sched& S, const Epi& E) {
    const int tid = threadIdx.x, wid = __builtin_amdgcn_readfirstlane(tid >> 6), lane = tid & 63, wr = wid >> 2, wc = wid & 3, fr = lane & 15, fq = lane >> 4;
    const int K = g.K, nt = K / BK;
    unsigned voffA[2], voffB[2];
#pragma unroll
    for (int i = 0; i < 2; ++i) { int R, C; stage_rc(tid * 16 + i * 8192, R, C); const int Rb = Epi::PERM ? ((R & ~31) + perm32(R & 31)) : R;
        voffA[i] = (unsigned)(R * K + C) * 2u; voffB[i] = (unsigned)(Rb * K + C) * 2u; }
    const size_t kstep = (size_t)(BK * 2);
    const size_t hstep = (size_t)HALF * K * 2;
    const size_t tstep = 2 * hstep;
    const unsigned ldsw = (unsigned)wid * 1024u;
    const int aoff = lds_byte(wr * 64 + fr, fq * 8), boff = lds_byte(wc * 32 + fr, fq * 8);
#define PG8_SA(b, h) (((b) * 2 + (h)) * HTB)
#define PG8_SB(b, h) ((4 + (b) * 2 + (h)) * HTB)
#define PG8_STAGE(bufoff, gbase, voff) do { _Pragma("unroll") for (int _i = 0; _i < 2; ++_i) \
        __builtin_amdgcn_global_load_lds((const unsigned*)((const char*)(gbase) + (voff)[_i]), (PG8_LAS unsigned*)(lds + (bufoff) + ldsw + _i * 8192), 16, 0, 0); } while (0)
#define PG8_LDA(dst, b, h) do { _Pragma("unroll") for (int m = 0; m < 4; ++m) _Pragma("unroll") for (int k = 0; k < 2; ++k) dst[m][k] = *(const PG8_LAS bf16x8*)(lds + PG8_SA(b, h) + aoff + m * 2048 + k * 1024); } while (0)
#define PG8_LDB(dst, b, h) do { _Pragma("unroll") for (int n = 0; n < 2; ++n) _Pragma("unroll") for (int k = 0; k < 2; ++k) dst[n][k] = *(const PG8_LAS bf16x8*)(lds + PG8_SB(b, h) + boff + n * 2048 + k * 1024); } while (0)
#define PG8_MMA(ai, bj, At, Bt) do { __builtin_amdgcn_s_setprio(1); _Pragma("unroll") for (int m = 0; m < 4; ++m) _Pragma("unroll") for (int n = 0; n < 2; ++n) _Pragma("unroll") for (int k = 0; k < 2; ++k) \
        acc[ai][bj][m][n] = __builtin_amdgcn_mfma_f32_16x16x32_bf16(Bt[n][k], At[m][k], acc[ai][bj][m][n], 0, 0, 0); __builtin_amdgcn_s_setprio(0); } while (0)
#define PG8_WAIT_V(n) asm volatile("s_waitcnt vmcnt(" #n ")" ::: "memory")
#define PG8_WAIT_L(n) asm volatile("s_waitcnt lgkmcnt(" #n ")" ::: "memory")
#define PG8_BAR __builtin_amdgcn_s_barrier()
#define PG8_SCHED __builtin_amdgcn_sched_barrier(0)
    Unit cur, nxt; int ui = 0;
    if (!S.next(0, cur)) return;
    f32x4 acc[2][2][4][2];
#pragma unroll
    for (int a = 0; a < 2; ++a)
#pragma unroll
        for (int b = 0; b < 2; ++b)
#pragma unroll
            for (int m = 0; m < 4; ++m)
#pragma unroll
                for (int n = 0; n < 2; ++n) acc[a][b][m][n] = (f32x4){0.f, 0.f, 0.f, 0.f};
    bf16x8 At[4][2], B0[2][2], B1[2][2];
    const char* cA = (const char*)g.A + (size_t)cur.pm * tstep; const char* cB = (const char*)g.Bt + (size_t)cur.pn * tstep;
    S.a_ready(cur);
    if constexpr (SP2) {
        PG8_STAGE(PG8_SB(0, 0), cB, voffB); PG8_STAGE(PG8_SB(0, 1), cB + hstep, voffB); PG8_STAGE(PG8_SA(0, 0), cA, voffA); PG8_STAGE(PG8_SA(0, 1), cA + hstep, voffA);
        if (wr == 1) PG8_BAR;
        PG8_WAIT_V(2); PG8_BAR;
        PG8_STAGE(PG8_SB(1, 0), cB + kstep, voffB); PG8_STAGE(PG8_SA(1, 0), cA + kstep, voffA); PG8_STAGE(PG8_SB(1, 1), cB + hstep + kstep, voffB);
        PG8_WAIT_V(6); PG8_BAR;
    } else {
        PG8_STAGE(PG8_SB(0, 0), cB, voffB); PG8_STAGE(PG8_SA(0, 0), cA, voffA); PG8_STAGE(PG8_SB(0, 1), cB + hstep, voffB); PG8_STAGE(PG8_SA(0, 1), cA + hstep, voffA);
        if (wr == 1) PG8_BAR;
        PG8_WAIT_V(4); PG8_BAR;
        PG8_STAGE(PG8_SB(1, 0), cB + kstep, voffB); PG8_STAGE(PG8_SA(1, 0), cA + kstep, voffA); PG8_STAGE(PG8_SB(1, 1), cB + hstep + kstep, voffB);
        PG8_WAIT_V(6); PG8_BAR;
    }
    for (;;) {
        const bool has_next = S.next(ui + 1, nxt);
        const char* nA = has_next ? (const char*)g.A + (size_t)nxt.pm * tstep : cA; const char* nB = has_next ? (const char*)g.Bt + (size_t)nxt.pn * tstep : cB;
        for (int t = 0; t < nt; t += 2) {
            const bool last = (t == nt - 2);
            const char* a1 = cA + (size_t)(t + 1) * kstep;
            const char* a2 = last ? nA : cA + (size_t)(t + 2) * kstep; const char* b2 = last ? nB : cB + (size_t)(t + 2) * kstep;
            const char* a3 = a2 + kstep; const char* b3 = b2 + kstep;
            if (last && has_next) S.a_ready(nxt);
            if constexpr (SP2) {
            PG8_LDB(B0, 0, 0); PG8_LDB(B1, 0, 1); PG8_SCHED; PG8_LDA(At, 0, 0); PG8_STAGE(PG8_SA(1, 1), a1 + hstep, voffA);
            PG8_WAIT_V(8); PG8_WAIT_L(0); PG8_BAR; PG8_MMA(0, 0, At, B0); PG8_MMA(0, 1, At, B1); PG8_BAR; PG8_SCHED;
            PG8_LDA(At, 0, 1); PG8_STAGE(PG8_SB(0, 0), b2, voffB); PG8_STAGE(PG8_SB(0, 1), b2 + hstep, voffB); PG8_STAGE(PG8_SA(0, 0), a2, voffA);
            PG8_WAIT_V(8); PG8_WAIT_L(0); PG8_BAR; PG8_MMA(1, 0, At, B0); PG8_MMA(1, 1, At, B1); PG8_BAR; PG8_SCHED;
            PG8_LDB(B0, 1, 0); PG8_LDB(B1, 1, 1); PG8_SCHED; PG8_LDA(At, 1, 0); PG8_STAGE(PG8_SA(0, 1), a2 + hstep, voffA);
            PG8_WAIT_V(8); PG8_WAIT_L(0); PG8_BAR; PG8_MMA(0, 0, At, B0); PG8_MMA(0, 1, At, B1); PG8_BAR; PG8_SCHED;
            PG8_LDA(At, 1, 1); PG8_STAGE(PG8_SB(1, 0), b3, voffB); PG8_STAGE(PG8_SB(1, 1), b3 + hstep, voffB); PG8_STAGE(PG8_SA(1, 0), a3, voffA);
            PG8_WAIT_V(8); PG8_WAIT_L(0); PG8_BAR; PG8_MMA(1, 0, At, B0); PG8_MMA(1, 1, At, B1); PG8_BAR; PG8_SCHED;
            } else {
            PG8_LDB(B0, 0, 0); PG8_SCHED; PG8_LDA(At, 0, 0); PG8_STAGE(PG8_SA(1, 1), a1 + hstep, voffA);
            PG8_WAIT_L(8); PG8_BAR; PG8_WAIT_L(0); PG8_MMA(0, 0, At, B0); PG8_BAR; PG8_SCHED;
            PG8_LDB(B1, 0, 1); PG8_STAGE(PG8_SB(0, 0), b2, voffB);
            PG8_BAR; PG8_WAIT_L(0); PG8_MMA(0, 1, At, B1); PG8_BAR;
            PG8_LDA(At, 0, 1); PG8_STAGE(PG8_SA(0, 0), a2, voffA);
            PG8_BAR; PG8_WAIT_L(0); PG8_MMA(1, 0, At, B0); PG8_BAR; PG8_SCHED;
            PG8_STAGE(PG8_SB(0, 1), b2 + hstep, voffB);
            PG8_WAIT_V(6); PG8_BAR; PG8_MMA(1, 1, At, B1); PG8_BAR;
            PG8_LDB(B0, 1, 0); PG8_SCHED; PG8_LDA(At, 1, 0); PG8_STAGE(PG8_SA(0, 1), a2 + hstep, voffA);
            PG8_WAIT_L(8); PG8_BAR; PG8_WAIT_L(0); PG8_MMA(0, 0, At, B0); PG8_BAR; PG8_SCHED;
            PG8_LDB(B1, 1, 1); PG8_STAGE(PG8_SB(1, 0), b3, voffB);
            PG8_BAR; PG8_WAIT_L(0); PG8_MMA(0, 1, At, B1); PG8_BAR;
            PG8_LDA(At, 1, 1); PG8_STAGE(PG8_SA(1, 0), a3, voffA);
            PG8_BAR; PG8_WAIT_L(0); PG8_MMA(1, 0, At, B0); PG8_BAR; PG8_SCHED;
            PG8_STAGE(PG8_SB(1, 1), b3 + hstep, voffB);
            PG8_WAIT_V(6); PG8_BAR; PG8_MMA(1, 1, At, B1); PG8_BAR;
            }
        }
        if constexpr (ALIGN_EPI) { if (wr == 0) PG8_BAR; }
        if constexpr (!Epi::AFTER_DRAIN) { E(acc, cur, wr, wc, fr, fq); S.done(cur); }
        if (!has_next) break;
#pragma unroll
        for (int a = 0; a < 2; ++a)
#pragma unroll
            for (int b = 0; b < 2; ++b)
#pragma unroll
                for (int m = 0; m < 4; ++m)
#pragma unroll
                    for (int n = 0; n < 2; ++n) acc[a][b][m][n] = (f32x4){0.f, 0.f, 0.f, 0.f};
        cur = nxt; cA = nA; cB = nB; ++ui;
        if constexpr (ALIGN_EPI) { if (wr == 1) PG8_BAR; }
    }
    PG8_WAIT_V(0);
    if constexpr (!ALIGN_EPI) { if (wr == 0) PG8_BAR; }
    PG8_BAR;
    if constexpr (Epi::AFTER_DRAIN) { E.fused(acc, cur, wr, wc, fr, fq, lds, wid, lane); S.done(cur); }
#undef PG8_SA
#undef PG8_SB
#undef PG8_STAGE
#undef PG8_LDA
#undef PG8_LDB
#undef PG8_MMA
#undef PG8_WAIT_V
#undef PG8_WAIT_L
#undef PG8_BAR
#undef PG8_SCHED
}
}
constexpr int NB = 8, SEQ = 4096, DM = 1024, MTOK = NB * SEQ;
constexpr int NPROJ = 3584;
constexpr int PCOLS_IN = 3600;
constexpr int NEXP = 16, CAP = 512, FFD = 2048, NSLOT = NEXP * NB * CAP;
constexpr float RMS_EPS = 1e-6f;
#ifndef N_LAUNCHES
#define N_LAUNCHES 1
#endif
constexpr int N_PHASES = 13;

constexpr size_t MiB = 1u << 20;
constexpr size_t WS_CTL = 0, CTL_ZERO_BYTES = 64 * 1024;
constexpr size_t WS_MOD = 1 * MiB;
constexpr size_t WS_BIN2 = 1 * MiB + 512 * 1024;
constexpr size_t WS_HID2 = 2 * MiB;
constexpr size_t WS_GATES = 3 * MiB;
constexpr size_t WS_AFF = 5 * MiB;
constexpr size_t WS_IDX = 7 * MiB, WS_GSEL = 7 * MiB + 256 * 1024;
constexpr size_t WS_INV = 8 * MiB;
constexpr size_t WS_WOUT = 12 * MiB;
constexpr size_t WS_WIN = 14 * MiB;
constexpr size_t WS_P = 24 * MiB;
constexpr size_t WS_H = 248 * MiB;
constexpr size_t WS_UT = 312 * MiB;
constexpr size_t WS_HM = 408 * MiB;
constexpr size_t WS_ZT = 472 * MiB;
constexpr size_t WS_KSP = 504 * MiB;
constexpr size_t WS_WGU = 24 * MiB;
constexpr size_t WS_XS = 152 * MiB;
constexpr size_t WS_HID = 280 * MiB;
constexpr size_t WS_HF = 280 * MiB;
constexpr size_t WS_WD = 152 * MiB;
constexpr size_t WS_YS = 24 * MiB;
constexpr size_t WS_END = 536 * MiB;

constexpr int RING_BYTES = 131072;
constexpr int MISC_OFF = RING_BYTES;
constexpr int LDS_BYTES = 147456;

#define GAS __attribute__((address_space(1)))
#define LAS __attribute__((address_space(3)))
#define DI __device__ __forceinline__
typedef unsigned short bf16;
typedef unsigned v4u __attribute__((ext_vector_type(4)));
typedef unsigned v2u __attribute__((ext_vector_type(2)));
typedef float f32x4 __attribute__((ext_vector_type(4)));
typedef GAS unsigned gu32;
#define LDS_WAIT() asm volatile("s_waitcnt lgkmcnt(0)" ::: "memory")
DI float bf2f(unsigned b) { return __uint_as_float(b << 16); }
DI float bflo(unsigned w) { return __uint_as_float(w << 16); }
DI float bfhi(unsigned w) { return __uint_as_float(w & 0xffff0000u); }
DI unsigned f2bf(float f) { unsigned u = __float_as_uint(f); return (u + 0x7fffu + ((u >> 16) & 1u)) >> 16; }
DI unsigned pk2(float lo, float hi) { return f2bf(lo) | (f2bf(hi) << 16); }
DI float wave_sum(float v) {
#pragma unroll
    for (int o = 1; o < 64; o <<= 1) v += __shfl_xor(v, o);
    return v;
}
DI float sigmoidf_(float x) { return 1.f / (1.f + __expf(-x)); }

namespace pg8 {
struct MoeOrderA {
    int G, c;
    __device__ bool next(int i, Unit& u) const {
        const long L = (long)i * G + c; if (L >= 4096) return false;
        const int e = (int)(L >> 8), r = (int)(L & 255), x = r & 7, j = r >> 3;
        u.pm = e * 16 + 4 * (x >> 1) + (j >> 3); u.pn = e * 16 + 8 * (x & 1) + (j & 7); return true;
    }
    __device__ __forceinline__ void a_ready(const Unit&) const {}
    __device__ __forceinline__ void done(const Unit&) const {}
};
struct MoeOrderB {
    int G, c;
    __device__ bool next(int i, Unit& u) const {
        const long L = (long)i * G + c; if (L >= 1024) return false;
        const int r = (int)(L & 255), e = (int)(L >> 8) * 4 + ((r & 7) >> 1), idx = ((r & 1) << 5) | (r >> 3);
        u.pm = e * 16 + (idx >> 2); u.pn = e * 4 + (idx & 3); return true;
    }
    __device__ __forceinline__ void a_ready(const Unit&) const {}
    __device__ __forceinline__ void done(const Unit&) const {}
};
struct EpiSwiGLU {
    static constexpr bool PERM = true, AFTER_DRAIN = false;
    bf16_t* O;
    __device__ __forceinline__ void operator()(const f32x4 (&acc)[2][2][4][2], const Unit& u, int wr, int wc, int fr, int fq) const {
        const int row0 = u.pm * BM + wr * 64 + fr, col0 = (u.pn & 15) * 128 + wc * 32 + 8 * fq;
#pragma unroll
        for (int ai = 0; ai < 2; ++ai)
#pragma unroll
            for (int m = 0; m < 4; ++m) {
                bf16_t* rowp = O + (size_t)(row0 + ai * HALF + m * 16) * 2048 + col0;
                float h[8];
#pragma unroll
                for (int n = 0; n < 2; ++n)
#pragma unroll
                    for (int i = 0; i < 4; ++i) { const float g = acc[ai][0][m][n][i], up = acc[ai][1][m][n][i]; h[4 * n + i] = g * __builtin_amdgcn_rcpf(1.f + __expf(-g)) * up; }
                u32x4 w; w.x = cvt_pk_bf16(h[0], h[1]); w.y = cvt_pk_bf16(h[2], h[3]); w.z = cvt_pk_bf16(h[4], h[5]); w.w = cvt_pk_bf16(h[6], h[7]);
                *(u32x4*)rowp = w;
            }
    }
};
struct EpiYs {
    static constexpr bool PERM = true, AFTER_DRAIN = false;
    bf16_t* O;
    __device__ __forceinline__ void operator()(const f32x4 (&acc)[2][2][4][2], const Unit& u, int wr, int wc, int fr, int fq) const {
        const int row0 = u.pm * BM + wr * 64 + fr, col0 = (u.pn & 3) * BM + wc * 32 + 8 * fq;
#pragma unroll
        for (int ai = 0; ai < 2; ++ai)
#pragma unroll
            for (int m = 0; m < 4; ++m) {
                bf16_t* rowp = O + (size_t)(row0 + ai * HALF + m * 16) * 1024 + col0;
#pragma unroll
                for (int bj = 0; bj < 2; ++bj) { const f32x4 v0 = acc[ai][bj][m][0], v1 = acc[ai][bj][m][1];
                    u32x4 w; w.x = cvt_pk_bf16(v0[0], v0[1]); w.y = cvt_pk_bf16(v0[2], v0[3]); w.z = cvt_pk_bf16(v1[0], v1[1]); w.w = cvt_pk_bf16(v1[2], v1[3]);
                    *(u32x4*)(rowp + bj * HALF) = w; }
            }
    }
};
struct EpiRes {
    static constexpr bool PERM = false, AFTER_DRAIN = false;
    const float* X; float* C; const float* mod;
    __device__ __forceinline__ void operator()(const f32x4 (&acc)[2][2][4][2], const Unit& u, int wr, int wc, int fr, int fq) const {
        const int row0 = u.pm * BM + wr * 64 + fr, col0 = u.pn * BM + wc * 32 + 4 * fq;
        const float* gp = mod + (size_t)((u.pm * BM) >> 12) * 6144 + 2048 + col0;
        f32x4 gv[2][2];
#pragma unroll
        for (int bj = 0; bj < 2; ++bj)
#pragma unroll
            for (int n = 0; n < 2; ++n) gv[bj][n] = *(const f32x4*)(gp + bj * HALF + n * 16);
#pragma unroll
        for (int ai = 0; ai < 2; ++ai)
#pragma unroll
            for (int m = 0; m < 4; ++m) { const size_t off = (size_t)(row0 + ai * HALF + m * 16) * 1024 + col0;
#pragma unroll
                for (int bj = 0; bj < 2; ++bj)
#pragma unroll
                    for (int n = 0; n < 2; ++n) { const f32x4 xv = *(const f32x4*)(X + off + bj * HALF + n * 16); *(f32x4*)(C + off + bj * HALF + n * 16) = xv + gv[bj][n] * acc[ai][bj][m][n]; } }
    }
};
}
#define XB_TMO      128
#define XB_XCNT(j)  (256  + 64 * (j))
#define XB_XSUB(j)  (1280 + 64 * (j))
#define XB_XGEN(j)  (2304 + 64 * (j))
#define XB_TOP      3328
#define XB_TOPGEN   3392
#define XCD_BAR_WORDS 3456
#define XB_SPIN_CAP (1u << 18)

__device__ __forceinline__ unsigned xb_ld(unsigned* p)              { return __hip_atomic_load(p, __ATOMIC_RELAXED, __HIP_MEMORY_SCOPE_AGENT); }
__device__ __forceinline__ unsigned xb_add(unsigned* p, unsigned v) { return __hip_atomic_fetch_add(p, v, __ATOMIC_RELAXED, __HIP_MEMORY_SCOPE_AGENT); }
__device__ __forceinline__ unsigned xb_xcc_id() { return (unsigned)__builtin_amdgcn_s_getreg((3 << 11) | 20) & 0xFu; }
#define XB_SPIN(cond, bar) do { unsigned _sp = 0; while (cond) { __builtin_amdgcn_s_sleep(1); \
    if ((++_sp & 255u) == 0u) { if (xb_ld(&(bar)[XB_TMO])) break; if (_sp > XB_SPIN_CAP) { atomicAdd(&(bar)[XB_TMO], 1u); break; } } } } while (0)

struct XcdBarrier {
    unsigned* bar; unsigned x;
    volatile LAS unsigned* st;
};

__device__ __forceinline__ XcdBarrier xcd_barrier_post(unsigned* bar, volatile LAS unsigned* st) {
    XcdBarrier b; b.bar = bar; b.x = xb_xcc_id(); b.st = st;
    if (threadIdx.x == 0) (void)xb_add(&bar[XB_XCNT(b.x)], 1u);
    return b;
}
__device__ __forceinline__ void xcd_barrier_complete(unsigned* bar, unsigned x, unsigned& nloc, unsigned& nx) {
    const unsigned G = gridDim.x * gridDim.y * gridDim.z;
    unsigned sum, cnt, mine, sp = 0u;
    for (;;) {
        sum = 0u; cnt = 0u; mine = 0u;
#pragma unroll
        for (unsigned j = 0; j < 16; ++j) { const unsigned c = xb_ld(&bar[XB_XCNT(j)]); sum += c; cnt += (c > 0u) ? 1u : 0u; mine = (j == x) ? c : mine; }
        if (sum == G) break;
        __builtin_amdgcn_s_sleep(1);
        if ((++sp & 255u) == 0u) { if (xb_ld(&bar[XB_TMO])) break; if (sp > XB_SPIN_CAP) { atomicAdd(&bar[XB_TMO], 1u); break; } }
    }
    nloc = mine > 0u ? mine : 1u; nx = cnt > 0u ? cnt : 1u;
}

__device__ __forceinline__ void xcd_barrier(const XcdBarrier& b) {
    asm volatile("s_waitcnt vmcnt(0)" ::: "memory");
    __syncthreads();
    if (threadIdx.x == 0) {
        unsigned* bar = b.bar;
        __builtin_amdgcn_s_waitcnt(0);
        unsigned nloc = b.st[0], nx = b.st[1];
        if (nloc == 0u) { xcd_barrier_complete(bar, b.x, nloc, nx); b.st[0] = nloc; b.st[1] = nx; }
        const unsigned old = xb_add(&bar[XB_XSUB(b.x)], 1u);
        const unsigned gen = old / nloc;
        if (old + 1u == (gen + 1u) * nloc) {
            __builtin_amdgcn_fence(__ATOMIC_RELEASE, "agent");
            asm volatile("s_waitcnt vmcnt(0)" ::: "memory");
            const unsigned og = xb_add(&bar[XB_TOP], 1u);
            const unsigned tg = og / nx;
            if (og + 1u == (tg + 1u) * nx) xb_add(&bar[XB_TOPGEN], 1u);
            else XB_SPIN(xb_ld(&bar[XB_TOPGEN]) == tg, bar);
            __builtin_amdgcn_fence(__ATOMIC_ACQUIRE, "agent");
            xb_add(&bar[XB_XGEN(b.x)], 1u);
            asm volatile("s_waitcnt vmcnt(0)" ::: "memory");
        } else {
            XB_SPIN(xb_ld(&bar[XB_XGEN(b.x)]) == gen, bar);
            __builtin_amdgcn_fence(__ATOMIC_ACQUIRE, "agent");
            asm volatile("s_waitcnt vmcnt(0)" ::: "memory");
        }
    }
    __syncthreads();
}
#define HD __host__ __device__ __forceinline__
typedef float cf2 __attribute__((ext_vector_type(2)));
#define MK2(a, b) ((cf2){(a), (b)})
HD cf2 c_add(cf2 a, cf2 b) { return MK2(a.x + b.x, a.y + b.y); }
HD cf2 c_sub(cf2 a, cf2 b) { return MK2(a.x - b.x, a.y - b.y); }
HD cf2 c_mul(cf2 a, cf2 b) { return MK2(a.x * b.x - a.y * b.y, a.x * b.y + a.y * b.x); }
HD cf2 c_mulc(cf2 a, cf2 b) { return MK2(a.x * b.x + a.y * b.y, a.y * b.x - a.x * b.y); }
HD int fphys(int i) { return i + (i >> 4); }
constexpr int FFT_XSLOTS = 8192 + 512;

#define W16_C1 0.92387953251128674f
#define W16_S1 0.38268343236508977f
#define W16_H  0.70710678118654752f
template <int J> HD cf2 mul_w16(cf2 d) {
    if constexpr (J == 0) return d;
    else if constexpr (J == 1) return c_mul(d, MK2(W16_C1, -W16_S1));
    else if constexpr (J == 2) return MK2((d.x + d.y) * W16_H, (d.y - d.x) * W16_H);
    else if constexpr (J == 3) return c_mul(d, MK2(W16_S1, -W16_C1));
    else if constexpr (J == 4) return MK2(d.y, -d.x);
    else if constexpr (J == 5) return c_mul(d, MK2(-W16_S1, -W16_C1));
    else if constexpr (J == 6) return MK2((d.y - d.x) * W16_H, -(d.x + d.y) * W16_H);
    else return c_mul(d, MK2(-W16_C1, -W16_S1));
}
HD void dft16(cf2 (&v)[16]) {
#define BF(i, j, TWJ) { const cf2 a_ = v[i], b_ = v[j]; v[i] = c_add(a_, b_); v[j] = mul_w16<TWJ>(c_sub(a_, b_)); }
    BF(0, 8, 0) BF(1, 9, 1) BF(2, 10, 2) BF(3, 11, 3) BF(4, 12, 4) BF(5, 13, 5) BF(6, 14, 6) BF(7, 15, 7)
    BF(0, 4, 0) BF(1, 5, 2) BF(2, 6, 4) BF(3, 7, 6)   BF(8, 12, 0) BF(9, 13, 2) BF(10, 14, 4) BF(11, 15, 6)
    BF(0, 2, 0) BF(1, 3, 4)  BF(4, 6, 0) BF(5, 7, 4)  BF(8, 10, 0) BF(9, 11, 4)  BF(12, 14, 0) BF(13, 15, 4)
    BF(0, 1, 0) BF(2, 3, 0) BF(4, 5, 0) BF(6, 7, 0) BF(8, 9, 0) BF(10, 11, 0) BF(12, 13, 0) BF(14, 15, 0)
#undef BF
#define SW(i, j) { const cf2 t_ = v[i]; v[i] = v[j]; v[j] = t_; }
    SW(1, 8) SW(2, 4) SW(3, 12) SW(5, 10) SW(7, 14) SW(11, 13)
#undef SW
}
HD void idft16(cf2 (&v)[16]) {
#pragma unroll
    for (int i = 0; i < 16; ++i) v[i] = MK2(v[i].y, v[i].x);
    dft16(v);
#pragma unroll
    for (int i = 0; i < 16; ++i) v[i] = MK2(v[i].y, v[i].x);
}
HD void c_powers(cf2 t, cf2 (&pw)[16]) {
    pw[0] = MK2(1.f, 0.f); pw[1] = t;
#pragma unroll
    for (int r = 2; r < 16; ++r) pw[r] = (r & 1) ? c_mul(pw[r - 1], t) : c_mul(pw[r >> 1], pw[r >> 1]);
}
HD cf2 w32_const(int k) {
    constexpr float C[16] = {1.f, 0.98078528040323043f, 0.92387953251128674f, 0.83146961230254524f, 0.70710678118654752f, 0.55557023301960218f, 0.38268343236508977f, 0.19509032201612825f,
                             0.f, -0.19509032201612825f, -0.38268343236508977f, -0.55557023301960218f, -0.70710678118654752f, -0.83146961230254524f, -0.92387953251128674f, -0.98078528040323043f};
    constexpr float S[16] = {0.f, 0.19509032201612825f, 0.38268343236508977f, 0.55557023301960218f, 0.70710678118654752f, 0.83146961230254524f, 0.92387953251128674f, 0.98078528040323043f,
                             1.f, 0.98078528040323043f, 0.92387953251128674f, 0.83146961230254524f, 0.70710678118654752f, 0.55557023301960218f, 0.38268343236508977f, 0.19509032201612825f};
    return MK2(C[k], -S[k]);
}
template <class XP, class TP> HD void fft_passA_fwd(int tid, const cf2 (&a)[16], const cf2 (&b)[16], XP X, TP TW4, TP TW8) {
    const int H = tid >> 8, lo = tid & 255;
    cf2 v[16];
    if (H == 0) {
#pragma unroll
        for (int k = 0; k < 16; ++k) v[k] = c_add(a[k], b[k]);
    } else {
        const cf2 t8 = TW8[lo];
#pragma unroll
        for (int k = 0; k < 16; ++k) v[k] = c_mul(c_sub(a[k], b[k]), c_mul(t8, w32_const(k)));
    }
    dft16(v);
    cf2 pw[16]; c_powers(TW4[lo], pw);
#pragma unroll
    for (int r = 0; r < 16; ++r) X[fphys(H * 4096 + r * 256 + lo)] = c_mul(v[r], pw[r]);
}
template <class XP, class TP> HD void fft_passB_fwd(int tid, XP X, TP TW4) {
    const int H = tid >> 8, hi = (tid >> 4) & 15, lo = tid & 15, base = H * 4096 + hi * 256 + lo;
    cf2 v[16];
#pragma unroll
    for (int k = 0; k < 16; ++k) v[k] = X[fphys(base + k * 16)];
    dft16(v);
    cf2 pw[16]; c_powers(TW4[16 * lo], pw);
#pragma unroll
    for (int r = 0; r < 16; ++r) X[fphys(base + r * 16)] = c_mul(v[r], pw[r]);
}
template <class XP> HD void fft_passC_fwd(int tid, XP X, cf2 (&v)[16]) {
    const int p0 = 17 * tid;
#pragma unroll
    for (int k = 0; k < 16; ++k) v[k] = X[p0 + k];
    dft16(v);
}
template <class XP> HD void fft_passC_inv(int tid, XP X, cf2 (&v)[16]) {
    const int p0 = 17 * tid;
    idft16(v);
#pragma unroll
    for (int k = 0; k < 16; ++k) X[p0 + k] = v[k];
}
template <class XP, class TP> HD void fft_passB_inv(int tid, XP X, TP TW4) {
    const int H = tid >> 8, hi = (tid >> 4) & 15, lo = tid & 15, base = H * 4096 + hi * 256 + lo;
    cf2 v[16], pw[16]; c_powers(TW4[16 * lo], pw);
#pragma unroll
    for (int r = 0; r < 16; ++r) v[r] = c_mulc(X[fphys(base + r * 16)], pw[r]);
    idft16(v);
#pragma unroll
    for (int k = 0; k < 16; ++k) X[fphys(base + k * 16)] = v[k];
}
template <class XP, class TP> HD void fft_passA_inv(int tid, XP X, TP TW4, TP TW8, cf2 (&u)[16]) {
    const int H = tid >> 8, lo = tid & 255;
    cf2 pw[16]; c_powers(TW4[lo], pw);
#pragma unroll
    for (int r = 0; r < 16; ++r) u[r] = c_mulc(X[fphys(H * 4096 + r * 256 + lo)], pw[r]);
    idft16(u);
    if (H == 1) {
        const cf2 t8 = TW8[lo];
#pragma unroll
        for (int k = 0; k < 16; ++k) u[k] = c_mulc(u[k], c_mul(t8, w32_const(k)));
    }
}
struct Args { const float* in[28]; float* out; unsigned char* ws; int ph_lo, ph_hi; };
struct Frame {
    LAS unsigned char* lds;
    int tid, lane, wave, G, blk;
    const struct Args* a;
};
#define IN_X 0
#define IN_C 1
#define IN_WADA 2
#define IN_BADA 3
#define IN_GMIX 4
#define IN_WIN 5
#define IN_BIN 6
#define IN_CQKW 7
#define IN_CQKB 8
#define IN_MNG 9
#define IN_CHYW 10
#define IN_CHYB 11
#define IN_HW1 12
#define IN_HB1 13
#define IN_HW2 14
#define IN_HB2 15
#define IN_HW3 16
#define IN_HFREQ 17
#define IN_HDELTA 18
#define IN_HBIAS 19
#define IN_HNG 20
#define IN_WOUT 21
#define IN_GFFN 22
#define IN_WROUTER 23
#define IN_WGATE 24
#define IN_WUP 25
#define IN_WDOWN 26
#define IN_GFINAL 27

DI void transpose_item(const float* src, int ldsrc, bf16* dst, int lddst, LAS float* scr, int lane) {
#pragma unroll 8
    for (int i = 0; i < 32; ++i) { const int kk = 2 * i + (lane >> 5); scr[kk * 33 + (lane & 31)] = src[(size_t)kk * ldsrc + (lane & 31)]; }
    LDS_WAIT(); asm volatile("" ::: "memory");
    const int c = lane & 7;
#pragma unroll
    for (int j = 0; j < 4; ++j) { const int n = (lane >> 3) + 8 * j; const LAS float* s = scr + (8 * c) * 33 + n;
        v4u o; o.x = pk2(s[0 * 33], s[1 * 33]); o.y = pk2(s[2 * 33], s[3 * 33]); o.z = pk2(s[4 * 33], s[5 * 33]); o.w = pk2(s[6 * 33], s[7 * 33]);
        *(v4u*)(dst + (size_t)n * lddst + 8 * c) = o; }
    LDS_WAIT(); asm volatile("" ::: "memory");
}
DI float reduce16(const float (&acc)[16], int lane) {
    float r8[8], r4[4], r2[2], r1;
    { const bool up = (lane & 32) != 0;
#pragma unroll
      for (int i = 0; i < 8; ++i) { const float mine = up ? acc[8 + i] : acc[i], other = up ? acc[i] : acc[8 + i]; r8[i] = mine + __shfl_xor(other, 32); } }
    { const bool up = (lane & 16) != 0;
#pragma unroll
      for (int i = 0; i < 4; ++i) { const float mine = up ? r8[4 + i] : r8[i], other = up ? r8[i] : r8[4 + i]; r4[i] = mine + __shfl_xor(other, 16); } }
    { const bool up = (lane & 8) != 0;
#pragma unroll
      for (int i = 0; i < 2; ++i) { const float mine = up ? r4[2 + i] : r4[i], other = up ? r4[i] : r4[2 + i]; r2[i] = mine + __shfl_xor(other, 8); } }
    { const bool up = (lane & 4) != 0; const float mine = up ? r2[1] : r2[0], other = up ? r2[0] : r2[1]; r1 = mine + __shfl_xor(other, 4); }
    r1 += __shfl_xor(r1, 1); r1 += __shfl_xor(r1, 2);
    return r1;
}
DI int reduce16_index(int lane) { return ((lane >> 5) & 1) * 8 + ((lane >> 4) & 1) * 4 + ((lane >> 3) & 1) * 2 + ((lane >> 2) & 1); }

DI void p0_prologue(Frame& F) {
    unsigned char* ws = F.a->ws;
    LAS float* scr = (LAS float*)(F.lds + F.wave * 16384);
    const int gw = F.blk * 8 + F.wave, NGW = F.G * 8, lane = F.lane;
    bf16* WIN = (bf16*)(ws + WS_WIN); bf16* WOUT = (bf16*)(ws + WS_WOUT);
    for (int it = gw; it < 1792 + 512; it += NGW) {
        if (it < 1792) { const int kb = it / 112, nb = it % 112, n0 = 32 * nb, k0 = 64 * kb, sc = n0 + (n0 >= 2048 ? 16 : 0);
            transpose_item(F.a->in[IN_WIN] + (size_t)k0 * PCOLS_IN + sc, PCOLS_IN, WIN + (size_t)n0 * 1024 + k0, 1024, scr, lane); }
        else { const int r = it - 1792, kb = r / 32, nb = r % 32, n0 = 32 * nb, k0 = 64 * kb;
            transpose_item(F.a->in[IN_WOUT] + (size_t)k0 * 1024 + n0, 1024, WOUT + (size_t)n0 * 1024 + k0, 1024, scr, lane); }
    }
    {
        float* HID2 = (float*)(ws + WS_HID2);
        const float* w1 = F.a->in[IN_HW1]; const float* w2 = F.a->in[IN_HW2];
        const float fr = F.a->in[IN_HFREQ][lane], b1 = F.a->in[IN_HB1][lane], b2 = F.a->in[IN_HB2][lane];
        for (int t = gw; t < SEQ; t += NGW) {
            float a1 = b1 + ((float)t * (1.f / 4095.f)) * w1[lane];
#pragma unroll 4
            for (int i = 0; i < 16; ++i) {
                const float band = 1e-4f + (float)i * ((15.f - 1e-4f) / 15.f);
                const float rev = band * (float)t * (1.f / 4096.f);
                const float fx = rev - floorf(rev);
                float sn, cs; sincospif(2.f * fx, &sn, &cs);
                a1 += cs * w1[(1 + i) * 64 + lane] - sn * w1[(17 + i) * 64 + lane];
            }
            const float h1 = sinf(fr * a1);
            float a2 = b2;
#pragma unroll 8
            for (int i = 0; i < 64; ++i) a2 += __shfl(h1, i) * w2[i * 64 + lane];
            HID2[t * 64 + lane] = sinf(fr * a2);
        }
    }
    { float* BIN2 = (float*)(ws + WS_BIN2); for (int n = F.blk * 512 + F.tid; n < NPROJ; n += F.G * 512) BIN2[n] = F.a->in[IN_BIN][n + (n >= 2048 ? 16 : 0)]; }
    __syncthreads();
    {
        LAS float* cs = (LAS float*)F.lds;
        LAS float* red = cs + 8192;
        float* MOD = (float*)(ws + WS_MOD); const float* wada = F.a->in[IN_WADA];
        for (int i = F.tid; i < 2048; i += 512) *(LAS f32x4*)(cs + 4 * i) = *(const f32x4*)(F.a->in[IN_C] + 4 * i);
        __syncthreads();
        const int ksl = F.tid >> 3, c4 = F.tid & 7;
        for (int it = F.blk; it < 192; it += F.G) {
            f32x4 w[16];
#pragma unroll
            for (int kk = 0; kk < 16; ++kk) w[kk] = *(const f32x4*)(wada + (size_t)(16 * ksl + kk) * 6144 + 32 * it + 4 * c4);
#pragma unroll
            for (int b = 0; b < 8; ++b) { f32x4 a = (f32x4){0.f, 0.f, 0.f, 0.f};
#pragma unroll
                for (int k4 = 0; k4 < 4; ++k4) { const f32x4 cv = *(const LAS f32x4*)(cs + b * 1024 + 16 * ksl + 4 * k4);
                    a += w[4 * k4] * cv.x + w[4 * k4 + 1] * cv.y + w[4 * k4 + 2] * cv.z + w[4 * k4 + 3] * cv.w; }
                *(LAS f32x4*)(red + (ksl * 8 + b) * 32 + 4 * c4) = a; }
            __syncthreads();
            if (F.tid < 256) { const int b = F.tid >> 5, col = F.tid & 31; float sacc = F.a->in[IN_BADA][32 * it + col];
#pragma unroll 8
                for (int k = 0; k < 64; ++k) sacc += red[(k * 8 + b) * 32 + col];
                MOD[b * 6144 + 32 * it + col] = sacc; }
            __syncthreads();
        }
    }
}

template <bool SECOND> DI void p_norm(Frame& F) {
    unsigned char* ws = F.a->ws; const int lane = F.lane;
    LAS float* Wt = (LAS float*)F.lds;
    for (int i = F.tid; i < 16384; i += 512) { const int k = i >> 4, g = i & 15; Wt[g * 1024 + k] = SECOND ? F.a->in[IN_WROUTER][k * 16 + g] : F.a->in[IN_WIN][(size_t)k * PCOLS_IN + 2048 + g]; }
    __syncthreads();
    const float* xin = SECOND ? (const float*)F.a->out : F.a->in[IN_X];
    const float* gvec = SECOND ? F.a->in[IN_GFFN] : F.a->in[IN_GMIX];
    const float* MOD = (const float*)(ws + WS_MOD);
    bf16* HO = (bf16*)(ws + (SECOND ? WS_HF : WS_H));
    const int gw = F.blk * 8 + F.wave, NGW = F.G * 8;
    for (int row = gw; row < MTOK; row += NGW) {
        const int b = row >> 12;
        const f32x4* xr = (const f32x4*)(xin + (size_t)row * 1024) + lane;
        f32x4 v[4]; float ss = 0.f;
#pragma unroll
        for (int j = 0; j < 4; ++j) { v[j] = xr[64 * j]; ss += (v[j].x * v[j].x + v[j].y * v[j].y) + (v[j].z * v[j].z + v[j].w * v[j].w); }
        const float rstd = rsqrtf(wave_sum(ss) * (1.f / 1024.f) + RMS_EPS);
        const float* mb = MOD + b * 6144 + (SECOND ? 3072 : 0);
#pragma unroll
        for (int j = 0; j < 4; ++j) { const int col = 256 * j + 4 * lane;
            const f32x4 g = *(const f32x4*)(gvec + col), sh = *(const f32x4*)(mb + col), sc = *(const f32x4*)(mb + 1024 + col);
            v[j] = v[j] * rstd * g * (sc + 1.f) + sh; }
        unsigned long long* o8 = (unsigned long long*)(HO + (size_t)row * 1024) + lane;
#pragma unroll
        for (int j = 0; j < 4; ++j) o8[64 * j] = (unsigned long long)pk2(v[j].x, v[j].y) | ((unsigned long long)pk2(v[j].z, v[j].w) << 32);
        float acc[16];
#pragma unroll
        for (int g = 0; g < 16; ++g) { float a = 0.f;
            if ((g & 3) == 0) asm volatile("" ::: "memory");
#pragma unroll
            for (int j = 0; j < 4; ++j) { const f32x4 w = *(const LAS f32x4*)(Wt + g * 1024 + 256 * j + 4 * lane); a += (v[j].x * w.x + v[j].y * w.y) + (v[j].z * w.z + v[j].w * w.w); }
            acc[g] = a; }
        const float val = reduce16(acc, lane); const int gi = reduce16_index(lane);
        if (!SECOND) { if ((lane & 3) == 0) ((float*)(ws + WS_GATES))[(size_t)row * 16 + gi] = val + F.a->in[IN_BIN][2048 + gi]; }
        else {
            float mx = val;
#pragma unroll
            for (int o = 4; o < 64; o <<= 1) mx = fmaxf(mx, __shfl_xor(mx, o));
            const float ex = __expf(val - mx); float sm = ex;
#pragma unroll
            for (int o = 4; o < 64; o <<= 1) sm += __shfl_xor(sm, o);
            if ((lane & 3) == 0) ((float*)(ws + WS_AFF))[((size_t)b * 16 + gi) * SEQ + (row & 4095)] = ex / sm;
        }
    }
}

DI void p3_prep(Frame& F) {
    unsigned char* ws = F.a->ws;
    const bf16* P = (const bf16*)(ws + WS_P);
    {
        bf16* QK = (bf16*)(ws + WS_H);
        const float* cw = F.a->in[IN_CQKW]; const float* cb = F.a->in[IN_CQKB];
        const int nthr = F.G * 512;
        for (int i = F.blk * 512 + F.tid; i < MTOK * 128; i += nthr) {
            const int token = i >> 7, cg = i & 127, t = token & 4095, c0 = 8 * cg;
            const bf16* p0 = P + (size_t)token * NPROJ + c0;
            const v4u cur = *(const v4u*)p0;
            v4u prv = (v4u){0u, 0u, 0u, 0u}, nxt = (v4u){0u, 0u, 0u, 0u};
            if (t > 0) prv = *(const v4u*)(p0 - NPROJ);
            if (t < SEQ - 1) nxt = *(const v4u*)(p0 + NPROJ);
            const float scale = (c0 >= 512) ? 0.08838834764831845f : 1.f;
            float o[8];
#pragma unroll
            for (int e = 0; e < 8; ++e) {
                const unsigned wp = prv[e >> 1], wc = cur[e >> 1], wn = nxt[e >> 1];
                const float xp = (e & 1) ? bfhi(wp) : bflo(wp), xc = (e & 1) ? bfhi(wc) : bflo(wc), xn = (e & 1) ? bfhi(wn) : bflo(wn);
                const int c = c0 + e;
                const float val = cb[c] + cw[c] * xp + cw[1024 + c] * xc + cw[2048 + c] * xn;
                o[e] = val * sigmoidf_(val) * scale;
            }
            v4u w; w.x = pk2(o[0], o[1]); w.y = pk2(o[2], o[3]); w.z = pk2(o[4], o[5]); w.w = pk2(o[6], o[7]);
            *(v4u*)(QK + (size_t)token * 1024 + c0) = w;
        }
    }
    {
        bf16* UT = (bf16*)(ws + WS_UT);
        LAS bf16* tile = (LAS bf16*)F.lds;
        const float* cw = F.a->in[IN_CHYW]; const float* cb = F.a->in[IN_CHYB];
        for (int u = F.blk; u < 4 * 64 * 24; u += F.G) {
            const int cgq = u % 24, tt = (u / 24) & 63, p = u / (24 * 64);
            for (int it = F.tid; it < 1024; it += 512) {
                const int cg8 = it & 7, tl = (it >> 3) & 63, bs = it >> 9;
                const int t = tt * 64 + tl, token = (2 * p + bs) * SEQ + t, hxc = cgq * 64 + cg8 * 8;
                const bf16* p0 = P + (size_t)token * NPROJ + 2048 + hxc;
                const v4u cur = *(const v4u*)p0;
                v4u prv = (v4u){0u, 0u, 0u, 0u}, nxt = (v4u){0u, 0u, 0u, 0u};
                if (t > 0) prv = *(const v4u*)(p0 - NPROJ);
                if (t < SEQ - 1) nxt = *(const v4u*)(p0 + NPROJ);
#pragma unroll
                for (int e = 0; e < 8; ++e) {
                    const unsigned wp = prv[e >> 1], wc = cur[e >> 1], wn = nxt[e >> 1];
                    const float xp = (e & 1) ? bfhi(wp) : bflo(wp), xc = (e & 1) ? bfhi(wc) : bflo(wc), xn = (e & 1) ? bfhi(wn) : bflo(wn);
                    const int c = hxc + e;
                    const float val = cb[c] + cw[c] * xp + cw[1536 + c] * xc + cw[3072 + c] * xn;
                    tile[((cg8 * 8 + e) * 64 + tl) * 2 + bs] = (bf16)f2bf(val);
                }
            }
            __syncthreads();
            for (int pc = F.tid; pc < 1024; pc += 512) {
                const int cl = pc >> 4, q = pc & 15, hxc = cgq * 64 + cl, part = hxc >> 9, c = hxc & 511;
                const v4u v = *(const LAS v4u*)(tile + cl * 128 + q * 8);
                *(v4u*)(UT + ((((size_t)part * 4 + p) * 512 + c) * SEQ + tt * 64) * 2 + q * 8) = v;
            }
            __syncthreads();
        }
    }
}

DI void p4_mlstm_seq(Frame& F) {
    unsigned char* ws = F.a->ws;
    constexpr int TB = 32;
    LAS float* qs = (LAS float*)F.lds; LAS float* ks = qs + TB * 128; LAS float* vs = ks + TB * 128; LAS float* ob = vs + TB * 128;
    LAS float* gi = ob + TB * 128; LAS float* gl = gi + TB;
    const bf16* QK = (const bf16*)(ws + WS_H); const bf16* P = (const bf16*)(ws + WS_P); const float* GATES = (const float*)(ws + WS_GATES);
    bf16* HM = (bf16*)(ws + WS_HM);
    const int tid = F.tid, v = tid >> 2, kq = tid & 3;
    for (int it = F.blk; it < 64; it += F.G) {
        const int b = it >> 3, h = (it >> 1) & 3, dir = it & 1;
        float C[32], n[32]; float m = -1e30f;
#pragma unroll
        for (int j = 0; j < 32; ++j) { C[j] = 0.f; n[j] = 0.f; }
        for (int tau0 = 0; tau0 < SEQ; tau0 += TB) {
#pragma unroll
            for (int r = 0; r < 3; ++r) {
                const int st = tid >> 4, ch = tid & 15, tau = tau0 + st, token = b * SEQ + (dir ? SEQ - 1 - tau : tau);
                const bf16* src = (r == 0) ? QK + (size_t)token * 1024 + h * 128 : (r == 1) ? QK + (size_t)token * 1024 + 512 + h * 128 : P + (size_t)token * NPROJ + 1024 + h * 128;
                const v4u w = *(const v4u*)(src + ch * 8);
                LAS float* d = ((r == 0) ? qs : (r == 1) ? ks : vs) + st * 128 + ch * 8;
                *(LAS f32x4*)d = (f32x4){bflo(w.x), bfhi(w.x), bflo(w.y), bfhi(w.y)};
                *(LAS f32x4*)(d + 4) = (f32x4){bflo(w.z), bfhi(w.z), bflo(w.w), bfhi(w.w)};
            }
            if (tid < TB) { const int tau = tau0 + tid, token = b * SEQ + (dir ? SEQ - 1 - tau : tau);
                const float ip = GATES[(size_t)token * 16 + 8 * dir + h], fp = GATES[(size_t)token * 16 + 8 * dir + 4 + h];
                gi[tid] = ip; gl[tid] = fminf(fp, 0.f) - log1pf(__expf(-fabsf(fp))); }
            __syncthreads();
            for (int s = 0; s < TB; ++s) {
                const float is = gi[s], lf = gl[s];
                const float mn = fmaxf(lf + m, is), fpr = __expf(lf + m - mn), ipr = __expf(is - mn); m = mn;
                const float iv = ipr * vs[s * 128 + v];
                float hv = 0.f, dn = 0.f;
#pragma unroll
                for (int j4 = 0; j4 < 8; ++j4) {
                    const f32x4 kk = *(const LAS f32x4*)(ks + s * 128 + 32 * kq + 4 * j4), qq = *(const LAS f32x4*)(qs + s * 128 + 32 * kq + 4 * j4);
#pragma unroll
                    for (int e = 0; e < 4; ++e) { const int j = 4 * j4 + e;
                        C[j] = fmaf(iv, kk[e], fpr * C[j]); n[j] = fmaf(ipr, kk[e], fpr * n[j]);
                        hv = fmaf(C[j], qq[e], hv); dn = fmaf(n[j], qq[e], dn); }
                }
                hv += __shfl_xor(hv, 1); hv += __shfl_xor(hv, 2); dn += __shfl_xor(dn, 1); dn += __shfl_xor(dn, 2);
                if (kq == 0) ob[s * 128 + v] = hv / fmaxf(fabsf(dn), __expf(-m));
            }
            __syncthreads();
            { const int st = tid >> 4, ch = tid & 15, tau = tau0 + st, token = b * SEQ + (dir ? SEQ - 1 - tau : tau);
              const f32x4 a = *(const LAS f32x4*)(ob + st * 128 + ch * 8), c2 = *(const LAS f32x4*)(ob + st * 128 + ch * 8 + 4);
              v4u w; w.x = pk2(a.x, a.y); w.y = pk2(a.z, a.w); w.z = pk2(c2.x, c2.y); w.w = pk2(c2.z, c2.w);
              *(v4u*)(HM + ((size_t)dir * MTOK + token) * 512 + h * 128 + ch * 8) = w; }
            __syncthreads();
        }
    }
}

#define LAUNDER(x) asm volatile("" : "+v"(x))
DI float filt_tap(const float* HID2, const LAS float* w3s, int t, float adelta) {
    const f32x4* hr = (const f32x4*)(HID2 + (size_t)t * 64); float s = 0.f;
#pragma unroll
    for (int i = 0; i < 16; ++i) { const f32x4 hh = hr[i]; s += (hh.x * w3s[4 * i] + hh.y * w3s[4 * i + 1]) + (hh.z * w3s[4 * i + 2] + hh.w * w3s[4 * i + 3]); }
    return s * (__expf(-(float)t * (1.f / 4095.f) * adelta) + 0.05f);
}
template <int HH> DI void hy_finalize(const cf2 (&u)[16], LAS cf2* X, LAS cf2* Z1, const unsigned* Uz, const unsigned* Ux1, const unsigned* Ux2, unsigned* zt, int lo_, int o, float bias) {
#pragma unroll
    for (int j = 0; j < 8; ++j) {
        const int t = (8 * HH + j) * 256 + lo_;
        const cf2 mine = u[8 * HH + j];
        const cf2 oth = X[fphys((HH ? 0 : 4096) + t)];
        const cf2 y = MK2(mine.x + oth.x, mine.y + oth.y);
        if (o == 0) { const unsigned wz = Uz[t], w1 = Ux1[t];
            Z1[t] = MK2(bflo(w1) * (y.x + bias * bflo(wz)), bfhi(w1) * (y.y + bias * bfhi(wz))); }
        else { const unsigned w2 = Ux2[t]; const cf2 z1 = Z1[t];
            zt[t] = pk2(bflo(w2) * (y.x + bias * z1.x), bfhi(w2) * (y.y + bias * z1.y)); }
    }
}
DI void p4_hyena(Frame& F) {
    unsigned char* ws = F.a->ws; const int tid = F.tid, H = tid >> 8, lo = tid & 255;
    LAS cf2* X = (LAS cf2*)F.lds;
    LAS cf2* Z1 = (LAS cf2*)(F.lds + 69632);
    LAS cf2* TW4 = (LAS cf2*)(F.lds + 102400); LAS cf2* TW8 = TW4 + 256;
    LAS float* W3S = (LAS float*)(F.lds + 106496);
    const float* HID2 = (const float*)(ws + WS_HID2);
    cf2* KG = (cf2*)(ws + WS_KSP) + (size_t)F.blk * 16384;
    const unsigned* UT = (const unsigned*)(ws + WS_UT); unsigned* ZT = (unsigned*)(ws + WS_ZT);
    if (tid < 256) { float sn, cs; sincospif((float)tid * (1.f / 2048.f), &sn, &cs); TW4[tid] = MK2(cs, -sn); sincospif((float)tid * (1.f / 4096.f), &sn, &cs); TW8[tid] = MK2(cs, -sn); }
    __syncthreads();
    LAS float* TS = (LAS float*)Z1;
    for (int c = F.blk; c < 512; c += F.G) {
        for (int o = 0; o < 2; ++o) {
            if (tid < 128) { const int d = tid >> 6, j = tid & 63; W3S[tid] = F.a->in[IN_HW3][(size_t)j * 2048 + (o * 2 + d) * 512 + c]; }
            __syncthreads();
            const float adf = fabsf(F.a->in[IN_HDELTA][(o * 2) * 512 + c]), adb = fabsf(F.a->in[IN_HDELTA][(o * 2 + 1) * 512 + c]);
#pragma unroll 1
            for (int n = tid; n < 8192; n += 512) {
                float val;
                if (n < SEQ) { val = filt_tap(HID2, W3S, n, adf); if (n == 0) val += filt_tap(HID2, W3S + 64, 0, adb); }
                else if (n == SEQ) val = 0.f;
                else val = filt_tap(HID2, W3S + 64, 2 * SEQ - n, adb);
                TS[n] = val;
            }
            __syncthreads();
            {
                int tl = tid; LAUNDER(tl); const int lo_ = tl & 255;
                cf2 a[16], b[16];
#pragma unroll
                for (int k = 0; k < 16; ++k) { a[k] = MK2(TS[k * 256 + lo_], 0.f); b[k] = MK2(TS[SEQ + k * 256 + lo_], 0.f); }
                fft_passA_fwd(tl, a, b, X, TW4, TW8);
            }
            __syncthreads();
            { int tl = tid; LAUNDER(tl); fft_passB_fwd(tl, X, TW4); }
            __syncthreads();
            { int tl = tid; LAUNDER(tl); cf2 v[16]; fft_passC_fwd(tl, X, v);
              cf2* kg = KG + o * 8192 + tl;
#pragma unroll
              for (int r = 0; r < 16; ++r) kg[r * 512] = MK2(v[r].x * (1.f / 8192.f), v[r].y * (1.f / 8192.f)); }
            __syncthreads();
        }
        const float bias0 = F.a->in[IN_HBIAS][c], bias1 = F.a->in[IN_HBIAS][512 + c];
#pragma unroll 1
        for (int p = 0; p < 4; ++p) {
            const unsigned* Ux1 = UT + (((size_t)0 * 4 + p) * 512 + c) * SEQ; const unsigned* Ux2 = UT + (((size_t)1 * 4 + p) * 512 + c) * SEQ; const unsigned* Uz = UT + (((size_t)2 * 4 + p) * 512 + c) * SEQ;
#pragma unroll 1
            for (int o = 0; o < 2; ++o) {
                { int tl = tid; LAUNDER(tl); const int lo_ = tl & 255;
                    cf2 a[16], b[16];
#pragma unroll
                    for (int k = 0; k < 16; ++k) {
                        if (o == 0) { const unsigned w = Uz[k * 256 + lo_]; a[k] = MK2(bflo(w), bfhi(w)); } else a[k] = Z1[k * 256 + lo_];
                        b[k] = MK2(0.f, 0.f); }
                    fft_passA_fwd(tl, a, b, X, TW4, TW8);
                }
                __syncthreads();
                { int tl = tid; LAUNDER(tl); fft_passB_fwd(tl, X, TW4); }
                __syncthreads();
                { int tl = tid; LAUNDER(tl); cf2 v[16]; fft_passC_fwd(tl, X, v);
                  const cf2* kg = KG + o * 8192 + tl;
#pragma unroll
                  for (int r = 0; r < 16; ++r) v[r] = c_mul(v[r], kg[r * 512]);
                  fft_passC_inv(tl, X, v); }
                __syncthreads();
                { int tl = tid; LAUNDER(tl); fft_passB_inv(tl, X, TW4); }
                __syncthreads();
                {
                    int tl = tid; LAUNDER(tl); const int H_ = tl >> 8, lo_ = tl & 255;
                    cf2 u[16]; fft_passA_inv(tl, X, TW4, TW8, u);
                    if (H_ == 0) {
#pragma unroll
                        for (int k = 8; k < 16; ++k) X[fphys(k * 256 + lo_)] = u[k];
                    } else {
#pragma unroll
                        for (int k = 0; k < 8; ++k) X[fphys(4096 + k * 256 + lo_)] = u[k];
                    }
                    __syncthreads();
                    const float bias = (o == 0) ? bias0 : bias1;
                    if (H_ == 0) hy_finalize<0>(u, X, Z1, Uz, Ux1, Ux2, ZT + ((size_t)p * 512 + c) * SEQ, lo_, o, bias);
                    else hy_finalize<1>(u, X, Z1, Uz, Ux1, Ux2, ZT + ((size_t)p * 512 + c) * SEQ, lo_, o, bias);
                }
                __syncthreads();
            }
        }
    }
}

DI void p5_post(Frame& F) {
    unsigned char* ws = F.a->ws; const int lane = F.lane;
    bf16* Y = (bf16*)(ws + WS_H); const bf16* P = (const bf16*)(ws + WS_P); const bf16* HM = (const bf16*)(ws + WS_HM);
    {
        const int gw = F.blk * 8 + F.wave, NGW = F.G * 8;
        const f32x4 g0 = *(const f32x4*)(F.a->in[IN_MNG] + 8 * lane), g1 = *(const f32x4*)(F.a->in[IN_MNG] + 8 * lane + 4);
        for (int row = gw; row < MTOK; row += NGW) {
            const v4u a = *(const v4u*)(HM + (size_t)row * 512 + 8 * lane), bq = *(const v4u*)(HM + ((size_t)MTOK + row) * 512 + 8 * lane);
            const v4u ov = *(const v4u*)(P + (size_t)row * NPROJ + 1536 + 8 * lane);
            float hsum[8], og[8];
#pragma unroll
            for (int e = 0; e < 4; ++e) { hsum[2 * e] = bflo(a[e]) + bflo(bq[e]); hsum[2 * e + 1] = bfhi(a[e]) + bfhi(bq[e]); og[2 * e] = bflo(ov[e]); og[2 * e + 1] = bfhi(ov[e]); }
            float ss = 0.f;
#pragma unroll
            for (int e = 0; e < 8; ++e) ss += hsum[e] * hsum[e];
            ss += __shfl_xor(ss, 1); ss += __shfl_xor(ss, 2); ss += __shfl_xor(ss, 4); ss += __shfl_xor(ss, 8);
            const float rstd = rsqrtf(ss * (1.f / 128.f) + RMS_EPS);
            const float gg[8] = {g0.x, g0.y, g0.z, g0.w, g1.x, g1.y, g1.z, g1.w};
            float o[8];
#pragma unroll
            for (int e = 0; e < 8; ++e) o[e] = sigmoidf_(og[e]) * hsum[e] * rstd * gg[e];
            v4u w; w.x = pk2(o[0], o[1]); w.y = pk2(o[2], o[3]); w.z = pk2(o[4], o[5]); w.w = pk2(o[6], o[7]);
            *(v4u*)(Y + (size_t)row * 1024 + 8 * lane) = w;
        }
    }
    {
        const bf16* ZT = (const bf16*)(ws + WS_ZT);
        LAS bf16* tile = (LAS bf16*)F.lds;
        const f32x4 g0 = *(const f32x4*)(F.a->in[IN_HNG] + 8 * lane), g1 = *(const f32x4*)(F.a->in[IN_HNG] + 8 * lane + 4);
        const float gg[8] = {g0.x, g0.y, g0.z, g0.w, g1.x, g1.y, g1.z, g1.w};
        __syncthreads();
        for (int u = F.blk; u < 4 * 128; u += F.G) {
            const int p = u >> 7, tt = u & 127;
            for (int pc = F.tid; pc < 4096; pc += 512) {
                const int c = pc >> 3, q = pc & 7;
                const v4u v = *(const v4u*)(ZT + (((size_t)p * 512 + c) * SEQ + tt * 32) * 2 + q * 8);
#pragma unroll
                for (int i = 0; i < 4; ++i) { tile[((4 * q + i) * 2 + 0) * 520 + c] = (bf16)(v[i] & 0xffffu); tile[((4 * q + i) * 2 + 1) * 520 + c] = (bf16)(v[i] >> 16); }
            }
            __syncthreads();
#pragma unroll 2
            for (int rr = 0; rr < 8; ++rr) {
                const int row = F.wave * 8 + rr, t = row >> 1, bs = row & 1, token = (2 * p + bs) * SEQ + tt * 32 + t;
                const v4u v = *(const LAS v4u*)(tile + row * 520 + 8 * lane);
                float z[8];
#pragma unroll
                for (int e = 0; e < 4; ++e) { z[2 * e] = bflo(v[e]); z[2 * e + 1] = bfhi(v[e]); }
                float ss = 0.f;
#pragma unroll
                for (int e = 0; e < 8; ++e) ss += z[e] * z[e];
                ss += __shfl_xor(ss, 1); ss += __shfl_xor(ss, 2); ss += __shfl_xor(ss, 4); ss += __shfl_xor(ss, 8);
                const float rstd = rsqrtf(ss * (1.f / 128.f) + RMS_EPS);
                v4u w; w.x = pk2(z[0] * rstd * gg[0], z[1] * rstd * gg[1]); w.y = pk2(z[2] * rstd * gg[2], z[3] * rstd * gg[3]);
                w.z = pk2(z[4] * rstd * gg[4], z[5] * rstd * gg[5]); w.w = pk2(z[6] * rstd * gg[6], z[7] * rstd * gg[7]);
                *(v4u*)(Y + (size_t)token * 1024 + 512 + 8 * lane) = w;
            }
            __syncthreads();
        }
    }
}

DI void conv_wgu(Frame& F) {
    LAS float* scr = (LAS float*)(F.lds + F.wave * 16384); bf16* WGU = (bf16*)(F.a->ws + WS_WGU);
    const int gw = F.blk * 8 + F.wave, NGW = F.G * 8;
    for (int it = gw; it < 16 * 16 * 128; it += NGW) {
        const int nb = it & 127, kb = (it >> 7) & 15, e = it >> 11, n0 = 32 * nb, k0 = 64 * kb, j = n0 >> 8, r = n0 & 255, f0 = 128 * j + (r & 127);
        const float* W = (r < 128 ? F.a->in[IN_WGATE] : F.a->in[IN_WUP]) + (size_t)e * 1024 * 2048;
        transpose_item(W + (size_t)k0 * 2048 + f0, 2048, WGU + ((size_t)e * 4096 + n0) * 1024 + k0, 1024, scr, F.lane);
    }
}
DI void conv_wd(Frame& F) {
    LAS float* scr = (LAS float*)(F.lds + F.wave * 16384); bf16* WD = (bf16*)(F.a->ws + WS_WD);
    const int gw = F.blk * 8 + F.wave, NGW = F.G * 8;
    for (int it = gw; it < 16 * 32 * 32; it += NGW) {
        const int nb = it & 31, kb = (it >> 5) & 31, e = it >> 10, n0 = 32 * nb, k0 = 64 * kb;
        transpose_item(F.a->in[IN_WDOWN] + (size_t)e * 2048 * 1024 + (size_t)k0 * 1024 + n0, 1024, WD + ((size_t)e * 1024 + n0) * 2048 + k0, 2048, scr, F.lane);
    }
}

DI void p8_topk(Frame& F) {
    unsigned char* ws = F.a->ws; const int tid = F.tid, lane = F.lane, wave = F.wave;
    LAS unsigned* hist = (LAS unsigned*)F.lds;
    LAS unsigned* wtot = hist + 256;
    LAS unsigned* ctl = wtot + 8;
    LAS int* sel = (LAS int*)(ctl + 8);
    const float* AFF = (const float*)(ws + WS_AFF); const bf16* HF = (const bf16*)(ws + WS_HF); bf16* XS = (bf16*)(ws + WS_XS);
    int* IDX = (int*)(ws + WS_IDX); float* GSEL = (float*)(ws + WS_GSEL); int* INV = (int*)(ws + WS_INV);
    for (int it = F.blk; it < NB * NEXP; it += F.G) {
        const int b = it >> 4, e = it & 15;
        unsigned k8[8];
        { const v4u a = *(const v4u*)(AFF + (size_t)it * SEQ + 8 * tid), c2 = *(const v4u*)(AFF + (size_t)it * SEQ + 8 * tid + 4);
          k8[0] = a.x; k8[1] = a.y; k8[2] = a.z; k8[3] = a.w; k8[4] = c2.x; k8[5] = c2.y; k8[6] = c2.z; k8[7] = c2.w; }
        unsigned prefix = 0u, need = CAP;
#pragma unroll 1
        for (int pass = 0; pass < 4; ++pass) {
            const int shift = 24 - 8 * pass; const unsigned mask = pass ? (0xffffffffu << (shift + 8)) : 0u;
            if (tid < 256) hist[tid] = 0u;
            __syncthreads();
#pragma unroll
            for (int i = 0; i < 8; ++i) if ((k8[i] & mask) == prefix) atomicAdd((unsigned*)(hist + ((k8[i] >> shift) & 255u)), 1u);
            __syncthreads();
            if (wave == 0) {
                const unsigned h0 = hist[4 * lane], h1 = hist[4 * lane + 1], h2 = hist[4 * lane + 2], h3 = hist[4 * lane + 3], s = h0 + h1 + h2 + h3;
                unsigned suf = s;
#pragma unroll
                for (int o = 1; o < 64; o <<= 1) { const unsigned t = __shfl_down(suf, o); if (lane + o < 64) suf += t; }
                const unsigned above = suf - s;
                if (above < need && need <= suf) {
                    unsigned rem = need - above; int bin;
                    if (h3 >= rem) bin = 3; else { rem -= h3; if (h2 >= rem) bin = 2; else { rem -= h2; if (h1 >= rem) bin = 1; else { rem -= h1; bin = 0; } } }
                    ctl[0] = prefix | ((unsigned)(4 * lane + bin) << shift); ctl[1] = rem;
                }
            }
            __syncthreads();
            prefix = ctl[0]; need = ctl[1];
        }
        const unsigned T = prefix;
        unsigned cg = 0u, ce = 0u;
#pragma unroll
        for (int i = 0; i < 8; ++i) { cg += (k8[i] > T) ? 1u : 0u; ce += (k8[i] == T) ? 1u : 0u; }
        const unsigned pack = cg | (ce << 16);
        unsigned inc = pack;
#pragma unroll
        for (int o = 1; o < 64; o <<= 1) { const unsigned t = __shfl_up(inc, o); if (lane >= o) inc += t; }
        if (lane == 63) wtot[wave] = inc;
        __syncthreads();
        unsigned woff = 0u;
#pragma unroll
        for (int w = 0; w < 8; ++w) woff += (w < wave) ? wtot[w] : 0u;
        const unsigned exc = woff + inc - pack;
        unsigned gtb = exc & 0xffffu, eqb = exc >> 16;
#pragma unroll
        for (int i = 0; i < 8; ++i) {
            const int idx = 8 * tid + i; const bool isgt = k8[i] > T, iseq = k8[i] == T, selc = isgt || (iseq && eqb < need);
            const int slot = (int)(gtb + (eqb < need ? eqb : need));
            if (selc) { sel[slot] = idx; IDX[it * CAP + slot] = idx; GSEL[it * CAP + slot] = __uint_as_float(k8[i]); }
            INV[((size_t)b * SEQ + idx) * 16 + e] = selc ? slot : -1;
            gtb += isgt ? 1u : 0u; eqb += iseq ? 1u : 0u;
        }
        __syncthreads();
        for (int s0 = wave * 64; s0 < wave * 64 + 64; s0 += 8) {
            v4u x0[8], x1[8];
#pragma unroll
            for (int r = 0; r < 8; ++r) { const v4u* src = (const v4u*)(HF + ((size_t)b * SEQ + sel[s0 + r]) * 1024); x0[r] = src[lane]; x1[r] = src[lane + 64]; }
#pragma unroll
            for (int r = 0; r < 8; ++r) { v4u* dst = (v4u*)(XS + (((size_t)e * NB + b) * CAP + s0 + r) * 1024); dst[lane] = x0[r]; dst[lane + 64] = x1[r]; }
        }
        __syncthreads();
    }
}

DI void p12_final(Frame& F) {
    unsigned char* ws = F.a->ws; const int lane = F.lane;
    const int* INV = (const int*)(ws + WS_INV); const float* GSEL = (const float*)(ws + WS_GSEL); const bf16* YS = (const bf16*)(ws + WS_YS); const float* MOD = (const float*)(ws + WS_MOD);
    const int gw = F.blk * 8 + F.wave, NGW = F.G * 8;
    for (int row = gw; row < MTOK; row += NGW) {
        const int b = row >> 12;
        f32x4* xr = (f32x4*)(F.a->out + (size_t)row * 1024) + lane;
        f32x4 v[4], acc[4];
#pragma unroll
        for (int j = 0; j < 4; ++j) { v[j] = xr[64 * j]; acc[j] = (f32x4){0.f, 0.f, 0.f, 0.f}; }
        const int myslot = INV[(size_t)row * 16 + (lane & 15)];
#pragma unroll 1
        for (int e = 0; e < 16; ++e) {
            const int s = __shfl(myslot, e);
            if (s >= 0) {
                const float g = GSEL[((size_t)b * 16 + e) * CAP + s];
                const v2u* yr = (const v2u*)(YS + (((size_t)e * NB + b) * CAP + s) * 1024) + lane;
#pragma unroll
                for (int j = 0; j < 4; ++j) { const v2u w = yr[64 * j]; acc[j] += (f32x4){bflo(w.x), bfhi(w.x), bflo(w.y), bfhi(w.y)} * g; }
            }
        }
        float ss = 0.f;
#pragma unroll
        for (int j = 0; j < 4; ++j) { const f32x4 gt = *(const f32x4*)(MOD + b * 6144 + 5120 + 256 * j + 4 * lane); v[j] = v[j] + gt * acc[j]; ss += (v[j].x * v[j].x + v[j].y * v[j].y) + (v[j].z * v[j].z + v[j].w * v[j].w); }
        const float rstd = rsqrtf(wave_sum(ss) * (1.f / 1024.f) + RMS_EPS);
#pragma unroll
        for (int j = 0; j < 4; ++j) { const f32x4 g = *(const f32x4*)(F.a->in[IN_GFINAL] + 256 * j + 4 * lane); xr[64 * j] = v[j] * rstd * g; }
    }
}

typedef short bf16x8_t __attribute__((ext_vector_type(8)));
DI unsigned offb(unsigned row, unsigned ch) { return 256u * row + 16u * (ch ^ (((row & 3u) << 2) | ((row >> 2) & 3u))); }
DI bf16x8_t tr_read2(unsigned a0, unsigned a1) {
    v2u lo, hi;
    asm volatile("ds_read_b64_tr_b16 %0, %2\n\tds_read_b64_tr_b16 %1, %3\n\ts_waitcnt lgkmcnt(0)" : "=&v"(lo), "=&v"(hi) : "v"(a0), "v"(a1) : "memory");
    const v4u w = (v4u){lo.x, lo.y, hi.x, hi.y};
    return __builtin_bit_cast(bf16x8_t, w);
}
DI bf16x8_t lds_frag(const LAS unsigned char* p) { return *(const LAS bf16x8_t*)p; }
#define MFMA16(a, b, c) __builtin_amdgcn_mfma_f32_16x16x32_bf16((a), (b), (c), 0, 0, 0)
constexpr int ML_QT = 0, ML_KT = 32768, ML_VT = 65536, ML_VE = 81920, ML_CB = 98304, ML_OUT = 110592, ML_SC = 118784, ML_SCSZ = 2688;
DI void p4_mlstm_mfma(Frame& F) {
    unsigned char* ws = F.a->ws; LAS unsigned char* L = F.lds;
    const bf16* QK = (const bf16*)(ws + WS_H); const bf16* P = (const bf16*)(ws + WS_P); const float* GATES = (const float*)(ws + WS_GATES);
    bf16* HM = (bf16*)(ws + WS_HM);
    const int tid = F.tid, lane = F.lane, wave = F.wave, fr = lane & 15, fq = lane >> 4, q4 = fr >> 2, p4 = fr & 3;
    const int tb = (wave < 4) ? wave : 11 - wave;
    const unsigned ldsb = (unsigned)(uintptr_t)L;
    for (int it = F.blk; it < 256; it += F.G) {
        const int vs = it & 3, dir = (it >> 2) & 1, h = (it >> 3) & 3, b = it >> 5;
        __syncthreads();
        for (int i = tid; i < 12288 / 16; i += 512) *(LAS v4u*)(L + ML_CB + 16 * i) = (v4u){0u, 0u, 0u, 0u};
        if (tid < 256) { const int row = tid >> 1, hf = tid & 1;
            *(LAS v4u*)(L + ML_VT + row * 128 + 64 + 16 * hf) = (v4u){hf ? 0u : 0x3F80u, 0u, 0u, 0u};
            *(LAS v4u*)(L + ML_VE + row * 128 + 64 + 16 * hf) = (v4u){0u, 0u, 0u, 0u}; }
        f32x4 Cacc[3];
#pragma unroll
        for (int vt = 0; vt < 3; ++vt) Cacc[vt] = (f32x4){0.f, 0.f, 0.f, 0.f};
        float m_in = -1e30f;
        float gpre[4] = {0.f, 0.f, 0.f, 0.f};
        v4u rq[4], rk[4], rv;
        auto load_gates = [&](int cj) {
#pragma unroll
            for (int e = 0; e < 2; ++e) { const int tg = cj * 128 + 2 * lane + e, token = b * SEQ + (dir ? SEQ - 1 - tg : tg);
                gpre[2 * e] = GATES[(size_t)token * 16 + 8 * dir + h]; gpre[2 * e + 1] = GATES[(size_t)token * 16 + 8 * dir + 4 + h]; }
        };
        auto scan = [&](int cj) {
            LAS float* SC = (LAS float*)(L + ML_SC + (cj & 1) * ML_SCSZ);
            const float lf0 = fminf(gpre[1], 0.f) - log1pf(__expf(-fabsf(gpre[1]))), lf1 = fminf(gpre[3], 0.f) - log1pf(__expf(-fabsf(gpre[3])));
            float inc = lf0 + lf1;
#pragma unroll
            for (int o = 1; o < 64; o <<= 1) { const float t = __shfl_up(inc, o); if (lane >= o) inc += t; }
            const float b1 = inc, b0 = inc - lf1, u0 = gpre[0] - b0, u1 = gpre[2] - b1;
            float imx = fmaxf(u0, u1);
#pragma unroll
            for (int o = 1; o < 64; o <<= 1) { const float t = __shfl_up(imx, o); if (lane >= o) imx = fmaxf(imx, t); }
            float exm = __shfl_up(imx, 1); if (lane == 0) exm = -3.0e38f;
            const float M0 = fmaxf(m_in, fmaxf(exm, u0)), M1 = fmaxf(m_in, imx);
            const float g = __shfl(b1, 63), Ml = __shfl(M1, 63);
            SC[2 * lane] = u0; SC[2 * lane + 1] = u1;
            SC[128 + 2 * lane] = M0; SC[128 + 2 * lane + 1] = M1;
            SC[256 + 2 * lane] = __expf(m_in - M0); SC[256 + 2 * lane + 1] = __expf(m_in - M1);
            SC[384 + 2 * lane] = __expf(-(b0 + M0)); SC[384 + 2 * lane + 1] = __expf(-(b1 + M1));
            SC[512 + 2 * lane] = __expf(u0 - Ml); SC[512 + 2 * lane + 1] = __expf(u1 - Ml);
            if (lane == 0) SC[640] = __expf(m_in - Ml);
            m_in = g + Ml;
        };
        auto load_tiles = [&](int cj) {
#pragma unroll
            for (int i = 0; i < 4; ++i) { const int id = tid + 512 * i, row = id >> 4, ch = id & 15, tg = cj * 128 + row, token = b * SEQ + (dir ? SEQ - 1 - tg : tg);
                rq[i] = *(const v4u*)(QK + (size_t)token * 1024 + h * 128 + 8 * ch); rk[i] = *(const v4u*)(QK + (size_t)token * 1024 + 512 + h * 128 + 8 * ch); }
            { const int row = tid >> 2, pc = tid & 3, tg = cj * 128 + row, token = b * SEQ + (dir ? SEQ - 1 - tg : tg);
              rv = *(const v4u*)(P + (size_t)token * NPROJ + 1024 + h * 128 + 32 * vs + 8 * pc); }
        };
        auto store_tiles = [&](int cj) {
            const LAS float* SC = (const LAS float*)(L + ML_SC + (cj & 1) * ML_SCSZ);
#pragma unroll
            for (int i = 0; i < 4; ++i) { const int id = tid + 512 * i, row = id >> 4, ch = id & 15;
                *(LAS v4u*)(L + ML_QT + offb(row, ch)) = rq[i]; *(LAS v4u*)(L + ML_KT + offb(row, ch)) = rk[i]; }
            { const int row = tid >> 2, pc = tid & 3; const float e = SC[512 + row];
              *(LAS v4u*)(L + ML_VT + row * 128 + 16 * pc) = rv;
              v4u w; w.x = pk2(bflo(rv.x) * e, bfhi(rv.x) * e); w.y = pk2(bflo(rv.y) * e, bfhi(rv.y) * e); w.z = pk2(bflo(rv.z) * e, bfhi(rv.z) * e); w.w = pk2(bflo(rv.w) * e, bfhi(rv.w) * e);
              *(LAS v4u*)(L + ML_VE + row * 128 + 16 * pc) = w;
              if (pc == 0) *(LAS bf16*)(L + ML_VE + row * 128 + 64) = (bf16)f2bf(e); }
        };
        if (wave == 0) { load_gates(0); scan(0); load_gates(1); }
        load_tiles(0);
        __syncthreads();
        store_tiles(0);
        __syncthreads();
#pragma unroll 1
        for (int cj = 0; cj < 32; ++cj) {
            const LAS float* SC = (const LAS float*)(L + ML_SC + (cj & 1) * ML_SCSZ);
            if (cj + 1 < 32) { if (wave == 0) { scan(cj + 1); if (cj + 2 < 32) load_gates(cj + 2); } load_tiles(cj + 1); }
            bf16x8_t qf[4];
#pragma unroll
            for (int ks = 0; ks < 4; ++ks) qf[ks] = lds_frag(L + ML_QT + offb(16 * tb + fr, 4 * ks + fq));
            f32x4 accO[3];
#pragma unroll
            for (int vt = 0; vt < 3; ++vt) { accO[vt] = (f32x4){0.f, 0.f, 0.f, 0.f};
#pragma unroll
                for (int ks = 0; ks < 4; ++ks) accO[vt] = MFMA16(qf[ks], lds_frag(L + ML_CB + offb(16 * vt + fr, 4 * ks + fq)), accO[vt]); }
            { const f32x4 ei = *(const LAS f32x4*)(SC + 256 + 16 * tb + 4 * fq);
#pragma unroll
              for (int vt = 0; vt < 3; ++vt) accO[vt] = accO[vt] * ei; }
            const float mrow_t = SC[128 + 16 * tb + fr];
            for (int ks2 = 0; ks2 <= (tb >> 1); ++ks2) {
                f32x4 st[2];
#pragma unroll
                for (int hh = 0; hh < 2; ++hh) {
                    const int sb = 2 * ks2 + hh;
                    st[hh] = (f32x4){0.f, 0.f, 0.f, 0.f};
                    if (sb <= tb) {
                        f32x4 acc = (f32x4){0.f, 0.f, 0.f, 0.f};
#pragma unroll
                        for (int kd = 0; kd < 4; ++kd) acc = MFMA16(lds_frag(L + ML_KT + offb(16 * sb + fr, 4 * kd + fq)), qf[kd], acc);
                        const f32x4 us = *(const LAS f32x4*)(SC + 16 * sb + 4 * fq);
#pragma unroll
                        for (int r = 0; r < 4; ++r) { const float val = acc[r] * __expf(us[r] - mrow_t); st[hh][r] = (16 * sb + 4 * fq + r <= 16 * tb + fr) ? val : 0.f; }
                    }
                }
                v4u sw; sw.x = pk2(st[0][0], st[0][1]); sw.y = pk2(st[0][2], st[0][3]); sw.z = pk2(st[1][0], st[1][1]); sw.w = pk2(st[1][2], st[1][3]);
                const bf16x8_t sp = __builtin_bit_cast(bf16x8_t, sw);
                const unsigned va = ldsb + ML_VT + (32 * ks2 + 4 * fq + q4) * 128 + 8 * p4;
#pragma unroll
                for (int vt = 0; vt < 3; ++vt) accO[vt] = MFMA16(sp, tr_read2(va + 32 * vt, va + 32 * vt + 16 * 128), accO[vt]);
            }
            { const f32x4 enm = *(const LAS f32x4*)(SC + 384 + 16 * tb + 4 * fq);
#pragma unroll
              for (int r = 0; r < 4; ++r) { const float den = __shfl(accO[2][r], lane & 48), inv = 1.f / fmaxf(fabsf(den), enm[r]);
                  const int t = 16 * tb + 4 * fq + r;
                  *(LAS bf16*)(L + ML_OUT + t * 64 + 2 * fr) = (bf16)f2bf(accO[0][r] * inv); *(LAS bf16*)(L + ML_OUT + t * 64 + 32 + 2 * fr) = (bf16)f2bf(accO[1][r] * inv); } }
            { const float sp = SC[640];
#pragma unroll
              for (int vt = 0; vt < 3; ++vt) Cacc[vt] = Cacc[vt] * sp; }
#pragma unroll
            for (int ks = 0; ks < 4; ++ks) {
                const unsigned r0 = 32 * ks + 8 * fq + q4;
                const bf16x8_t kb = tr_read2(ldsb + ML_KT + offb(r0, 2 * wave + (p4 >> 1)) + 8 * (p4 & 1), ldsb + ML_KT + offb(r0 + 4, 2 * wave + (p4 >> 1)) + 8 * (p4 & 1));
                const unsigned ea = ldsb + ML_VE + r0 * 128 + 8 * p4;
#pragma unroll
                for (int vt = 0; vt < 3; ++vt) Cacc[vt] = MFMA16(tr_read2(ea + 32 * vt, ea + 32 * vt + 4 * 128), kb, Cacc[vt]);
            }
            __syncthreads();
#pragma unroll
            for (int vt = 0; vt < 3; ++vt)
#pragma unroll
                for (int r = 0; r < 4; ++r) { const int v = 16 * vt + 4 * fq + r, d = 16 * wave + fr;
                    *(LAS bf16*)(L + ML_CB + offb(v, d >> 3) + 2 * (d & 7)) = (bf16)f2bf(Cacc[vt][r]); }
            { const int row = tid >> 2, pc = tid & 3, tg = cj * 128 + row, token = b * SEQ + (dir ? SEQ - 1 - tg : tg);
              *(v4u*)(HM + ((size_t)dir * MTOK + token) * 512 + h * 128 + 32 * vs + 8 * pc) = *(const LAS v4u*)(L + ML_OUT + row * 64 + 16 * pc); }
            if (cj + 1 < 32) store_tiles(cj + 1);
            __syncthreads();
        }
    }
}
__global__ void __launch_bounds__(512, 2) fwd_kernel(Args args) {
    extern __shared__ __attribute__((aligned(16))) unsigned char lds[];
    Frame F;
    F.lds = (LAS unsigned char*)lds;
    F.tid = threadIdx.x; F.lane = F.tid & 63; F.wave = __builtin_amdgcn_readfirstlane(F.tid >> 6);
    F.G = gridDim.x; F.blk = blockIdx.x;
    F.a = &args;
    volatile LAS unsigned* MISC = (volatile LAS unsigned*)(F.lds + MISC_OFF);
    if (F.tid < 64) MISC[F.tid] = 0u;
    __syncthreads();
    XcdBarrier bar; bar.bar = (unsigned*)(F.a->ws + WS_CTL); bar.x = 0; bar.st = nullptr;
    if (N_LAUNCHES == 1) bar = xcd_barrier_post((unsigned*)(F.a->ws + WS_CTL), MISC + 8);
    const int lo = args.ph_lo, hi = args.ph_hi;
#define IN(k) (lo <= (k) && (k) < hi)
#define SEAM(k) do { if (IN(k) && IN((k) + 1)) xcd_barrier(bar); } while (0)
    unsigned char* ws = F.a->ws;
    if (IN(0)) { p0_prologue(F); } SEAM(0);
    if (IN(1)) { p_norm<false>(F); } SEAM(1);
    if (IN(2)) {
        pg8::Gemm g{(const pg8::bf16_t*)(ws + WS_H), (const pg8::bf16_t*)(ws + WS_WIN), MTOK, NPROJ, DM}; pg8::StaticOrder S; S.init(MTOK, NPROJ, F.G, F.blk);
        pg8::EpiBf16<0> E{(pg8::bf16_t*)(ws + WS_P), NPROJ, (const float*)(ws + WS_BIN2), 0, 0, 1.f};
        pg8::gemm_phase<pg8::EpiBf16<0>, pg8::StaticOrder, true, true>(F.lds, g, S, E);
    } SEAM(2);
    if (IN(3)) { p3_prep(F); } SEAM(3);
    if (IN(4)) { p4_hyena(F); __syncthreads(); p4_mlstm_mfma(F); } SEAM(4);
    if (IN(5)) { p5_post(F); } SEAM(5);
    if (IN(6)) {
        pg8::Gemm g{(const pg8::bf16_t*)(ws + WS_H), (const pg8::bf16_t*)(ws + WS_WOUT), MTOK, DM, DM}; pg8::StaticOrder S; S.init(MTOK, DM, F.G, F.blk);
        pg8::EpiRes E{F.a->in[IN_X], F.a->out, (const float*)(ws + WS_MOD)};
        pg8::gemm_phase<pg8::EpiRes, pg8::StaticOrder, true, true>(F.lds, g, S, E);
    } SEAM(6);
    if (IN(7)) { p_norm<true>(F); __syncthreads(); conv_wgu(F); } SEAM(7);
    if (IN(8)) { p8_topk(F); } SEAM(8);
    if (IN(9)) {
        pg8::Gemm g{(const pg8::bf16_t*)(ws + WS_XS), (const pg8::bf16_t*)(ws + WS_WGU), NSLOT, NEXP * 4096, DM}; pg8::MoeOrderA S{F.G, F.blk};
        pg8::EpiSwiGLU E{(pg8::bf16_t*)(ws + WS_HID)};
        pg8::gemm_phase<pg8::EpiSwiGLU, pg8::MoeOrderA, true, true>(F.lds, g, S, E);
    } SEAM(9);
    if (IN(10)) { conv_wd(F); } SEAM(10);
    if (IN(11)) {
        pg8::Gemm g{(const pg8::bf16_t*)(ws + WS_HID), (const pg8::bf16_t*)(ws + WS_WD), NSLOT, NEXP * 1024, FFD}; pg8::MoeOrderB S{F.G, F.blk};
        pg8::EpiYs E{(pg8::bf16_t*)(ws + WS_YS)};
        pg8::gemm_phase<pg8::EpiYs, pg8::MoeOrderB, true, true>(F.lds, g, S, E);
    } SEAM(11);
    if (IN(12)) { p12_final(F); }
#undef IN
#undef SEAM
}

extern "C" void kernel_launch(void* const* d_in, const int* in_sizes, int n_in, void* d_out, int out_size, void* d_ws, size_t ws_size, hipStream_t stream) {
    static int grid = 0;
    if (grid == 0) {
        if (n_in != 28 || out_size != MTOK * DM || ws_size < WS_END) { fprintf(stderr, "kernel_launch: unexpected shapes (n_in %d, out %d, ws %zu < %zu)\n", n_in, out_size, ws_size, (size_t)WS_END); grid = -1; return; }
        int dev = 0, cus = 0;
        if (hipGetDevice(&dev) != hipSuccess || hipDeviceGetAttribute(&cus, hipDeviceAttributeMultiprocessorCount, dev) != hipSuccess) { grid = -1; return; }
        if (hipFuncSetAttribute((const void*)fwd_kernel, hipFuncAttributeMaxDynamicSharedMemorySize, LDS_BYTES) != hipSuccess) { fprintf(stderr, "kernel_launch: hipFuncSetAttribute failed\n"); grid = -1; return; }
        int per_cu = 0;
        if (hipOccupancyMaxActiveBlocksPerMultiprocessor(&per_cu, (const void*)fwd_kernel, 512, LDS_BYTES) != hipSuccess || per_cu < 1) fprintf(stderr, "kernel_launch: occupancy query reports %d\n", per_cu);
        (void)hipGetLastError();
        grid = cus > 256 ? 256 : cus;
    }
    if (grid < 0) return;
    (void)hipMemsetAsync((char*)d_ws + WS_CTL, 0, CTL_ZERO_BYTES, stream);
    Args a{};
    for (int i = 0; i < 28; ++i) a.in[i] = (const float*)d_in[i];
    a.out = (float*)d_out; a.ws = (unsigned char*)d_ws;
    if (N_LAUNCHES == 1) { a.ph_lo = 0; a.ph_hi = N_PHASES; hipLaunchKernelGGL(fwd_kernel, dim3(grid), dim3(512), LDS_BYTES, stream, a); }
    else for (int p = 0; p < N_PHASES; ++p) { a.ph_lo = p; a.ph_hi = p + 1; hipLaunchKernelGGL(fwd_kernel, dim3(grid), dim3(512), LDS_BYTES, stream, a); }
}
```

```cpp
#include <hip/hip_runtime.h>
#include <cstdio>
#include <cstdint>
#define N_LAUNCHES 1
#define DUPMASK 0
namespace pg8 {
#define PG8_LAS __attribute__((address_space(3)))
typedef unsigned short bf16_t;
typedef short bf16x8 __attribute__((ext_vector_type(8)));
typedef float f32x4 __attribute__((ext_vector_type(4)));
typedef unsigned u32x4 __attribute__((ext_vector_type(4)));
constexpr int BM = 256, BK = 64, HALF = 128, HTB = HALF * BK * 2  , STAGE_BYTES = 8 * HTB, NXCD = 8, WGM = 8;

__host__ __device__ __forceinline__ int lds_byte(int r, int c) { const int st = (r >> 4) * 2 + (c >> 5), rr = r & 15, cc = c & 31, ob = rr * 64 + cc * 2; return st * 1024 + (ob ^ (((ob >> 9) & 1) << 5)); }
__host__ __device__ __forceinline__ void stage_rc(int b, int& R, int& C) { const int st = b / 1024, sb = b % 1024, swz = sb ^ (((sb >> 9) & 1) << 5); R = (st >> 1) * 16 + swz / 64; C = (st & 1) * 32 + (swz % 64) / 2; }
__host__ __device__ __forceinline__ int perm32(int rho) { const int n = rho >> 4, i = rho & 15; return 8 * (i >> 2) + 4 * n + (i & 3); }

struct Unit { int pm, pn; };
struct Gemm { const bf16_t* A; const bf16_t* Bt; int M, N, K; };

struct StaticOrder {
    int nM, nN, nwg, G, c;
    __host__ __device__ void init(int M, int N, int G_, int c_) { nM = M / BM; nN = N / BM; nwg = nM * nN; G = G_; c = c_; }
    __host__ __device__ bool next(int i, Unit& u) const {
        const long L = (long)i * G + c; if (L >= nwg) return false;
        int wgid = (int)L; { const int q = nwg / NXCD, r = nwg % NXCD, xcd = wgid % NXCD, off = wgid / NXCD; wgid = (xcd < r ? xcd * (q + 1) : r * (q + 1) + (xcd - r) * q) + off; }
        const int nig = WGM * nN, gid = wgid / nig, fm = gid * WGM, gsz = (nM - fm) < WGM ? (nM - fm) : WGM;
        u.pm = fm + ((wgid % nig) % gsz); u.pn = (wgid % nig) / gsz; return true;
    }
    __device__ __forceinline__ void a_ready(const Unit&) const {}
    __device__ __forceinline__ void done(const Unit&) const {}
};

__device__ __forceinline__ unsigned cvt_pk_bf16(float lo, float hi) { unsigned r; asm volatile("v_cvt_pk_bf16_f32 %0, %1, %2" : "=v"(r) : "v"(lo), "v"(hi)); return r; }
typedef float f32x2 __attribute__((ext_vector_type(2)));
__device__ __forceinline__ f32x2 gelu_pk(f32x2 v) {
    const f32x2 av = __builtin_elementwise_abs(v), d = av * 0.2316418882f + 1.0f;
    f32x2 t; t.x = __builtin_amdgcn_rcpf(d.x); t.y = __builtin_amdgcn_rcpf(d.y);
    f32x2 q = t * 0.5307027145f + (-0.7265760135f); q = q * t + 0.7107068705f; q = q * t + (-0.142248368f); q = q * t + 0.127414796f; q = q * t;
    const f32x2 s = (v * v) * (-0.72134752044f);
    f32x2 e; e.x = __builtin_amdgcn_exp2f(s.x); e.y = __builtin_amdgcn_exp2f(s.y);
    const f32x2 m = v * (q * e), r = v - m;
    f32x2 o; o.x = v.x < 0.f ? m.x : r.x; o.y = v.y < 0.f ? m.y : r.y; return o;
}

template <int ACT  > struct EpiBf16 {
    static constexpr bool PERM = true, AFTER_DRAIN = false; static_assert(ACT == 0 || ACT == 1, "EpiBf16: ACT is 0 (none) or 1 (gelu_pk)");
    bf16_t* O; int ldc; const float* bias; int split_cols; size_t split_stride; float scale0;
    __device__ __forceinline__ void operator()(const f32x4 (&acc)[2][2][4][2], const Unit& u, int wr, int wc, int fr, int fq) const {
        const int row0 = u.pm * BM + wr * 64 + fr; int colt = u.pn * BM; bf16_t* base = O;
        float sc = 1.f; if (split_cols) { const int t = colt / split_cols; base += (size_t)t * split_stride; colt -= t * split_cols; if (t == 0) sc = scale0; }
        const int col0 = colt + wc * 32 + 8 * fq, bcol0 = u.pn * BM + wc * 32 + 8 * fq;
        f32x4 bv[2][2];
#pragma unroll
        for (int bj = 0; bj < 2; ++bj)
#pragma unroll
            for (int n = 0; n < 2; ++n) bv[bj][n] = bias ? *(const f32x4*)(bias + bcol0 + bj * HALF + 4 * n) : (f32x4){0.f, 0.f, 0.f, 0.f};
#pragma unroll
        for (int ai = 0; ai < 2; ++ai)
#pragma unroll
            for (int m = 0; m < 4; ++m) { bf16_t* rowp = base + (size_t)(row0 + ai * HALF + m * 16) * ldc + col0;
#pragma unroll
                for (int bj = 0; bj < 2; ++bj) { f32x4 v0 = acc[ai][bj][m][0] + bv[bj][0], v1 = acc[ai][bj][m][1] + bv[bj][1];
                    if (ACT == 1) { f32x2 a = gelu_pk((f32x2){v0[0], v0[1]}), b = gelu_pk((f32x2){v0[2], v0[3]}), c = gelu_pk((f32x2){v1[0], v1[1]}), d = gelu_pk((f32x2){v1[2], v1[3]});
                        v0 = (f32x4){a.x, a.y, b.x, b.y}; v1 = (f32x4){c.x, c.y, d.x, d.y}; }
                    v0 = v0 * sc; v1 = v1 * sc; u32x4 w; w.x = cvt_pk_bf16(v0[0], v0[1]); w.y = cvt_pk_bf16(v0[2], v0[3]); w.z = cvt_pk_bf16(v1[0], v1[1]); w.w = cvt_pk_bf16(v1[2], v1[3]);
                    *(u32x4*)(rowp + bj * HALF) = w; } }
    }
};


template <class Epi, class Sched, bool ALIGN_EPI = false, bool SP2 = false>
__device__ __forceinline__ void gemm_phase(PG8_LAS unsigned char* lds, const Gemm g, const Sched& S, const Epi& E) {
    const int tid = threadIdx.x, wid = __builtin_amdgcn_readfirstlane(tid >> 6), lane = tid & 63, wr = wid >> 2, wc = wid & 3, fr = lane & 15, fq = lane >> 4;
    const int K = g.K, nt = K / BK;
    unsigned voffA[2], voffB[2];
#pragma unroll
    for (int i = 0; i < 2; ++i) { int R, C; stage_rc(tid * 16 + i * 8192, R, C); const int Rb = Epi::PERM ? ((R & ~31) + perm32(R & 31)) : R;
        voffA[i] = (unsigned)(R * K + C) * 2u; voffB[i] = (unsigned)(Rb * K + C) * 2u; }
    const size_t kstep = (size_t)(BK * 2);
    const size_t hstep = (size_t)HALF * K * 2;
    const size_t tstep = 2 * hstep;
    const unsigned ldsw = (unsigned)wid * 1024u;
    const int aoff = lds_byte(wr * 64 + fr, fq * 8), boff = lds_byte(wc * 32 + fr, fq * 8);
#define PG8_SA(b, h) (((b) * 2 + (h)) * HTB)
#define PG8_SB(b, h) ((4 + (b) * 2 + (h)) * HTB)
#define PG8_STAGE(bufoff, gbase, voff) do { _Pragma("unroll") for (int _i = 0; _i < 2; ++_i) \
        __builtin_amdgcn_global_load_lds((const unsigned*)((const char*)(gbase) + (voff)[_i]), (PG8_LAS unsigned*)(lds + (bufoff) + ldsw + _i * 8192), 16, 0, 0); } while (0)
#define PG8_LDA(dst, b, h) do { _Pragma("unroll") for (int m = 0; m < 4; ++m) _Pragma("unroll") for (int k = 0; k < 2; ++k) dst[m][k] = *(const PG8_LAS bf16x8*)(lds + PG8_SA(b, h) + aoff + m * 2048 + k * 1024); } while (0)
#define PG8_LDB(dst, b, h) do { _Pragma("unroll") for (int n = 0; n < 2; ++n) _Pragma("unroll") for (int k = 0; k < 2; ++k) dst[n][k] = *(const PG8_LAS bf16x8*)(lds + PG8_SB(b, h) + boff + n * 2048 + k * 1024); } while (0)
#define PG8_MMA(ai, bj, At, Bt) do { __builtin_amdgcn_s_setprio(1); _Pragma("unroll") for (int m = 0; m < 4; ++m) _Pragma("unroll") for (int n = 0; n < 2; ++n) _Pragma("unroll") for (int k = 0; k < 2; ++k) \
        acc[ai][bj][m][n] = __builtin_amdgcn_mfma_f32_16x16x32_bf16(Bt[n][k], At[m][k], acc[ai][bj][m][n], 0, 0, 0); __builtin_amdgcn_s_setprio(0); } while (0)
#define PG8_WAIT_V(n) asm volatile("s_waitcnt vmcnt(" #n ")" ::: "memory")
#define PG8_WAIT_L(n) asm volatile("s_waitcnt lgkmcnt(" #n ")" ::: "memory")
#define PG8_BAR __builtin_amdgcn_s_barrier()
#define PG8_SCHED __builtin_amdgcn_sched_barrier(0)
    Unit cur, nxt; int ui = 0;
    if (!S.next(0, cur)) return;
    f32x4 acc[2][2][4][2];
#pragma unroll
    for (int a = 0; a < 2; ++a)
#pragma unroll
        for (int b = 0; b < 2; ++b)
#pragma unroll
            for (int m = 0; m < 4; ++m)
#pragma unroll
                for (int n = 0; n < 2; ++n) acc[a][b][m][n] = (f32x4){0.f, 0.f, 0.f, 0.f};
    bf16x8 At[4][2], B0[2][2], B1[2][2];
    const char* cA = (const char*)g.A + (size_t)cur.pm * tstep; const char* cB = (const char*)g.Bt + (size_t)cur.pn * tstep;
    S.a_ready(cur);
    if constexpr (SP2) {
        PG8_STAGE(PG8_SB(0, 0), cB, voffB); PG8_STAGE(PG8_SB(0, 1), cB + hstep, voffB); PG8_STAGE(PG8_SA(0, 0), cA, voffA); PG8_STAGE(PG8_SA(0, 1), cA + hstep, voffA);
        if (wr == 1) PG8_BAR;
        PG8_WAIT_V(2); PG8_BAR;
        PG8_STAGE(PG8_SB(1, 0), cB + kstep, voffB); PG8_STAGE(PG8_SA(1, 0), cA + kstep, voffA); PG8_STAGE(PG8_SB(1, 1), cB + hstep + kstep, voffB);
        PG8_WAIT_V(6); PG8_BAR;
    } else {
        PG8_STAGE(PG8_SB(0, 0), cB, voffB); PG8_STAGE(PG8_SA(0, 0), cA, voffA); PG8_STAGE(PG8_SB(0, 1), cB + hstep, voffB); PG8_STAGE(PG8_SA(0, 1), cA + hstep, voffA);
        if (wr == 1) PG8_BAR;
        PG8_WAIT_V(4); PG8_BAR;
        PG8_STAGE(PG8_SB(1, 0), cB + kstep, voffB); PG8_STAGE(PG8_SA(1, 0), cA + kstep, voffA); PG8_STAGE(PG8_SB(1, 1), cB + hstep + kstep, voffB);
        PG8_WAIT_V(6); PG8_BAR;
    }
    for (;;) {
        const bool has_next = S.next(ui + 1, nxt);
        const char* nA = has_next ? (const char*)g.A + (size_t)nxt.pm * tstep : cA; const char* nB = has_next ? (const char*)g.Bt + (size_t)nxt.pn * tstep : cB;
        for (int t = 0; t < nt; t += 2) {
            const bool last = (t == nt - 2);
            const char* a1 = cA + (size_t)(t + 1) * kstep;
            const char* a2 = last ? nA : cA + (size_t)(t + 2) * kstep; const char* b2 = last ? nB : cB + (size_t)(t + 2) * kstep;
            const char* a3 = a2 + kstep; const char* b3 = b2 + kstep;
            if (last && has_next) S.a_ready(nxt);
            if constexpr (SP2) {
            PG8_LDB(B0, 0, 0); PG8_LDB(B1, 0, 1); PG8_SCHED; PG8_LDA(At, 0, 0); PG8_STAGE(PG8_SA(1, 1), a1 + hstep, voffA);
            PG8_WAIT_V(8); PG8_WAIT_L(0); PG8_BAR; PG8_MMA(0, 0, At, B0); PG8_MMA(0, 1, At, B1); PG8_BAR; PG8_SCHED;
            PG8_LDA(At, 0, 1); PG8_STAGE(PG8_SB(0, 0), b2, voffB); PG8_STAGE(PG8_SB(0, 1), b2 + hstep, voffB); PG8_STAGE(PG8_SA(0, 0), a2, voffA);
            PG8_WAIT_V(8); PG8_WAIT_L(0); PG8_BAR; PG8_MMA(1, 0, At, B0); PG8_MMA(1, 1, At, B1); PG8_BAR; PG8_SCHED;
            PG8_LDB(B0, 1, 0); PG8_LDB(B1, 1, 1); PG8_SCHED; PG8_LDA(At, 1, 0); PG8_STAGE(PG8_SA(0, 1), a2 + hstep, voffA);
            PG8_WAIT_V(8); PG8_WAIT_L(0); PG8_BAR; PG8_MMA(0, 0, At, B0); PG8_MMA(0, 1, At, B1); PG8_BAR; PG8_SCHED;
            PG8_LDA(At, 1, 1); PG8_STAGE(PG8_SB(1, 0), b3, voffB); PG8_STAGE(PG8_SB(1, 1), b3 + hstep, voffB); PG8_STAGE(PG8_SA(1, 0), a3, voffA);
            PG8_WAIT_V(8); PG8_WAIT_L(0); PG8_BAR; PG8_MMA(1, 0, At, B0); PG8_MMA(1, 1, At, B1); PG8_BAR; PG8_SCHED;
            } else {
            PG8_LDB(B0, 0, 0); PG8_SCHED; PG8_LDA(At, 0, 0); PG8_STAGE(PG8_SA(1, 1), a1 + hstep, voffA);
            PG8_WAIT_L(8); PG8_BAR; PG8_WAIT_L(0); PG8_MMA(0, 0, At, B0); PG8_BAR; PG8_SCHED;
            PG8_LDB(B1, 0, 1); PG8_STAGE(PG8_SB(0, 0), b2, voffB);
            PG8_BAR; PG8_WAIT_L(0); PG8_MMA(0, 1, At, B1); PG8_BAR;
            PG8_LDA(At, 0, 1); PG8_STAGE(PG8_SA(0, 0), a2, voffA);
            PG8_BAR; PG8_WAIT_L(0); PG8_MMA(1, 0, At, B0); PG8_BAR; PG8_SCHED;
            PG8_STAGE(PG8_SB(0, 1), b2 + hstep, voffB);
            PG8_WAIT_V(6); PG8_BAR; PG8_MMA(1, 1, At, B1); PG8_BAR;
            PG8_LDB(B0, 1, 0); PG8_SCHED; PG8_LDA(At, 1, 0); PG8_STAGE(PG8_SA(0, 1), a2 + hstep, voffA);
            PG8_WAIT_L(8); PG8_BAR; PG8_WAIT_L(0); PG8_MMA(0, 0, At, B0); PG8_BAR; PG8_SCHED;
            PG8_LDB(B1, 1, 1); PG8_STAGE(PG8_SB(1, 0), b3, voffB);
            PG8_BAR; PG8_WAIT_L(0); PG8_MMA(0, 1, At, B1); PG8_BAR;
            PG8_LDA(At, 1, 1); PG8_STAGE(PG8_SA(1, 0), a3, voffA);
            PG8_BAR; PG8_WAIT_L(0); PG8_MMA(1, 0, At, B0); PG8_BAR; PG8_SCHED;
            PG8_STAGE(PG8_SB(1, 1), b3 + hstep, voffB);
            PG8_WAIT_V(6); PG8_BAR; PG8_MMA(1, 1, At, B1); PG8_BAR;
            }
        }
        if constexpr (ALIGN_EPI) { if (wr == 0) PG8_BAR; }
        if constexpr (!Epi::AFTER_DRAIN) { E(acc, cur, wr, wc, fr, fq); S.done(cur); }
        if (!has_next) break;
#pragma unroll
        for (int a = 0; a < 2; ++a)
#pragma unroll
            for (int b = 0; b < 2; ++b)
#pragma unroll
                for (int m = 0; m < 4; ++m)
#pragma unroll
                    for (int n = 0; n < 2; ++n) acc[a][b][m][n] = (f32x4){0.f, 0.f, 0.f, 0.f};
        cur = nxt; cA = nA; cB = nB; ++ui;
        if constexpr (ALIGN_EPI) { if (wr == 1) PG8_BAR; }
    }
    PG8_WAIT_V(0);
    if constexpr (!ALIGN_EPI) { if (wr == 0) PG8_BAR; }
    PG8_BAR;
    if constexpr (Epi::AFTER_DRAIN) { E.fused(acc, cur, wr, wc, fr, fq, lds, wid, lane); S.done(cur); }
#undef PG8_SA
#undef PG8_SB
#undef PG8_STAGE
#undef PG8_LDA
#undef PG8_LDB
#undef PG8_MMA
#undef PG8_WAIT_V
#undef PG8_WAIT_L
#undef PG8_BAR
#undef PG8_SCHED
}
}
constexpr int NB = 8, SEQ = 4096, DM = 1024, MTOK = NB * SEQ;
constexpr int NPROJ = 3584;
constexpr int PCOLS_IN = 3600;
constexpr int NEXP = 16, CAP = 512, FFD = 2048, NSLOT = NEXP * NB * CAP;
constexpr float RMS_EPS = 1e-6f;
#ifndef N_LAUNCHES
#define N_LAUNCHES 1
#endif
constexpr int N_PHASES = 13;

constexpr size_t MiB = 1u << 20;
constexpr size_t WS_CTL = 0, CTL_ZERO_BYTES = 64 * 1024;
constexpr size_t WS_MOD = 1 * MiB;
constexpr size_t WS_BIN2 = 1 * MiB + 512 * 1024;
constexpr size_t WS_HID2 = 2 * MiB;
constexpr size_t WS_GATES = 3 * MiB;
constexpr size_t WS_AFF = 5 * MiB;
constexpr size_t WS_IDX = 7 * MiB, WS_GSEL = 7 * MiB + 256 * 1024;
constexpr size_t WS_INV = 8 * MiB;
constexpr size_t WS_WOUT = 12 * MiB;
constexpr size_t WS_WIN = 14 * MiB;
constexpr size_t WS_P = 24 * MiB;
constexpr size_t WS_H = 248 * MiB;
constexpr size_t WS_UT = 312 * MiB;
constexpr size_t WS_HM = 408 * MiB;
constexpr size_t WS_ZT = 472 * MiB;
constexpr size_t WS_KSP = 504 * MiB;
constexpr size_t WS_WGU = 24 * MiB;
constexpr size_t WS_XS = 152 * MiB;
constexpr size_t WS_HID = 280 * MiB;
constexpr size_t WS_HF = 280 * MiB;
constexpr size_t WS_WD = 152 * MiB;
constexpr size_t WS_YS = 24 * MiB;
constexpr size_t WS_END = 536 * MiB;

constexpr int RING_BYTES = 131072;
constexpr int MISC_OFF = 147456 - 256;
constexpr int LDS_BYTES = 147456;

#define GAS __attribute__((address_space(1)))
#define LAS __attribute__((address_space(3)))
#define DI __device__ __forceinline__
typedef unsigned short bf16;
typedef unsigned v4u __attribute__((ext_vector_type(4)));
typedef unsigned v2u __attribute__((ext_vector_type(2)));
typedef float f32x4 __attribute__((ext_vector_type(4)));
typedef GAS unsigned gu32;
#define LDS_WAIT() asm volatile("s_waitcnt lgkmcnt(0)" ::: "memory")
DI float bf2f(unsigned b) { return __uint_as_float(b << 16); }
DI float bflo(unsigned w) { return __uint_as_float(w << 16); }
DI float bfhi(unsigned w) { return __uint_as_float(w & 0xffff0000u); }
DI unsigned f2bf(float f) { unsigned u = __float_as_uint(f); return (u + 0x7fffu + ((u >> 16) & 1u)) >> 16; }
DI unsigned pk2(float lo, float hi) { return f2bf(lo) | (f2bf(hi) << 16); }
DI float wave_sum(float v) {
#pragma unroll
    for (int o = 1; o < 64; o <<= 1) v += __shfl_xor(v, o);
    return v;
}
DI float sigmoidf_(float x) { return 1.f / (1.f + __expf(-x)); }

namespace pg8 {
struct MoeOrderA {
    int G, c;
    __device__ bool next(int i, Unit& u) const {
        const long L = (long)i * G + c; if (L >= 4096) return false;
        const int e = (int)(L >> 8), r = (int)(L & 255), x = r & 7, j = r >> 3;
        u.pm = e * 16 + 4 * (x >> 1) + (j >> 3); u.pn = e * 16 + 8 * (x & 1) + (j & 7); return true;
    }
    __device__ __forceinline__ void a_ready(const Unit&) const {}
    __device__ __forceinline__ void done(const Unit&) const {}
};
struct MoeOrderB {
    int G, c;
    __device__ bool next(int i, Unit& u) const {
        const long L = (long)i * G + c; if (L >= 1024) return false;
        const int r = (int)(L & 255), e = (int)(L >> 8) * 4 + ((r & 7) >> 1), idx = ((r & 1) << 5) | (r >> 3);
        u.pm = e * 16 + (idx >> 2); u.pn = e * 4 + (idx & 3); return true;
    }
    __device__ __forceinline__ void a_ready(const Unit&) const {}
    __device__ __forceinline__ void done(const Unit&) const {}
};
struct EpiSwiGLU {
    static constexpr bool PERM = true, AFTER_DRAIN = false;
    bf16_t* O;
    __device__ __forceinline__ void operator()(const f32x4 (&acc)[2][2][4][2], const Unit& u, int wr, int wc, int fr, int fq) const {
        const int row0 = u.pm * BM + wr * 64 + fr, col0 = (u.pn & 15) * 128 + wc * 32 + 8 * fq;
#pragma unroll
        for (int ai = 0; ai < 2; ++ai)
#pragma unroll
            for (int m = 0; m < 4; ++m) {
                bf16_t* rowp = O + (size_t)(row0 + ai * HALF + m * 16) * 2048 + col0;
                float h[8];
#pragma unroll
                for (int n = 0; n < 2; ++n)
#pragma unroll
                    for (int i = 0; i < 4; ++i) { const float g = acc[ai][0][m][n][i], up = acc[ai][1][m][n][i]; h[4 * n + i] = g * __builtin_amdgcn_rcpf(1.f + __expf(-g)) * up; }
                u32x4 w; w.x = cvt_pk_bf16(h[0], h[1]); w.y = cvt_pk_bf16(h[2], h[3]); w.z = cvt_pk_bf16(h[4], h[5]); w.w = cvt_pk_bf16(h[6], h[7]);
                *(u32x4*)rowp = w;
            }
    }
};
struct EpiYs {
    static constexpr bool PERM = true, AFTER_DRAIN = false;
    bf16_t* O;
    __device__ __forceinline__ void operator()(const f32x4 (&acc)[2][2][4][2], const Unit& u, int wr, int wc, int fr, int fq) const {
        const int row0 = u.pm * BM + wr * 64 + fr, col0 = (u.pn & 3) * BM + wc * 32 + 8 * fq;
#pragma unroll
        for (int ai = 0; ai < 2; ++ai)
#pragma unroll
            for (int m = 0; m < 4; ++m) {
                bf16_t* rowp = O + (size_t)(row0 + ai * HALF + m * 16) * 1024 + col0;
#pragma unroll
                for (int bj = 0; bj < 2; ++bj) { const f32x4 v0 = acc[ai][bj][m][0], v1 = acc[ai][bj][m][1];
                    u32x4 w; w.x = cvt_pk_bf16(v0[0], v0[1]); w.y = cvt_pk_bf16(v0[2], v0[3]); w.z = cvt_pk_bf16(v1[0], v1[1]); w.w = cvt_pk_bf16(v1[2], v1[3]);
                    *(u32x4*)(rowp + bj * HALF) = w; }
            }
    }
};
struct EpiRes {
    static constexpr bool PERM = false, AFTER_DRAIN = false;
    const float* X; float* C; const float* mod;
    __device__ __forceinline__ void operator()(const f32x4 (&acc)[2][2][4][2], const Unit& u, int wr, int wc, int fr, int fq) const {
        const int row0 = u.pm * BM + wr * 64 + fr, col0 = u.pn * BM + wc * 32 + 4 * fq;
        const float* gp = mod + (size_t)((u.pm * BM) >> 12) * 6144 + 2048 + col0;
        f32x4 gv[2][2];
#pragma unroll
        for (int bj = 0; bj < 2; ++bj)
#pragma unroll
            for (int n = 0; n < 2; ++n) gv[bj][n] = *(const f32x4*)(gp + bj * HALF + n * 16);
#pragma unroll
        for (int ai = 0; ai < 2; ++ai)
#pragma unroll
            for (int m = 0; m < 4; ++m) { const size_t off = (size_t)(row0 + ai * HALF + m * 16) * 1024 + col0;
#pragma unroll
                for (int bj = 0; bj < 2; ++bj)
#pragma unroll
                    for (int n = 0; n < 2; ++n) { const f32x4 xv = *(const f32x4*)(X + off + bj * HALF + n * 16); *(f32x4*)(C + off + bj * HALF + n * 16) = xv + gv[bj][n] * acc[ai][bj][m][n]; } }
    }
};
}
#define XB_TMO      128
#define XB_XCNT(j)  (256  + 64 * (j))
#define XB_XSUB(j)  (1280 + 64 * (j))
#define XB_XGEN(j)  (2304 + 64 * (j))
#define XB_TOP      3328
#define XB_TOPGEN   3392
#define XCD_BAR_WORDS 3456
#define XB_SPIN_CAP (1u << 18)

__device__ __forceinline__ unsigned xb_ld(unsigned* p)              { return __hip_atomic_load(p, __ATOMIC_RELAXED, __HIP_MEMORY_SCOPE_AGENT); }
__device__ __forceinline__ unsigned xb_add(unsigned* p, unsigned v) { return __hip_atomic_fetch_add(p, v, __ATOMIC_RELAXED, __HIP_MEMORY_SCOPE_AGENT); }
__device__ __forceinline__ unsigned xb_xcc_id() { return (unsigned)__builtin_amdgcn_s_getreg((3 << 11) | 20) & 0xFu; }
#define XB_SPIN(cond, bar) do { unsigned _sp = 0; while (cond) { __builtin_amdgcn_s_sleep(1); \
    if ((++_sp & 255u) == 0u) { if (xb_ld(&(bar)[XB_TMO])) break; if (_sp > XB_SPIN_CAP) { atomicAdd(&(bar)[XB_TMO], 1u); break; } } } } while (0)

struct XcdBarrier {
    unsigned* bar; unsigned x;
    volatile LAS unsigned* st;
};

__device__ __forceinline__ XcdBarrier xcd_barrier_post(unsigned* bar, volatile LAS unsigned* st) {
    XcdBarrier b; b.bar = bar; b.x = xb_xcc_id(); b.st = st;
    if (threadIdx.x == 0) (void)xb_add(&bar[XB_XCNT(b.x)], 1u);
    return b;
}
__device__ __forceinline__ void xcd_barrier_complete(unsigned* bar, unsigned x, unsigned& nloc, unsigned& nx) {
    const unsigned G = gridDim.x * gridDim.y * gridDim.z;
    unsigned sum, cnt, mine, sp = 0u;
    for (;;) {
        sum = 0u; cnt = 0u; mine = 0u;
#pragma unroll
        for (unsigned j = 0; j < 16; ++j) { const unsigned c = xb_ld(&bar[XB_XCNT(j)]); sum += c; cnt += (c > 0u) ? 1u : 0u; mine = (j == x) ? c : mine; }
        if (sum == G) break;
        __builtin_amdgcn_s_sleep(1);
        if ((++sp & 255u) == 0u) { if (xb_ld(&bar[XB_TMO])) break; if (sp > XB_SPIN_CAP) { atomicAdd(&bar[XB_TMO], 1u); break; } }
    }
    nloc = mine > 0u ? mine : 1u; nx = cnt > 0u ? cnt : 1u;
}

__device__ __forceinline__ void xcd_barrier(const XcdBarrier& b) {
    asm volatile("s_waitcnt vmcnt(0)" ::: "memory");
    __syncthreads();
    if (threadIdx.x == 0) {
        unsigned* bar = b.bar;
        __builtin_amdgcn_s_waitcnt(0);
        unsigned nloc = b.st[0], nx = b.st[1];
        if (nloc == 0u) { xcd_barrier_complete(bar, b.x, nloc, nx); b.st[0] = nloc; b.st[1] = nx; }
        const unsigned old = xb_add(&bar[XB_XSUB(b.x)], 1u);
        const unsigned gen = old / nloc;
        if (old + 1u == (gen + 1u) * nloc) {
            __builtin_amdgcn_fence(__ATOMIC_RELEASE, "agent");
            asm volatile("s_waitcnt vmcnt(0)" ::: "memory");
            const unsigned og = xb_add(&bar[XB_TOP], 1u);
            const unsigned tg = og / nx;
            if (og + 1u == (tg + 1u) * nx) xb_add(&bar[XB_TOPGEN], 1u);
            else XB_SPIN(xb_ld(&bar[XB_TOPGEN]) == tg, bar);
            __builtin_amdgcn_fence(__ATOMIC_ACQUIRE, "agent");
            xb_add(&bar[XB_XGEN(b.x)], 1u);
            asm volatile("s_waitcnt vmcnt(0)" ::: "memory");
        } else {
            XB_SPIN(xb_ld(&bar[XB_XGEN(b.x)]) == gen, bar);
            __builtin_amdgcn_fence(__ATOMIC_ACQUIRE, "agent");
            asm volatile("s_waitcnt vmcnt(0)" ::: "memory");
        }
    }
    __syncthreads();
}
#define HD __host__ __device__ __forceinline__
typedef float cf2 __attribute__((ext_vector_type(2)));
#define MK2(a, b) ((cf2){(a), (b)})
HD cf2 c_add(cf2 a, cf2 b) { return MK2(a.x + b.x, a.y + b.y); }
HD cf2 c_sub(cf2 a, cf2 b) { return MK2(a.x - b.x, a.y - b.y); }
HD cf2 c_mul(cf2 a, cf2 b) { return MK2(a.x * b.x - a.y * b.y, a.x * b.y + a.y * b.x); }
HD cf2 c_mulc(cf2 a, cf2 b) { return MK2(a.x * b.x + a.y * b.y, a.y * b.x - a.x * b.y); }
HD int fphys(int i) { return i + (i >> 4); }
constexpr int FFT_XSLOTS = 8192 + 512;

#define W16_C1 0.92387953251128674f
#define W16_S1 0.38268343236508977f
#define W16_H  0.70710678118654752f
template <int J> HD cf2 mul_w16(cf2 d) {
    if constexpr (J == 0) return d;
    else if constexpr (J == 1) return c_mul(d, MK2(W16_C1, -W16_S1));
    else if constexpr (J == 2) return MK2((d.x + d.y) * W16_H, (d.y - d.x) * W16_H);
    else if constexpr (J == 3) return c_mul(d, MK2(W16_S1, -W16_C1));
    else if constexpr (J == 4) return MK2(d.y, -d.x);
    else if constexpr (J == 5) return c_mul(d, MK2(-W16_S1, -W16_C1));
    else if constexpr (J == 6) return MK2((d.y - d.x) * W16_H, -(d.x + d.y) * W16_H);
    else return c_mul(d, MK2(-W16_C1, -W16_S1));
}
HD void dft16(cf2 (&v)[16]) {
#define BF(i, j, TWJ) { const cf2 a_ = v[i], b_ = v[j]; v[i] = c_add(a_, b_); v[j] = mul_w16<TWJ>(c_sub(a_, b_)); }
    BF(0, 8, 0) BF(1, 9, 1) BF(2, 10, 2) BF(3, 11, 3) BF(4, 12, 4) BF(5, 13, 5) BF(6, 14, 6) BF(7, 15, 7)
    BF(0, 4, 0) BF(1, 5, 2) BF(2, 6, 4) BF(3, 7, 6)   BF(8, 12, 0) BF(9, 13, 2) BF(10, 14, 4) BF(11, 15, 6)
    BF(0, 2, 0) BF(1, 3, 4)  BF(4, 6, 0) BF(5, 7, 4)  BF(8, 10, 0) BF(9, 11, 4)  BF(12, 14, 0) BF(13, 15, 4)
    BF(0, 1, 0) BF(2, 3, 0) BF(4, 5, 0) BF(6, 7, 0) BF(8, 9, 0) BF(10, 11, 0) BF(12, 13, 0) BF(14, 15, 0)
#undef BF
#define SW(i, j) { const cf2 t_ = v[i]; v[i] = v[j]; v[j] = t_; }
    SW(1, 8) SW(2, 4) SW(3, 12) SW(5, 10) SW(7, 14) SW(11, 13)
#undef SW
}
HD void idft16(cf2 (&v)[16]) {
#pragma unroll
    for (int i = 0; i < 16; ++i) v[i] = MK2(v[i].y, v[i].x);
    dft16(v);
#pragma unroll
    for (int i = 0; i < 16; ++i) v[i] = MK2(v[i].y, v[i].x);
}
HD void c_powers(cf2 t, cf2 (&pw)[16]) {
    pw[0] = MK2(1.f, 0.f); pw[1] = t;
#pragma unroll
    for (int r = 2; r < 16; ++r) pw[r] = (r & 1) ? c_mul(pw[r - 1], t) : c_mul(pw[r >> 1], pw[r >> 1]);
}
HD cf2 w32_const(int k) {
    constexpr float C[16] = {1.f, 0.98078528040323043f, 0.92387953251128674f, 0.83146961230254524f, 0.70710678118654752f, 0.55557023301960218f, 0.38268343236508977f, 0.19509032201612825f,
                             0.f, -0.19509032201612825f, -0.38268343236508977f, -0.55557023301960218f, -0.70710678118654752f, -0.83146961230254524f, -0.92387953251128674f, -0.98078528040323043f};
    constexpr float S[16] = {0.f, 0.19509032201612825f, 0.38268343236508977f, 0.55557023301960218f, 0.70710678118654752f, 0.83146961230254524f, 0.92387953251128674f, 0.98078528040323043f,
                             1.f, 0.98078528040323043f, 0.92387953251128674f, 0.83146961230254524f, 0.70710678118654752f, 0.55557023301960218f, 0.38268343236508977f, 0.19509032201612825f};
    return MK2(C[k], -S[k]);
}
template <class XP, class TP> HD void fft_passA_fwd(int tid, const cf2 (&a)[16], const cf2 (&b)[16], XP X, TP TWA, TP TW8) {
    const int H = tid >> 8, lo = tid & 255;
    cf2 v[16];
    if (H == 0) {
#pragma unroll
        for (int k = 0; k < 16; ++k) v[k] = c_add(a[k], b[k]);
    } else {
        const cf2 t8 = TW8[lo];
#pragma unroll
        for (int k = 0; k < 16; ++k) v[k] = c_mul(c_sub(a[k], b[k]), c_mul(t8, w32_const(k)));
    }
    dft16(v);
    X[fphys(H * 4096 + lo)] = v[0];
#pragma unroll
    for (int r = 1; r < 16; ++r) X[fphys(H * 4096 + r * 256 + lo)] = c_mul(v[r], TWA[r * 256 + lo]);
}
template <class XP, class TP> HD void fft_passB_fwd(int tid, XP X, TP TWB) {
    const int H = tid >> 8, hi = (tid >> 4) & 15, lo = tid & 15, base = H * 4096 + hi * 256 + lo;
    cf2 v[16];
#pragma unroll
    for (int k = 0; k < 16; ++k) v[k] = X[fphys(base + k * 16)];
    dft16(v);
    X[fphys(base)] = v[0];
#pragma unroll
    for (int r = 1; r < 16; ++r) X[fphys(base + r * 16)] = c_mul(v[r], TWB[r * 16 + lo]);
}
template <class XP> HD void fft_passC_fwd(int tid, XP X, cf2 (&v)[16]) {
    const int p0 = 17 * tid;
#pragma unroll
    for (int k = 0; k < 16; ++k) v[k] = X[p0 + k];
    dft16(v);
}
template <class XP> HD void fft_passC_inv(int tid, XP X, cf2 (&v)[16]) {
    const int p0 = 17 * tid;
    idft16(v);
#pragma unroll
    for (int k = 0; k < 16; ++k) X[p0 + k] = v[k];
}
template <class XP, class TP> HD void fft_passB_inv(int tid, XP X, TP TWB) {
    const int H = tid >> 8, hi = (tid >> 4) & 15, lo = tid & 15, base = H * 4096 + hi * 256 + lo;
    cf2 v[16];
    v[0] = X[fphys(base)];
#pragma unroll
    for (int r = 1; r < 16; ++r) v[r] = c_mulc(X[fphys(base + r * 16)], TWB[r * 16 + lo]);
    idft16(v);
#pragma unroll
    for (int k = 0; k < 16; ++k) X[fphys(base + k * 16)] = v[k];
}
template <class XP, class TP> HD void fft_passA_inv(int tid, XP X, TP TWA, TP TW8, cf2 (&u)[16]) {
    const int H = tid >> 8, lo = tid & 255;
    u[0] = X[fphys(H * 4096 + lo)];
#pragma unroll
    for (int r = 1; r < 16; ++r) u[r] = c_mulc(X[fphys(H * 4096 + r * 256 + lo)], TWA[r * 256 + lo]);
    idft16(u);
    if (H == 1) {
        const cf2 t8 = TW8[lo];
#pragma unroll
        for (int k = 0; k < 16; ++k) u[k] = c_mulc(u[k], c_mul(t8, w32_const(k)));
    }
}
struct Args { const float* in[28]; float* out; unsigned char* ws; int ph_lo, ph_hi; };
struct Frame {
    LAS unsigned char* lds;
    int tid, lane, wave, G, blk;
    const struct Args* a;
};
#define IN_X 0
#define IN_C 1
#define IN_WADA 2
#define IN_BADA 3
#define IN_GMIX 4
#define IN_WIN 5
#define IN_BIN 6
#define IN_CQKW 7
#define IN_CQKB 8
#define IN_MNG 9
#define IN_CHYW 10
#define IN_CHYB 11
#define IN_HW1 12
#define IN_HB1 13
#define IN_HW2 14
#define IN_HB2 15
#define IN_HW3 16
#define IN_HFREQ 17
#define IN_HDELTA 18
#define IN_HBIAS 19
#define IN_HNG 20
#define IN_WOUT 21
#define IN_GFFN 22
#define IN_WROUTER 23
#define IN_WGATE 24
#define IN_WUP 25
#define IN_WDOWN 26
#define IN_GFINAL 27

DI void transpose_item(const float* src, int ldsrc, bf16* dst, int lddst, LAS float* scr, int lane) {
#pragma unroll 8
    for (int i = 0; i < 32; ++i) { const int kk = 2 * i + (lane >> 5); scr[kk * 33 + (lane & 31)] = src[(size_t)kk * ldsrc + (lane & 31)]; }
    LDS_WAIT(); asm volatile("" ::: "memory");
    const int c = lane & 7;
#pragma unroll
    for (int j = 0; j < 4; ++j) { const int n = (lane >> 3) + 8 * j; const LAS float* s = scr + (8 * c) * 33 + n;
        v4u o; o.x = pk2(s[0 * 33], s[1 * 33]); o.y = pk2(s[2 * 33], s[3 * 33]); o.z = pk2(s[4 * 33], s[5 * 33]); o.w = pk2(s[6 * 33], s[7 * 33]);
        *(v4u*)(dst + (size_t)n * lddst + 8 * c) = o; }
    LDS_WAIT(); asm volatile("" ::: "memory");
}
DI float reduce16(const float (&acc)[16], int lane) {
    float r8[8], r4[4], r2[2], r1;
    { const bool up = (lane & 32) != 0;
#pragma unroll
      for (int i = 0; i < 8; ++i) { const float mine = up ? acc[8 + i] : acc[i], other = up ? acc[i] : acc[8 + i]; r8[i] = mine + __shfl_xor(other, 32); } }
    { const bool up = (lane & 16) != 0;
#pragma unroll
      for (int i = 0; i < 4; ++i) { const float mine = up ? r8[4 + i] : r8[i], other = up ? r8[i] : r8[4 + i]; r4[i] = mine + __shfl_xor(other, 16); } }
    { const bool up = (lane & 8) != 0;
#pragma unroll
      for (int i = 0; i < 2; ++i) { const float mine = up ? r4[2 + i] : r4[i], other = up ? r4[i] : r4[2 + i]; r2[i] = mine + __shfl_xor(other, 8); } }
    { const bool up = (lane & 4) != 0; const float mine = up ? r2[1] : r2[0], other = up ? r2[0] : r2[1]; r1 = mine + __shfl_xor(other, 4); }
    r1 += __shfl_xor(r1, 1); r1 += __shfl_xor(r1, 2);
    return r1;
}
DI int reduce16_index(int lane) { return ((lane >> 5) & 1) * 8 + ((lane >> 4) & 1) * 4 + ((lane >> 3) & 1) * 2 + ((lane >> 2) & 1); }

DI void p0_prologue(Frame& F) {
    unsigned char* ws = F.a->ws;
    LAS float* scr = (LAS float*)(F.lds + F.wave * 16384);
    const int gw = F.blk * 8 + F.wave, NGW = F.G * 8, lane = F.lane;
    bf16* WIN = (bf16*)(ws + WS_WIN); bf16* WOUT = (bf16*)(ws + WS_WOUT);
    for (int it = gw; it < 1792 + 512; it += NGW) {
        if (it < 1792) { const int kb = it / 112, nb = it % 112, n0 = 32 * nb, k0 = 64 * kb, sc = n0 + (n0 >= 2048 ? 16 : 0);
            transpose_item(F.a->in[IN_WIN] + (size_t)k0 * PCOLS_IN + sc, PCOLS_IN, WIN + (size_t)n0 * 1024 + k0, 1024, scr, lane); }
        else { const int r = it - 1792, kb = r / 32, nb = r % 32, n0 = 32 * nb, k0 = 64 * kb;
            transpose_item(F.a->in[IN_WOUT] + (size_t)k0 * 1024 + n0, 1024, WOUT + (size_t)n0 * 1024 + k0, 1024, scr, lane); }
    }
    {
        float* HID2 = (float*)(ws + WS_HID2);
        const float* w1 = F.a->in[IN_HW1]; const float* w2 = F.a->in[IN_HW2];
        const float fr = F.a->in[IN_HFREQ][lane], b1 = F.a->in[IN_HB1][lane], b2 = F.a->in[IN_HB2][lane];
        for (int t = gw; t < SEQ; t += NGW) {
            float a1 = b1 + ((float)t * (1.f / 4095.f)) * w1[lane];
#pragma unroll 4
            for (int i = 0; i < 16; ++i) {
                const float band = 1e-4f + (float)i * ((15.f - 1e-4f) / 15.f);
                const float rev = band * (float)t * (1.f / 4096.f);
                const float fx = rev - floorf(rev);
                float sn, cs; sincospif(2.f * fx, &sn, &cs);
                a1 += cs * w1[(1 + i) * 64 + lane] - sn * w1[(17 + i) * 64 + lane];
            }
            const float h1 = sinf(fr * a1);
            float a2 = b2;
#pragma unroll 8
            for (int i = 0; i < 64; ++i) a2 += __shfl(h1, i) * w2[i * 64 + lane];
            HID2[t * 64 + lane] = sinf(fr * a2);
        }
    }
    { float* BIN2 = (float*)(ws + WS_BIN2); for (int n = F.blk * 512 + F.tid; n < NPROJ; n += F.G * 512) BIN2[n] = F.a->in[IN_BIN][n + (n >= 2048 ? 16 : 0)]; }
    __syncthreads();
    {
        LAS float* cs = (LAS float*)F.lds;
        LAS float* red = cs + 8192;
        float* MOD = (float*)(ws + WS_MOD); const float* wada = F.a->in[IN_WADA];
        for (int i = F.tid; i < 2048; i += 512) *(LAS f32x4*)(cs + 4 * i) = *(const f32x4*)(F.a->in[IN_C] + 4 * i);
        __syncthreads();
        const int ksl = F.tid >> 3, c4 = F.tid & 7;
        for (int it = F.blk; it < 192; it += F.G) {
            f32x4 w[16];
#pragma unroll
            for (int kk = 0; kk < 16; ++kk) w[kk] = *(const f32x4*)(wada + (size_t)(16 * ksl + kk) * 6144 + 32 * it + 4 * c4);
#pragma unroll
            for (int b = 0; b < 8; ++b) { f32x4 a = (f32x4){0.f, 0.f, 0.f, 0.f};
#pragma unroll
                for (int k4 = 0; k4 < 4; ++k4) { const f32x4 cv = *(const LAS f32x4*)(cs + b * 1024 + 16 * ksl + 4 * k4);
                    a += w[4 * k4] * cv.x + w[4 * k4 + 1] * cv.y + w[4 * k4 + 2] * cv.z + w[4 * k4 + 3] * cv.w; }
                *(LAS f32x4*)(red + (ksl * 8 + b) * 32 + 4 * c4) = a; }
            __syncthreads();
            if (F.tid < 256) { const int b = F.tid >> 5, col = F.tid & 31; float sacc = F.a->in[IN_BADA][32 * it + col];
#pragma unroll 8
                for (int k = 0; k < 64; ++k) sacc += red[(k * 8 + b) * 32 + col];
                MOD[b * 6144 + 32 * it + col] = sacc; }
            __syncthreads();
        }
    }
}

template <bool SECOND> DI void p_norm(Frame& F) {
    unsigned char* ws = F.a->ws; const int lane = F.lane;
    LAS float* Wt = (LAS float*)F.lds;
    for (int i = F.tid; i < 16384; i += 512) { const int k = i >> 4, g = i & 15; Wt[g * 1024 + k] = SECOND ? F.a->in[IN_WROUTER][k * 16 + g] : F.a->in[IN_WIN][(size_t)k * PCOLS_IN + 2048 + g]; }
    __syncthreads();
    const float* xin = SECOND ? (const float*)F.a->out : F.a->in[IN_X];
    const float* gvec = SECOND ? F.a->in[IN_GFFN] : F.a->in[IN_GMIX];
    const float* MOD = (const float*)(ws + WS_MOD);
    bf16* HO = (bf16*)(ws + (SECOND ? WS_HF : WS_H));
    const int gw = F.blk * 8 + F.wave, NGW = F.G * 8;
    for (int row = gw; row < MTOK; row += NGW) {
        const int b = row >> 12;
        const f32x4* xr = (const f32x4*)(xin + (size_t)row * 1024) + lane;
        f32x4 v[4]; float ss = 0.f;
#pragma unroll
        for (int j = 0; j < 4; ++j) { v[j] = xr[64 * j]; ss += (v[j].x * v[j].x + v[j].y * v[j].y) + (v[j].z * v[j].z + v[j].w * v[j].w); }
        const float rstd = rsqrtf(wave_sum(ss) * (1.f / 1024.f) + RMS_EPS);
        const float* mb = MOD + b * 6144 + (SECOND ? 3072 : 0);
#pragma unroll
        for (int j = 0; j < 4; ++j) { const int col = 256 * j + 4 * lane;
            const f32x4 g = *(const f32x4*)(gvec + col), sh = *(const f32x4*)(mb + col), sc = *(const f32x4*)(mb + 1024 + col);
            v[j] = v[j] * rstd * g * (sc + 1.f) + sh; }
        unsigned long long* o8 = (unsigned long long*)(HO + (size_t)row * 1024) + lane;
#pragma unroll
        for (int j = 0; j < 4; ++j) o8[64 * j] = (unsigned long long)pk2(v[j].x, v[j].y) | ((unsigned long long)pk2(v[j].z, v[j].w) << 32);
        float acc[16];
#pragma unroll
        for (int g = 0; g < 16; ++g) { float a = 0.f;
            if ((g & 3) == 0) asm volatile("" ::: "memory");
#pragma unroll
            for (int j = 0; j < 4; ++j) { const f32x4 w = *(const LAS f32x4*)(Wt + g * 1024 + 256 * j + 4 * lane); a += (v[j].x * w.x + v[j].y * w.y) + (v[j].z * w.z + v[j].w * w.w); }
            acc[g] = a; }
        const float val = reduce16(acc, lane); const int gi = reduce16_index(lane);
        if (!SECOND) { if ((lane & 3) == 0) ((float*)(ws + WS_GATES))[(size_t)row * 16 + gi] = val + F.a->in[IN_BIN][2048 + gi]; }
        else {
            float mx = val;
#pragma unroll
            for (int o = 4; o < 64; o <<= 1) mx = fmaxf(mx, __shfl_xor(mx, o));
            const float ex = __expf(val - mx); float sm = ex;
#pragma unroll
            for (int o = 4; o < 64; o <<= 1) sm += __shfl_xor(sm, o);
            if ((lane & 3) == 0) ((float*)(ws + WS_AFF))[((size_t)b * 16 + gi) * SEQ + (row & 4095)] = ex / sm;
        }
    }
}

DI void p3_prep(Frame& F) {
    unsigned char* ws = F.a->ws;
    const bf16* P = (const bf16*)(ws + WS_P);
    {
        bf16* QK = (bf16*)(ws + WS_H);
        const float* cw = F.a->in[IN_CQKW]; const float* cb = F.a->in[IN_CQKB];
        const int nthr = F.G * 512;
        for (int i = F.blk * 512 + F.tid; i < MTOK * 128; i += nthr) {
            const int token = i >> 7, cg = i & 127, t = token & 4095, c0 = 8 * cg;
            const bf16* p0 = P + (size_t)token * NPROJ + c0;
            const v4u cur = *(const v4u*)p0;
            v4u prv = (v4u){0u, 0u, 0u, 0u}, nxt = (v4u){0u, 0u, 0u, 0u};
            if (t > 0) prv = *(const v4u*)(p0 - NPROJ);
            if (t < SEQ - 1) nxt = *(const v4u*)(p0 + NPROJ);
            const float scale = (c0 >= 512) ? 0.08838834764831845f : 1.f;
            float o[8];
#pragma unroll
            for (int e = 0; e < 8; ++e) {
                const unsigned wp = prv[e >> 1], wc = cur[e >> 1], wn = nxt[e >> 1];
                const float xp = (e & 1) ? bfhi(wp) : bflo(wp), xc = (e & 1) ? bfhi(wc) : bflo(wc), xn = (e & 1) ? bfhi(wn) : bflo(wn);
                const int c = c0 + e;
                const float val = cb[c] + cw[c] * xp + cw[1024 + c] * xc + cw[2048 + c] * xn;
                o[e] = val * sigmoidf_(val) * scale;
            }
            v4u w; w.x = pk2(o[0], o[1]); w.y = pk2(o[2], o[3]); w.z = pk2(o[4], o[5]); w.w = pk2(o[6], o[7]);
            *(v4u*)(QK + (size_t)token * 1024 + c0) = w;
        }
    }
    {
        bf16* UT = (bf16*)(ws + WS_UT);
        LAS bf16* tile = (LAS bf16*)F.lds;
        const float* cw = F.a->in[IN_CHYW]; const float* cb = F.a->in[IN_CHYB];
        for (int u = F.blk; u < 4 * 64 * 24; u += F.G) {
            const int cgq = u % 24, tt = (u / 24) & 63, p = u / (24 * 64);
            for (int it = F.tid; it < 1024; it += 512) {
                const int cg8 = it & 7, tl = (it >> 3) & 63, bs = it >> 9;
                const int t = tt * 64 + tl, token = (2 * p + bs) * SEQ + t, hxc = cgq * 64 + cg8 * 8;
                const bf16* p0 = P + (size_t)token * NPROJ + 2048 + hxc;
                const v4u cur = *(const v4u*)p0;
                v4u prv = (v4u){0u, 0u, 0u, 0u}, nxt = (v4u){0u, 0u, 0u, 0u};
                if (t > 0) prv = *(const v4u*)(p0 - NPROJ);
                if (t < SEQ - 1) nxt = *(const v4u*)(p0 + NPROJ);
#pragma unroll
                for (int e = 0; e < 8; ++e) {
                    const unsigned wp = prv[e >> 1], wc = cur[e >> 1], wn = nxt[e >> 1];
                    const float xp = (e & 1) ? bfhi(wp) : bflo(wp), xc = (e & 1) ? bfhi(wc) : bflo(wc), xn = (e & 1) ? bfhi(wn) : bflo(wn);
                    const int c = hxc + e;
                    const float val = cb[c] + cw[c] * xp + cw[1536 + c] * xc + cw[3072 + c] * xn;
                    tile[((cg8 * 8 + e) * 64 + tl) * 2 + bs] = (bf16)f2bf(val);
                }
            }
            __syncthreads();
            for (int pc = F.tid; pc < 1024; pc += 512) {
                const int cl = pc >> 4, q = pc & 15, hxc = cgq * 64 + cl, part = hxc >> 9, c = hxc & 511;
                const v4u v = *(const LAS v4u*)(tile + cl * 128 + q * 8);
                *(v4u*)(UT + ((((size_t)part * 4 + p) * 512 + c) * SEQ + tt * 64) * 2 + q * 8) = v;
            }
            __syncthreads();
        }
    }
}

DI void p4_mlstm_seq(Frame& F) {
    unsigned char* ws = F.a->ws;
    constexpr int TB = 32;
    LAS float* qs = (LAS float*)F.lds; LAS float* ks = qs + TB * 128; LAS float* vs = ks + TB * 128; LAS float* ob = vs + TB * 128;
    LAS float* gi = ob + TB * 128; LAS float* gl = gi + TB;
    const bf16* QK = (const bf16*)(ws + WS_H); const bf16* P = (const bf16*)(ws + WS_P); const float* GATES = (const float*)(ws + WS_GATES);
    bf16* HM = (bf16*)(ws + WS_HM);
    const int tid = F.tid, v = tid >> 2, kq = tid & 3;
    for (int it = F.blk; it < 64; it += F.G) {
        const int b = it >> 3, h = (it >> 1) & 3, dir = it & 1;
        float C[32], n[32]; float m = -1e30f;
#pragma unroll
        for (int j = 0; j < 32; ++j) { C[j] = 0.f; n[j] = 0.f; }
        for (int tau0 = 0; tau0 < SEQ; tau0 += TB) {
#pragma unroll
            for (int r = 0; r < 3; ++r) {
                const int st = tid >> 4, ch = tid & 15, tau = tau0 + st, token = b * SEQ + (dir ? SEQ - 1 - tau : tau);
                const bf16* src = (r == 0) ? QK + (size_t)token * 1024 + h * 128 : (r == 1) ? QK + (size_t)token * 1024 + 512 + h * 128 : P + (size_t)token * NPROJ + 1024 + h * 128;
                const v4u w = *(const v4u*)(src + ch * 8);
                LAS float* d = ((r == 0) ? qs : (r == 1) ? ks : vs) + st * 128 + ch * 8;
                *(LAS f32x4*)d = (f32x4){bflo(w.x), bfhi(w.x), bflo(w.y), bfhi(w.y)};
                *(LAS f32x4*)(d + 4) = (f32x4){bflo(w.z), bfhi(w.z), bflo(w.w), bfhi(w.w)};
            }
            if (tid < TB) { const int tau = tau0 + tid, token = b * SEQ + (dir ? SEQ - 1 - tau : tau);
                const float ip = GATES[(size_t)token * 16 + 8 * dir + h], fp = GATES[(size_t)token * 16 + 8 * dir + 4 + h];
                gi[tid] = ip; gl[tid] = fminf(fp, 0.f) - log1pf(__expf(-fabsf(fp))); }
            __syncthreads();
            for (int s = 0; s < TB; ++s) {
                const float is = gi[s], lf = gl[s];
                const float mn = fmaxf(lf + m, is), fpr = __expf(lf + m - mn), ipr = __expf(is - mn); m = mn;
                const float iv = ipr * vs[s * 128 + v];
                float hv = 0.f, dn = 0.f;
#pragma unroll
                for (int j4 = 0; j4 < 8; ++j4) {
                    const f32x4 kk = *(const LAS f32x4*)(ks + s * 128 + 32 * kq + 4 * j4), qq = *(const LAS f32x4*)(qs + s * 128 + 32 * kq + 4 * j4);
#pragma unroll
                    for (int e = 0; e < 4; ++e) { const int j = 4 * j4 + e;
                        C[j] = fmaf(iv, kk[e], fpr * C[j]); n[j] = fmaf(ipr, kk[e], fpr * n[j]);
                        hv = fmaf(C[j], qq[e], hv); dn = fmaf(n[j], qq[e], dn); }
                }
                hv += __shfl_xor(hv, 1); hv += __shfl_xor(hv, 2); dn += __shfl_xor(dn, 1); dn += __shfl_xor(dn, 2);
                if (kq == 0) ob[s * 128 + v] = hv / fmaxf(fabsf(dn), __expf(-m));
            }
            __syncthreads();
            { const int st = tid >> 4, ch = tid & 15, tau = tau0 + st, token = b * SEQ + (dir ? SEQ - 1 - tau : tau);
              const f32x4 a = *(const LAS f32x4*)(ob + st * 128 + ch * 8), c2 = *(const LAS f32x4*)(ob + st * 128 + ch * 8 + 4);
              v4u w; w.x = pk2(a.x, a.y); w.y = pk2(a.z, a.w); w.z = pk2(c2.x, c2.y); w.w = pk2(c2.z, c2.w);
              *(v4u*)(HM + ((size_t)dir * MTOK + token) * 512 + h * 128 + ch * 8) = w; }
            __syncthreads();
        }
    }
}

#define LAUNDER(x) asm volatile("" : "+v"(x))
DI float filt_tap(const float* HID2, const LAS float* w3s, int t, float adelta) {
    const f32x4* hr = (const f32x4*)(HID2 + (size_t)t * 64); float s = 0.f;
#pragma unroll
    for (int i = 0; i < 16; ++i) { const f32x4 hh = hr[i]; s += (hh.x * w3s[4 * i] + hh.y * w3s[4 * i + 1]) + (hh.z * w3s[4 * i + 2] + hh.w * w3s[4 * i + 3]); }
    return s * (__expf(-(float)t * (1.f / 4095.f) * adelta) + 0.05f);
}
#define LDS_BARRIER() do { asm volatile("s_waitcnt lgkmcnt(0)" ::: "memory"); __builtin_amdgcn_s_barrier(); asm volatile("" ::: "memory"); } while (0)
constexpr int HY_X = 0, HY_Z1 = 69632, HY_TWA = 102400, HY_TWB = 135168, HY_TW8 = 137216, HY_W3S = 139264;
template <int HH, int O> DI void hy_finalize(const cf2 (&u)[16], LAS cf2* X, LAS cf2* Z1, const unsigned (&fz)[8], const unsigned (&fx)[8], unsigned* zt, int lo_, float bias) {
#pragma unroll
    for (int j = 0; j < 8; ++j) {
        const int t = (8 * HH + j) * 256 + lo_;
        const cf2 mine = u[8 * HH + j];
        const cf2 oth = X[fphys((HH ? 0 : 4096) + t)];
        const cf2 y = MK2(mine.x + oth.x, mine.y + oth.y);
        if (O == 0) Z1[t] = MK2(bflo(fx[j]) * (y.x + bias * bflo(fz[j])), bfhi(fx[j]) * (y.y + bias * bfhi(fz[j])));
        else { const cf2 z1 = Z1[t]; zt[t] = pk2(bflo(fx[j]) * (y.x + bias * z1.x), bfhi(fx[j]) * (y.y + bias * z1.y)); }
    }
}
template <int O> DI void hy_conv(int tid, const unsigned (&vin)[16], LAS cf2* X, LAS cf2* Z1, const LAS cf2* TWA, const LAS cf2* TWB, const LAS cf2* TW8,
                                 const cf2* kg, const unsigned* Uz, const unsigned* Ux, unsigned* zt, float bias) {
    { int tl = tid; LAUNDER(tl); const int lo_ = tl & 255;
      cf2 a[16], b[16];
#pragma unroll
      for (int k = 0; k < 16; ++k) { if (O == 0) a[k] = MK2(bflo(vin[k]), bfhi(vin[k])); else a[k] = Z1[k * 256 + lo_]; b[k] = MK2(0.f, 0.f); }
      fft_passA_fwd(tl, a, b, X, TWA, TW8); }
    LDS_BARRIER();
    cf2 kgv[16];
    { int tl = tid; LAUNDER(tl);
#pragma unroll
      for (int r = 0; r < 16; ++r) kgv[r] = kg[r * 512 + tl];
      fft_passB_fwd(tl, X, TWB); }
    LDS_BARRIER();
    unsigned fz[8], fx[8];
    { int tl = tid; LAUNDER(tl); const int t0 = (tl >> 8) * 2048 + (tl & 255);
#pragma unroll
      for (int j = 0; j < 8; ++j) { fx[j] = Ux[t0 + j * 256]; fz[j] = (O == 0) ? Uz[t0 + j * 256] : 0u; }
      cf2 v[16]; fft_passC_fwd(tl, X, v);
#pragma unroll
      for (int r = 0; r < 16; ++r) v[r] = c_mul(v[r], kgv[r]);
      fft_passC_inv(tl, X, v); }
    LDS_BARRIER();
    { int tl = tid; LAUNDER(tl); fft_passB_inv(tl, X, TWB); }
    LDS_BARRIER();
    { int tl = tid; LAUNDER(tl); const int H_ = tl >> 8, lo_ = tl & 255;
      cf2 u[16]; fft_passA_inv(tl, X, TWA, TW8, u);
      if (H_ == 0) {
#pragma unroll
          for (int k = 8; k < 16; ++k) X[fphys(k * 256 + lo_)] = u[k];
      } else {
#pragma unroll
          for (int k = 0; k < 8; ++k) X[fphys(4096 + k * 256 + lo_)] = u[k];
      }
      LDS_BARRIER();
      if (H_ == 0) hy_finalize<0, O>(u, X, Z1, fz, fx, zt, lo_, bias); else hy_finalize<1, O>(u, X, Z1, fz, fx, zt, lo_, bias); }
    LDS_BARRIER();
}
DI void p4_hyena(Frame& F) {
    unsigned char* ws = F.a->ws; const int tid = F.tid;
    LAS cf2* X = (LAS cf2*)(F.lds + HY_X); LAS cf2* Z1 = (LAS cf2*)(F.lds + HY_Z1);
    LAS cf2* TWA = (LAS cf2*)(F.lds + HY_TWA); LAS cf2* TWB = (LAS cf2*)(F.lds + HY_TWB); LAS cf2* TW8 = (LAS cf2*)(F.lds + HY_TW8);
    LAS float* W3S = (LAS float*)(F.lds + HY_W3S);
    LAS float* TS = (LAS float*)Z1;
    const float* HID2 = (const float*)(ws + WS_HID2);
    cf2* KG = (cf2*)(ws + WS_KSP) + (size_t)F.blk * 16384;
    const unsigned* UT = (const unsigned*)(ws + WS_UT); unsigned* ZT = (unsigned*)(ws + WS_ZT);
#pragma unroll 1
    for (int i = tid; i < 4096; i += 512) { const int r = i >> 8, lo = i & 255; float sn, cs; sincospif((float)(r * lo) * (1.f / 2048.f), &sn, &cs); TWA[i] = MK2(cs, -sn); }
    if (tid < 256) { float sn, cs; const int r = tid >> 4, lo = tid & 15; sincospif((float)(r * lo) * (1.f / 128.f), &sn, &cs); TWB[tid] = MK2(cs, -sn);
        sincospif((float)tid * (1.f / 4096.f), &sn, &cs); TW8[tid] = MK2(cs, -sn); }
    __syncthreads();
    for (int c = F.blk; c < 512; c += F.G) {
        for (int o = 0; o < 2; ++o) {
            if (tid < 128) { const int d = tid >> 6, j = tid & 63; W3S[tid] = F.a->in[IN_HW3][(size_t)j * 2048 + (o * 2 + d) * 512 + c]; }
            __syncthreads();
            const float adf = fabsf(F.a->in[IN_HDELTA][(o * 2) * 512 + c]), adb = fabsf(F.a->in[IN_HDELTA][(o * 2 + 1) * 512 + c]);
            {
                const int g16 = tid >> 4, l16 = tid & 15;
                const f32x4 wf = *(const LAS f32x4*)(W3S + 4 * l16), wb = *(const LAS f32x4*)(W3S + 64 + 4 * l16);
                if (tid == 0) TS[SEQ] = 0.f;
#pragma unroll 8
                for (int it = 0; it < 128; ++it) {
                    const int t = 32 * it + g16;
                    const f32x4 hv = *(const f32x4*)(HID2 + (size_t)t * 64 + 4 * l16);
                    float pf = (hv.x * wf.x + hv.y * wf.y) + (hv.z * wf.z + hv.w * wf.w), pb = (hv.x * wb.x + hv.y * wb.y) + (hv.z * wb.z + hv.w * wb.w);
                    pf += __shfl_xor(pf, 1); pb += __shfl_xor(pb, 1); pf += __shfl_xor(pf, 2); pb += __shfl_xor(pb, 2);
                    pf += __shfl_xor(pf, 4); pb += __shfl_xor(pb, 4); pf += __shfl_xor(pf, 8); pb += __shfl_xor(pb, 8);
                    if (l16 == 0) {
                        const float tt = (float)t * (1.f / 4095.f);
                        const float hf = pf * (__expf(-tt * adf) + 0.05f), hb = pb * (__expf(-tt * adb) + 0.05f);
                        if (t == 0) TS[0] = hf + hb; else { TS[t] = hf; TS[2 * SEQ - t] = hb; }
                    }
                }
            }
            __syncthreads();
            { int tl = tid; LAUNDER(tl); const int lo_ = tl & 255;
              cf2 a[16], b[16];
#pragma unroll
              for (int k = 0; k < 16; ++k) { a[k] = MK2(TS[k * 256 + lo_], 0.f); b[k] = MK2(TS[SEQ + k * 256 + lo_], 0.f); }
              fft_passA_fwd(tl, a, b, X, TWA, TW8); }
            __syncthreads();
            { int tl = tid; LAUNDER(tl); fft_passB_fwd(tl, X, TWB); }
            __syncthreads();
            { int tl = tid; LAUNDER(tl); cf2 v[16]; fft_passC_fwd(tl, X, v);
              cf2* kg = KG + o * 8192 + tl;
#pragma unroll
              for (int r = 0; r < 16; ++r) kg[r * 512] = MK2(v[r].x * (1.f / 8192.f), v[r].y * (1.f / 8192.f)); }
            __syncthreads();
        }
        const float bias0 = F.a->in[IN_HBIAS][c], bias1 = F.a->in[IN_HBIAS][512 + c];
        unsigned vin[16];
        { const unsigned* Uz = UT + (((size_t)2 * 4 + 0) * 512 + c) * SEQ + (tid & 255);
#pragma unroll
          for (int k = 0; k < 16; ++k) vin[k] = Uz[k * 256]; }
#pragma unroll 1
        for (int p = 0; p < 4; ++p) {
            const unsigned* Ux1 = UT + (((size_t)0 * 4 + p) * 512 + c) * SEQ; const unsigned* Ux2 = UT + (((size_t)1 * 4 + p) * 512 + c) * SEQ; const unsigned* Uz = UT + (((size_t)2 * 4 + p) * 512 + c) * SEQ;
            unsigned* zt = ZT + ((size_t)p * 512 + c) * SEQ;
            hy_conv<0>(tid, vin, X, Z1, TWA, TWB, TW8, KG, Uz, Ux1, zt, bias0);
            if (p < 3) { const unsigned* Un = Uz + (size_t)512 * SEQ + (tid & 255);
#pragma unroll
                for (int k = 0; k < 16; ++k) vin[k] = Un[k * 256]; }
            hy_conv<1>(tid, vin, X, Z1, TWA, TWB, TW8, KG + 8192, Uz, Ux2, zt, bias1);
        }
    }
}

DI void p5_post(Frame& F) {
    unsigned char* ws = F.a->ws; const int lane = F.lane;
    bf16* Y = (bf16*)(ws + WS_H); const bf16* P = (const bf16*)(ws + WS_P); const bf16* HM = (const bf16*)(ws + WS_HM);
    {
        const int gw = F.blk * 8 + F.wave, NGW = F.G * 8;
        const f32x4 g0 = *(const f32x4*)(F.a->in[IN_MNG] + 8 * lane), g1 = *(const f32x4*)(F.a->in[IN_MNG] + 8 * lane + 4);
        for (int row = gw; row < MTOK; row += NGW) {
            const v4u a = *(const v4u*)(HM + (size_t)row * 512 + 8 * lane), bq = *(const v4u*)(HM + ((size_t)MTOK + row) * 512 + 8 * lane);
            const v4u ov = *(const v4u*)(P + (size_t)row * NPROJ + 1536 + 8 * lane);
            float hsum[8], og[8];
#pragma unroll
            for (int e = 0; e < 4; ++e) { hsum[2 * e] = bflo(a[e]) + bflo(bq[e]); hsum[2 * e + 1] = bfhi(a[e]) + bfhi(bq[e]); og[2 * e] = bflo(ov[e]); og[2 * e + 1] = bfhi(ov[e]); }
            float ss = 0.f;
#pragma unroll
            for (int e = 0; e < 8; ++e) ss += hsum[e] * hsum[e];
            ss += __shfl_xor(ss, 1); ss += __shfl_xor(ss, 2); ss += __shfl_xor(ss, 4); ss += __shfl_xor(ss, 8);
            const float rstd = rsqrtf(ss * (1.f / 128.f) + RMS_EPS);
            const float gg[8] = {g0.x, g0.y, g0.z, g0.w, g1.x, g1.y, g1.z, g1.w};
            float o[8];
#pragma unroll
            for (int e = 0; e < 8; ++e) o[e] = sigmoidf_(og[e]) * hsum[e] * rstd * gg[e];
            v4u w; w.x = pk2(o[0], o[1]); w.y = pk2(o[2], o[3]); w.z = pk2(o[4], o[5]); w.w = pk2(o[6], o[7]);
            *(v4u*)(Y + (size_t)row * 1024 + 8 * lane) = w;
        }
    }
    {
        const bf16* ZT = (const bf16*)(ws + WS_ZT);
        LAS bf16* tile = (LAS bf16*)F.lds;
        const f32x4 g0 = *(const f32x4*)(F.a->in[IN_HNG] + 8 * lane), g1 = *(const f32x4*)(F.a->in[IN_HNG] + 8 * lane + 4);
        const float gg[8] = {g0.x, g0.y, g0.z, g0.w, g1.x, g1.y, g1.z, g1.w};
        __syncthreads();
        for (int u = F.blk; u < 4 * 128; u += F.G) {
            const int p = u >> 7, tt = u & 127;
            for (int pc = F.tid; pc < 4096; pc += 512) {
                const int c = pc >> 3, q = pc & 7;
                const v4u v = *(const v4u*)(ZT + (((size_t)p * 512 + c) * SEQ + tt * 32) * 2 + q * 8);
#pragma unroll
                for (int i = 0; i < 4; ++i) { tile[((4 * q + i) * 2 + 0) * 520 + c] = (bf16)(v[i] & 0xffffu); tile[((4 * q + i) * 2 + 1) * 520 + c] = (bf16)(v[i] >> 16); }
            }
            __syncthreads();
#pragma unroll 2
            for (int rr = 0; rr < 8; ++rr) {
                const int row = F.wave * 8 + rr, t = row >> 1, bs = row & 1, token = (2 * p + bs) * SEQ + tt * 32 + t;
                const v4u v = *(const LAS v4u*)(tile + row * 520 + 8 * lane);
                float z[8];
#pragma unroll
                for (int e = 0; e < 4; ++e) { z[2 * e] = bflo(v[e]); z[2 * e + 1] = bfhi(v[e]); }
                float ss = 0.f;
#pragma unroll
                for (int e = 0; e < 8; ++e) ss += z[e] * z[e];
                ss += __shfl_xor(ss, 1); ss += __shfl_xor(ss, 2); ss += __shfl_xor(ss, 4); ss += __shfl_xor(ss, 8);
                const float rstd = rsqrtf(ss * (1.f / 128.f) + RMS_EPS);
                v4u w; w.x = pk2(z[0] * rstd * gg[0], z[1] * rstd * gg[1]); w.y = pk2(z[2] * rstd * gg[2], z[3] * rstd * gg[3]);
                w.z = pk2(z[4] * rstd * gg[4], z[5] * rstd * gg[5]); w.w = pk2(z[6] * rstd * gg[6], z[7] * rstd * gg[7]);
                *(v4u*)(Y + (size_t)token * 1024 + 512 + 8 * lane) = w;
            }
            __syncthreads();
        }
    }
}

DI void conv_wgu(Frame& F) {
    LAS float* scr = (LAS float*)(F.lds + F.wave * 16384); bf16* WGU = (bf16*)(F.a->ws + WS_WGU);
    const int gw = F.blk * 8 + F.wave, NGW = F.G * 8;
    for (int it = gw; it < 16 * 16 * 128; it += NGW) {
        const int nb = it & 127, kb = (it >> 7) & 15, e = it >> 11, n0 = 32 * nb, k0 = 64 * kb, j = n0 >> 8, r = n0 & 255, f0 = 128 * j + (r & 127);
        const float* W = (r < 128 ? F.a->in[IN_WGATE] : F.a->in[IN_WUP]) + (size_t)e * 1024 * 2048;
        transpose_item(W + (size_t)k0 * 2048 + f0, 2048, WGU + ((size_t)e * 4096 + n0) * 1024 + k0, 1024, scr, F.lane);
    }
}
DI void conv_wd(Frame& F) {
    LAS float* scr = (LAS float*)(F.lds + F.wave * 16384); bf16* WD = (bf16*)(F.a->ws + WS_WD);
    const int gw = F.blk * 8 + F.wave, NGW = F.G * 8;
    for (int it = gw; it < 16 * 32 * 32; it += NGW) {
        const int nb = it & 31, kb = (it >> 5) & 31, e = it >> 10, n0 = 32 * nb, k0 = 64 * kb;
        transpose_item(F.a->in[IN_WDOWN] + (size_t)e * 2048 * 1024 + (size_t)k0 * 1024 + n0, 1024, WD + ((size_t)e * 1024 + n0) * 2048 + k0, 2048, scr, F.lane);
    }
}

DI void p8_topk(Frame& F) {
    unsigned char* ws = F.a->ws; const int tid = F.tid, lane = F.lane, wave = F.wave;
    LAS unsigned* hist = (LAS unsigned*)F.lds;
    LAS unsigned* wtot = hist + 256;
    LAS unsigned* ctl = wtot + 8;
    LAS int* sel = (LAS int*)(ctl + 8);
    const float* AFF = (const float*)(ws + WS_AFF); const bf16* HF = (const bf16*)(ws + WS_HF); bf16* XS = (bf16*)(ws + WS_XS);
    int* IDX = (int*)(ws + WS_IDX); float* GSEL = (float*)(ws + WS_GSEL); int* INV = (int*)(ws + WS_INV);
    for (int it = F.blk; it < NB * NEXP; it += F.G) {
        const int b = it >> 4, e = it & 15;
        unsigned k8[8];
        { const v4u a = *(const v4u*)(AFF + (size_t)it * SEQ + 8 * tid), c2 = *(const v4u*)(AFF + (size_t)it * SEQ + 8 * tid + 4);
          k8[0] = a.x; k8[1] = a.y; k8[2] = a.z; k8[3] = a.w; k8[4] = c2.x; k8[5] = c2.y; k8[6] = c2.z; k8[7] = c2.w; }
        unsigned prefix = 0u, need = CAP;
#pragma unroll 1
        for (int pass = 0; pass < 4; ++pass) {
            const int shift = 24 - 8 * pass; const unsigned mask = pass ? (0xffffffffu << (shift + 8)) : 0u;
            if (tid < 256) hist[tid] = 0u;
            __syncthreads();
#pragma unroll
            for (int i = 0; i < 8; ++i) if ((k8[i] & mask) == prefix) atomicAdd((unsigned*)(hist + ((k8[i] >> shift) & 255u)), 1u);
            __syncthreads();
            if (wave == 0) {
                const unsigned h0 = hist[4 * lane], h1 = hist[4 * lane + 1], h2 = hist[4 * lane + 2], h3 = hist[4 * lane + 3], s = h0 + h1 + h2 + h3;
                unsigned suf = s;
#pragma unroll
                for (int o = 1; o < 64; o <<= 1) { const unsigned t = __shfl_down(suf, o); if (lane + o < 64) suf += t; }
                const unsigned above = suf - s;
                if (above < need && need <= suf) {
                    unsigned rem = need - above; int bin;
                    if (h3 >= rem) bin = 3; else { rem -= h3; if (h2 >= rem) bin = 2; else { rem -= h2; if (h1 >= rem) bin = 1; else { rem -= h1; bin = 0; } } }
                    ctl[0] = prefix | ((unsigned)(4 * lane + bin) << shift); ctl[1] = rem;
                }
            }
            __syncthreads();
            prefix = ctl[0]; need = ctl[1];
        }
        const unsigned T = prefix;
        unsigned cg = 0u, ce = 0u;
#pragma unroll
        for (int i = 0; i < 8; ++i) { cg += (k8[i] > T) ? 1u : 0u; ce += (k8[i] == T) ? 1u : 0u; }
        const unsigned pack = cg | (ce << 16);
        unsigned inc = pack;
#pragma unroll
        for (int o = 1; o < 64; o <<= 1) { const unsigned t = __shfl_up(inc, o); if (lane >= o) inc += t; }
        if (lane == 63) wtot[wave] = inc;
        __syncthreads();
        unsigned woff = 0u;
#pragma unroll
        for (int w = 0; w < 8; ++w) woff += (w < wave) ? wtot[w] : 0u;
        const unsigned exc = woff + inc - pack;
        unsigned gtb = exc & 0xffffu, eqb = exc >> 16;
#pragma unroll
        for (int i = 0; i < 8; ++i) {
            const int idx = 8 * tid + i; const bool isgt = k8[i] > T, iseq = k8[i] == T, selc = isgt || (iseq && eqb < need);
            const int slot = (int)(gtb + (eqb < need ? eqb : need));
            if (selc) { sel[slot] = idx; IDX[it * CAP + slot] = idx; GSEL[it * CAP + slot] = __uint_as_float(k8[i]); }
            INV[((size_t)b * SEQ + idx) * 16 + e] = selc ? slot : -1;
            gtb += isgt ? 1u : 0u; eqb += iseq ? 1u : 0u;
        }
        __syncthreads();
        for (int s0 = wave * 64; s0 < wave * 64 + 64; s0 += 8) {
            v4u x0[8], x1[8];
#pragma unroll
            for (int r = 0; r < 8; ++r) { const v4u* src = (const v4u*)(HF + ((size_t)b * SEQ + sel[s0 + r]) * 1024); x0[r] = src[lane]; x1[r] = src[lane + 64]; }
#pragma unroll
            for (int r = 0; r < 8; ++r) { v4u* dst = (v4u*)(XS + (((size_t)e * NB + b) * CAP + s0 + r) * 1024); dst[lane] = x0[r]; dst[lane + 64] = x1[r]; }
        }
        __syncthreads();
    }
}

DI void p12_final(Frame& F) {
    unsigned char* ws = F.a->ws; const int lane = F.lane;
    const int* INV = (const int*)(ws + WS_INV); const float* GSEL = (const float*)(ws + WS_GSEL); const bf16* YS = (const bf16*)(ws + WS_YS); const float* MOD = (const float*)(ws + WS_MOD);
    const int gw = F.blk * 8 + F.wave, NGW = F.G * 8;
    for (int row = gw; row < MTOK; row += NGW) {
        const int b = row >> 12;
        f32x4* xr = (f32x4*)(F.a->out + (size_t)row * 1024) + lane;
        f32x4 v[4], acc[4];
#pragma unroll
        for (int j = 0; j < 4; ++j) { v[j] = xr[64 * j]; acc[j] = (f32x4){0.f, 0.f, 0.f, 0.f}; }
        const int myslot = INV[(size_t)row * 16 + (lane & 15)];
#pragma unroll 1
        for (int e = 0; e < 16; ++e) {
            const int s = __shfl(myslot, e);
            if (s >= 0) {
                const float g = GSEL[((size_t)b * 16 + e) * CAP + s];
                const v2u* yr = (const v2u*)(YS + (((size_t)e * NB + b) * CAP + s) * 1024) + lane;
#pragma unroll
                for (int j = 0; j < 4; ++j) { const v2u w = yr[64 * j]; acc[j] += (f32x4){bflo(w.x), bfhi(w.x), bflo(w.y), bfhi(w.y)} * g; }
            }
        }
        float ss = 0.f;
#pragma unroll
        for (int j = 0; j < 4; ++j) { const f32x4 gt = *(const f32x4*)(MOD + b * 6144 + 5120 + 256 * j + 4 * lane); v[j] = v[j] + gt * acc[j]; ss += (v[j].x * v[j].x + v[j].y * v[j].y) + (v[j].z * v[j].z + v[j].w * v[j].w); }
        const float rstd = rsqrtf(wave_sum(ss) * (1.f / 1024.f) + RMS_EPS);
#pragma unroll
        for (int j = 0; j < 4; ++j) { const f32x4 g = *(const f32x4*)(F.a->in[IN_GFINAL] + 256 * j + 4 * lane); xr[64 * j] = v[j] * rstd * g; }
    }
}

typedef short bf16x8_t __attribute__((ext_vector_type(8)));
DI unsigned offb(unsigned row, unsigned ch) { return 256u * row + 16u * (ch ^ (((row & 3u) << 2) | ((row >> 2) & 3u))); }
DI bf16x8_t tr_read2(unsigned a0, unsigned a1) {
    v2u lo, hi;
    asm volatile("ds_read_b64_tr_b16 %0, %2\n\tds_read_b64_tr_b16 %1, %3\n\ts_waitcnt lgkmcnt(0)" : "=&v"(lo), "=&v"(hi) : "v"(a0), "v"(a1) : "memory");
    const v4u w = (v4u){lo.x, lo.y, hi.x, hi.y};
    return __builtin_bit_cast(bf16x8_t, w);
}
DI bf16x8_t lds_frag(const LAS unsigned char* p) { return *(const LAS bf16x8_t*)p; }
#define MFMA16(a, b, c) __builtin_amdgcn_mfma_f32_16x16x32_bf16((a), (b), (c), 0, 0, 0)
constexpr int ML_QT = 0, ML_KT = 32768, ML_VT = 65536, ML_VE = 81920, ML_CB = 98304, ML_OUT = 110592, ML_SC = 118784, ML_SCSZ = 2688;
DI void p4_mlstm_mfma(Frame& F) {
    unsigned char* ws = F.a->ws; LAS unsigned char* L = F.lds;
    const bf16* QK = (const bf16*)(ws + WS_H); const bf16* P = (const bf16*)(ws + WS_P); const float* GATES = (const float*)(ws + WS_GATES);
    bf16* HM = (bf16*)(ws + WS_HM);
    const int tid = F.tid, lane = F.lane, wave = F.wave, fr = lane & 15, fq = lane >> 4, q4 = fr >> 2, p4 = fr & 3;
    const int tb = (wave < 4) ? wave : 11 - wave;
    const unsigned ldsb = (unsigned)(uintptr_t)L;
    for (int it = F.blk; it < 256; it += F.G) {
        const int vs = it & 3, dir = (it >> 2) & 1, h = (it >> 3) & 3, b = it >> 5;
        __syncthreads();
        for (int i = tid; i < 12288 / 16; i += 512) *(LAS v4u*)(L + ML_CB + 16 * i) = (v4u){0u, 0u, 0u, 0u};
        if (tid < 256) { const int row = tid >> 1, hf = tid & 1;
            *(LAS v4u*)(L + ML_VT + row * 128 + 64 + 16 * hf) = (v4u){hf ? 0u : 0x3F80u, 0u, 0u, 0u};
            *(LAS v4u*)(L + ML_VE + row * 128 + 64 + 16 * hf) = (v4u){0u, 0u, 0u, 0u}; }
        f32x4 Cacc[3];
#pragma unroll
        for (int vt = 0; vt < 3; ++vt) Cacc[vt] = (f32x4){0.f, 0.f, 0.f, 0.f};
        float m_in = -1e30f;
        float gpre[4] = {0.f, 0.f, 0.f, 0.f};
        v4u rq[4], rk[4], rv;
        auto load_gates = [&](int cj) {
#pragma unroll
            for (int e = 0; e < 2; ++e) { const int tg = cj * 128 + 2 * lane + e, token = b * SEQ + (dir ? SEQ - 1 - tg : tg);
                gpre[2 * e] = GATES[(size_t)token * 16 + 8 * dir + h]; gpre[2 * e + 1] = GATES[(size_t)token * 16 + 8 * dir + 4 + h]; }
        };
        auto scan = [&](int cj) {
            LAS float* SC = (LAS float*)(L + ML_SC + (cj & 1) * ML_SCSZ);
            const float lf0 = fminf(gpre[1], 0.f) - log1pf(__expf(-fabsf(gpre[1]))), lf1 = fminf(gpre[3], 0.f) - log1pf(__expf(-fabsf(gpre[3])));
            float inc = lf0 + lf1;
#pragma unroll
            for (int o = 1; o < 64; o <<= 1) { const float t = __shfl_up(inc, o); if (lane >= o) inc += t; }
            const float b1 = inc, b0 = inc - lf1, u0 = gpre[0] - b0, u1 = gpre[2] - b1;
            float imx = fmaxf(u0, u1);
#pragma unroll
            for (int o = 1; o < 64; o <<= 1) { const float t = __shfl_up(imx, o); if (lane >= o) imx = fmaxf(imx, t); }
            float exm = __shfl_up(imx, 1); if (lane == 0) exm = -3.0e38f;
            const float M0 = fmaxf(m_in, fmaxf(exm, u0)), M1 = fmaxf(m_in, imx);
            const float g = __shfl(b1, 63), Ml = __shfl(M1, 63);
            SC[2 * lane] = u0; SC[2 * lane + 1] = u1;
            SC[128 + 2 * lane] = M0; SC[128 + 2 * lane + 1] = M1;
            SC[256 + 2 * lane] = __expf(m_in - M0); SC[256 + 2 * lane + 1] = __expf(m_in - M1);
            SC[384 + 2 * lane] = __expf(-(b0 + M0)); SC[384 + 2 * lane + 1] = __expf(-(b1 + M1));
            SC[512 + 2 * lane] = __expf(u0 - Ml); SC[512 + 2 * lane + 1] = __expf(u1 - Ml);
            if (lane == 0) SC[640] = __expf(m_in - Ml);
            m_in = g + Ml;
        };
        auto load_tiles = [&](int cj) {
#pragma unroll
            for (int i = 0; i < 4; ++i) { const int id = tid + 512 * i, row = id >> 4, ch = id & 15, tg = cj * 128 + row, token = b * SEQ + (dir ? SEQ - 1 - tg : tg);
                rq[i] = *(const v4u*)(QK + (size_t)token * 1024 + h * 128 + 8 * ch); rk[i] = *(const v4u*)(QK + (size_t)token * 1024 + 512 + h * 128 + 8 * ch); }
            { const int row = tid >> 2, pc = tid & 3, tg = cj * 128 + row, token = b * SEQ + (dir ? SEQ - 1 - tg : tg);
              rv = *(const v4u*)(P + (size_t)token * NPROJ + 1024 + h * 128 + 32 * vs + 8 * pc); }
        };
        auto store_tiles = [&](int cj) {
            const LAS float* SC = (const LAS float*)(L + ML_SC + (cj & 1) * ML_SCSZ);
#pragma unroll
            for (int i = 0; i < 4; ++i) { const int id = tid + 512 * i, row = id >> 4, ch = id & 15;
                *(LAS v4u*)(L + ML_QT + offb(row, ch)) = rq[i]; *(LAS v4u*)(L + ML_KT + offb(row, ch)) = rk[i]; }
            { const int row = tid >> 2, pc = tid & 3; const float e = SC[512 + row];
              *(LAS v4u*)(L + ML_VT + row * 128 + 16 * pc) = rv;
              v4u w; w.x = pk2(bflo(rv.x) * e, bfhi(rv.x) * e); w.y = pk2(bflo(rv.y) * e, bfhi(rv.y) * e); w.z = pk2(bflo(rv.z) * e, bfhi(rv.z) * e); w.w = pk2(bflo(rv.w) * e, bfhi(rv.w) * e);
              *(LAS v4u*)(L + ML_VE + row * 128 + 16 * pc) = w;
              if (pc == 0) *(LAS bf16*)(L + ML_VE + row * 128 + 64) = (bf16)f2bf(e); }
        };
        if (wave == 0) { load_gates(0); scan(0); load_gates(1); }
        load_tiles(0);
        __syncthreads();
        store_tiles(0);
        __syncthreads();
#pragma unroll 1
        for (int cj = 0; cj < 32; ++cj) {
            const LAS float* SC = (const LAS float*)(L + ML_SC + (cj & 1) * ML_SCSZ);
            if (cj + 1 < 32) { if (wave == 0) { scan(cj + 1); if (cj + 2 < 32) load_gates(cj + 2); } load_tiles(cj + 1); }
            bf16x8_t qf[4];
#pragma unroll
            for (int ks = 0; ks < 4; ++ks) qf[ks] = lds_frag(L + ML_QT + offb(16 * tb + fr, 4 * ks + fq));
            f32x4 accO[3];
#pragma unroll
            for (int vt = 0; vt < 3; ++vt) { accO[vt] = (f32x4){0.f, 0.f, 0.f, 0.f};
#pragma unroll
                for (int ks = 0; ks < 4; ++ks) accO[vt] = MFMA16(qf[ks], lds_frag(L + ML_CB + offb(16 * vt + fr, 4 * ks + fq)), accO[vt]); }
            { const f32x4 ei = *(const LAS f32x4*)(SC + 256 + 16 * tb + 4 * fq);
#pragma unroll
              for (int vt = 0; vt < 3; ++vt) accO[vt] = accO[vt] * ei; }
            const float mrow_t = SC[128 + 16 * tb + fr];
            for (int ks2 = 0; ks2 <= (tb >> 1); ++ks2) {
                f32x4 st[2];
#pragma unroll
                for (int hh = 0; hh < 2; ++hh) {
                    const int sb = 2 * ks2 + hh;
                    st[hh] = (f32x4){0.f, 0.f, 0.f, 0.f};
                    if (sb <= tb) {
                        f32x4 acc = (f32x4){0.f, 0.f, 0.f, 0.f};
#pragma unroll
                        for (int kd = 0; kd < 4; ++kd) acc = MFMA16(lds_frag(L + ML_KT + offb(16 * sb + fr, 4 * kd + fq)), qf[kd], acc);
                        const f32x4 us = *(const LAS f32x4*)(SC + 16 * sb + 4 * fq);
#pragma unroll
                        for (int r = 0; r < 4; ++r) { const float val = acc[r] * __expf(us[r] - mrow_t); st[hh][r] = (16 * sb + 4 * fq + r <= 16 * tb + fr) ? val : 0.f; }
                    }
                }
                v4u sw; sw.x = pk2(st[0][0], st[0][1]); sw.y = pk2(st[0][2], st[0][3]); sw.z = pk2(st[1][0], st[1][1]); sw.w = pk2(st[1][2], st[1][3]);
                const bf16x8_t sp = __builtin_bit_cast(bf16x8_t, sw);
                const unsigned va = ldsb + ML_VT + (32 * ks2 + 4 * fq + q4) * 128 + 8 * p4;
#pragma unroll
                for (int vt = 0; vt < 3; ++vt) accO[vt] = MFMA16(sp, tr_read2(va + 32 * vt, va + 32 * vt + 16 * 128), accO[vt]);
            }
            { const f32x4 enm = *(const LAS f32x4*)(SC + 384 + 16 * tb + 4 * fq);
#pragma unroll
              for (int r = 0; r < 4; ++r) { const float den = __shfl(accO[2][r], lane & 48), inv = 1.f / fmaxf(fabsf(den), enm[r]);
                  const int t = 16 * tb + 4 * fq + r;
                  *(LAS bf16*)(L + ML_OUT + t * 64 + 2 * fr) = (bf16)f2bf(accO[0][r] * inv); *(LAS bf16*)(L + ML_OUT + t * 64 + 32 + 2 * fr) = (bf16)f2bf(accO[1][r] * inv); } }
            { const float sp = SC[640];
#pragma unroll
              for (int vt = 0; vt < 3; ++vt) Cacc[vt] = Cacc[vt] * sp; }
#pragma unroll
            for (int ks = 0; ks < 4; ++ks) {
                const unsigned r0 = 32 * ks + 8 * fq + q4;
                const bf16x8_t kb = tr_read2(ldsb + ML_KT + offb(r0, 2 * wave + (p4 >> 1)) + 8 * (p4 & 1), ldsb + ML_KT + offb(r0 + 4, 2 * wave + (p4 >> 1)) + 8 * (p4 & 1));
                const unsigned ea = ldsb + ML_VE + r0 * 128 + 8 * p4;
#pragma unroll
                for (int vt = 0; vt < 3; ++vt) Cacc[vt] = MFMA16(tr_read2(ea + 32 * vt, ea + 32 * vt + 4 * 128), kb, Cacc[vt]);
            }
            __syncthreads();
#pragma unroll
            for (int vt = 0; vt < 3; ++vt)
#pragma unroll
                for (int r = 0; r < 4; ++r) { const int v = 16 * vt + 4 * fq + r, d = 16 * wave + fr;
                    *(LAS bf16*)(L + ML_CB + offb(v, d >> 3) + 2 * (d & 7)) = (bf16)f2bf(Cacc[vt][r]); }
            { const int row = tid >> 2, pc = tid & 3, tg = cj * 128 + row, token = b * SEQ + (dir ? SEQ - 1 - tg : tg);
              *(v4u*)(HM + ((size_t)dir * MTOK + token) * 512 + h * 128 + 32 * vs + 8 * pc) = *(const LAS v4u*)(L + ML_OUT + row * 64 + 16 * pc); }
            if (cj + 1 < 32) store_tiles(cj + 1);
            __syncthreads();
        }
    }
}
__global__ void __launch_bounds__(512, 2) fwd_kernel(Args args) {
    extern __shared__ __attribute__((aligned(16))) unsigned char lds[];
    Frame F;
    F.lds = (LAS unsigned char*)lds;
    F.tid = threadIdx.x; F.lane = F.tid & 63; F.wave = __builtin_amdgcn_readfirstlane(F.tid >> 6);
    F.G = gridDim.x; F.blk = blockIdx.x;
    F.a = &args;
    volatile LAS unsigned* MISC = (volatile LAS unsigned*)(F.lds + MISC_OFF);
    if (F.tid < 64) MISC[F.tid] = 0u;
    __syncthreads();
    XcdBarrier bar; bar.bar = (unsigned*)(F.a->ws + WS_CTL); bar.x = 0; bar.st = nullptr;
    if (N_LAUNCHES == 1) bar = xcd_barrier_post((unsigned*)(F.a->ws + WS_CTL), MISC + 8);
    const int lo = args.ph_lo, hi = args.ph_hi;
#define IN(k) (lo <= (k) && (k) < hi)
#ifndef DUPMASK
#define DUPMASK 0
#endif
#define DUP(k) ((DUPMASK >> (k)) & 1)
#define SEAM(k) do { if (IN(k) && IN((k) + 1)) xcd_barrier(bar); } while (0)
    unsigned char* ws = F.a->ws;
    if (IN(0)) { p0_prologue(F); if (DUP(0)) { __syncthreads(); p0_prologue(F); } } SEAM(0);
    if (IN(1)) { p_norm<false>(F); if (DUP(1)) { __syncthreads(); p_norm<false>(F); } } SEAM(1);
    if (IN(2)) {
        pg8::Gemm g{(const pg8::bf16_t*)(ws + WS_H), (const pg8::bf16_t*)(ws + WS_WIN), MTOK, NPROJ, DM}; pg8::StaticOrder S; S.init(MTOK, NPROJ, F.G, F.blk);
        pg8::EpiBf16<0> E{(pg8::bf16_t*)(ws + WS_P), NPROJ, (const float*)(ws + WS_BIN2), 0, 0, 1.f};
        pg8::gemm_phase<pg8::EpiBf16<0>, pg8::StaticOrder, true, true>(F.lds, g, S, E);
    } SEAM(2);
    if (IN(3)) { p3_prep(F); if (DUP(3)) { __syncthreads(); p3_prep(F); } } SEAM(3);
    if (IN(4)) { p4_hyena(F); if (DUP(4)) { __syncthreads(); p4_hyena(F); } __syncthreads(); p4_mlstm_mfma(F); if (DUP(13)) { __syncthreads(); p4_mlstm_mfma(F); } } SEAM(4);
    if (IN(5)) { p5_post(F); if (DUP(5)) { __syncthreads(); p5_post(F); } } SEAM(5);
    if (IN(6)) {
        pg8::Gemm g{(const pg8::bf16_t*)(ws + WS_H), (const pg8::bf16_t*)(ws + WS_WOUT), MTOK, DM, DM}; pg8::StaticOrder S; S.init(MTOK, DM, F.G, F.blk);
        pg8::EpiRes E{F.a->in[IN_X], F.a->out, (const float*)(ws + WS_MOD)};
        pg8::gemm_phase<pg8::EpiRes, pg8::StaticOrder, true, true>(F.lds, g, S, E);
    } SEAM(6);
    if (IN(7)) { p_norm<true>(F); if (DUP(7)) { __syncthreads(); p_norm<true>(F); } __syncthreads(); conv_wgu(F); if (DUP(14)) { __syncthreads(); conv_wgu(F); } } SEAM(7);
    if (IN(8)) { p8_topk(F); if (DUP(8)) { __syncthreads(); p8_topk(F); } } SEAM(8);
    if (IN(9)) {
        pg8::Gemm g{(const pg8::bf16_t*)(ws + WS_XS), (const pg8::bf16_t*)(ws + WS_WGU), NSLOT, NEXP * 4096, DM}; pg8::MoeOrderA S{F.G, F.blk};
        pg8::EpiSwiGLU E{(pg8::bf16_t*)(ws + WS_HID)};
        pg8::gemm_phase<pg8::EpiSwiGLU, pg8::MoeOrderA, true, true>(F.lds, g, S, E);
    } SEAM(9);
    if (IN(10)) { conv_wd(F); if (DUP(10)) { __syncthreads(); conv_wd(F); } } SEAM(10);
    if (IN(11)) {
        pg8::Gemm g{(const pg8::bf16_t*)(ws + WS_HID), (const pg8::bf16_t*)(ws + WS_WD), NSLOT, NEXP * 1024, FFD}; pg8::MoeOrderB S{F.G, F.blk};
        pg8::EpiYs E{(pg8::bf16_t*)(ws + WS_YS)};
        pg8::gemm_phase<pg8::EpiYs, pg8::MoeOrderB, true, true>(F.lds, g, S, E);
    } SEAM(11);
    if (IN(12)) { p12_final(F); }
#undef IN
#undef SEAM
}

extern "C" void kernel_launch(void* const* d_in, const int* in_sizes, int n_in, void* d_out, int out_size, void* d_ws, size_t ws_size, hipStream_t stream) {
    static int grid = 0;
    if (grid == 0) {
        if (n_in != 28 || out_size != MTOK * DM || ws_size < WS_END) { fprintf(stderr, "kernel_launch: unexpected shapes (n_in %d, out %d, ws %zu < %zu)\n", n_in, out_size, ws_size, (size_t)WS_END); grid = -1; return; }
        int dev = 0, cus = 0;
        if (hipGetDevice(&dev) != hipSuccess || hipDeviceGetAttribute(&cus, hipDeviceAttributeMultiprocessorCount, dev) != hipSuccess) { grid = -1; return; }
        if (hipFuncSetAttribute((const void*)fwd_kernel, hipFuncAttributeMaxDynamicSharedMemorySize, LDS_BYTES) != hipSuccess) { fprintf(stderr, "kernel_launch: hipFuncSetAttribute failed\n"); grid = -1; return; }
        int per_cu = 0;
        if (hipOccupancyMaxActiveBlocksPerMultiprocessor(&per_cu, (const void*)fwd_kernel, 512, LDS_BYTES) != hipSuccess || per_cu < 1) fprintf(stderr, "kernel_launch: occupancy query reports %d\n", per_cu);
        (void)hipGetLastError();
        grid = cus > 256 ? 256 : cus;
    }
    if (grid < 0) return;
    (void)hipMemsetAsync((char*)d_ws + WS_CTL, 0, CTL_ZERO_BYTES, stream);
    Args a{};
    for (int i = 0; i < 28; ++i) a.in[i] = (const float*)d_in[i];
    a.out = (float*)d_out; a.ws = (unsigned char*)d_ws;
    if (N_LAUNCHES == 1) { a.ph_lo = 0; a.ph_hi = N_PHASES; hipLaunchKernelGGL(fwd_kernel, dim3(grid), dim3(512), LDS_BYTES, stream, a); }
    else for (int p = 0; p < N_PHASES; ++p) { a.ph_lo = p; a.ph_hi = p + 1; hipLaunchKernelGGL(fwd_kernel, dim3(grid), dim3(512), LDS_BYTES, stream, a); }
}
```

```cpp
#include <hip/hip_runtime.h>
#include <cstdio>
#include <cstdint>
#include <type_traits>
#define N_LAUNCHES 1
#define DUPMASK 0
__device__ __forceinline__ int lane_id() { return (int)__builtin_amdgcn_mbcnt_hi(~0u, __builtin_amdgcn_mbcnt_lo(~0u, 0u)); }
namespace pg8 {
#define PG8_LAS __attribute__((address_space(3)))
typedef unsigned short bf16_t;
typedef short bf16x8 __attribute__((ext_vector_type(8)));
typedef float f32x4 __attribute__((ext_vector_type(4)));
typedef unsigned u32x4 __attribute__((ext_vector_type(4)));
constexpr int BM = 256, BK = 64, HALF = 128, HTB = HALF * BK * 2  , STAGE_BYTES = 8 * HTB, NXCD = 8, WGM = 8;

__host__ __device__ __forceinline__ int lds_byte(int r, int c) { const int st = (r >> 4) * 2 + (c >> 5), rr = r & 15, cc = c & 31, ob = rr * 64 + cc * 2; return st * 1024 + (ob ^ (((ob >> 9) & 1) << 5)); }
__host__ __device__ __forceinline__ void stage_rc(int b, int& R, int& C) { const int st = b / 1024, sb = b % 1024, swz = sb ^ (((sb >> 9) & 1) << 5); R = (st >> 1) * 16 + swz / 64; C = (st & 1) * 32 + (swz % 64) / 2; }
__host__ __device__ __forceinline__ int perm32(int rho) { const int n = rho >> 4, i = rho & 15; return 8 * (i >> 2) + 4 * n + (i & 3); }

struct Unit { int pm, pn; };
struct Gemm { const bf16_t* A; const bf16_t* Bt; int M, N, K; };

struct StaticOrder {
    int nM, nN, nwg, G, c;
    __host__ __device__ void init(int M, int N, int G_, int c_) { nM = M / BM; nN = N / BM; nwg = nM * nN; G = G_; c = c_; }
    __host__ __device__ bool next(int i, Unit& u) const {
        const long L = (long)i * G + c; if (L >= nwg) return false;
        int wgid = (int)L; { const int q = nwg / NXCD, r = nwg % NXCD, xcd = wgid % NXCD, off = wgid / NXCD; wgid = (xcd < r ? xcd * (q + 1) : r * (q + 1) + (xcd - r) * q) + off; }
        const int nig = WGM * nN, gid = wgid / nig, fm = gid * WGM, gsz = (nM - fm) < WGM ? (nM - fm) : WGM;
        u.pm = fm + ((wgid % nig) % gsz); u.pn = (wgid % nig) / gsz; return true;
    }
    __device__ __forceinline__ void a_ready(const Unit&) const {}
    __device__ __forceinline__ void done(const Unit&) const {}
};

__device__ __forceinline__ unsigned cvt_pk_bf16(float lo, float hi) { unsigned r; asm volatile("v_cvt_pk_bf16_f32 %0, %1, %2" : "=v"(r) : "v"(lo), "v"(hi)); return r; }
typedef float f32x2 __attribute__((ext_vector_type(2)));
__device__ __forceinline__ f32x2 gelu_pk(f32x2 v) {
    const f32x2 av = __builtin_elementwise_abs(v), d = av * 0.2316418882f + 1.0f;
    f32x2 t; t.x = __builtin_amdgcn_rcpf(d.x); t.y = __builtin_amdgcn_rcpf(d.y);
    f32x2 q = t * 0.5307027145f + (-0.7265760135f); q = q * t + 0.7107068705f; q = q * t + (-0.142248368f); q = q * t + 0.127414796f; q = q * t;
    const f32x2 s = (v * v) * (-0.72134752044f);
    f32x2 e; e.x = __builtin_amdgcn_exp2f(s.x); e.y = __builtin_amdgcn_exp2f(s.y);
    const f32x2 m = v * (q * e), r = v - m;
    f32x2 o; o.x = v.x < 0.f ? m.x : r.x; o.y = v.y < 0.f ? m.y : r.y; return o;
}

template <int ACT  > struct EpiBf16 {
    static constexpr bool PERM = true, AFTER_DRAIN = false; static_assert(ACT == 0 || ACT == 1, "EpiBf16: ACT is 0 (none) or 1 (gelu_pk)");
    bf16_t* O; int ldc; const float* bias; int split_cols; size_t split_stride; float scale0;
    __device__ __forceinline__ void operator()(const f32x4 (&acc)[2][2][4][2], const Unit& u, int wr, int wc, int fr, int fq) const {
        const int row0 = u.pm * BM + wr * 64 + fr; int colt = u.pn * BM; bf16_t* base = O;
        float sc = 1.f; if (split_cols) { const int t = colt / split_cols; base += (size_t)t * split_stride; colt -= t * split_cols; if (t == 0) sc = scale0; }
        const int col0 = colt + wc * 32 + 8 * fq, bcol0 = u.pn * BM + wc * 32 + 8 * fq;
        f32x4 bv[2][2];
#pragma unroll
        for (int bj = 0; bj < 2; ++bj)
#pragma unroll
            for (int n = 0; n < 2; ++n) bv[bj][n] = bias ? *(const f32x4*)(bias + bcol0 + bj * HALF + 4 * n) : (f32x4){0.f, 0.f, 0.f, 0.f};
#pragma unroll
        for (int ai = 0; ai < 2; ++ai)
#pragma unroll
            for (int m = 0; m < 4; ++m) { bf16_t* rowp = base + (size_t)(row0 + ai * HALF + m * 16) * ldc + col0;
#pragma unroll
                for (int bj = 0; bj < 2; ++bj) { f32x4 v0 = acc[ai][bj][m][0] + bv[bj][0], v1 = acc[ai][bj][m][1] + bv[bj][1];
                    if (ACT == 1) { f32x2 a = gelu_pk((f32x2){v0[0], v0[1]}), b = gelu_pk((f32x2){v0[2], v0[3]}), c = gelu_pk((f32x2){v1[0], v1[1]}), d = gelu_pk((f32x2){v1[2], v1[3]});
                        v0 = (f32x4){a.x, a.y, b.x, b.y}; v1 = (f32x4){c.x, c.y, d.x, d.y}; }
                    v0 = v0 * sc; v1 = v1 * sc; u32x4 w; w.x = cvt_pk_bf16(v0[0], v0[1]); w.y = cvt_pk_bf16(v0[2], v0[3]); w.z = cvt_pk_bf16(v1[0], v1[1]); w.w = cvt_pk_bf16(v1[2], v1[3]);
                    *(u32x4*)(rowp + bj * HALF) = w; } }
    }
};


template <class Epi, class Sched, bool ALIGN_EPI = false, bool SP2 = false>
__device__ __forceinline__ void gemm_phase(PG8_LAS unsigned char* lds, const Gemm g, const Sched& S, const Epi& E, const int tid_in) {
    const int tid = tid_in, wid = __builtin_amdgcn_readfirstlane(tid >> 6), lane = tid & 63, wr = wid >> 2, wc = wid & 3, fr = lane & 15, fq = lane >> 4;
    const int K = g.K, nt = K / BK;
    unsigned voffA[2], voffB[2];
#pragma unroll
    for (int i = 0; i < 2; ++i) { int R, C; stage_rc(tid * 16 + i * 8192, R, C); const int Rb = Epi::PERM ? ((R & ~31) + perm32(R & 31)) : R;
        voffA[i] = (unsigned)(R * K + C) * 2u; voffB[i] = (unsigned)(Rb * K + C) * 2u; }
    const size_t kstep = (size_t)(BK * 2);
    const size_t hstep = (size_t)HALF * K * 2;
    const size_t tstep = 2 * hstep;
    const unsigned ldsw = (unsigned)wid * 1024u;
    const int aoff = lds_byte(wr * 64 + fr, fq * 8), boff = lds_byte(wc * 32 + fr, fq * 8);
#define PG8_SA(b, h) (((b) * 2 + (h)) * HTB)
#define PG8_SB(b, h) ((4 + (b) * 2 + (h)) * HTB)
#define PG8_STAGE(bufoff, gbase, voff) do { _Pragma("unroll") for (int _i = 0; _i < 2; ++_i) \
        __builtin_amdgcn_global_load_lds((const unsigned*)((const char*)(gbase) + (voff)[_i]), (PG8_LAS unsigned*)(lds + (bufoff) + ldsw + _i * 8192), 16, 0, 0); } while (0)
#define PG8_LDA(dst, b, h) do { _Pragma("unroll") for (int m = 0; m < 4; ++m) _Pragma("unroll") for (int k = 0; k < 2; ++k) dst[m][k] = *(const PG8_LAS bf16x8*)(lds + PG8_SA(b, h) + aoff + m * 2048 + k * 1024); } while (0)
#define PG8_LDB(dst, b, h) do { _Pragma("unroll") for (int n = 0; n < 2; ++n) _Pragma("unroll") for (int k = 0; k < 2; ++k) dst[n][k] = *(const PG8_LAS bf16x8*)(lds + PG8_SB(b, h) + boff + n * 2048 + k * 1024); } while (0)
#define PG8_MMA(ai, bj, At, Bt) do { __builtin_amdgcn_s_setprio(1); _Pragma("unroll") for (int m = 0; m < 4; ++m) _Pragma("unroll") for (int n = 0; n < 2; ++n) _Pragma("unroll") for (int k = 0; k < 2; ++k) \
        acc[ai][bj][m][n] = __builtin_amdgcn_mfma_f32_16x16x32_bf16(Bt[n][k], At[m][k], acc[ai][bj][m][n], 0, 0, 0); __builtin_amdgcn_s_setprio(0); } while (0)
#define PG8_WAIT_V(n) asm volatile("s_waitcnt vmcnt(" #n ")" ::: "memory")
#define PG8_WAIT_L(n) asm volatile("s_waitcnt lgkmcnt(" #n ")" ::: "memory")
#define PG8_BAR __builtin_amdgcn_s_barrier()
#define PG8_SCHED __builtin_amdgcn_sched_barrier(0)
    Unit cur, nxt; int ui = 0;
    if (!S.next(0, cur)) return;
    f32x4 acc[2][2][4][2];
#pragma unroll
    for (int a = 0; a < 2; ++a)
#pragma unroll
        for (int b = 0; b < 2; ++b)
#pragma unroll
            for (int m = 0; m < 4; ++m)
#pragma unroll
                for (int n = 0; n < 2; ++n) acc[a][b][m][n] = (f32x4){0.f, 0.f, 0.f, 0.f};
    bf16x8 At[4][2], B0[2][2], B1[2][2];
    const char* cA = (const char*)g.A + (size_t)cur.pm * tstep; const char* cB = (const char*)g.Bt + (size_t)cur.pn * tstep;
    S.a_ready(cur);
    if constexpr (SP2) {
        PG8_STAGE(PG8_SB(0, 0), cB, voffB); PG8_STAGE(PG8_SB(0, 1), cB + hstep, voffB); PG8_STAGE(PG8_SA(0, 0), cA, voffA); PG8_STAGE(PG8_SA(0, 1), cA + hstep, voffA);
        if (wr == 1) PG8_BAR;
        PG8_WAIT_V(2); PG8_BAR;
        PG8_STAGE(PG8_SB(1, 0), cB + kstep, voffB); PG8_STAGE(PG8_SA(1, 0), cA + kstep, voffA); PG8_STAGE(PG8_SB(1, 1), cB + hstep + kstep, voffB);
        PG8_WAIT_V(6); PG8_BAR;
    } else {
        PG8_STAGE(PG8_SB(0, 0), cB, voffB); PG8_STAGE(PG8_SA(0, 0), cA, voffA); PG8_STAGE(PG8_SB(0, 1), cB + hstep, voffB); PG8_STAGE(PG8_SA(0, 1), cA + hstep, voffA);
        if (wr == 1) PG8_BAR;
        PG8_WAIT_V(4); PG8_BAR;
        PG8_STAGE(PG8_SB(1, 0), cB + kstep, voffB); PG8_STAGE(PG8_SA(1, 0), cA + kstep, voffA); PG8_STAGE(PG8_SB(1, 1), cB + hstep + kstep, voffB);
        PG8_WAIT_V(6); PG8_BAR;
    }
    for (;;) {
        const bool has_next = S.next(ui + 1, nxt);
        const char* nA = has_next ? (const char*)g.A + (size_t)nxt.pm * tstep : cA; const char* nB = has_next ? (const char*)g.Bt + (size_t)nxt.pn * tstep : cB;
        for (int t = 0; t < nt; t += 2) {
            const bool last = (t == nt - 2);
            const char* a1 = cA + (size_t)(t + 1) * kstep;
            const char* a2 = last ? nA : cA + (size_t)(t + 2) * kstep; const char* b2 = last ? nB : cB + (size_t)(t + 2) * kstep;
            const char* a3 = a2 + kstep; const char* b3 = b2 + kstep;
            if (last && has_next) S.a_ready(nxt);
            if constexpr (SP2) {
            PG8_LDB(B0, 0, 0); PG8_LDB(B1, 0, 1); PG8_SCHED; PG8_LDA(At, 0, 0); PG8_STAGE(PG8_SA(1, 1), a1 + hstep, voffA);
            PG8_WAIT_V(8); PG8_WAIT_L(0); PG8_BAR; PG8_MMA(0, 0, At, B0); PG8_MMA(0, 1, At, B1); PG8_BAR; PG8_SCHED;
            PG8_LDA(At, 0, 1); PG8_STAGE(PG8_SB(0, 0), b2, voffB); PG8_STAGE(PG8_SB(0, 1), b2 + hstep, voffB); PG8_STAGE(PG8_SA(0, 0), a2, voffA);
            PG8_WAIT_V(8); PG8_WAIT_L(0); PG8_BAR; PG8_MMA(1, 0, At, B0); PG8_MMA(1, 1, At, B1); PG8_BAR; PG8_SCHED;
            PG8_LDB(B0, 1, 0); PG8_LDB(B1, 1, 1); PG8_SCHED; PG8_LDA(At, 1, 0); PG8_STAGE(PG8_SA(0, 1), a2 + hstep, voffA);
            PG8_WAIT_V(8); PG8_WAIT_L(0); PG8_BAR; PG8_MMA(0, 0, At, B0); PG8_MMA(0, 1, At, B1); PG8_BAR; PG8_SCHED;
            PG8_LDA(At, 1, 1); PG8_STAGE(PG8_SB(1, 0), b3, voffB); PG8_STAGE(PG8_SB(1, 1), b3 + hstep, voffB); PG8_STAGE(PG8_SA(1, 0), a3, voffA);
            PG8_WAIT_V(8); PG8_WAIT_L(0); PG8_BAR; PG8_MMA(1, 0, At, B0); PG8_MMA(1, 1, At, B1); PG8_BAR; PG8_SCHED;
            } else {
            PG8_LDB(B0, 0, 0); PG8_SCHED; PG8_LDA(At, 0, 0); PG8_STAGE(PG8_SA(1, 1), a1 + hstep, voffA);
            PG8_WAIT_L(8); PG8_BAR; PG8_WAIT_L(0); PG8_MMA(0, 0, At, B0); PG8_BAR; PG8_SCHED;
            PG8_LDB(B1, 0, 1); PG8_STAGE(PG8_SB(0, 0), b2, voffB);
            PG8_BAR; PG8_WAIT_L(0); PG8_MMA(0, 1, At, B1); PG8_BAR;
            PG8_LDA(At, 0, 1); PG8_STAGE(PG8_SA(0, 0), a2, voffA);
            PG8_BAR; PG8_WAIT_L(0); PG8_MMA(1, 0, At, B0); PG8_BAR; PG8_SCHED;
            PG8_STAGE(PG8_SB(0, 1), b2 + hstep, voffB);
            PG8_WAIT_V(6); PG8_BAR; PG8_MMA(1, 1, At, B1); PG8_BAR;
            PG8_LDB(B0, 1, 0); PG8_SCHED; PG8_LDA(At, 1, 0); PG8_STAGE(PG8_SA(0, 1), a2 + hstep, voffA);
            PG8_WAIT_L(8); PG8_BAR; PG8_WAIT_L(0); PG8_MMA(0, 0, At, B0); PG8_BAR; PG8_SCHED;
            PG8_LDB(B1, 1, 1); PG8_STAGE(PG8_SB(1, 0), b3, voffB);
            PG8_BAR; PG8_WAIT_L(0); PG8_MMA(0, 1, At, B1); PG8_BAR;
            PG8_LDA(At, 1, 1); PG8_STAGE(PG8_SA(1, 0), a3, voffA);
            PG8_BAR; PG8_WAIT_L(0); PG8_MMA(1, 0, At, B0); PG8_BAR; PG8_SCHED;
            PG8_STAGE(PG8_SB(1, 1), b3 + hstep, voffB);
            PG8_WAIT_V(6); PG8_BAR; PG8_MMA(1, 1, At, B1); PG8_BAR;
            }
        }
        if constexpr (ALIGN_EPI) { if (wr == 0) PG8_BAR; }
        if constexpr (!Epi::AFTER_DRAIN) { E(acc, cur, wr, wc, fr, fq); S.done(cur); }
        if (!has_next) break;
#pragma unroll
        for (int a = 0; a < 2; ++a)
#pragma unroll
            for (int b = 0; b < 2; ++b)
#pragma unroll
                for (int m = 0; m < 4; ++m)
#pragma unroll
                    for (int n = 0; n < 2; ++n) acc[a][b][m][n] = (f32x4){0.f, 0.f, 0.f, 0.f};
        cur = nxt; cA = nA; cB = nB; ++ui;
        if constexpr (ALIGN_EPI) { if (wr == 1) PG8_BAR; }
    }
    PG8_WAIT_V(0);
    if constexpr (!ALIGN_EPI) { if (wr == 0) PG8_BAR; }
    PG8_BAR;
    if constexpr (Epi::AFTER_DRAIN) { E.fused(acc, cur, wr, wc, fr, fq, lds, wid, lane); S.done(cur); }
#undef PG8_SA
#undef PG8_SB
#undef PG8_STAGE
#undef PG8_LDA
#undef PG8_LDB
#undef PG8_MMA
#undef PG8_WAIT_V
#undef PG8_WAIT_L
#undef PG8_BAR
#undef PG8_SCHED
}
}
namespace pg8 {
typedef int v4i_t __attribute__((ext_vector_type(4)));
typedef int v8i_t __attribute__((ext_vector_type(8)));
template <class Epi, class Sched, bool ALIGN_EPI = true>
__device__ __forceinline__ void gemm_phase_gather_fp8(PG8_LAS unsigned char* lds, const Gemm g, const Sched& S, const Epi& E, const PG8_LAS unsigned short* gidx, int rowbase, const int tid_in, const int scale_w_e8m0) {
    const int tid = tid_in, wid = __builtin_amdgcn_readfirstlane(tid >> 6), lane = tid & 63, wr = wid >> 2, wc = wid & 3, fr = lane & 15, fq = lane >> 4;
    const int K = g.K; int nt = K / BK; asm volatile("" : "+s"(nt));
    unsigned voffB[2]; int RA[2], CA[2];
#pragma unroll
    for (int i = 0; i < 2; ++i) { int R, C; stage_rc(tid * 16 + i * 8192, R, C); const int Rb = Epi::PERM ? ((R & ~31) + perm32(R & 31)) : R;
        RA[i] = R; CA[i] = C; voffB[i] = (unsigned)(Rb * K + C) * 2u; }
    const size_t kstep = (size_t)(BK * 2);
    const size_t hstep = (size_t)HALF * K * 2;
    const size_t tstep = 2 * hstep;
    const unsigned ldsw = (unsigned)wid * 1024u;
    const int aoff = lds_byte(wr * 64 + fr, fq * 8), boff = lds_byte(wc * 32 + fr, fq * 8);
#define PG8_SA(b, h) (((b) * 2 + (h)) * HTB)
#define PG8_SB(b, h) ((4 + (b) * 2 + (h)) * HTB)
#define PG8_STAGE(bufoff, gbase, voff) do { _Pragma("unroll") for (int _i = 0; _i < 2; ++_i) \
        __builtin_amdgcn_global_load_lds((const unsigned*)((const char*)(gbase) + (voff)[_i]), (PG8_LAS unsigned*)(lds + (bufoff) + ldsw + _i * 8192), 16, 0, 0); } while (0)
#define PG8_LDA(dst, b, h) do { _Pragma("unroll") for (int m = 0; m < 4; ++m) dst[m] = PG8_CAT(*(const PG8_LAS v4i_t*)(lds + PG8_SA(b, h) + aoff + m * 2048), *(const PG8_LAS v4i_t*)(lds + PG8_SA(b, h) + aoff + m * 2048 + 1024)); } while (0)
#define PG8_LDB(dst, b, h) do { _Pragma("unroll") for (int n = 0; n < 2; ++n) dst[n] = PG8_CAT(*(const PG8_LAS v4i_t*)(lds + PG8_SB(b, h) + boff + n * 2048), *(const PG8_LAS v4i_t*)(lds + PG8_SB(b, h) + boff + n * 2048 + 1024)); } while (0)
#define PG8_CAT(x0, x1) __builtin_shufflevector((x0), (x1), 0, 1, 2, 3, 4, 5, 6, 7)
#define PG8_MMA(ai, bj, At, Bt) do { __builtin_amdgcn_s_setprio(1); _Pragma("unroll") for (int m = 0; m < 4; ++m) _Pragma("unroll") for (int n = 0; n < 2; ++n) \
        asm volatile("v_mfma_scale_f32_16x16x128_f8f6f4 %0, %1, %2, %0, %3, %4 op_sel_hi:[0,0,0]" : "+v"(acc[ai][bj][m][n]) : "v"(Bt[n]), "v"(At[m]), "v"(sclw), "v"(scl)); __builtin_amdgcn_s_setprio(0); } while (0)
#define PG8_WAIT_V(n) asm volatile("s_waitcnt vmcnt(" #n ")" ::: "memory")
#define PG8_WAIT_L(n) asm volatile("s_waitcnt lgkmcnt(" #n ")" ::: "memory")
#define PG8_BAR __builtin_amdgcn_s_barrier()
#define PG8_SCHED __builtin_amdgcn_sched_barrier(0)
#define PG8_GOFF(dst, ui_) do { _Pragma("unroll") for (int _h = 0; _h < 2; ++_h) _Pragma("unroll") for (int _i = 0; _i < 2; ++_i) \
        dst[_h][_i] = (unsigned)((rowbase + (int)gidx[(ui_) * 256 + _h * HALF + RA[_i]]) * K + CA[_i]) * 2u; } while (0)
    Unit cur, nxt; int ui = 0;
    if (!S.next(0, cur)) return;
    f32x4 acc[2][2][4][2];
#pragma unroll
    for (int a = 0; a < 2; ++a)
#pragma unroll
        for (int b = 0; b < 2; ++b)
#pragma unroll
            for (int m = 0; m < 4; ++m)
#pragma unroll
                for (int n = 0; n < 2; ++n) acc[a][b][m][n] = (f32x4){0.f, 0.f, 0.f, 0.f};
    v8i_t At[4], B0[2], B1[2];
    int scl = 127, sclw = scale_w_e8m0; asm volatile("" : "+v"(scl), "+v"(sclw));
    unsigned gofC[2][2], g2[2][2];
    PG8_GOFF(gofC, 0);
#pragma unroll
    for (int _h = 0; _h < 2; ++_h)
#pragma unroll
        for (int _i = 0; _i < 2; ++_i) g2[_h][_i] = gofC[_h][_i];
    const char* A0 = (const char*)g.A;
    const char* cB = (const char*)g.Bt + (size_t)cur.pn * tstep;
    S.a_ready(cur);
    PG8_STAGE(PG8_SB(0, 0), cB, voffB); PG8_STAGE(PG8_SB(0, 1), cB + hstep, voffB); PG8_STAGE(PG8_SA(0, 0), A0, gofC[0]); PG8_STAGE(PG8_SA(0, 1), A0, gofC[1]);
    if (wr == 1) PG8_BAR;
    PG8_WAIT_V(2); PG8_BAR;
    PG8_STAGE(PG8_SB(1, 0), cB + kstep, voffB); PG8_STAGE(PG8_SA(1, 0), A0 + kstep, gofC[0]); PG8_STAGE(PG8_SB(1, 1), cB + hstep + kstep, voffB);
    PG8_WAIT_V(6); PG8_BAR;
    for (;;) {
        const bool has_next = S.next(ui + 1, nxt);
        const char* nB = has_next ? (const char*)g.Bt + (size_t)nxt.pn * tstep : cB;
#pragma unroll 1
        for (int t = 0; t < nt; t += 2) {
            const bool last = (t == nt - 2);
            const char* a1 = A0 + (size_t)(t + 1) * kstep;
            const char* a2 = last ? A0 : A0 + (size_t)(t + 2) * kstep; const char* b2 = last ? nB : cB + (size_t)(t + 2) * kstep;
            const char* a3 = a2 + kstep; const char* b3 = b2 + kstep;
            if (last && has_next) PG8_GOFF(g2, ui + 1);
            if (last && has_next) S.a_ready(nxt);
            PG8_LDB(B0, 0, 0); PG8_LDB(B1, 0, 1); PG8_SCHED; PG8_LDA(At, 0, 0); PG8_STAGE(PG8_SA(1, 1), a1, gofC[1]);
            PG8_WAIT_V(8); PG8_WAIT_L(0); PG8_BAR; PG8_MMA(0, 0, At, B0); PG8_MMA(0, 1, At, B1); PG8_BAR; PG8_SCHED;
            PG8_LDA(At, 0, 1); PG8_STAGE(PG8_SB(0, 0), b2, voffB); PG8_STAGE(PG8_SB(0, 1), b2 + hstep, voffB); PG8_STAGE(PG8_SA(0, 0), a2, g2[0]);
            PG8_WAIT_V(8); PG8_WAIT_L(0); PG8_BAR; PG8_MMA(1, 0, At, B0); PG8_MMA(1, 1, At, B1); PG8_BAR; PG8_SCHED;
            PG8_LDB(B0, 1, 0); PG8_LDB(B1, 1, 1); PG8_SCHED; PG8_LDA(At, 1, 0); PG8_STAGE(PG8_SA(0, 1), a2, g2[1]);
            PG8_WAIT_V(8); PG8_WAIT_L(0); PG8_BAR; PG8_MMA(0, 0, At, B0); PG8_MMA(0, 1, At, B1); PG8_BAR; PG8_SCHED;
            PG8_LDA(At, 1, 1); PG8_STAGE(PG8_SB(1, 0), b3, voffB); PG8_STAGE(PG8_SB(1, 1), b3 + hstep, voffB); PG8_STAGE(PG8_SA(1, 0), a3, g2[0]);
            PG8_WAIT_V(8); PG8_WAIT_L(0); PG8_BAR; PG8_MMA(1, 0, At, B0); PG8_MMA(1, 1, At, B1); PG8_BAR; PG8_SCHED;
        }
        if constexpr (ALIGN_EPI) { if (wr == 0) PG8_BAR; }
        asm volatile("s_nop 15\n\ts_nop 15" : "+v"(acc[0][0][0][0]), "+v"(acc[0][0][0][1]), "+v"(acc[0][0][1][0]), "+v"(acc[0][0][1][1]), "+v"(acc[0][0][2][0]), "+v"(acc[0][0][2][1]), "+v"(acc[0][0][3][0]), "+v"(acc[0][0][3][1]), "+v"(acc[0][1][0][0]), "+v"(acc[0][1][0][1]), "+v"(acc[0][1][1][0]), "+v"(acc[0][1][1][1]), "+v"(acc[0][1][2][0]), "+v"(acc[0][1][2][1]), "+v"(acc[0][1][3][0]), "+v"(acc[0][1][3][1]));
        asm volatile("" : "+v"(acc[1][0][0][0]), "+v"(acc[1][0][0][1]), "+v"(acc[1][0][1][0]), "+v"(acc[1][0][1][1]), "+v"(acc[1][0][2][0]), "+v"(acc[1][0][2][1]), "+v"(acc[1][0][3][0]), "+v"(acc[1][0][3][1]), "+v"(acc[1][1][0][0]), "+v"(acc[1][1][0][1]), "+v"(acc[1][1][1][0]), "+v"(acc[1][1][1][1]), "+v"(acc[1][1][2][0]), "+v"(acc[1][1][2][1]), "+v"(acc[1][1][3][0]), "+v"(acc[1][1][3][1]));
        E(acc, cur, wr, wc, fr, fq); S.done(cur);
        if (!has_next) break;
#pragma unroll
        for (int a = 0; a < 2; ++a)
#pragma unroll
            for (int b = 0; b < 2; ++b)
#pragma unroll
                for (int m = 0; m < 4; ++m)
#pragma unroll
                    for (int n = 0; n < 2; ++n) acc[a][b][m][n] = (f32x4){0.f, 0.f, 0.f, 0.f};
        cur = nxt; cB = nB; ++ui;
#pragma unroll
        for (int _h = 0; _h < 2; ++_h)
#pragma unroll
            for (int _i = 0; _i < 2; ++_i) gofC[_h][_i] = g2[_h][_i];
        if constexpr (ALIGN_EPI) { if (wr == 1) PG8_BAR; }
    }
    PG8_WAIT_V(0);
    if constexpr (!ALIGN_EPI) { if (wr == 0) PG8_BAR; }
    PG8_BAR;
#undef PG8_GOFF
#undef PG8_CAT
#undef PG8_SA
#undef PG8_SB
#undef PG8_STAGE
#undef PG8_LDA
#undef PG8_LDB
#undef PG8_MMA
#undef PG8_WAIT_V
#undef PG8_WAIT_L
#undef PG8_BAR
#undef PG8_SCHED
}
}
constexpr int NB = 8, SEQ = 4096, DM = 1024, MTOK = NB * SEQ;
constexpr int NPROJ = 3584;
constexpr int PCOLS_IN = 3600;
constexpr int NEXP = 16, CAP = 512, FFD = 2048, NSLOT = NEXP * NB * CAP;
constexpr float RMS_EPS = 1e-6f;
#ifndef N_LAUNCHES
#define N_LAUNCHES 1
#endif
constexpr int N_PHASES = 12;

constexpr size_t MiB = 1u << 20;
constexpr size_t WS_CTL = 0, CTL_ZERO_BYTES = 64 * 1024;
constexpr size_t WS_QHEAD = 32768;
constexpr size_t WS_MOD = 1 * MiB;
constexpr size_t WS_BIN2 = 1 * MiB + 512 * 1024;
constexpr size_t WS_HEXT = 2 * MiB;
constexpr size_t WS_W3EXT = 21 * MiB;
constexpr size_t WS_GATES = 4 * MiB;
constexpr size_t WS_AFF = 6 * MiB;
constexpr size_t WS_IDX = 8 * MiB, WS_GSEL = 8 * MiB + 256 * 1024;
constexpr size_t WS_INV = 9 * MiB;
constexpr size_t WS_WOUT = 12 * MiB;
constexpr size_t WS_WIN = 14 * MiB;
constexpr size_t WS_P = 24 * MiB;
constexpr size_t WS_H = 248 * MiB;
constexpr size_t WS_UT = 312 * MiB;
constexpr size_t WS_HM = 408 * MiB;
constexpr size_t WS_X1 = WS_HM;
constexpr size_t WS_ZT = 472 * MiB;
constexpr size_t WS_KSP = 504 * MiB;
constexpr size_t WS_WGU = 24 * MiB;
constexpr size_t WS_HID = 280 * MiB;
constexpr size_t WS_HF = 216 * MiB;
constexpr size_t WS_WD = 152 * MiB;
constexpr size_t WS_YS = 24 * MiB;
constexpr size_t WS_END = 536 * MiB;

constexpr int RING_BYTES = 131072;
constexpr int MISC_OFF = 147456 - 256;
constexpr int LDS_BYTES = 147456;

#define GAS __attribute__((address_space(1)))
#define LAS __attribute__((address_space(3)))
#define DI __device__ __forceinline__
typedef unsigned short bf16;
typedef unsigned v4u __attribute__((ext_vector_type(4)));
typedef unsigned v2u __attribute__((ext_vector_type(2)));
typedef float f32x4 __attribute__((ext_vector_type(4)));
typedef GAS unsigned gu32;
#define LDS_WAIT() asm volatile("s_waitcnt lgkmcnt(0)" ::: "memory")
DI float bf2f(unsigned b) { return __uint_as_float(b << 16); }
DI float bflo(unsigned w) { return __uint_as_float(w << 16); }
DI float bfhi(unsigned w) { return __uint_as_float(w & 0xffff0000u); }
DI unsigned f2bf(float f) { unsigned u = __float_as_uint(f); return (u + 0x7fffu + ((u >> 16) & 1u)) >> 16; }
DI unsigned pk2(float lo, float hi) { unsigned r; asm("v_cvt_pk_bf16_f32 %0, %1, %2" : "=v"(r) : "v"(lo), "v"(hi)); return r; }
#define DPP_XOR1 0xB1
#define DPP_XOR2 0x4E
#define DPP_HMIRROR 0x141
#define DPP_MIRROR 0x140
template <int CTRL> DI float dpp_mov(float v) { return __builtin_bit_cast(float, __builtin_amdgcn_update_dpp(0, __builtin_bit_cast(int, v), CTRL, 0xf, 0xf, true)); }
DI float row16_sum(float v) { v += dpp_mov<DPP_XOR1>(v); v += dpp_mov<DPP_XOR2>(v); v += dpp_mov<DPP_HMIRROR>(v); v += dpp_mov<DPP_MIRROR>(v); return v; }
DI float row16_max(float v) { v = fmaxf(v, dpp_mov<DPP_XOR1>(v)); v = fmaxf(v, dpp_mov<DPP_XOR2>(v)); v = fmaxf(v, dpp_mov<DPP_HMIRROR>(v)); v = fmaxf(v, dpp_mov<DPP_MIRROR>(v)); return v; }
DI float lane_bcast(float v, int l) { return __builtin_bit_cast(float, __builtin_amdgcn_readlane(__builtin_bit_cast(int, v), l)); }
DI float wave_sum(float v) { const float r = row16_sum(v); return (lane_bcast(r, 0) + lane_bcast(r, 16)) + (lane_bcast(r, 32) + lane_bcast(r, 48)); }
DI float sigmoidf_(float x) { return __builtin_amdgcn_rcpf(1.f + __expf(-x)); }

namespace pg8 {
struct MoeOrderA {
    int G, c;
    __device__ bool next(int i, Unit& u) const {
        const long L = (long)i * G + c; if (L >= 4096) return false;
        const int e = (int)(L >> 8), r = (int)(L & 255), x = r & 7, j = r >> 3;
        u.pm = e * 16 + 4 * (x >> 1) + (j >> 3); u.pn = e * 16 + 8 * (x & 1) + (j & 7); return true;
    }
    __device__ __forceinline__ void a_ready(const Unit&) const {}
    __device__ __forceinline__ void done(const Unit&) const {}
};
struct MoeOrderB {
    int G, c;
    __device__ bool next(int i, Unit& u) const {
        const long L = (long)i * G + c; if (L >= 1024) return false;
        const int r = (int)(L & 255), e = (int)(L >> 8) * 4 + ((r & 7) >> 1), idx = ((r & 1) << 5) | (r >> 3);
        u.pm = e * 16 + (idx >> 2); u.pn = e * 4 + (idx & 3); return true;
    }
    __device__ __forceinline__ void a_ready(const Unit&) const {}
    __device__ __forceinline__ void done(const Unit&) const {}
};
struct EpiSwiGLU {
    static constexpr bool PERM = true, AFTER_DRAIN = false;
    unsigned char* O;
    __device__ __forceinline__ void operator()(const f32x4 (&acc)[2][2][4][2], const Unit& u, int wr, int wc, int fr, int fq) const {
        const int row0 = u.pm * BM + wr * 64 + fr, col0 = (u.pn & 15) * 128 + wc * 32 + 8 * fq;
#pragma unroll
        for (int ai = 0; ai < 2; ++ai)
#pragma unroll
            for (int m = 0; m < 4; ++m) {
                unsigned char* rowp = O + (size_t)(row0 + ai * HALF + m * 16) * 2048 + col0;
                float h[8];
#pragma unroll
                for (int n = 0; n < 2; ++n)
#pragma unroll
                    for (int i = 0; i < 4; ++i) { const float g = acc[ai][0][m][n][i], up = acc[ai][1][m][n][i]; h[4 * n + i] = (g * up) * __builtin_amdgcn_rcpf(1.f + __builtin_amdgcn_exp2f(g * -1.4426950408889634f)); }
                int w0 = 0, w1 = 0;
                w0 = __builtin_amdgcn_cvt_pk_fp8_f32(h[0], h[1], w0, false); w0 = __builtin_amdgcn_cvt_pk_fp8_f32(h[2], h[3], w0, true);
                w1 = __builtin_amdgcn_cvt_pk_fp8_f32(h[4], h[5], w1, false); w1 = __builtin_amdgcn_cvt_pk_fp8_f32(h[6], h[7], w1, true);
                typedef unsigned u32x2e __attribute__((ext_vector_type(2)));
                *(u32x2e*)rowp = (u32x2e){(unsigned)w0, (unsigned)w1};
            }
    }
};
struct EpiYs {
    static constexpr bool PERM = true, AFTER_DRAIN = false;
    unsigned char* O;
    __device__ __forceinline__ void operator()(const f32x4 (&acc)[2][2][4][2], const Unit& u, int wr, int wc, int fr, int fq) const {
        const int row0 = u.pm * BM + wr * 64 + fr, col0 = (u.pn & 3) * BM + wc * 32 + 8 * fq;
#pragma unroll
        for (int ai = 0; ai < 2; ++ai)
#pragma unroll
            for (int m = 0; m < 4; ++m) {
                unsigned char* rowp = O + (size_t)(row0 + ai * HALF + m * 16) * 1024 + col0;
#pragma unroll
                for (int bj = 0; bj < 2; ++bj) { const f32x4 v0 = acc[ai][bj][m][0], v1 = acc[ai][bj][m][1];
                    int w0 = 0, w1 = 0;
                    w0 = __builtin_amdgcn_cvt_pk_fp8_f32(v0[0], v0[1], w0, false); w0 = __builtin_amdgcn_cvt_pk_fp8_f32(v0[2], v0[3], w0, true);
                    w1 = __builtin_amdgcn_cvt_pk_fp8_f32(v1[0], v1[1], w1, false); w1 = __builtin_amdgcn_cvt_pk_fp8_f32(v1[2], v1[3], w1, true);
                    typedef unsigned u32x2e __attribute__((ext_vector_type(2)));
                    *(u32x2e*)(rowp + bj * HALF) = (u32x2e){(unsigned)w0, (unsigned)w1}; }
            }
    }
};
struct EpiF32P {
    static constexpr bool PERM = false, AFTER_DRAIN = false;
    float* C; int ldc;
    __device__ __forceinline__ void operator()(const f32x4 (&acc)[2][2][4][2], const Unit& u, int wr, int wc, int fr, int fq) const {
        const int row0 = u.pm * BM + wr * 64 + fr, col0 = u.pn * BM + wc * 32 + 4 * fq;
#pragma unroll
        for (int ai = 0; ai < 2; ++ai)
#pragma unroll
            for (int m = 0; m < 4; ++m) { float* rowp = C + (size_t)(row0 + ai * HALF + m * 16) * ldc + col0;
#pragma unroll
                for (int bj = 0; bj < 2; ++bj)
#pragma unroll
                    for (int n = 0; n < 2; ++n) *(f32x4*)(rowp + bj * HALF + n * 16) = acc[ai][bj][m][n]; }
    }
};
struct EpiRes {
    static constexpr bool PERM = true, AFTER_DRAIN = false;
    const float* X; bf16_t* C; const float* mod;
    __device__ __forceinline__ void operator()(const f32x4 (&acc)[2][2][4][2], const Unit& u, int wr, int wc, int fr, int fq) const {
        const int row0 = u.pm * BM + wr * 64 + fr, col0 = u.pn * BM + wc * 32 + 8 * fq;
        const float* gp = mod + (size_t)((u.pm * BM) >> 12) * 6144 + 2048 + col0;
        f32x4 gv[2][2];
#pragma unroll
        for (int bj = 0; bj < 2; ++bj)
#pragma unroll
            for (int n = 0; n < 2; ++n) gv[bj][n] = *(const f32x4*)(gp + bj * HALF + 4 * n);
#pragma unroll
        for (int ai = 0; ai < 2; ++ai)
#pragma unroll
            for (int m = 0; m < 4; ++m) { const size_t off = (size_t)(row0 + ai * HALF + m * 16) * 1024 + col0;
#pragma unroll
                for (int bj = 0; bj < 2; ++bj) {
                    const f32x4 x0 = *(const f32x4*)(X + off + bj * HALF), x1 = *(const f32x4*)(X + off + bj * HALF + 4);
                    const f32x4 v0 = x0 + gv[bj][0] * acc[ai][bj][m][0], v1 = x1 + gv[bj][1] * acc[ai][bj][m][1];
                    u32x4 w; w.x = cvt_pk_bf16(v0[0], v0[1]); w.y = cvt_pk_bf16(v0[2], v0[3]); w.z = cvt_pk_bf16(v1[0], v1[1]); w.w = cvt_pk_bf16(v1[2], v1[3]);
                    *(u32x4*)(C + off + bj * HALF) = w; } }
    }
};
}
#define XB_TMO      128
#define XB_XCNT(j)  (256  + 64 * (j))
#define XB_XSUB(j)  (1280 + 64 * (j))
#define XB_XGEN(j)  (2304 + 64 * (j))
#define XB_TOP      3328
#define XB_TOPGEN   3392
#define XCD_BAR_WORDS 3456
#define XB_SPIN_CAP (1u << 18)

__device__ __forceinline__ unsigned xb_ld(unsigned* p)              { return __hip_atomic_load(p, __ATOMIC_RELAXED, __HIP_MEMORY_SCOPE_AGENT); }
__device__ __forceinline__ unsigned xb_add(unsigned* p, unsigned v) { return __hip_atomic_fetch_add(p, v, __ATOMIC_RELAXED, __HIP_MEMORY_SCOPE_AGENT); }
__device__ __forceinline__ unsigned xb_xcc_id() { return (unsigned)__builtin_amdgcn_s_getreg((3 << 11) | 20) & 0xFu; }
#define XB_SPIN(cond, bar) do { unsigned _sp = 0; while (cond) { __builtin_amdgcn_s_sleep(1); \
    if ((++_sp & 255u) == 0u) { if (xb_ld(&(bar)[XB_TMO])) break; if (_sp > XB_SPIN_CAP) { atomicAdd(&(bar)[XB_TMO], 1u); break; } } } } while (0)

struct XcdBarrier {
    unsigned* bar; unsigned x;
    volatile LAS unsigned* st;
};

__device__ __forceinline__ XcdBarrier xcd_barrier_post(unsigned* bar, volatile LAS unsigned* st, const bool leader) {
    XcdBarrier b; b.bar = bar; b.x = xb_xcc_id(); b.st = st;
    if (leader) (void)xb_add(&bar[XB_XCNT(b.x)], 1u);
    return b;
}
__device__ __forceinline__ void xcd_barrier_complete(unsigned* bar, unsigned x, unsigned& nloc, unsigned& nx) {
    const unsigned G = gridDim.x * gridDim.y * gridDim.z;
    unsigned sum, cnt, mine, sp = 0u;
    for (;;) {
        sum = 0u; cnt = 0u; mine = 0u;
#pragma unroll
        for (unsigned j = 0; j < 16; ++j) { const unsigned c = xb_ld(&bar[XB_XCNT(j)]); sum += c; cnt += (c > 0u) ? 1u : 0u; mine = (j == x) ? c : mine; }
        if (sum == G) break;
        __builtin_amdgcn_s_sleep(1);
        if ((++sp & 255u) == 0u) { if (xb_ld(&bar[XB_TMO])) break; if (sp > XB_SPIN_CAP) { atomicAdd(&bar[XB_TMO], 1u); break; } }
    }
    nloc = mine > 0u ? mine : 1u; nx = cnt > 0u ? cnt : 1u;
}

__device__ __forceinline__ void xcd_barrier(const XcdBarrier& b, const bool leader) {
    asm volatile("s_waitcnt vmcnt(0)" ::: "memory");
    __syncthreads();
    if (leader) {
        unsigned* bar = b.bar;
        __builtin_amdgcn_s_waitcnt(0);
        unsigned nloc = b.st[0], nx = b.st[1];
        if (nloc == 0u) { xcd_barrier_complete(bar, b.x, nloc, nx); b.st[0] = nloc; b.st[1] = nx; }
        const unsigned old = xb_add(&bar[XB_XSUB(b.x)], 1u);
        const unsigned gen = old / nloc;
        if (old + 1u == (gen + 1u) * nloc) {
            __builtin_amdgcn_fence(__ATOMIC_RELEASE, "agent");
            asm volatile("s_waitcnt vmcnt(0)" ::: "memory");
            const unsigned og = xb_add(&bar[XB_TOP], 1u);
            const unsigned tg = og / nx;
            if (og + 1u == (tg + 1u) * nx) xb_add(&bar[XB_TOPGEN], 1u);
            else XB_SPIN(xb_ld(&bar[XB_TOPGEN]) == tg, bar);
            __builtin_amdgcn_fence(__ATOMIC_ACQUIRE, "agent");
            xb_add(&bar[XB_XGEN(b.x)], 1u);
            asm volatile("s_waitcnt vmcnt(0)" ::: "memory");
        } else {
            XB_SPIN(xb_ld(&bar[XB_XGEN(b.x)]) == gen, bar);
            __builtin_amdgcn_fence(__ATOMIC_ACQUIRE, "agent");
            asm volatile("s_waitcnt vmcnt(0)" ::: "memory");
        }
    }
    __syncthreads();
}
#define HD __host__ __device__ __forceinline__
typedef float cf2 __attribute__((ext_vector_type(2)));
#define MK2(a, b) ((cf2){(a), (b)})
#define W16_C1 0.92387953251128674f
#define W16_S1 0.38268343236508977f
#define W16_H  0.70710678118654752f
HD cf2 w32_const(int k) {
    constexpr float C[16] = {1.f, 0.98078528040323043f, 0.92387953251128674f, 0.83146961230254524f, 0.70710678118654752f, 0.55557023301960218f, 0.38268343236508977f, 0.19509032201612825f,
                             0.f, -0.19509032201612825f, -0.38268343236508977f, -0.55557023301960218f, -0.70710678118654752f, -0.83146961230254524f, -0.92387953251128674f, -0.98078528040323043f};
    constexpr float S[16] = {0.f, 0.19509032201612825f, 0.38268343236508977f, 0.55557023301960218f, 0.70710678118654752f, 0.83146961230254524f, 0.92387953251128674f, 0.98078528040323043f,
                             1.f, 0.98078528040323043f, 0.92387953251128674f, 0.83146961230254524f, 0.70710678118654752f, 0.55557023301960218f, 0.38268343236508977f, 0.19509032201612825f};
    return MK2(C[k], -S[k]);
}
#ifndef DUPMASK
#define DUPMASK 0
#endif
#define DUP(k) ((DUPMASK >> (k)) & 1)
struct Args { const float* in[28]; float* out; unsigned char* ws; int ph_lo, ph_hi; };
struct Frame {
    LAS unsigned char* lds;
    int tid, lane, wave, G, blk;
    const struct Args* a;
};
#define REFRESH(F) do { int l_ = lane_id(); asm volatile("" : "+v"(l_)); (F).lane = l_; (F).tid = (F).wave * 64 + l_; } while (0)
#define IN_X 0
#define IN_C 1
#define IN_WADA 2
#define IN_BADA 3
#define IN_GMIX 4
#define IN_WIN 5
#define IN_BIN 6
#define IN_CQKW 7
#define IN_CQKB 8
#define IN_MNG 9
#define IN_CHYW 10
#define IN_CHYB 11
#define IN_HW1 12
#define IN_HB1 13
#define IN_HW2 14
#define IN_HB2 15
#define IN_HW3 16
#define IN_HFREQ 17
#define IN_HDELTA 18
#define IN_HBIAS 19
#define IN_HNG 20
#define IN_WOUT 21
#define IN_GFFN 22
#define IN_WROUTER 23
#define IN_WGATE 24
#define IN_WUP 25
#define IN_WDOWN 26
#define IN_GFINAL 27

DI void transpose_item(const float* src, int ldsrc, bf16* dst, int lddst, LAS float* scr, int lane) {
#pragma unroll 8
    for (int i = 0; i < 32; ++i) { const int kk = 2 * i + (lane >> 5); scr[kk * 33 + (lane & 31)] = src[(size_t)kk * ldsrc + (lane & 31)]; }
    LDS_WAIT(); asm volatile("" ::: "memory");
    const int c = lane & 7;
#pragma unroll
    for (int j = 0; j < 4; ++j) { const int n = (lane >> 3) + 8 * j; const LAS float* s = scr + (8 * c) * 33 + n;
        v4u o; o.x = pk2(s[0 * 33], s[1 * 33]); o.y = pk2(s[2 * 33], s[3 * 33]); o.z = pk2(s[4 * 33], s[5 * 33]); o.w = pk2(s[6 * 33], s[7 * 33]);
        *(v4u*)(dst + (size_t)n * lddst + 8 * c) = o; }
    LDS_WAIT(); asm volatile("" ::: "memory");
}
DI unsigned pk4_fp8(float a, float b, float c2, float d) { int w = 0; w = __builtin_amdgcn_cvt_pk_fp8_f32(a, b, w, false); w = __builtin_amdgcn_cvt_pk_fp8_f32(c2, d, w, true); return (unsigned)w; }
DI void transpose_item_fp8(const float* src, int ldsrc, unsigned char* dst, int lddst, float scale, LAS float* scr, int lane) {
#pragma unroll 8
    for (int i = 0; i < 32; ++i) { const int kk = 2 * i + (lane >> 5); scr[kk * 33 + (lane & 31)] = src[(size_t)kk * ldsrc + (lane & 31)]; }
    LDS_WAIT(); asm volatile("" ::: "memory");
    const int c = lane & 7;
#pragma unroll
    for (int j = 0; j < 4; ++j) { const int n = (lane >> 3) + 8 * j; const LAS float* s = scr + (8 * c) * 33 + n;
        v2u o; o.x = pk4_fp8(s[0 * 33] * scale, s[1 * 33] * scale, s[2 * 33] * scale, s[3 * 33] * scale); o.y = pk4_fp8(s[4 * 33] * scale, s[5 * 33] * scale, s[6 * 33] * scale, s[7 * 33] * scale);
        *(v2u*)(dst + (size_t)n * lddst + 8 * c) = o; }
    LDS_WAIT(); asm volatile("" ::: "memory");
}
DI float reduce16(const float (&acc)[16], int lane) {
    float r8[8], r4[4], r2[2], r1;
    { const bool up = (lane & 32) != 0;
#pragma unroll
      for (int i = 0; i < 8; ++i) { const float mine = up ? acc[8 + i] : acc[i], other = up ? acc[i] : acc[8 + i]; r8[i] = mine + __shfl_xor(other, 32); } }
    { const bool up = (lane & 16) != 0;
#pragma unroll
      for (int i = 0; i < 4; ++i) { const float mine = up ? r8[4 + i] : r8[i], other = up ? r8[i] : r8[4 + i]; r4[i] = mine + __shfl_xor(other, 16); } }
    { const bool up = (lane & 8) != 0;
#pragma unroll
      for (int i = 0; i < 2; ++i) { const float mine = up ? r4[2 + i] : r4[i], other = up ? r4[i] : r4[2 + i]; r2[i] = mine + __shfl_xor(other, 8); } }
    { const bool up = (lane & 4) != 0; const float mine = up ? r2[1] : r2[0], other = up ? r2[0] : r2[1]; r1 = mine + __shfl_xor(other, 4); }
    r1 += __shfl_xor(r1, 1); r1 += __shfl_xor(r1, 2);
    return r1;
}
DI int reduce16_index(int lane) { return ((lane >> 5) & 1) * 8 + ((lane >> 4) & 1) * 4 + ((lane >> 3) & 1) * 2 + ((lane >> 2) & 1); }

DI void p0_prologue(Frame& F) {
    unsigned char* ws = F.a->ws;
    LAS float* scr = (LAS float*)(F.lds + F.wave * 16384);
    const int gw = F.blk * 8 + F.wave, NGW = F.G * 8, lane = F.lane;
    bf16* WIN = (bf16*)(ws + WS_WIN); bf16* WOUT = (bf16*)(ws + WS_WOUT);
    for (int it = gw; it < 1792 + 512; it += NGW) {
        if (it < 1792) { const int kb = it / 112, nb = it % 112, n0 = 32 * nb, k0 = 64 * kb, sc = n0 + (n0 >= 2048 ? 16 : 0);
            transpose_item(F.a->in[IN_WIN] + (size_t)k0 * PCOLS_IN + sc, PCOLS_IN, WIN + (size_t)n0 * 1024 + k0, 1024, scr, lane); }
        else { const int r = it - 1792, kb = r / 32, nb = r % 32, n0 = 32 * nb, k0 = 64 * kb;
            transpose_item(F.a->in[IN_WOUT] + (size_t)k0 * 1024 + n0, 1024, WOUT + (size_t)n0 * 1024 + k0, 1024, scr, lane); }
    }
    {
        bf16* HEXT = (bf16*)(ws + WS_HEXT);
        const float* w1 = F.a->in[IN_HW1]; const float* w2 = F.a->in[IN_HW2];
        const float fr = F.a->in[IN_HFREQ][lane], b1 = F.a->in[IN_HB1][lane], b2 = F.a->in[IN_HB2][lane];
        for (int t = gw; t < SEQ; t += NGW) {
            float a1 = b1 + ((float)t * (1.f / 4095.f)) * w1[lane];
#pragma unroll 4
            for (int i = 0; i < 16; ++i) {
                const float band = 1e-4f + (float)i * ((15.f - 1e-4f) / 15.f);
                const float rev = band * (float)t * (1.f / 4096.f);
                const float fx = rev - floorf(rev);
                float sn, cs; sincospif(2.f * fx, &sn, &cs);
                a1 += cs * w1[(1 + i) * 64 + lane] - sn * w1[(17 + i) * 64 + lane];
            }
            const float h1 = sinf(fr * a1);
            float a2 = b2;
#pragma unroll 8
            for (int i = 0; i < 64; ++i) a2 += __shfl(h1, i) * w2[i * 64 + lane];
            const float h2 = sinf(fr * a2);
            const unsigned hi = f2bf(h2), lo = f2bf(h2 - bf2f(hi));
            bf16* hr = HEXT + (size_t)t * 256 + lane;
            hr[0] = (bf16)hi; hr[64] = (bf16)lo; hr[128] = (bf16)hi; hr[192] = 0;
        }
        bf16* W3EXT = (bf16*)(ws + WS_W3EXT); const float* w3 = F.a->in[IN_HW3];
        for (int i = F.blk * 512 + F.tid; i < 64 * 2048; i += F.G * 512) { const int j = i >> 11, col = i & 2047; const float w = w3[i];
            const unsigned hi = f2bf(w), lo = f2bf(w - bf2f(hi)); bf16* wr_ = W3EXT + (size_t)col * 256 + j;
            wr_[0] = (bf16)hi; wr_[64] = (bf16)hi; wr_[128] = (bf16)lo; wr_[192] = 0; }
    }
    { float* BIN2 = (float*)(ws + WS_BIN2); for (int n = F.blk * 512 + F.tid; n < NPROJ; n += F.G * 512) BIN2[n] = F.a->in[IN_BIN][n + (n >= 2048 ? 16 : 0)]; }
    __syncthreads();
    {
        LAS float* cs = (LAS float*)F.lds;
        LAS float* red = cs + 8192;
        float* MOD = (float*)(ws + WS_MOD); const float* wada = F.a->in[IN_WADA];
        for (int i = F.tid; i < 2048; i += 512) *(LAS f32x4*)(cs + 4 * i) = *(const f32x4*)(F.a->in[IN_C] + 4 * i);
        __syncthreads();
        const int ksl = F.tid >> 3, c4 = F.tid & 7;
        for (int it = F.blk; it < 192; it += F.G) {
            f32x4 w[16];
#pragma unroll
            for (int kk = 0; kk < 16; ++kk) w[kk] = *(const f32x4*)(wada + (size_t)(16 * ksl + kk) * 6144 + 32 * it + 4 * c4);
#pragma unroll
            for (int b = 0; b < 8; ++b) { f32x4 a = (f32x4){0.f, 0.f, 0.f, 0.f};
#pragma unroll
                for (int k4 = 0; k4 < 4; ++k4) { const f32x4 cv = *(const LAS f32x4*)(cs + b * 1024 + 16 * ksl + 4 * k4);
                    a += w[4 * k4] * cv.x + w[4 * k4 + 1] * cv.y + w[4 * k4 + 2] * cv.z + w[4 * k4 + 3] * cv.w; }
                *(LAS f32x4*)(red + (ksl * 8 + b) * 32 + 4 * c4) = a; }
            __syncthreads();
            if (F.tid < 256) { const int b = F.tid >> 5, col = F.tid & 31; float sacc = F.a->in[IN_BADA][32 * it + col];
#pragma unroll 8
                for (int k = 0; k < 64; ++k) sacc += red[(k * 8 + b) * 32 + col];
                MOD[b * 6144 + 32 * it + col] = sacc; }
            __syncthreads();
        }
    }
}

template <bool SECOND, int MODE = 0> DI void p_norm(Frame& F) {
    unsigned char* ws = F.a->ws; const int lane = F.lane;
    LAS float* Wt = (LAS float*)(F.lds + (MODE != 0 ? 8 * 8704 : 0));
    if (MODE == 0) {
    for (int i = F.tid; i < 16384; i += 512) { const int k = i >> 4, g = i & 15; Wt[g * 1024 + k] = SECOND ? F.a->in[IN_WROUTER][k * 16 + g] : F.a->in[IN_WIN][(size_t)k * PCOLS_IN + 2048 + g]; }
    __syncthreads();
    }
    const float* xin = F.a->in[IN_X]; const bf16* x1in = (const bf16*)(ws + WS_X1);
    const float* gvec = SECOND ? F.a->in[IN_GFFN] : F.a->in[IN_GMIX];
    const float* MOD = (const float*)(ws + WS_MOD);
    bf16* HO = (bf16*)(ws + WS_H); unsigned* HO8 = (unsigned*)(ws + WS_HF);
    const int gw = (MODE == 4) ? F.blk * 4 + (F.wave - 4) : F.blk * 8 + F.wave, NGW = (MODE == 4) ? F.G * 4 : F.G * 8;
    typedef typename std::conditional<SECOND, v2u, f32x4>::type raw_t;
    auto load_rows = [&](raw_t (&raw)[4][4], int rq) {
#pragma unroll
        for (int r = 0; r < 4; ++r) { const raw_t* xr = SECOND ? (const raw_t*)((const v2u*)(x1in + (size_t)(4 * rq + r) * 1024) + lane) : (const raw_t*)((const f32x4*)(xin + (size_t)(4 * rq + r) * 1024) + lane);
#pragma unroll
            for (int j = 0; j < 4; ++j) raw[r][j] = __builtin_nontemporal_load(xr + 64 * j); }
    };
    auto process = [&](const raw_t (&raw)[4][4], int rq) __attribute__((always_inline)) {
        const int row0 = 4 * rq, b = row0 >> 12;
        f32x4 v[4][4]; float ss[4];
#pragma unroll
        for (int r = 0; r < 4; ++r) { ss[r] = 0.f;
#pragma unroll
            for (int j = 0; j < 4; ++j) {
                if constexpr (SECOND) { const v2u w = raw[r][j]; v[r][j] = (f32x4){__builtin_bit_cast(float, w.x << 16), __builtin_bit_cast(float, w.x & 0xffff0000u), __builtin_bit_cast(float, w.y << 16), __builtin_bit_cast(float, w.y & 0xffff0000u)}; }
                else v[r][j] = raw[r][j];
                ss[r] += (v[r][j].x * v[r][j].x + v[r][j].y * v[r][j].y) + (v[r][j].z * v[r][j].z + v[r][j].w * v[r][j].w); } }
#pragma unroll
        for (int r = 0; r < 4; ++r) ss[r] = wave_sum(ss[r]);
        const float* mb = MOD + b * 6144 + (SECOND ? 3072 : 0);
#pragma unroll
        for (int j = 0; j < 4; ++j) { const int col = 256 * j + 4 * lane;
            const f32x4 g = *(const f32x4*)(gvec + col), sh = *(const f32x4*)(mb + col), sc = *(const f32x4*)(mb + 1024 + col);
            const f32x4 gs = g * (sc + 1.f);
#pragma unroll
            for (int r = 0; r < 4; ++r) v[r][j] = v[r][j] * (rsqrtf(ss[r] * (1.f / 1024.f) + RMS_EPS)) * gs + sh; }
#pragma unroll
        for (int r = 0; r < 4; ++r) {
            if (SECOND) { unsigned* o4 = HO8 + (size_t)(row0 + r) * 256 + lane;
#pragma unroll
                for (int j = 0; j < 4; ++j) o4[64 * j] = pk4_fp8(v[r][j].x, v[r][j].y, v[r][j].z, v[r][j].w); }
            else { unsigned long long* o8 = (unsigned long long*)(HO + (size_t)(row0 + r) * 1024) + lane;
#pragma unroll
                for (int j = 0; j < 4; ++j) o8[64 * j] = (unsigned long long)pk2(v[r][j].x, v[r][j].y) | ((unsigned long long)pk2(v[r][j].z, v[r][j].w) << 32); } }
        float b4[4][4];
#pragma unroll
        for (int q = 0; q < 4; ++q) {
            asm volatile("" ::: "memory");
            float t[4][4];
#pragma unroll
            for (int k = 0; k < 4; ++k) { const int g = q + 4 * k;
                f32x4 w[4];
#pragma unroll
                for (int j = 0; j < 4; ++j) w[j] = *(const LAS f32x4*)(Wt + g * 1024 + 256 * j + 4 * lane);
#pragma unroll
                for (int r = 0; r < 4; ++r) { float a = 0.f;
#pragma unroll
                    for (int j = 0; j < 4; ++j) a += (v[r][j].x * w[j].x + v[r][j].y * w[j].y) + (v[r][j].z * w[j].z + v[r][j].w * w[j].w);
                    t[k][r] = a; } }
            const bool up8 = (lane & 8) != 0, up4 = (lane & 4) != 0;
#pragma unroll
            for (int r = 0; r < 4; ++r) {
                const float u0 = (up8 ? t[2][r] : t[0][r]) + dpp_mov<DPP_MIRROR>(up8 ? t[0][r] : t[2][r]);
                const float u1 = (up8 ? t[3][r] : t[1][r]) + dpp_mov<DPP_MIRROR>(up8 ? t[1][r] : t[3][r]);
                b4[r][q] = (up4 ? u1 : u0) + dpp_mov<DPP_HMIRROR>(up4 ? u0 : u1); }
        }
        float a4[4], a2[2], val;
#pragma unroll
        for (int r = 0; r < 4; ++r) { float b2[2];
            { const bool up = (lane & 2) != 0;
#pragma unroll
              for (int q = 0; q < 2; ++q) { const float mine = up ? b4[r][q + 2] : b4[r][q], oth = up ? b4[r][q] : b4[r][q + 2]; b2[q] = mine + dpp_mov<DPP_XOR2>(oth); } }
            { const bool up = (lane & 1) != 0; const float mine = up ? b2[1] : b2[0], oth = up ? b2[0] : b2[1]; a4[r] = mine + dpp_mov<DPP_XOR1>(oth); }
        }
        { const bool up = (lane & 32) != 0;
#pragma unroll
          for (int q = 0; q < 2; ++q) { const float mine = up ? a4[q + 2] : a4[q], oth = up ? a4[q] : a4[q + 2]; a2[q] = mine + __shfl_xor(oth, 32); } }
        { const bool up = (lane & 16) != 0; const float mine = up ? a2[1] : a2[0], oth = up ? a2[0] : a2[1]; val = mine + __shfl_xor(oth, 16); }
        const int r_ = lane >> 4, g_ = lane & 15;
        if (!SECOND) ((float*)(ws + WS_GATES))[(size_t)row0 * 16 + lane] = val + F.a->in[IN_BIN][2048 + g_];
        else {
            const float mx = row16_max(val);
            const float ex = __expf(val - mx); const float sm = row16_sum(ex);
            ((float*)(ws + WS_AFF))[((size_t)b * 16 + g_) * SEQ + ((row0 + r_) & 4095)] = ex / sm;
        }
    };
    raw_t rawA[4][4], rawB[4][4];
    int rq = gw; bool hasA = rq < MTOK / 4;
    if (hasA) load_rows(rawA, rq);
#pragma unroll 1
    while (hasA) {
        const int rqB = rq + NGW; const bool hasB = rqB < MTOK / 4;
        if (hasB) load_rows(rawB, rqB);
        process(rawA, rq);
        if (!hasB) break;
        rq = rqB + NGW; hasA = rq < MTOK / 4;
        if (hasA) load_rows(rawA, rq);
        process(rawB, rqB);
    }
}

DI void p3_prep(Frame& F) {
    unsigned char* ws = F.a->ws;
    const bf16* P = (const bf16*)(ws + WS_P);
    {
        bf16* QK = (bf16*)(ws + WS_H);
        const float* cw = F.a->in[IN_CQKW]; const float* cb = F.a->in[IN_CQKB];
        const int nthr = F.G * 512;
        const int cg = F.tid & 127, c0 = 8 * cg;
        float wq0[8], wq1[8], wq2[8], bq[8];
#pragma unroll
        for (int e = 0; e < 8; ++e) { wq0[e] = cw[c0 + e]; wq1[e] = cw[1024 + c0 + e]; wq2[e] = cw[2048 + c0 + e]; bq[e] = cb[c0 + e]; }
        const float scale = (c0 >= 512) ? 0.08838834764831845f : 1.f;
        auto load_trip = [&](v4u (&cur)[4], v4u (&prv)[4], v4u (&nxt)[4], int i0) {
#pragma unroll
            for (int q = 0; q < 4; ++q) { const int token = (i0 + q * nthr) >> 7, t = token & 4095;
                const bf16* p0 = P + (size_t)token * NPROJ + c0;
                cur[q] = *(const v4u*)p0; prv[q] = (v4u){0u, 0u, 0u, 0u}; nxt[q] = (v4u){0u, 0u, 0u, 0u};
                if (t > 0) prv[q] = *(const v4u*)(p0 - NPROJ);
                if (t < SEQ - 1) nxt[q] = *(const v4u*)(p0 + NPROJ); }
        };
        auto process = [&](const v4u (&cur)[4], const v4u (&prv)[4], const v4u (&nxt)[4], int i0) __attribute__((always_inline)) {
#pragma unroll
            for (int q = 0; q < 4; ++q) { const int token = (i0 + q * nthr) >> 7;
                float o[8];
#pragma unroll
                for (int e = 0; e < 8; ++e) {
                    const unsigned wp = prv[q][e >> 1], wc = cur[q][e >> 1], wn = nxt[q][e >> 1];
                    const float xp = (e & 1) ? bfhi(wp) : bflo(wp), xc = (e & 1) ? bfhi(wc) : bflo(wc), xn = (e & 1) ? bfhi(wn) : bflo(wn);
                    const float val = bq[e] + wq0[e] * xp + wq1[e] * xc + wq2[e] * xn;
                    o[e] = val * sigmoidf_(val) * scale;
                }
                v4u w; w.x = pk2(o[0], o[1]); w.y = pk2(o[2], o[3]); w.z = pk2(o[4], o[5]); w.w = pk2(o[6], o[7]);
                *(v4u*)(QK + (size_t)token * 1024 + c0) = w; }
        };
        v4u cA[4], pA[4], nA[4], cB[4], pB[4], nB[4];
        int i0 = F.blk * 512 + F.tid; bool hasA = i0 < MTOK * 128;
        if (hasA) load_trip(cA, pA, nA, i0);
#pragma unroll 1
        while (hasA) {
            const int iB = i0 + 4 * nthr; const bool hasB = iB < MTOK * 128;
            if (hasB) load_trip(cB, pB, nB, iB);
            process(cA, pA, nA, i0);
            if (!hasB) break;
            i0 = iB + 4 * nthr; hasA = i0 < MTOK * 128;
            if (hasA) load_trip(cA, pA, nA, i0);
            process(cB, pB, nB, iB);
        }
    }
    {
        unsigned* UT = (unsigned*)(ws + WS_UT);
        LAS unsigned* tile = (LAS unsigned*)(F.lds + F.wave * 8704);
        const float* cw = F.a->in[IN_CHYW]; const float* cb = F.a->in[IN_CHYB];
        const int lane = F.lane, cg = lane & 7, tl = lane >> 3;
        const int gw = F.blk * 8 + F.wave, NGW = F.G * 8;
        __syncthreads();
#pragma unroll 1
        for (int u = gw; u < 4 * 128 * 24; u += NGW) {
            const int cgq = u % 24, tt = (u / 24) & 127, p = u / (24 * 128), hxc = cgq * 64 + cg * 8;
            float w0[8], w1[8], w2[8], bb[8];
#pragma unroll
            for (int e4 = 0; e4 < 2; ++e4) { const f32x4 a0 = *(const f32x4*)(cw + hxc + 4 * e4), a1 = *(const f32x4*)(cw + 1536 + hxc + 4 * e4), a2 = *(const f32x4*)(cw + 3072 + hxc + 4 * e4), a3 = *(const f32x4*)(cb + hxc + 4 * e4);
#pragma unroll
                for (int i = 0; i < 4; ++i) { w0[4 * e4 + i] = a0[i]; w1[4 * e4 + i] = a1[i]; w2[4 * e4 + i] = a2[i]; bb[4 * e4 + i] = a3[i]; } }
#pragma unroll
            for (int g = 0; g < 4; ++g) {
                const int t = tt * 32 + 8 * g + tl;
                unsigned short o[2][8];
#pragma unroll
                for (int bs = 0; bs < 2; ++bs) {
                    const bf16* p0 = P + (size_t)((2 * p + bs) * SEQ + t) * NPROJ + 2048 + hxc;
                    const v4u cur = *(const v4u*)p0;
                    v4u prv = (v4u){0u, 0u, 0u, 0u}, nxt = (v4u){0u, 0u, 0u, 0u};
                    if (t > 0) prv = *(const v4u*)(p0 - NPROJ);
                    if (t < SEQ - 1) nxt = *(const v4u*)(p0 + NPROJ);
#pragma unroll
                    for (int e = 0; e < 8; ++e) {
                        const unsigned wp = prv[e >> 1], wc = cur[e >> 1], wn = nxt[e >> 1];
                        const float xp = (e & 1) ? bfhi(wp) : bflo(wp), xc = (e & 1) ? bfhi(wc) : bflo(wc), xn = (e & 1) ? bfhi(wn) : bflo(wn);
                        o[bs][e] = (unsigned short)f2bf(bb[e] + w0[e] * xp + w1[e] * xc + w2[e] * xn);
                    }
                }
#pragma unroll
                for (int e = 0; e < 8; ++e) tile[(cg * 8 + e) * 33 + 8 * g + tl] = (unsigned)o[0][e] | ((unsigned)o[1][e] << 16);
            }
            LDS_WAIT(); asm volatile("" ::: "memory");
#pragma unroll 8
            for (int i = 0; i < 32; ++i) { const int cl = 2 * i + (lane >> 5), t5 = lane & 31, hx = cgq * 64 + cl, part = hx >> 9, ch = hx & 511;
                UT[(((size_t)part * 4 + p) * 512 + ch) * SEQ + tt * 32 + t5] = tile[cl * 33 + t5]; }
            LDS_WAIT(); asm volatile("" ::: "memory");
        }
    }
}

#define LAUNDER(x) asm volatile("" : "+v"(x))
#define LDS_BARRIER() do { asm volatile("s_waitcnt lgkmcnt(0)" ::: "memory"); __builtin_amdgcn_s_barrier(); asm volatile("" ::: "memory"); } while (0)

DI void p5_post(Frame& F) {
    unsigned char* ws = F.a->ws; const int lane = F.lane;
    bf16* Y = (bf16*)(ws + WS_H); const bf16* P = (const bf16*)(ws + WS_P); const bf16* HM = (const bf16*)(ws + WS_HM);
    {
        const int gw = F.blk * 8 + F.wave, NGW = F.G * 8;
        const f32x4 g0 = *(const f32x4*)(F.a->in[IN_MNG] + 8 * lane), g1 = *(const f32x4*)(F.a->in[IN_MNG] + 8 * lane + 4);
        for (int row = gw; row < MTOK; row += NGW) {
            const v4u a = *(const v4u*)(HM + (size_t)row * 512 + 8 * lane), bq = *(const v4u*)(HM + ((size_t)MTOK + row) * 512 + 8 * lane);
            const v4u ov = *(const v4u*)(P + (size_t)row * NPROJ + 1536 + 8 * lane);
            float hsum[8], og[8];
#pragma unroll
            for (int e = 0; e < 4; ++e) { hsum[2 * e] = bflo(a[e]) + bflo(bq[e]); hsum[2 * e + 1] = bfhi(a[e]) + bfhi(bq[e]); og[2 * e] = bflo(ov[e]); og[2 * e + 1] = bfhi(ov[e]); }
            float ss = 0.f;
#pragma unroll
            for (int e = 0; e < 8; ++e) ss += hsum[e] * hsum[e];
            ss = row16_sum(ss);
            const float rstd = rsqrtf(ss * (1.f / 128.f) + RMS_EPS);
            const float gg[8] = {g0.x, g0.y, g0.z, g0.w, g1.x, g1.y, g1.z, g1.w};
            float o[8];
#pragma unroll
            for (int e = 0; e < 8; ++e) o[e] = sigmoidf_(og[e]) * hsum[e] * rstd * gg[e];
            v4u w; w.x = pk2(o[0], o[1]); w.y = pk2(o[2], o[3]); w.z = pk2(o[4], o[5]); w.w = pk2(o[6], o[7]);
            *(v4u*)(Y + (size_t)row * 1024 + 8 * lane) = w;
        }
    }
    {
        const bf16* ZT = (const bf16*)(ws + WS_ZT);
        LAS bf16* tile = (LAS bf16*)F.lds;
        const f32x4 g0 = *(const f32x4*)(F.a->in[IN_HNG] + 8 * lane), g1 = *(const f32x4*)(F.a->in[IN_HNG] + 8 * lane + 4);
        const float gg[8] = {g0.x, g0.y, g0.z, g0.w, g1.x, g1.y, g1.z, g1.w};
        __syncthreads();
        for (int u = F.blk; u < 4 * 128; u += F.G) {
            const int p = u >> 7, tt = u & 127;
            for (int pc = F.tid; pc < 4096; pc += 512) {
                const int c = pc >> 3, q = pc & 7;
                const v4u v = *(const v4u*)(ZT + (((size_t)p * 512 + c) * SEQ + tt * 32) * 2 + q * 8);
#pragma unroll
                for (int i = 0; i < 4; ++i) { tile[((4 * q + i) * 2 + 0) * 520 + c] = (bf16)(v[i] & 0xffffu); tile[((4 * q + i) * 2 + 1) * 520 + c] = (bf16)(v[i] >> 16); }
            }
            __syncthreads();
#pragma unroll 2
            for (int rr = 0; rr < 8; ++rr) {
                const int row = F.wave * 8 + rr, t = row >> 1, bs = row & 1, token = (2 * p + bs) * SEQ + tt * 32 + t;
                const v4u v = *(const LAS v4u*)(tile + row * 520 + 8 * lane);
                float z[8];
#pragma unroll
                for (int e = 0; e < 4; ++e) { z[2 * e] = bflo(v[e]); z[2 * e + 1] = bfhi(v[e]); }
                float ss = 0.f;
#pragma unroll
                for (int e = 0; e < 8; ++e) ss += z[e] * z[e];
                ss = row16_sum(ss);
                const float rstd = rsqrtf(ss * (1.f / 128.f) + RMS_EPS);
                v4u w; w.x = pk2(z[0] * rstd * gg[0], z[1] * rstd * gg[1]); w.y = pk2(z[2] * rstd * gg[2], z[3] * rstd * gg[3]);
                w.z = pk2(z[4] * rstd * gg[4], z[5] * rstd * gg[5]); w.w = pk2(z[6] * rstd * gg[6], z[7] * rstd * gg[7]);
                *(v4u*)(Y + (size_t)token * 1024 + 512 + 8 * lane) = w;
            }
            __syncthreads();
        }
    }
}

template <int WSEL> DI void conv_experts(Frame& F) {
    LAS float* scr = (LAS float*)(F.lds + F.wave * 8704); unsigned char* WGU8 = F.a->ws + WS_WGU; unsigned char* WD8 = F.a->ws + WS_WD;
    const int gw = WSEL ? F.blk * 4 + F.wave : F.blk * 8 + F.wave, NGW = WSEL ? F.G * 4 : F.G * 8;
#pragma unroll 1
    for (int base = 4 * gw; base < 49152; base += 4 * NGW) {
#pragma unroll 1
        for (int q = 0; q < 4; ++q) {
            const int it = (int)base + q;
            if (it >= 16384) {
                const int i1 = it - 16384, nb = i1 & 127, kb = (i1 >> 7) & 15, e = i1 >> 11, n0 = 32 * nb, k0 = 64 * kb, j = n0 >> 8, r = n0 & 255, f0 = 128 * j + (r & 127);
                const float* W = (r < 128 ? F.a->in[IN_WGATE] : F.a->in[IN_WUP]) + (size_t)e * 1024 * 2048;
                transpose_item_fp8(W + (size_t)k0 * 2048 + f0, 2048, WGU8 + ((size_t)e * 4096 + n0) * 1024 + k0, 1024, 64.f, scr, F.lane);
            } else {
                const int nb = it & 31, kb = (it >> 5) & 31, e = it >> 10, n0 = 32 * nb, k0 = 64 * kb;
                transpose_item_fp8(F.a->in[IN_WDOWN] + (size_t)e * 2048 * 1024 + (size_t)k0 * 1024 + n0, 1024, WD8 + ((size_t)e * 1024 + n0) * 2048 + k0, 2048, 64.f, scr, F.lane);
            }
        }
    }
}

DI void p8_topk(Frame& F) {
    unsigned char* ws = F.a->ws; const int tid = F.tid, lane = F.lane, wave = F.wave;
    LAS unsigned* hist = (LAS unsigned*)F.lds;
    LAS unsigned* wtot = hist + 256;
    LAS unsigned* ctl = wtot + 8;
    const float* AFF = (const float*)(ws + WS_AFF);
    int* IDX = (int*)(ws + WS_IDX); float* GSEL = (float*)(ws + WS_GSEL); int* INV = (int*)(ws + WS_INV);
    for (int it = F.blk; it < NB * NEXP; it += F.G) {
        const int b = it >> 4, e = it & 15;
        unsigned k8[8];
        { const v4u a = *(const v4u*)(AFF + (size_t)it * SEQ + 8 * tid), c2 = *(const v4u*)(AFF + (size_t)it * SEQ + 8 * tid + 4);
          k8[0] = a.x; k8[1] = a.y; k8[2] = a.z; k8[3] = a.w; k8[4] = c2.x; k8[5] = c2.y; k8[6] = c2.z; k8[7] = c2.w; }
        unsigned prefix = 0u, need = CAP;
#pragma unroll 1
        for (int pass = 0; pass < 4; ++pass) {
            const int shift = 24 - 8 * pass; const unsigned mask = pass ? (0xffffffffu << (shift + 8)) : 0u;
            if (tid < 256) hist[tid] = 0u;
            __syncthreads();
#pragma unroll
            for (int i = 0; i < 8; ++i) if ((k8[i] & mask) == prefix) atomicAdd((unsigned*)(hist + ((k8[i] >> shift) & 255u)), 1u);
            __syncthreads();
            if (wave == 0) {
                const unsigned h0 = hist[4 * lane], h1 = hist[4 * lane + 1], h2 = hist[4 * lane + 2], h3 = hist[4 * lane + 3], s = h0 + h1 + h2 + h3;
                unsigned suf = s;
#pragma unroll
                for (int o = 1; o < 64; o <<= 1) { const unsigned t = __shfl_down(suf, o); if (lane + o < 64) suf += t; }
                const unsigned above = suf - s;
                if (above < need && need <= suf) {
                    unsigned rem = need - above; int bin;
                    if (h3 >= rem) bin = 3; else { rem -= h3; if (h2 >= rem) bin = 2; else { rem -= h2; if (h1 >= rem) bin = 1; else { rem -= h1; bin = 0; } } }
                    ctl[0] = prefix | ((unsigned)(4 * lane + bin) << shift); ctl[1] = rem;
                }
            }
            __syncthreads();
            prefix = ctl[0]; need = ctl[1];
        }
        const unsigned T = prefix;
        unsigned cg = 0u, ce = 0u;
#pragma unroll
        for (int i = 0; i < 8; ++i) { cg += (k8[i] > T) ? 1u : 0u; ce += (k8[i] == T) ? 1u : 0u; }
        const unsigned pack = cg | (ce << 16);
        unsigned inc = pack;
#pragma unroll
        for (int o = 1; o < 64; o <<= 1) { const unsigned t = __shfl_up(inc, o); if (lane >= o) inc += t; }
        if (lane == 63) wtot[wave] = inc;
        __syncthreads();
        unsigned woff = 0u;
#pragma unroll
        for (int w = 0; w < 8; ++w) woff += (w < wave) ? wtot[w] : 0u;
        const unsigned exc = woff + inc - pack;
        unsigned gtb = exc & 0xffffu, eqb = exc >> 16;
#pragma unroll
        for (int i = 0; i < 8; ++i) {
            const int idx = 8 * tid + i; const bool isgt = k8[i] > T, iseq = k8[i] == T, selc = isgt || (iseq && eqb < need);
            const int slot = (int)(gtb + (eqb < need ? eqb : need));
            if (selc) { IDX[it * CAP + slot] = idx; GSEL[it * CAP + slot] = __uint_as_float(k8[i]); }
            INV[((size_t)b * SEQ + idx) * 16 + e] = selc ? slot : -1;
            gtb += isgt ? 1u : 0u; eqb += iseq ? 1u : 0u;
        }
        __syncthreads();
    }
}

typedef float f32x2 __attribute__((ext_vector_type(2)));
template <bool DRY> DI void p12_final(Frame& F) {
    unsigned char* ws = F.a->ws; const int lane = F.lane;
    const int* INV = (const int*)(ws + WS_INV); const float* GSEL = (const float*)(ws + WS_GSEL); const unsigned char* YS = ws + WS_YS; const float* MOD = (const float*)(ws + WS_MOD);
    const int gw = F.blk * 8 + F.wave, NGW = F.G * 8;
    int nslot = INV[(size_t)(4 * gw) * 16 + lane];
    float ngate = (nslot >= 0) ? GSEL[((size_t)((4 * gw) >> 12) * 16 + (lane & 15)) * CAP + nslot] : 0.f;
#pragma unroll 1
    for (int rq = gw; rq < MTOK / 4; rq += NGW) {
        const int row0 = 4 * rq, b = row0 >> 12;
        const int myslot = nslot; const float mygate = ngate;
        const int rown = 4 * ((rq + NGW < MTOK / 4) ? rq + NGW : rq);
        nslot = INV[(size_t)rown * 16 + lane];
        f32x4 v[4][4];
#pragma unroll
        for (int r = 0; r < 4; ++r) { const v2u* xb = (const v2u*)((const bf16*)(ws + WS_X1) + (size_t)(row0 + r) * 1024) + lane;
#pragma unroll
            for (int j = 0; j < 4; ++j) { const v2u w = xb[64 * j]; v[r][j] = (f32x4){__builtin_bit_cast(float, w.x << 16), __builtin_bit_cast(float, w.x & 0xffff0000u), __builtin_bit_cast(float, w.y << 16), __builtin_bit_cast(float, w.y & 0xffff0000u)}; } }
        const unsigned long long mask = __ballot(myslot >= 0);
        f32x4 gt[4];
#pragma unroll
        for (int j = 0; j < 4; ++j) gt[j] = *(const f32x4*)(MOD + b * 6144 + 5120 + 256 * j + 4 * lane);
        float ssq[4];
#pragma unroll
        for (int r = 0; r < 4; ++r) {
            unsigned m = (unsigned)(mask >> (16 * r)) & 0xffffu;
            unsigned y[4][4]; float gk[4];
#pragma unroll
            for (int k = 0; k < 4; ++k) {
                const bool has = (m != 0u); const int e = has ? __builtin_ctz(m) : 0; if (has) m &= m - 1u;
                const int s = has ? __builtin_amdgcn_readlane(myslot, 16 * r + e) : 0;
                gk[k] = has ? __builtin_bit_cast(float, __builtin_amdgcn_readlane(__builtin_bit_cast(int, mygate), 16 * r + e)) * (1.f / 16.f) : 0.f;
                const unsigned* yr = (const unsigned*)(YS + (((size_t)e * NB + b) * CAP + s) * 1024) + lane;
#pragma unroll
                for (int j = 0; j < 4; ++j) y[k][j] = yr[64 * j];
            }
            if (r == 1) ngate = (nslot >= 0) ? GSEL[((size_t)(rown >> 12) * 16 + (lane & 15)) * CAP + nslot] : 0.f;
            f32x4 acc[4];
#pragma unroll
            for (int j = 0; j < 4; ++j) { acc[j] = (f32x4){0.f, 0.f, 0.f, 0.f};
#pragma unroll
                for (int k = 0; k < 4; ++k) { const f32x2 lo2 = __builtin_amdgcn_cvt_pk_f32_fp8((int)y[k][j], false), hi2 = __builtin_amdgcn_cvt_pk_f32_fp8((int)y[k][j], true); acc[j] += (f32x4){lo2.x, lo2.y, hi2.x, hi2.y} * gk[k]; } }
            while (m != 0u) {
                const int e = __builtin_ctz(m); m &= m - 1u;
                const int s = __builtin_amdgcn_readlane(myslot, 16 * r + e);
                const float g = __builtin_bit_cast(float, __builtin_amdgcn_readlane(__builtin_bit_cast(int, mygate), 16 * r + e)) * (1.f / 16.f);
                const unsigned* yr = (const unsigned*)(YS + (((size_t)e * NB + b) * CAP + s) * 1024) + lane;
#pragma unroll
                for (int j = 0; j < 4; ++j) { const unsigned w = yr[64 * j]; const f32x2 lo2 = __builtin_amdgcn_cvt_pk_f32_fp8((int)w, false), hi2 = __builtin_amdgcn_cvt_pk_f32_fp8((int)w, true); acc[j] += (f32x4){lo2.x, lo2.y, hi2.x, hi2.y} * g; }
            }
            float ss = 0.f;
#pragma unroll
            for (int j = 0; j < 4; ++j) { v[r][j] = v[r][j] + gt[j] * acc[j]; ss += (v[r][j].x * v[r][j].x + v[r][j].y * v[r][j].y) + (v[r][j].z * v[r][j].z + v[r][j].w * v[r][j].w); }
            ssq[r] = ss;
        }
#pragma unroll
        for (int r = 0; r < 4; ++r) ssq[r] = wave_sum(ssq[r]);
#pragma unroll
        for (int r = 0; r < 4; ++r) { const float rstd = rsqrtf(ssq[r] * (1.f / 1024.f) + RMS_EPS); f32x4* xr = (f32x4*)((DRY ? (float*)(ws + WS_HID) : F.a->out) + (size_t)(row0 + r) * 1024) + lane;
#pragma unroll
            for (int j = 0; j < 4; ++j) { const f32x4 g = *(const f32x4*)(F.a->in[IN_GFINAL] + 256 * j + 4 * lane); xr[64 * j] = v[r][j] * rstd * g; } }
    }
}

typedef short bf16x8_t __attribute__((ext_vector_type(8)));
DI unsigned offb(unsigned row, unsigned ch) { return 256u * row + 16u * (ch ^ (((row & 3u) << 2) | ((row >> 2) & 3u))); }
DI bf16x8_t tr_read2(unsigned a0, unsigned a1) {
    v2u lo, hi;
    asm volatile("ds_read_b64_tr_b16 %0, %2\n\tds_read_b64_tr_b16 %1, %3\n\ts_waitcnt lgkmcnt(0)" : "=&v"(lo), "=&v"(hi) : "v"(a0), "v"(a1) : "memory");
    const v4u w = (v4u){lo.x, lo.y, hi.x, hi.y};
    return __builtin_bit_cast(bf16x8_t, w);
}
#define TR2(d0, d1, a, o0, o1) "ds_read_b64_tr_b16 %" #d0 ", %" #a " offset:" #o0 "\n\tds_read_b64_tr_b16 %" #d1 ", %" #a " offset:" #o1 "\n\t"
DI void tr_read_vt3(unsigned a, bf16x8_t (&f)[3]) {
    v2u l0, h0, l1, h1, l2, h2;
    asm volatile(TR2(0, 1, 6, 0, 2048) TR2(2, 3, 6, 32, 2080) TR2(4, 5, 6, 64, 2112) "s_waitcnt lgkmcnt(0)"
                 : "=&v"(l0), "=&v"(h0), "=&v"(l1), "=&v"(h1), "=&v"(l2), "=&v"(h2) : "v"(a) : "memory");
    f[0] = __builtin_bit_cast(bf16x8_t, (v4u){l0.x, l0.y, h0.x, h0.y}); f[1] = __builtin_bit_cast(bf16x8_t, (v4u){l1.x, l1.y, h1.x, h1.y}); f[2] = __builtin_bit_cast(bf16x8_t, (v4u){l2.x, l2.y, h2.x, h2.y});
}
DI void tr_read_ve6(unsigned a, bf16x8_t (&f)[2][3]) {
    v2u r[12];
    asm volatile(TR2(0, 1, 12, 0, 512) TR2(2, 3, 12, 32, 544) TR2(4, 5, 12, 64, 576) TR2(6, 7, 12, 4096, 4608) TR2(8, 9, 12, 4128, 4640) TR2(10, 11, 12, 4160, 4672) "s_waitcnt lgkmcnt(0)"
                 : "=&v"(r[0]), "=&v"(r[1]), "=&v"(r[2]), "=&v"(r[3]), "=&v"(r[4]), "=&v"(r[5]), "=&v"(r[6]), "=&v"(r[7]), "=&v"(r[8]), "=&v"(r[9]), "=&v"(r[10]), "=&v"(r[11]) : "v"(a) : "memory");
#pragma unroll
    for (int k = 0; k < 2; ++k)
#pragma unroll
        for (int vt = 0; vt < 3; ++vt) f[k][vt] = __builtin_bit_cast(bf16x8_t, (v4u){r[6 * k + 2 * vt].x, r[6 * k + 2 * vt].y, r[6 * k + 2 * vt + 1].x, r[6 * k + 2 * vt + 1].y});
}
DI void tr_read_kt4(unsigned a0, unsigned a1, bf16x8_t (&f)[4]) {
    v2u r[8];
    asm volatile("ds_read_b64_tr_b16 %0, %8\n\tds_read_b64_tr_b16 %1, %9\n\tds_read_b64_tr_b16 %2, %8 offset:8192\n\tds_read_b64_tr_b16 %3, %9 offset:8192\n\t"
                 "ds_read_b64_tr_b16 %4, %8 offset:16384\n\tds_read_b64_tr_b16 %5, %9 offset:16384\n\tds_read_b64_tr_b16 %6, %8 offset:24576\n\tds_read_b64_tr_b16 %7, %9 offset:24576\n\ts_waitcnt lgkmcnt(0)"
                 : "=&v"(r[0]), "=&v"(r[1]), "=&v"(r[2]), "=&v"(r[3]), "=&v"(r[4]), "=&v"(r[5]), "=&v"(r[6]), "=&v"(r[7]) : "v"(a0), "v"(a1) : "memory");
#pragma unroll
    for (int k = 0; k < 4; ++k) f[k] = __builtin_bit_cast(bf16x8_t, (v4u){r[2 * k].x, r[2 * k].y, r[2 * k + 1].x, r[2 * k + 1].y});
}
typedef __bf16 bf16pair_t __attribute__((ext_vector_type(2)));
DI unsigned cvtpk(float a, float b) { const bf16pair_t v = (bf16pair_t){(__bf16)a, (__bf16)b}; return __builtin_bit_cast(unsigned, v); }
DI bf16x8_t pack8(const f32x4& a, const f32x4& b) { v4u w; asm volatile("v_cvt_pk_bf16_f32 %0, %4, %5\n\tv_cvt_pk_bf16_f32 %1, %6, %7\n\tv_cvt_pk_bf16_f32 %2, %8, %9\n\tv_cvt_pk_bf16_f32 %3, %10, %11\n\ts_nop 1" : "=&v"(w.x), "=&v"(w.y), "=&v"(w.z), "=&v"(w.w) : "v"(a.x), "v"(a.y), "v"(a.z), "v"(a.w), "v"(b.x), "v"(b.y), "v"(b.z), "v"(b.w)); return __builtin_bit_cast(bf16x8_t, w); }
DI bf16x8_t lds_frag(const LAS unsigned char* p) { return *(const LAS bf16x8_t*)p; }
#define MFMA16(a, b, c) __builtin_amdgcn_mfma_f32_16x16x32_bf16((a), (b), (c), 0, 0, 0)
constexpr int ML_QT = 0, ML_KT = 32768, ML_VT = 65536, ML_VE = 81920, ML_CB = 98304, ML_OUT = 110592, ML_SC = 118784, ML_SCSZ = 2688;
DI void p4_mlstm_mfma(Frame& F) {
    unsigned char* ws = F.a->ws; LAS unsigned char* L = F.lds;
    const bf16* QK = (const bf16*)(ws + WS_H); const bf16* P = (const bf16*)(ws + WS_P); const float* GATES = (const float*)(ws + WS_GATES);
    bf16* HM = (bf16*)(ws + WS_HM);
    const int tid = F.tid, lane = F.lane, wave = F.wave, fr = lane & 15, fq = lane >> 4, q4 = fr >> 2, p4 = fr & 3;
    const int tb = (wave < 4) ? wave : 11 - wave;
    const unsigned ldsb = (unsigned)(uintptr_t)L;
    unsigned ro[4], cbw[4], tso[4];
#pragma unroll
    for (int k = 0; k < 4; ++k) { ro[k] = offb(fr, 4 * k + fq); cbw[k] = offb(4 * fq + k, 2 * wave + (fr >> 3)) + 2 * (fr & 7); tso[k] = offb((tid + 512 * k) >> 4, (tid + 512 * k) & 15); }
    for (int it0 = F.blk; it0 < 256; it0 += F.G) {
        const int it = (F.G == 256) ? (((it0 & 7) * 4 + (it0 >> 6)) * 8 + ((it0 >> 3) & 7)) : it0;
        const int vs = it & 3, dir = (it >> 2) & 1, h = (it >> 3) & 3, b = it >> 5;
        __syncthreads();
        for (int i = tid; i < 12288 / 16; i += 512) *(LAS v4u*)(L + ML_CB + 16 * i) = (v4u){0u, 0u, 0u, 0u};
        if (tid < 256) { const int row = tid >> 1, hf = tid & 1;
            *(LAS v4u*)(L + ML_VT + row * 128 + 64 + 16 * hf) = (v4u){hf ? 0u : 0x3F80u, 0u, 0u, 0u};
            *(LAS v4u*)(L + ML_VE + row * 128 + 64 + 16 * hf) = (v4u){0u, 0u, 0u, 0u}; }
        f32x4 Cacc[3];
#pragma unroll
        for (int vt = 0; vt < 3; ++vt) Cacc[vt] = (f32x4){0.f, 0.f, 0.f, 0.f};
        float m_in = -1e30f;
        float gpre[4] = {0.f, 0.f, 0.f, 0.f};
        v4u rqA[4], rkA[4], rvA, rqB[4], rkB[4], rvB;
        auto load_gates = [&](int cj) {
#pragma unroll
            for (int e = 0; e < 2; ++e) { const int tg = cj * 128 + 2 * lane + e, token = b * SEQ + (dir ? SEQ - 1 - tg : tg);
                gpre[2 * e] = GATES[(size_t)token * 16 + 8 * dir + h]; gpre[2 * e + 1] = GATES[(size_t)token * 16 + 8 * dir + 4 + h]; }
        };
        auto scan = [&](int cj) {
            LAS float* SC = (LAS float*)(L + ML_SC + (cj & 1) * ML_SCSZ);
            const float lf0 = fminf(gpre[1], 0.f) - log1pf(__expf(-fabsf(gpre[1]))), lf1 = fminf(gpre[3], 0.f) - log1pf(__expf(-fabsf(gpre[3])));
            float inc = lf0 + lf1;
#pragma unroll
            for (int o = 1; o < 64; o <<= 1) { const float t = __shfl_up(inc, o); if (lane >= o) inc += t; }
            const float b1 = inc, b0 = inc - lf1, u0 = gpre[0] - b0, u1 = gpre[2] - b1;
            float imx = fmaxf(u0, u1);
#pragma unroll
            for (int o = 1; o < 64; o <<= 1) { const float t = __shfl_up(imx, o); if (lane >= o) imx = fmaxf(imx, t); }
            float exm = __shfl_up(imx, 1); if (lane == 0) exm = -3.0e38f;
            const float M0 = fmaxf(m_in, fmaxf(exm, u0)), M1 = fmaxf(m_in, imx);
            const float g = __shfl(b1, 63), Ml = __shfl(M1, 63);
            SC[2 * lane] = u0; SC[2 * lane + 1] = u1;
            SC[128 + 2 * lane] = M0; SC[128 + 2 * lane + 1] = M1;
            SC[256 + 2 * lane] = __expf(m_in - M0); SC[256 + 2 * lane + 1] = __expf(m_in - M1);
            SC[384 + 2 * lane] = __expf(-(b0 + M0)); SC[384 + 2 * lane + 1] = __expf(-(b1 + M1));
            SC[512 + 2 * lane] = __expf(u0 - Ml); SC[512 + 2 * lane + 1] = __expf(u1 - Ml);
            if (lane == 0) SC[640] = __expf(m_in - Ml);
            m_in = g + Ml;
        };
        auto load_tiles = [&](int cj, v4u (&rq)[4], v4u (&rk)[4], v4u& rv) {
#pragma unroll
            for (int i = 0; i < 4; ++i) { const int id = tid + 512 * i, row = id >> 4, ch = id & 15, tg = cj * 128 + row, token = b * SEQ + (dir ? SEQ - 1 - tg : tg);
                rq[i] = *(const v4u*)(QK + (size_t)token * 1024 + h * 128 + 8 * ch); rk[i] = *(const v4u*)(QK + (size_t)token * 1024 + 512 + h * 128 + 8 * ch); }
            { const int row = tid >> 2, pc = tid & 3, tg = cj * 128 + row, token = b * SEQ + (dir ? SEQ - 1 - tg : tg);
              rv = *(const v4u*)(P + (size_t)token * NPROJ + 1024 + h * 128 + 32 * vs + 8 * pc); }
        };
        auto store_tiles = [&](int cj, const v4u (&rq)[4], const v4u (&rk)[4], const v4u& rv) {
            const LAS float* SC = (const LAS float*)(L + ML_SC + (cj & 1) * ML_SCSZ);
#pragma unroll
            for (int i = 0; i < 4; ++i) { *(LAS v4u*)(L + ML_QT + tso[i]) = rq[i]; *(LAS v4u*)(L + ML_KT + tso[i]) = rk[i]; }
            { const int row = tid >> 2, pc = tid & 3; const float e = SC[512 + row];
              *(LAS v4u*)(L + ML_VT + row * 128 + 16 * pc) = rv;
              v4u w; w.x = cvtpk(bflo(rv.x) * e, bfhi(rv.x) * e); w.y = cvtpk(bflo(rv.y) * e, bfhi(rv.y) * e); w.z = cvtpk(bflo(rv.z) * e, bfhi(rv.z) * e); w.w = cvtpk(bflo(rv.w) * e, bfhi(rv.w) * e);
              *(LAS v4u*)(L + ML_VE + row * 128 + 16 * pc) = w;
              if (pc == 0) *(LAS bf16*)(L + ML_VE + row * 128 + 64) = (bf16)f2bf(e); }
        };
        if (wave == 0) { load_gates(0); scan(0); load_gates(1); }
        load_tiles(0, rqA, rkA, rvA);
        __syncthreads();
        store_tiles(0, rqA, rkA, rvA);
        load_tiles(1, rqB, rkB, rvB); load_tiles(2, rqA, rkA, rvA);
        LDS_BARRIER();
#pragma unroll 1
        for (int cj2 = 0; cj2 < 32; cj2 += 2) {
#pragma unroll
          for (int par = 0; par < 2; ++par) {
            const int cj = cj2 + par;
            const LAS float* SC = (const LAS float*)(L + ML_SC + (cj & 1) * ML_SCSZ);
            if (cj + 1 < 32) { if (wave == 0) { scan(cj + 1); if (cj + 2 < 32) load_gates(cj + 2); } }
            bf16x8_t qf[4];
#pragma unroll
            for (int ks = 0; ks < 4; ++ks) qf[ks] = lds_frag(L + ML_QT + tb * 4096 + ro[ks]);
            f32x4 accO[3];
#pragma unroll
            for (int vt = 0; vt < 3; ++vt) { accO[vt] = (f32x4){0.f, 0.f, 0.f, 0.f};
#pragma unroll
                for (int ks = 0; ks < 4; ++ks) accO[vt] = MFMA16(qf[ks], lds_frag(L + ML_CB + vt * 4096 + ro[ks]), accO[vt]); }
            { const f32x4 ei = *(const LAS f32x4*)(SC + 256 + 16 * tb + 4 * fq);
#pragma unroll
              for (int vt = 0; vt < 3; ++vt) accO[vt] = accO[vt] * ei; }
            const float mrow_t = SC[128 + 16 * tb + fr];
            for (int ks2 = 0; ks2 <= (tb >> 1); ++ks2) {
                f32x4 st[2];
#pragma unroll
                for (int hh = 0; hh < 2; ++hh) {
                    const int sb = 2 * ks2 + hh;
                    st[hh] = (f32x4){0.f, 0.f, 0.f, 0.f};
                    if (sb <= tb) {
                        f32x4 acc = (f32x4){0.f, 0.f, 0.f, 0.f};
#pragma unroll
                        for (int kd = 0; kd < 4; ++kd) acc = MFMA16(lds_frag(L + ML_KT + sb * 4096 + ro[kd]), qf[kd], acc);
                        const f32x4 us = *(const LAS f32x4*)(SC + 16 * sb + 4 * fq);
#pragma unroll
                        for (int r = 0; r < 4; ++r) st[hh][r] = acc[r] * __expf(us[r] - mrow_t);
                        if (sb == tb) {
#pragma unroll
                            for (int r = 0; r < 4; ++r) st[hh][r] = (4 * fq + r <= fr) ? st[hh][r] : 0.f; }
                    }
                }
                const bf16x8_t sp = pack8(st[0], st[1]);
                bf16x8_t vf[3]; tr_read_vt3(ldsb + ML_VT + (32 * ks2 + 4 * fq + q4) * 128 + 8 * p4, vf);
#pragma unroll
                for (int vt = 0; vt < 3; ++vt) accO[vt] = MFMA16(sp, vf[vt], accO[vt]);
            }
            { const f32x4 enm = *(const LAS f32x4*)(SC + 384 + 16 * tb + 4 * fq);
#pragma unroll
              for (int r = 0; r < 4; ++r) { const float den = __shfl(accO[2][r], lane & 48), inv = 1.f / fmaxf(fabsf(den), enm[r]);
                  const int t = 16 * tb + 4 * fq + r;
                  const unsigned pr = cvtpk(accO[0][r] * inv, accO[1][r] * inv);
                  *(LAS bf16*)(L + ML_OUT + t * 64 + 2 * fr) = (bf16)(pr & 0xffffu); *(LAS bf16*)(L + ML_OUT + t * 64 + 32 + 2 * fr) = (bf16)(pr >> 16); } }
            { const float sp = SC[640];
#pragma unroll
              for (int vt = 0; vt < 3; ++vt) Cacc[vt] = Cacc[vt] * sp; }
            {
                const unsigned r0 = 8 * fq + q4;
                bf16x8_t kb[4]; tr_read_kt4(ldsb + ML_KT + offb(r0, 2 * wave + (p4 >> 1)) + 8 * (p4 & 1), ldsb + ML_KT + offb(r0 + 4, 2 * wave + (p4 >> 1)) + 8 * (p4 & 1), kb);
                const unsigned ea = ldsb + ML_VE + r0 * 128 + 8 * p4;
#pragma unroll
                for (int kp = 0; kp < 2; ++kp) {
                    bf16x8_t ve[2][3]; tr_read_ve6(ea + kp * 64 * 128, ve);
#pragma unroll
                    for (int k = 0; k < 2; ++k)
#pragma unroll
                        for (int vt = 0; vt < 3; ++vt) Cacc[vt] = MFMA16(ve[k][vt], kb[2 * kp + k], Cacc[vt]);
                }
            }
            LDS_BARRIER();
#pragma unroll
            for (int vt = 0; vt < 3; ++vt)
#pragma unroll
                for (int r = 0; r < 4; r += 2) { const unsigned pr = cvtpk(Cacc[vt][r], Cacc[vt][r + 1]);
                    *(LAS bf16*)(L + ML_CB + vt * 4096 + cbw[r]) = (bf16)(pr & 0xffffu); *(LAS bf16*)(L + ML_CB + vt * 4096 + cbw[r + 1]) = (bf16)(pr >> 16); }
            { const int row = tid >> 2, pc = tid & 3, tg = cj * 128 + row, token = b * SEQ + (dir ? SEQ - 1 - tg : tg);
              *(v4u*)(HM + ((size_t)dir * MTOK + token) * 512 + h * 128 + 32 * vs + 8 * pc) = *(const LAS v4u*)(L + ML_OUT + row * 64 + 16 * pc); }
            if (par == 0) { if (cj + 1 < 32) store_tiles(cj + 1, rqB, rkB, rvB); if (cj + 3 < 32) load_tiles(cj + 3, rqB, rkB, rvB); }
            else          { if (cj + 1 < 32) store_tiles(cj + 1, rqA, rkA, rvA); if (cj + 3 < 32) load_tiles(cj + 3, rqA, rkA, rvA); }
            LDS_BARRIER();
          }
        }
    }
}
HD unsigned pkc(float re, float im) {
#if defined(__HIP_DEVICE_COMPILE__)
    unsigned r; asm("v_cvt_pk_bf16_f32 %0, %1, %2" : "=v"(r) : "v"(re), "v"(im)); return r;
#else
    unsigned a = __builtin_bit_cast(unsigned, re), b = __builtin_bit_cast(unsigned, im);
    a = (a + 0x7fffu + ((a >> 16) & 1u)) >> 16; b = (b + 0x7fffu + ((b >> 16) & 1u)) >> 16; return a | (b << 16);
#endif
}
HD cf2 upk(unsigned w) { return MK2(__builtin_bit_cast(float, w << 16), __builtin_bit_cast(float, w & 0xffff0000u)); }
HD int wphys(int i) { return i + (i >> 4); }
HD cf2 p_mul(cf2 a, cf2 b) { return MK2(a.x * b.x - a.y * b.y, a.x * b.y + a.y * b.x); }
HD cf2 p_mulc(cf2 a, cf2 b) { return MK2(a.x * b.x + a.y * b.y, a.y * b.x - a.x * b.y); }
constexpr int FFT2_XWORDS = 8192 + 512;
HD float cos16(int j) {
#if defined(__HIP_DEVICE_COMPILE__)
    return cospif((float)(j & 15) * 0.125f);
#else
    constexpr float C[16] = {1.f, W16_C1, W16_H, W16_S1, 0.f, -W16_S1, -W16_H, -W16_C1, -1.f, -W16_C1, -W16_H, -W16_S1, 0.f, W16_S1, W16_H, W16_C1}; return C[j & 15];
#endif
}
HD float sin16(int j) { return cos16(j + 12); }
HD void dft_mat_frag(int lane, int s, bool inv, unsigned (&w)[4]) {
    const int r = lane & 31, h = lane >> 5, rr = r >> 1, rp = r & 1;
    float v[8];
#pragma unroll
    for (int j = 0; j < 8; ++j) {
        const int k = 16 * s + 8 * h + j, kk = k >> 1, kp = k & 1, a = (rr * kk) & 15;
        const float c = cos16(a), sn = inv ? -sin16(a) : sin16(a);
        v[j] = (rp == 0) ? (kp == 0 ? c : sn) : (kp == 0 ? -sn : c);
    }
#pragma unroll
    for (int j = 0; j < 4; ++j) w[j] = pkc(v[2 * j], v[2 * j + 1]);
}
HD cf2 tw8k(cf2 t8, int kbase, int h) { const cf2 w0 = w32_const(kbase), w1 = w32_const(kbase + 4); const cf2 w = h ? w1 : w0; return p_mul(t8, w); }
HD cf2 tw8k2(cf2 t8, int kbase, int h) { const cf2 w0 = w32_const(kbase), w1 = w32_const(kbase + 2); const cf2 w = h ? w1 : w0; return p_mul(t8, w); }

template <class TP> HD void f2_passA_fwd_tw(int wave, int lane, TP TW8, cf2 (&wl)[8]) {
    const int n = lane & 31, h = lane >> 5, lo = 32 * wave + n; const cf2 t8 = TW8[lo];
#pragma unroll
    for (int s = 0; s < 2; ++s)
#pragma unroll
        for (int i = 0; i < 4; ++i) wl[4 * s + i] = tw8k(t8, 8 * s + i, h);
}
template <bool BZ> HD void f2_passA_fwd_build(const unsigned (&a8)[8], const unsigned (&b8)[8], const cf2 (&wl)[8], unsigned (&B0)[2][4], unsigned (&B1)[2][4]) {
#pragma unroll
    for (int s = 0; s < 2; ++s)
#pragma unroll
        for (int i = 0; i < 4; ++i) {
            const cf2 a = upk(a8[4 * s + i]); cf2 d = a;
            if (BZ) B0[s][i] = a8[4 * s + i];
            else { const cf2 b = upk(b8[4 * s + i]); B0[s][i] = pkc(a.x + b.x, a.y + b.y); d = MK2(a.x - b.x, a.y - b.y); }
            const cf2 p = p_mul(d, wl[4 * s + i]); B1[s][i] = pkc(p.x, p.y);
        }
}
template <bool BZ, class TP> HD void f2_passA_fwd_load(int wave, int lane, const unsigned (&a8)[8], const unsigned (&b8)[8], TP TW8, unsigned (&B0)[2][4], unsigned (&B1)[2][4]) {
    cf2 wl[8]; f2_passA_fwd_tw(wave, lane, TW8, wl); f2_passA_fwd_build<BZ>(a8, b8, wl, B0, B1);
}
template <class TP> HD void f2_passA_fwd_twr(int wave, int lane, TP TWA, cf2 (&tw)[8]) {
    const int n = lane & 31, h = lane >> 5, lo = 32 * wave + n, t0 = 512 * h + lo;
#pragma unroll
    for (int g = 0; g < 4; ++g)
#pragma unroll
        for (int e = 0; e < 2; ++e) tw[2 * g + e] = TWA[(4 * g + e) * 256 + t0];
}
template <class XP> HD void f2_passA_fwd_st(int wave, int lane, int q, const float (&acc)[16], XP X, const cf2 (&tw)[8]) {
    const int n = lane & 31, h = lane >> 5, lo = 32 * wave + n, p0 = wphys(q * 4096 + lo) + 544 * h;
#pragma unroll
    for (int g = 0; g < 4; ++g)
#pragma unroll
        for (int e = 0; e < 2; ++e) {
            const cf2 o = p_mul(MK2(acc[4 * g + 2 * e], acc[4 * g + 2 * e + 1]), tw[2 * g + e]);
            X[p0 + 272 * (4 * g + e)] = pkc(o.x, o.y);
        }
}
template <class XP, class TP> HD void f2_passA_fwd_store(int wave, int lane, int q, const float (&acc)[16], XP X, TP TWA) { cf2 tw[8]; f2_passA_fwd_twr(wave, lane, TWA, tw); f2_passA_fwd_st(wave, lane, q, acc, X, tw); }
template <class XP> HD void f2_passB_load(int wave, int lane, int q, XP X, unsigned (&B)[2][4]) {
    const int n = lane & 31, h = lane >> 5, bb = 32 * wave + n, p0 = wphys(q * 4096 + (bb >> 4) * 256 + (bb & 15));
#pragma unroll
    for (int s = 0; s < 2; ++s)
#pragma unroll
        for (int i = 0; i < 4; ++i) B[s][i] = X[p0 + 17 * (8 * s + 4 * h + i)];
}
template <class TP> HD void f2_passB_fwd_twr(int wave, int lane, TP TWB, cf2 (&tw)[8]) {
    const int n = lane & 31, h = lane >> 5, bb = 32 * wave + n, lo16 = bb & 15, t0 = 32 * h + lo16;
#pragma unroll
    for (int g = 0; g < 4; ++g)
#pragma unroll
        for (int e = 0; e < 2; ++e) tw[2 * g + e] = TWB[(4 * g + e) * 16 + t0];
}
template <class XP> HD void f2_passB_fwd_st(int wave, int lane, int q, const float (&acc)[16], XP X, const cf2 (&tw)[8]) {
    const int n = lane & 31, h = lane >> 5, bb = 32 * wave + n, lo16 = bb & 15, p0 = wphys(q * 4096 + (bb >> 4) * 256 + lo16) + 34 * h;
#pragma unroll
    for (int g = 0; g < 4; ++g)
#pragma unroll
        for (int e = 0; e < 2; ++e) {
            const cf2 o = p_mul(MK2(acc[4 * g + 2 * e], acc[4 * g + 2 * e + 1]), tw[2 * g + e]);
            X[p0 + 17 * (4 * g + e)] = pkc(o.x, o.y);
        }
}
template <class XP, class TP> HD void f2_passB_fwd_store(int wave, int lane, int q, const float (&acc)[16], XP X, TP TWB) { cf2 tw[8]; f2_passB_fwd_twr(wave, lane, TWB, tw); f2_passB_fwd_st(wave, lane, q, acc, X, tw); }
template <class TP> HD void f2_passB_inv_twr(int wave, int lane, TP TWA, cf2 (&tw)[8]) {
    const int n = lane & 31, h = lane >> 5, bb = 32 * wave + n, hi = bb >> 4, lo16 = bb & 15, t0 = hi * 256 + 32 * h + lo16;
#pragma unroll
    for (int g = 0; g < 4; ++g)
#pragma unroll
        for (int e = 0; e < 2; ++e) tw[2 * g + e] = TWA[t0 + 16 * (4 * g + e)];
}
template <class XP> HD void f2_passB_inv_st(int wave, int lane, int q, const float (&acc)[16], XP X, const cf2 (&tw)[8]) {
    const int n = lane & 31, h = lane >> 5, bb = 32 * wave + n, hi = bb >> 4, lo16 = bb & 15, p0 = wphys(q * 4096 + hi * 256 + lo16) + 34 * h;
#pragma unroll
    for (int g = 0; g < 4; ++g)
#pragma unroll
        for (int e = 0; e < 2; ++e) {
            const cf2 o = p_mulc(MK2(acc[4 * g + 2 * e], acc[4 * g + 2 * e + 1]), tw[2 * g + e]);
            X[p0 + 17 * (4 * g + e)] = pkc(o.x, o.y);
        }
}
template <class XP, class TP> HD void f2_passB_inv_store(int wave, int lane, int q, const float (&acc)[16], XP X, TP TWA) { cf2 tw[8]; f2_passB_inv_twr(wave, lane, TWA, tw); f2_passB_inv_st(wave, lane, q, acc, X, tw); }
template <class XP> HD void f2_passC_load(int wave, int lane, int q, XP X, unsigned (&B)[2][4]) {
    const int n = lane & 31, h = lane >> 5, p0 = 17 * (q * 256 + 32 * wave + n);
#pragma unroll
    for (int s = 0; s < 2; ++s)
#pragma unroll
        for (int i = 0; i < 4; ++i) B[s][i] = X[p0 + 8 * s + 4 * h + i];
}
template <class XP> HD void f2_passC_fwd_store(int wave, int lane, int q, const float (&acc)[16], const cf2 (&kv)[8], XP X) {
    const int n = lane & 31, h = lane >> 5, p0 = 17 * (q * 256 + 32 * wave + n);
#pragma unroll
    for (int g = 0; g < 4; ++g)
#pragma unroll
        for (int e = 0; e < 2; ++e) {
            const cf2 o = p_mul(MK2(acc[4 * g + 2 * e], acc[4 * g + 2 * e + 1]), kv[2 * g + e]);
            X[p0 + 4 * g + e + 2 * h] = pkc(o.x, o.y);
        }
}
template <class TP> HD void f2_passC_inv_twr(int wave, int lane, TP TWB, cf2 (&tw)[8]) {
    const int n = lane & 31, h = lane >> 5, bb = 32 * wave + n, rB = bb & 15, t0 = rB * 16 + 2 * h;
#pragma unroll
    for (int g = 0; g < 4; ++g)
#pragma unroll
        for (int e = 0; e < 2; ++e) tw[2 * g + e] = TWB[t0 + 4 * g + e];
}
template <class XP> HD void f2_passC_inv_st(int wave, int lane, int q, const float (&acc)[16], XP X, const cf2 (&tw)[8]) {
    const int n = lane & 31, h = lane >> 5, bb = 32 * wave + n, p0 = 17 * (q * 256 + bb) + 2 * h;
#pragma unroll
    for (int g = 0; g < 4; ++g)
#pragma unroll
        for (int e = 0; e < 2; ++e) {
            const cf2 o = p_mulc(MK2(acc[4 * g + 2 * e], acc[4 * g + 2 * e + 1]), tw[2 * g + e]);
            X[p0 + 4 * g + e] = pkc(o.x, o.y);
        }
}
template <class XP, class TP> HD void f2_passC_inv_store(int wave, int lane, int q, const float (&acc)[16], XP X, TP TWB) { cf2 tw[8]; f2_passC_inv_twr(wave, lane, TWB, tw); f2_passC_inv_st(wave, lane, q, acc, X, tw); }
template <class XP> HD void f2_passA_inv_load(int wave, int lane, int q, XP X, unsigned (&B)[2][4]) {
    const int n = lane & 31, h = lane >> 5, p0 = wphys(q * 4096 + 32 * wave + n);
#pragma unroll
    for (int s = 0; s < 2; ++s)
#pragma unroll
        for (int i = 0; i < 4; ++i) B[s][i] = X[p0 + 272 * (8 * s + 4 * h + i)];
}
template <class TP> HD void f2_passA_inv_tw(int wave, int lane, TP TW8, cf2 (&wc)[8]) {
    const int n = lane & 31, h = lane >> 5, lo = 32 * wave + n; const cf2 t8 = TW8[lo];
#pragma unroll
    for (int g = 0; g < 4; ++g)
#pragma unroll
        for (int e = 0; e < 2; ++e) wc[2 * g + e] = tw8k2(t8, 4 * g + e, h);
}
HD void f2_passA_inv_comb(const float (&acc0)[16], const float (&acc1)[16], const cf2 (&wc)[8], cf2 (&y)[8]) {
#pragma unroll
    for (int g = 0; g < 4; ++g)
#pragma unroll
        for (int e = 0; e < 2; ++e) {
            const cf2 u0 = MK2(acc0[4 * g + 2 * e], acc0[4 * g + 2 * e + 1]), u1 = MK2(acc1[4 * g + 2 * e], acc1[4 * g + 2 * e + 1]);
            const cf2 p = p_mulc(u1, wc[2 * g + e]);
            y[2 * g + e] = MK2(u0.x + p.x, u0.y + p.y);
        }
}
template <class TP> HD void f2_passA_inv_combine(int wave, int lane, const float (&acc0)[16], const float (&acc1)[16], TP TW8, cf2 (&y)[8]) { cf2 wc[8]; f2_passA_inv_tw(wave, lane, TW8, wc); f2_passA_inv_comb(acc0, acc1, wc, y); }
typedef float f32x16 __attribute__((ext_vector_type(16)));
#define MFMA32(a, b, c) __builtin_amdgcn_mfma_f32_32x32x16_bf16(__builtin_bit_cast(bf16x8_t, (a)), __builtin_bit_cast(bf16x8_t, (b)), (c), 0, 0, 0)
constexpr int H3_X = 0, H3_XQ = 34816, H3_Z1 = 69632, H3_ZQ = 16384, H3_TWA = 102400, H3_TWB = 135168, H3_TW8 = 137216, H3_TS = 34816;
struct DftMats { v4u f[2], i[2]; };
DI void h3_mm2(const DftMats& M, bool inv, const unsigned (&B0)[2][4], const unsigned (&B1)[2][4], float (&out0)[16], float (&out1)[16]) {
    f32x16 acc0, acc1;
#pragma unroll
    for (int i = 0; i < 16; ++i) { acc0[i] = 0.f; acc1[i] = 0.f; }
    const v4u b00 = (v4u){B0[0][0], B0[0][1], B0[0][2], B0[0][3]}, b01 = (v4u){B0[1][0], B0[1][1], B0[1][2], B0[1][3]};
    const v4u b10 = (v4u){B1[0][0], B1[0][1], B1[0][2], B1[0][3]}, b11 = (v4u){B1[1][0], B1[1][1], B1[1][2], B1[1][3]};
    acc0 = MFMA32(inv ? M.i[0] : M.f[0], b00, acc0); acc1 = MFMA32(inv ? M.i[0] : M.f[0], b10, acc1);
    acc0 = MFMA32(inv ? M.i[1] : M.f[1], b01, acc0); acc1 = MFMA32(inv ? M.i[1] : M.f[1], b11, acc1);
#pragma unroll
    for (int i = 0; i < 16; ++i) { out0[i] = acc0[i]; out1[i] = acc1[i]; }
}
DI void mfma_ready(unsigned (&B)[2][4]) {
    asm volatile("s_nop 1" : "+v"(B[0][0]), "+v"(B[0][1]), "+v"(B[0][2]), "+v"(B[0][3]), "+v"(B[1][0]), "+v"(B[1][1]), "+v"(B[1][2]), "+v"(B[1][3]));
}
template <int O> DI void hy3_conv2(int wave, int lane0, const DftMats& M, const unsigned (&vinA)[8], const unsigned (&vinB)[8], LAS unsigned* X0, LAS unsigned* Z10, const LAS cf2* TWA, const LAS cf2* TWB, const LAS cf2* TW8,
                                   const cf2* kg, const unsigned* UzA, const unsigned* UxA, unsigned* ztA, const unsigned* UzB, const unsigned* UxB, unsigned* ztB, float bias) {
    const unsigned zero8[8] = {0u, 0u, 0u, 0u, 0u, 0u, 0u, 0u};
    LAS unsigned* X1 = X0 + H3_XQ / 4; LAS unsigned* Z11 = Z10 + H3_ZQ / 4;
    { int lane = lane0; LAUNDER(lane); const int n = lane & 31, h = lane >> 5, lo = 32 * wave + n;
      cf2 wl[8], tw[8]; f2_passA_fwd_tw(wave, lane, TW8, wl); f2_passA_fwd_twr(wave, lane, TWA, tw);
      unsigned a8[8], b8[8];
#pragma unroll
      for (int s = 0; s < 2; ++s)
#pragma unroll
          for (int i = 0; i < 4; ++i) { a8[4 * s + i] = (O == 0) ? vinA[4 * s + i] : Z10[(8 * s + 4 * h + i) * 256 + lo]; b8[4 * s + i] = (O == 0) ? vinB[4 * s + i] : Z11[(8 * s + 4 * h + i) * 256 + lo]; }
      unsigned B0[2][4], B1[2][4], C0[2][4], C1[2][4];
      f2_passA_fwd_build<true>(a8, zero8, wl, B0, B1); f2_passA_fwd_build<true>(b8, zero8, wl, C0, C1);
      mfma_ready(B0); mfma_ready(B1); mfma_ready(C0); mfma_ready(C1);
      float a0[16], a1[16], c0[16], c1[16]; h3_mm2(M, false, B0, B1, a0, a1); h3_mm2(M, false, C0, C1, c0, c1);
      f2_passA_fwd_st(wave, lane, 0, a0, X0, tw); f2_passA_fwd_st(wave, lane, 1, a1, X0, tw); f2_passA_fwd_st(wave, lane, 0, c0, X1, tw); f2_passA_fwd_st(wave, lane, 1, c1, X1, tw); }
    LDS_BARRIER();
    cf2 kv0[8], kv1[8];
    { int lane = lane0; LAUNDER(lane);
#pragma unroll
      for (int p = 0; p < 8; ++p) { kv0[p] = kg[((0 * 8 + wave) * 8 + p) * 64 + lane]; kv1[p] = kg[((1 * 8 + wave) * 8 + p) * 64 + lane]; }
      cf2 tw[8]; f2_passB_fwd_twr(wave, lane, TWB, tw);
      unsigned B0[2][4], B1[2][4], C0[2][4], C1[2][4];
      f2_passB_load(wave, lane, 0, X0, B0); f2_passB_load(wave, lane, 1, X0, B1); f2_passB_load(wave, lane, 0, X1, C0); f2_passB_load(wave, lane, 1, X1, C1);
      float a0[16], a1[16], c0[16], c1[16]; h3_mm2(M, false, B0, B1, a0, a1); h3_mm2(M, false, C0, C1, c0, c1);
      f2_passB_fwd_st(wave, lane, 0, a0, X0, tw); f2_passB_fwd_st(wave, lane, 1, a1, X0, tw); f2_passB_fwd_st(wave, lane, 0, c0, X1, tw); f2_passB_fwd_st(wave, lane, 1, c1, X1, tw); }
    LDS_WAIT(); asm volatile("" ::: "memory");
    { int lane = lane0; LAUNDER(lane);
      cf2 tw[8]; f2_passC_inv_twr(wave, lane, TWB, tw);
      unsigned B0[2][4], B1[2][4], C0[2][4], C1[2][4];
      f2_passC_load(wave, lane, 0, X0, B0); f2_passC_load(wave, lane, 1, X0, B1); f2_passC_load(wave, lane, 0, X1, C0); f2_passC_load(wave, lane, 1, X1, C1);
      float a0[16], a1[16], c0[16], c1[16]; h3_mm2(M, false, B0, B1, a0, a1); h3_mm2(M, false, C0, C1, c0, c1);
      f2_passC_fwd_store(wave, lane, 0, a0, kv0, X0); f2_passC_fwd_store(wave, lane, 1, a1, kv1, X0); f2_passC_fwd_store(wave, lane, 0, c0, kv0, X1); f2_passC_fwd_store(wave, lane, 1, c1, kv1, X1);
      asm volatile("" ::: "memory");
      f2_passC_load(wave, lane, 0, X0, B0); f2_passC_load(wave, lane, 1, X0, B1); f2_passC_load(wave, lane, 0, X1, C0); f2_passC_load(wave, lane, 1, X1, C1);
      h3_mm2(M, true, B0, B1, a0, a1); h3_mm2(M, true, C0, C1, c0, c1);
      f2_passC_inv_st(wave, lane, 0, a0, X0, tw); f2_passC_inv_st(wave, lane, 1, a1, X0, tw); f2_passC_inv_st(wave, lane, 0, c0, X1, tw); f2_passC_inv_st(wave, lane, 1, c1, X1, tw); }
    LDS_WAIT(); asm volatile("" ::: "memory");
    unsigned fxA[8], fzA[8], fxB[8], fzB[8];
    { int lane = lane0; LAUNDER(lane);
      { const int n = lane & 31, h = lane >> 5, lo = 32 * wave + n;
#pragma unroll
        for (int g = 0; g < 4; ++g)
#pragma unroll
            for (int e = 0; e < 2; ++e) { const int t = (4 * g + 2 * h + e) * 256 + lo; fxA[2 * g + e] = UxA[t]; fzA[2 * g + e] = (O == 0) ? UzA[t] : 0u; fxB[2 * g + e] = UxB[t]; fzB[2 * g + e] = (O == 0) ? UzB[t] : 0u; } }
      cf2 tw[8]; f2_passB_inv_twr(wave, lane, TWA, tw);
      unsigned B0[2][4], B1[2][4], C0[2][4], C1[2][4];
      f2_passB_load(wave, lane, 0, X0, B0); f2_passB_load(wave, lane, 1, X0, B1); f2_passB_load(wave, lane, 0, X1, C0); f2_passB_load(wave, lane, 1, X1, C1);
      float a0[16], a1[16], c0[16], c1[16]; h3_mm2(M, true, B0, B1, a0, a1); h3_mm2(M, true, C0, C1, c0, c1);
      f2_passB_inv_st(wave, lane, 0, a0, X0, tw); f2_passB_inv_st(wave, lane, 1, a1, X0, tw); f2_passB_inv_st(wave, lane, 0, c0, X1, tw); f2_passB_inv_st(wave, lane, 1, c1, X1, tw); }
    LDS_BARRIER();
    { int lane = lane0; LAUNDER(lane); const int n = lane & 31, h = lane >> 5, lo = 32 * wave + n;
      cf2 wc[8]; f2_passA_inv_tw(wave, lane, TW8, wc);
      unsigned B0[2][4], B1[2][4], C0[2][4], C1[2][4];
      f2_passA_inv_load(wave, lane, 0, X0, B0); f2_passA_inv_load(wave, lane, 1, X0, B1); f2_passA_inv_load(wave, lane, 0, X1, C0); f2_passA_inv_load(wave, lane, 1, X1, C1);
      unsigned zq[2][8];
#pragma unroll
      for (int p = 0; p < 8; ++p) { const int t = (4 * (p >> 1) + 2 * h + (p & 1)) * 256 + lo; zq[0][p] = (O == 1) ? Z10[t] : 0u; zq[1][p] = (O == 1) ? Z11[t] : 0u; }
      float a0[16], a1[16], c0[16], c1[16]; h3_mm2(M, true, B0, B1, a0, a1); h3_mm2(M, true, C0, C1, c0, c1);
#pragma unroll
      for (int q = 0; q < 2; ++q) { LAS unsigned* Z1 = q ? Z11 : Z10; unsigned* zt = q ? ztB : ztA;
          cf2 y[8]; if (q == 0) f2_passA_inv_comb(a0, a1, wc, y); else f2_passA_inv_comb(c0, c1, wc, y);
#pragma unroll
          for (int g = 0; g < 4; ++g)
#pragma unroll
              for (int e = 0; e < 2; ++e) { const int p = 2 * g + e, t = (4 * g + 2 * h + e) * 256 + lo; const unsigned fx = q ? fxB[p] : fxA[p], fz = q ? fzB[p] : fzA[p];
                  if (O == 0) Z1[t] = pkc(bflo(fx) * (y[p].x + bias * bflo(fz)), bfhi(fx) * (y[p].y + bias * bfhi(fz)));
                  else { const cf2 z1 = upk(zq[q][p]); zt[t] = pkc(bflo(fx) * (y[p].x + bias * z1.x), bfhi(fx) * (y[p].y + bias * z1.y)); } } } }
    LDS_BARRIER();
}
DI void p4_hyena3(Frame& F) {
    unsigned char* ws = F.a->ws; const int tid = F.tid, wave = F.wave;
    LAS unsigned* X = (LAS unsigned*)(F.lds + H3_X); LAS unsigned* Z1 = (LAS unsigned*)(F.lds + H3_Z1);
    LAS cf2* TWA = (LAS cf2*)(F.lds + H3_TWA); LAS cf2* TWB = (LAS cf2*)(F.lds + H3_TWB); LAS cf2* TW8 = (LAS cf2*)(F.lds + H3_TW8);
    LAS float* TS = (LAS float*)(F.lds + H3_TS);
    const float* FILT = (const float*)F.a->out;
    cf2* KG = (cf2*)(ws + WS_KSP) + (size_t)F.blk * 16384;
    const unsigned* UT = (const unsigned*)(ws + WS_UT); unsigned* ZT = (unsigned*)(ws + WS_ZT);
#pragma unroll 1
    for (int i = tid; i < 4096; i += 512) { const int r = i >> 8, lo = i & 255; float sn, cs; sincospif((float)(r * lo) * (1.f / 2048.f), &sn, &cs); TWA[i] = MK2(cs, -sn); }
    if (tid < 256) { float sn, cs; const int r = tid >> 4, lo = tid & 15; sincospif((float)(r * lo) * (1.f / 128.f), &sn, &cs); TWB[tid] = MK2(cs, -sn);
        sincospif((float)tid * (1.f / 4096.f), &sn, &cs); TW8[tid] = MK2(cs, -sn); }
    DftMats M;
    { unsigned w[4];
      dft_mat_frag(F.lane, 0, false, w); M.f[0] = (v4u){w[0], w[1], w[2], w[3]}; dft_mat_frag(F.lane, 1, false, w); M.f[1] = (v4u){w[0], w[1], w[2], w[3]};
      dft_mat_frag(F.lane, 0, true, w); M.i[0] = (v4u){w[0], w[1], w[2], w[3]}; dft_mat_frag(F.lane, 1, true, w); M.i[1] = (v4u){w[0], w[1], w[2], w[3]}; }
    __syncthreads();
    for (int c = F.blk; c < 512; c += F.G) {
        for (int o2 = 0; o2 < (DUP(15) ? 4 : 2); ++o2) { const int o = o2 & 1;
            const float adf = fabsf(F.a->in[IN_HDELTA][(o * 2) * 512 + c]), adb = fabsf(F.a->in[IN_HDELTA][(o * 2 + 1) * 512 + c]);
            {
                const float* Ff = FILT + (size_t)((o * 2) * 512 + c) * SEQ; const float* Fb = FILT + (size_t)((o * 2 + 1) * 512 + c) * SEQ;
                if (tid == 0) TS[SEQ] = 0.f;
#pragma unroll
                for (int i = 0; i < 8; i += 2) {
                    const int t0 = tid + 512 * i, t1 = t0 + 512; const float f0 = Ff[t0], b0 = Fb[t0], f1 = Ff[t1], b1 = Fb[t1];
                    const float tt0 = (float)t0 * (1.f / 4095.f), tt1 = (float)t1 * (1.f / 4095.f);
                    const float hf0 = f0 * (__expf(-tt0 * adf) + 0.05f), hb0 = b0 * (__expf(-tt0 * adb) + 0.05f), hf1 = f1 * (__expf(-tt1 * adf) + 0.05f), hb1 = b1 * (__expf(-tt1 * adb) + 0.05f);
                    if (t0 == 0) TS[0] = hf0 + hb0; else { TS[t0] = hf0; TS[2 * SEQ - t0] = hb0; }
                    TS[t1] = hf1; TS[2 * SEQ - t1] = hb1; }
            }
            __syncthreads();
            { int lane = F.lane; LAUNDER(lane); const int n = lane & 31, h = lane >> 5, lo = 32 * wave + n;
              unsigned B0[2][4], B1[2][4]; const cf2 t8 = TW8[lo];
#pragma unroll
              for (int s = 0; s < 2; ++s)
#pragma unroll
                  for (int i = 0; i < 4; ++i) { const int t = (8 * s + 4 * h + i) * 256 + lo; const float a = TS[t], b = TS[SEQ + t], d = a - b; const cf2 w = tw8k(t8, 8 * s + i, h);
                      B0[s][i] = pkc(a + b, 0.f); B1[s][i] = pkc(d * w.x, d * w.y); }
              mfma_ready(B0); mfma_ready(B1);
              float a0[16], a1[16]; h3_mm2(M, false, B0, B1, a0, a1);
              f2_passA_fwd_store(wave, lane, 0, a0, X, TWA); f2_passA_fwd_store(wave, lane, 1, a1, X, TWA); }
            __syncthreads();
            { int lane = F.lane; LAUNDER(lane);
              unsigned B0[2][4], B1[2][4]; f2_passB_load(wave, lane, 0, X, B0); f2_passB_load(wave, lane, 1, X, B1);
              float a0[16], a1[16]; h3_mm2(M, false, B0, B1, a0, a1);
              f2_passB_fwd_store(wave, lane, 0, a0, X, TWB); f2_passB_fwd_store(wave, lane, 1, a1, X, TWB); }
            LDS_WAIT(); asm volatile("" ::: "memory");
            { int lane = F.lane; LAUNDER(lane);
              unsigned B0[2][4], B1[2][4]; f2_passC_load(wave, lane, 0, X, B0); f2_passC_load(wave, lane, 1, X, B1);
              float a0[16], a1[16]; h3_mm2(M, false, B0, B1, a0, a1);
              cf2* kg = KG + o * 8192;
#pragma unroll
              for (int p = 0; p < 8; ++p) { const int g = p >> 1, e = p & 1;
                  kg[((0 * 8 + wave) * 8 + p) * 64 + lane] = MK2(a0[4 * g + 2 * e] * (1.f / 8192.f), a0[4 * g + 2 * e + 1] * (1.f / 8192.f));
                  kg[((1 * 8 + wave) * 8 + p) * 64 + lane] = MK2(a1[4 * g + 2 * e] * (1.f / 8192.f), a1[4 * g + 2 * e + 1] * (1.f / 8192.f)); } }
            __syncthreads();
        }
        const float bias0 = F.a->in[IN_HBIAS][c], bias1 = F.a->in[IN_HBIAS][512 + c];
        unsigned vinA[8], vinB[8];
        { const int n = F.lane & 31, h = F.lane >> 5, lo = 32 * wave + n; const unsigned* Uz = UT + (((size_t)2 * 4 + 0) * 512 + c) * SEQ + lo;
#pragma unroll
          for (int s = 0; s < 2; ++s)
#pragma unroll
              for (int i = 0; i < 4; ++i) { vinA[4 * s + i] = Uz[(8 * s + 4 * h + i) * 256]; vinB[4 * s + i] = Uz[(size_t)512 * SEQ + (8 * s + 4 * h + i) * 256]; } }
#pragma unroll 1
        for (int p2 = 0; p2 < (DUP(16) ? 4 : 2); ++p2) { const int p = 2 * (p2 & 1);
            const unsigned* Ux1 = UT + (((size_t)0 * 4 + p) * 512 + c) * SEQ; const unsigned* Ux2 = UT + (((size_t)1 * 4 + p) * 512 + c) * SEQ; const unsigned* Uz = UT + (((size_t)2 * 4 + p) * 512 + c) * SEQ;
            unsigned* zt = ZT + ((size_t)p * 512 + c) * SEQ; const size_t PQ = (size_t)512 * SEQ;
            hy3_conv2<0>(wave, F.lane, M, vinA, vinB, X, Z1, TWA, TWB, TW8, KG, Uz, Ux1, zt, Uz + PQ, Ux1 + PQ, zt + PQ, bias0);
            if (DUP(16) || p < 2) { const int n = F.lane & 31, h = F.lane >> 5, lo = 32 * wave + n; const unsigned* Un = UT + (((size_t)2 * 4 + ((p + 2) & 3)) * 512 + c) * SEQ + lo;
#pragma unroll
                for (int s = 0; s < 2; ++s)
#pragma unroll
                    for (int i = 0; i < 4; ++i) { vinA[4 * s + i] = Un[(8 * s + 4 * h + i) * 256]; vinB[4 * s + i] = Un[PQ + (8 * s + 4 * h + i) * 256]; } }
            hy3_conv2<1>(wave, F.lane, M, vinA, vinB, X, Z1, TWA, TWB, TW8, KG + 8192, Uz, Ux2, zt, Uz + PQ, Ux2 + PQ, zt + PQ, bias1);
        }
    }
}
__global__ void __launch_bounds__(512, 2) fwd_kernel(Args args) {
    extern __shared__ __attribute__((aligned(16))) unsigned char lds[];
    Frame F;
    F.lds = (LAS unsigned char*)lds;
    F.wave = __builtin_amdgcn_readfirstlane((int)threadIdx.x >> 6); F.lane = lane_id(); F.tid = F.wave * 64 + F.lane;
    F.G = gridDim.x; F.blk = blockIdx.x;
    F.a = &args;
    volatile LAS unsigned* MISC = (volatile LAS unsigned*)(F.lds + MISC_OFF);
    if (F.tid < 64) MISC[F.tid] = 0u;
    __syncthreads();
    if (N_LAUNCHES == 1) (void)xcd_barrier_post((unsigned*)(F.a->ws + WS_CTL), MISC + 8, F.tid == 0);
    const int lo = args.ph_lo, hi = args.ph_hi;
#define IN(k) (lo <= (k) && (k) < hi)

#define SEAM(k) do { if (IN(k) && IN((k) + 1)) { XcdBarrier b_; b_.bar = (unsigned*)(F.a->ws + WS_CTL); b_.x = xb_xcc_id(); b_.st = MISC + 8; xcd_barrier(b_, F.wave == 0 && lane_id() == 0); } } while (0)
    unsigned char* ws = F.a->ws;
    if (IN(0)) { REFRESH(F); p0_prologue(F); if (DUP(0)) { __syncthreads(); p0_prologue(F); } } SEAM(0);
    if (DUP(17) && IN(0) && IN(1)) { for (int q = 0; q < 8; ++q) { XcdBarrier b_; b_.bar = (unsigned*)(F.a->ws + WS_CTL); b_.x = xb_xcc_id(); b_.st = MISC + 8; xcd_barrier(b_, F.wave == 0 && lane_id() == 0); } }
    if (IN(1)) { REFRESH(F);
        {
            pg8::Gemm g{(const pg8::bf16_t*)(ws + WS_W3EXT), (const pg8::bf16_t*)(ws + WS_HEXT), 2048, SEQ, 256}; pg8::StaticOrder S; S.init(2048, SEQ, F.G, F.blk);
            pg8::EpiF32P E{F.a->out, SEQ};
            pg8::gemm_phase<pg8::EpiF32P, pg8::StaticOrder, true, true>(F.lds, g, S, E, F.tid);
        }
        __syncthreads();
        p_norm<false>(F); if (DUP(1)) { __syncthreads(); p_norm<false>(F); } } SEAM(1);
    if (IN(2)) { REFRESH(F);
        pg8::Gemm g{(const pg8::bf16_t*)(ws + WS_H), (const pg8::bf16_t*)(ws + WS_WIN), MTOK, NPROJ, DM}; pg8::StaticOrder S; S.init(MTOK, NPROJ, F.G, F.blk);
        pg8::EpiBf16<0> E{(pg8::bf16_t*)(ws + WS_P), NPROJ, (const float*)(ws + WS_BIN2), 0, 0, 1.f};
        pg8::gemm_phase<pg8::EpiBf16<0>, pg8::StaticOrder, true, true>(F.lds, g, S, E, F.tid);
        if (DUP(2)) { __syncthreads(); pg8::gemm_phase<pg8::EpiBf16<0>, pg8::StaticOrder, true, true>(F.lds, g, S, E, F.tid); }
    } SEAM(2);
    if (IN(3)) { REFRESH(F); p3_prep(F); if (DUP(3)) { __syncthreads(); p3_prep(F); } } SEAM(3);
    if (IN(4)) { REFRESH(F); p4_hyena3(F); if (DUP(4)) { __syncthreads(); p4_hyena3(F); } __syncthreads(); p4_mlstm_mfma(F); if (DUP(13)) { __syncthreads(); p4_mlstm_mfma(F); } } SEAM(4);
    if (IN(5)) { REFRESH(F); p5_post(F); if (DUP(5)) { __syncthreads(); p5_post(F); } } SEAM(5);
    if (IN(6)) { REFRESH(F);
        pg8::Gemm g{(const pg8::bf16_t*)(ws + WS_H), (const pg8::bf16_t*)(ws + WS_WOUT), MTOK, DM, DM}; pg8::StaticOrder S; S.init(MTOK, DM, F.G, F.blk);
        pg8::EpiRes E{F.a->in[IN_X], (pg8::bf16_t*)(ws + WS_X1), (const float*)(ws + WS_MOD)};
        pg8::gemm_phase<pg8::EpiRes, pg8::StaticOrder, true, true>(F.lds, g, S, E, F.tid);
        if (DUP(6)) { __syncthreads(); pg8::gemm_phase<pg8::EpiRes, pg8::StaticOrder, true, true>(F.lds, g, S, E, F.tid); }
    } SEAM(6);
    if (IN(7)) { REFRESH(F);
        { LAS float* Wt = (LAS float*)(F.lds + 8 * 8704); for (int i = F.tid; i < 16384; i += 512) { const int k = i >> 4, g = i & 15; Wt[g * 1024 + k] = F.a->in[IN_WROUTER][k * 16 + g]; } }
        __syncthreads();
        if (F.wave < 4) conv_experts<1>(F); else p_norm<true, 4>(F);
    } SEAM(7);
    if (IN(8)) { REFRESH(F); p8_topk(F); } SEAM(8);
    if (IN(9)) { REFRESH(F);
        pg8::Gemm g{(const pg8::bf16_t*)(ws + WS_HF), (const pg8::bf16_t*)(ws + WS_WGU), NSLOT, NEXP * 4096, DM / 2}; pg8::MoeOrderA S{F.G, F.blk};
        LAS unsigned short* gidx = (LAS unsigned short*)(F.lds + RING_BYTES);
        { const int* IDX = (const int*)(ws + WS_IDX);
          for (int q = F.tid; q < 4096; q += 512) { pg8::Unit u; const int i = q >> 8, r = q & 255;
              if (S.next(i, u)) { const int e = u.pm >> 4, pml = u.pm & 15, b = pml >> 1, s0 = (pml & 1) * 256; gidx[q] = (unsigned short)(b * SEQ + IDX[(b * 16 + e) * CAP + s0 + r]); } } }
        __syncthreads();
        pg8::EpiSwiGLU E{ws + WS_HID};
        pg8::gemm_phase_gather_fp8<pg8::EpiSwiGLU, pg8::MoeOrderA>(F.lds, g, S, E, gidx, 0, F.tid, 121);
        if (DUP(9)) { __syncthreads(); pg8::gemm_phase_gather_fp8<pg8::EpiSwiGLU, pg8::MoeOrderA>(F.lds, g, S, E, gidx, 0, F.tid, 121); }
    } SEAM(9);
    if (IN(10)) { REFRESH(F);
        pg8::Gemm g{(const pg8::bf16_t*)(ws + WS_HID), (const pg8::bf16_t*)(ws + WS_WD), NSLOT, NEXP * 1024, FFD / 2}; pg8::MoeOrderB S{F.G, F.blk};
        LAS unsigned short* gidx = (LAS unsigned short*)(F.lds + RING_BYTES);
        for (int q = F.tid; q < 4096; q += 512) { pg8::Unit u; const int i = q >> 8, r = q & 255; if (S.next(i, u)) gidx[q] = (unsigned short)(u.pm * 256 + r); }
        __syncthreads();
        pg8::EpiYs E{ws + WS_YS};
        pg8::gemm_phase_gather_fp8<pg8::EpiYs, pg8::MoeOrderB>(F.lds, g, S, E, gidx, 0, F.tid, 125);
        if (DUP(10)) { __syncthreads(); pg8::gemm_phase_gather_fp8<pg8::EpiYs, pg8::MoeOrderB>(F.lds, g, S, E, gidx, 0, F.tid, 125); }
    } SEAM(10);
    if (IN(11)) { REFRESH(F); if (DUP(11)) { p12_final<true>(F); __syncthreads(); } p12_final<false>(F); }
#undef IN
#undef SEAM
}

extern "C" void kernel_launch(void* const* d_in, const int* in_sizes, int n_in, void* d_out, int out_size, void* d_ws, size_t ws_size, hipStream_t stream) {
    static int grid = 0;
    if (grid == 0) {
        if (n_in != 28 || out_size != MTOK * DM || ws_size < WS_END) { fprintf(stderr, "kernel_launch: unexpected shapes (n_in %d, out %d, ws %zu < %zu)\n", n_in, out_size, ws_size, (size_t)WS_END); grid = -1; return; }
        int dev = 0, cus = 0;
        if (hipGetDevice(&dev) != hipSuccess || hipDeviceGetAttribute(&cus, hipDeviceAttributeMultiprocessorCount, dev) != hipSuccess) { grid = -1; return; }
        if (hipFuncSetAttribute((const void*)fwd_kernel, hipFuncAttributeMaxDynamicSharedMemorySize, LDS_BYTES) != hipSuccess) { fprintf(stderr, "kernel_launch: hipFuncSetAttribute failed\n"); grid = -1; return; }
        int per_cu = 0;
        if (hipOccupancyMaxActiveBlocksPerMultiprocessor(&per_cu, (const void*)fwd_kernel, 512, LDS_BYTES) != hipSuccess || per_cu < 1) fprintf(stderr, "kernel_launch: occupancy query reports %d\n", per_cu);
        (void)hipGetLastError();
        grid = cus > 256 ? 256 : cus;
    }
    if (grid < 0) return;
    (void)hipMemsetAsync((char*)d_ws + WS_CTL, 0, CTL_ZERO_BYTES, stream);
    Args a{};
    for (int i = 0; i < 28; ++i) a.in[i] = (const float*)d_in[i];
    a.out = (float*)d_out; a.ws = (unsigned char*)d_ws;
    if (N_LAUNCHES == 1) { a.ph_lo = 0; a.ph_hi = N_PHASES; hipLaunchKernelGGL(fwd_kernel, dim3(grid), dim3(512), LDS_BYTES, stream, a); }
    else for (int p = 0; p < N_PHASES; ++p) { a.ph_lo = p; a.ph_hi = p + 1; hipLaunchKernelGGL(fwd_kernel, dim3(grid), dim3(512), LDS_BYTES, stream, a); }
}
```

```cpp
#include <hip/hip_runtime.h>
#include <cstdio>
#include <cstdint>
#include <type_traits>
#define N_LAUNCHES 1
#define DUPMASK 0
__device__ __forceinline__ int lane_id() { return (int)__builtin_amdgcn_mbcnt_hi(~0u, __builtin_amdgcn_mbcnt_lo(~0u, 0u)); }
namespace pg8 {
#define PG8_LAS __attribute__((address_space(3)))
typedef unsigned short bf16_t;
typedef short bf16x8 __attribute__((ext_vector_type(8)));
typedef float f32x4 __attribute__((ext_vector_type(4)));
typedef unsigned u32x4 __attribute__((ext_vector_type(4)));
constexpr int BM = 256, BK = 64, HALF = 128, HTB = HALF * BK * 2  , STAGE_BYTES = 8 * HTB, NXCD = 8, WGM = 8;

__host__ __device__ __forceinline__ int lds_byte(int r, int c) { const int st = (r >> 4) * 2 + (c >> 5), rr = r & 15, cc = c & 31, ob = rr * 64 + cc * 2; return st * 1024 + (ob ^ (((ob >> 9) & 1) << 5)); }
__host__ __device__ __forceinline__ void stage_rc(int b, int& R, int& C) { const int st = b / 1024, sb = b % 1024, swz = sb ^ (((sb >> 9) & 1) << 5); R = (st >> 1) * 16 + swz / 64; C = (st & 1) * 32 + (swz % 64) / 2; }
__host__ __device__ __forceinline__ int perm32(int rho) { const int n = rho >> 4, i = rho & 15; return 8 * (i >> 2) + 4 * n + (i & 3); }

struct Unit { int pm, pn; };
struct Gemm { const bf16_t* A; const bf16_t* Bt; int M, N, K; };

struct StaticOrder {
    int nM, nN, nwg, G, c;
    __host__ __device__ void init(int M, int N, int G_, int c_) { nM = M / BM; nN = N / BM; nwg = nM * nN; G = G_; c = c_; }
    __host__ __device__ bool next(int i, Unit& u) const {
        const long L = (long)i * G + c; if (L >= nwg) return false;
        int wgid = (int)L; { const int q = nwg / NXCD, r = nwg % NXCD, xcd = wgid % NXCD, off = wgid / NXCD; wgid = (xcd < r ? xcd * (q + 1) : r * (q + 1) + (xcd - r) * q) + off; }
        const int nig = WGM * nN, gid = wgid / nig, fm = gid * WGM, gsz = (nM - fm) < WGM ? (nM - fm) : WGM;
        u.pm = fm + ((wgid % nig) % gsz); u.pn = (wgid % nig) / gsz; return true;
    }
    __device__ __forceinline__ void a_ready(const Unit&) const {}
    __device__ __forceinline__ void done(const Unit&) const {}
};

__device__ __forceinline__ unsigned cvt_pk_bf16(float lo, float hi) { unsigned r; asm volatile("v_cvt_pk_bf16_f32 %0, %1, %2" : "=v"(r) : "v"(lo), "v"(hi)); return r; }
typedef float f32x2 __attribute__((ext_vector_type(2)));
__device__ __forceinline__ f32x2 gelu_pk(f32x2 v) {
    const f32x2 av = __builtin_elementwise_abs(v), d = av * 0.2316418882f + 1.0f;
    f32x2 t; t.x = __builtin_amdgcn_rcpf(d.x); t.y = __builtin_amdgcn_rcpf(d.y);
    f32x2 q = t * 0.5307027145f + (-0.7265760135f); q = q * t + 0.7107068705f; q = q * t + (-0.142248368f); q = q * t + 0.127414796f; q = q * t;
    const f32x2 s = (v * v) * (-0.72134752044f);
    f32x2 e; e.x = __builtin_amdgcn_exp2f(s.x); e.y = __builtin_amdgcn_exp2f(s.y);
    const f32x2 m = v * (q * e), r = v - m;
    f32x2 o; o.x = v.x < 0.f ? m.x : r.x; o.y = v.y < 0.f ? m.y : r.y; return o;
}

template <int ACT  > struct EpiBf16 {
    static constexpr bool PERM = true, AFTER_DRAIN = false; static_assert(ACT == 0 || ACT == 1, "EpiBf16: ACT is 0 (none) or 1 (gelu_pk)");
    bf16_t* O; int ldc; const float* bias; int split_cols; size_t split_stride; float scale0;
    __device__ __forceinline__ void operator()(const f32x4 (&acc)[2][2][4][2], const Unit& u, int wr, int wc, int fr, int fq) const {
        const int row0 = u.pm * BM + wr * 64 + fr; int colt = u.pn * BM; bf16_t* base = O;
        float sc = 1.f; if (split_cols) { const int t = colt / split_cols; base += (size_t)t * split_stride; colt -= t * split_cols; if (t == 0) sc = scale0; }
        const int col0 = colt + wc * 32 + 8 * fq, bcol0 = u.pn * BM + wc * 32 + 8 * fq;
        f32x4 bv[2][2];
#pragma unroll
        for (int bj = 0; bj < 2; ++bj)
#pragma unroll
            for (int n = 0; n < 2; ++n) bv[bj][n] = bias ? *(const f32x4*)(bias + bcol0 + bj * HALF + 4 * n) : (f32x4){0.f, 0.f, 0.f, 0.f};
#pragma unroll
        for (int ai = 0; ai < 2; ++ai)
#pragma unroll
            for (int m = 0; m < 4; ++m) { bf16_t* rowp = base + (size_t)(row0 + ai * HALF + m * 16) * ldc + col0;
#pragma unroll
                for (int bj = 0; bj < 2; ++bj) { f32x4 v0 = acc[ai][bj][m][0] + bv[bj][0], v1 = acc[ai][bj][m][1] + bv[bj][1];
                    if (ACT == 1) { f32x2 a = gelu_pk((f32x2){v0[0], v0[1]}), b = gelu_pk((f32x2){v0[2], v0[3]}), c = gelu_pk((f32x2){v1[0], v1[1]}), d = gelu_pk((f32x2){v1[2], v1[3]});
                        v0 = (f32x4){a.x, a.y, b.x, b.y}; v1 = (f32x4){c.x, c.y, d.x, d.y}; }
                    v0 = v0 * sc; v1 = v1 * sc; u32x4 w; w.x = cvt_pk_bf16(v0[0], v0[1]); w.y = cvt_pk_bf16(v0[2], v0[3]); w.z = cvt_pk_bf16(v1[0], v1[1]); w.w = cvt_pk_bf16(v1[2], v1[3]);
                    *(u32x4*)(rowp + bj * HALF) = w; } }
    }
};


template <class Epi, class Sched, bool ALIGN_EPI = false, bool SP2 = false>
__device__ __forceinline__ void gemm_phase(PG8_LAS unsigned char* lds, const Gemm g, const Sched& S, const Epi& E, const int tid_in) {
    const int tid = tid_in, wid = __builtin_amdgcn_readfirstlane(tid >> 6), lane = tid & 63, wr = wid >> 2, wc = wid & 3, fr = lane & 15, fq = lane >> 4;
    const int K = g.K, nt = K / BK;
    unsigned voffA[2], voffB[2];
#pragma unroll
    for (int i = 0; i < 2; ++i) { int R, C; stage_rc(tid * 16 + i * 8192, R, C); const int Rb = Epi::PERM ? ((R & ~31) + perm32(R & 31)) : R;
        voffA[i] = (unsigned)(R * K + C) * 2u; voffB[i] = (unsigned)(Rb * K + C) * 2u; }
    const size_t kstep = (size_t)(BK * 2);
    const size_t hstep = (size_t)HALF * K * 2;
    const size_t tstep = 2 * hstep;
    const unsigned ldsw = (unsigned)wid * 1024u;
    const int aoff = lds_byte(wr * 64 + fr, fq * 8), boff = lds_byte(wc * 32 + fr, fq * 8);
#define PG8_SA(b, h) (((b) * 2 + (h)) * HTB)
#define PG8_SB(b, h) ((4 + (b) * 2 + (h)) * HTB)
#define PG8_STAGE(bufoff, gbase, voff) do { _Pragma("unroll") for (int _i = 0; _i < 2; ++_i) \
        __builtin_amdgcn_global_load_lds((const unsigned*)((const char*)(gbase) + (voff)[_i]), (PG8_LAS unsigned*)(lds + (bufoff) + ldsw + _i * 8192), 16, 0, 0); } while (0)
#define PG8_LDA(dst, b, h) do { _Pragma("unroll") for (int m = 0; m < 4; ++m) _Pragma("unroll") for (int k = 0; k < 2; ++k) dst[m][k] = *(const PG8_LAS bf16x8*)(lds + PG8_SA(b, h) + aoff + m * 2048 + k * 1024); } while (0)
#define PG8_LDB(dst, b, h) do { _Pragma("unroll") for (int n = 0; n < 2; ++n) _Pragma("unroll") for (int k = 0; k < 2; ++k) dst[n][k] = *(const PG8_LAS bf16x8*)(lds + PG8_SB(b, h) + boff + n * 2048 + k * 1024); } while (0)
#define PG8_MMA(ai, bj, At, Bt) do { __builtin_amdgcn_s_setprio(1); _Pragma("unroll") for (int m = 0; m < 4; ++m) _Pragma("unroll") for (int n = 0; n < 2; ++n) _Pragma("unroll") for (int k = 0; k < 2; ++k) \
        acc[ai][bj][m][n] = __builtin_amdgcn_mfma_f32_16x16x32_bf16(Bt[n][k], At[m][k], acc[ai][bj][m][n], 0, 0, 0); __builtin_amdgcn_s_setprio(0); } while (0)
#define PG8_WAIT_V(n) asm volatile("s_waitcnt vmcnt(" #n ")" ::: "memory")
#define PG8_WAIT_L(n) asm volatile("s_waitcnt lgkmcnt(" #n ")" ::: "memory")
#define PG8_BAR __builtin_amdgcn_s_barrier()
#define PG8_SCHED __builtin_amdgcn_sched_barrier(0)
    Unit cur, nxt; int ui = 0;
    if (!S.next(0, cur)) return;
    f32x4 acc[2][2][4][2];
#pragma unroll
    for (int a = 0; a < 2; ++a)
#pragma unroll
        for (int b = 0; b < 2; ++b)
#pragma unroll
            for (int m = 0; m < 4; ++m)
#pragma unroll
                for (int n = 0; n < 2; ++n) acc[a][b][m][n] = (f32x4){0.f, 0.f, 0.f, 0.f};
    bf16x8 At[4][2], B0[2][2], B1[2][2];
    const char* cA = (const char*)g.A + (size_t)cur.pm * tstep; const char* cB = (const char*)g.Bt + (size_t)cur.pn * tstep;
    S.a_ready(cur);
    if constexpr (SP2) {
        PG8_STAGE(PG8_SB(0, 0), cB, voffB); PG8_STAGE(PG8_SB(0, 1), cB + hstep, voffB); PG8_STAGE(PG8_SA(0, 0), cA, voffA); PG8_STAGE(PG8_SA(0, 1), cA + hstep, voffA);
        if (wr == 1) PG8_BAR;
        PG8_WAIT_V(2); PG8_BAR;
        PG8_STAGE(PG8_SB(1, 0), cB + kstep, voffB); PG8_STAGE(PG8_SA(1, 0), cA + kstep, voffA); PG8_STAGE(PG8_SB(1, 1), cB + hstep + kstep, voffB);
        PG8_WAIT_V(6); PG8_BAR;
    } else {
        PG8_STAGE(PG8_SB(0, 0), cB, voffB); PG8_STAGE(PG8_SA(0, 0), cA, voffA); PG8_STAGE(PG8_SB(0, 1), cB + hstep, voffB); PG8_STAGE(PG8_SA(0, 1), cA + hstep, voffA);
        if (wr == 1) PG8_BAR;
        PG8_WAIT_V(4); PG8_BAR;
        PG8_STAGE(PG8_SB(1, 0), cB + kstep, voffB); PG8_STAGE(PG8_SA(1, 0), cA + kstep, voffA); PG8_STAGE(PG8_SB(1, 1), cB + hstep + kstep, voffB);
        PG8_WAIT_V(6); PG8_BAR;
    }
    for (;;) {
        const bool has_next = S.next(ui + 1, nxt);
        const char* nA = has_next ? (const char*)g.A + (size_t)nxt.pm * tstep : cA; const char* nB = has_next ? (const char*)g.Bt + (size_t)nxt.pn * tstep : cB;
        for (int t = 0; t < nt; t += 2) {
            const bool last = (t == nt - 2);
            const char* a1 = cA + (size_t)(t + 1) * kstep;
            const char* a2 = last ? nA : cA + (size_t)(t + 2) * kstep; const char* b2 = last ? nB : cB + (size_t)(t + 2) * kstep;
            const char* a3 = a2 + kstep; const char* b3 = b2 + kstep;
            if (last && has_next) S.a_ready(nxt);
            if constexpr (SP2) {
            PG8_LDB(B0, 0, 0); PG8_LDB(B1, 0, 1); PG8_SCHED; PG8_LDA(At, 0, 0); PG8_STAGE(PG8_SA(1, 1), a1 + hstep, voffA);
            PG8_WAIT_V(8); PG8_WAIT_L(0); PG8_BAR; PG8_MMA(0, 0, At, B0); PG8_MMA(0, 1, At, B1); PG8_BAR; PG8_SCHED;
            PG8_LDA(At, 0, 1); PG8_STAGE(PG8_SB(0, 0), b2, voffB); PG8_STAGE(PG8_SB(0, 1), b2 + hstep, voffB); PG8_STAGE(PG8_SA(0, 0), a2, voffA);
            PG8_WAIT_V(8); PG8_WAIT_L(0); PG8_BAR; PG8_MMA(1, 0, At, B0); PG8_MMA(1, 1, At, B1); PG8_BAR; PG8_SCHED;
            PG8_LDB(B0, 1, 0); PG8_LDB(B1, 1, 1); PG8_SCHED; PG8_LDA(At, 1, 0); PG8_STAGE(PG8_SA(0, 1), a2 + hstep, voffA);
            PG8_WAIT_V(8); PG8_WAIT_L(0); PG8_BAR; PG8_MMA(0, 0, At, B0); PG8_MMA(0, 1, At, B1); PG8_BAR; PG8_SCHED;
            PG8_LDA(At, 1, 1); PG8_STAGE(PG8_SB(1, 0), b3, voffB); PG8_STAGE(PG8_SB(1, 1), b3 + hstep, voffB); PG8_STAGE(PG8_SA(1, 0), a3, voffA);
            PG8_WAIT_V(8); PG8_WAIT_L(0); PG8_BAR; PG8_MMA(1, 0, At, B0); PG8_MMA(1, 1, At, B1); PG8_BAR; PG8_SCHED;
            } else {
            PG8_LDB(B0, 0, 0); PG8_SCHED; PG8_LDA(At, 0, 0); PG8_STAGE(PG8_SA(1, 1), a1 + hstep, voffA);
            PG8_WAIT_L(8); PG8_BAR; PG8_WAIT_L(0); PG8_MMA(0, 0, At, B0); PG8_BAR; PG8_SCHED;
            PG8_LDB(B1, 0, 1); PG8_STAGE(PG8_SB(0, 0), b2, voffB);
            PG8_BAR; PG8_WAIT_L(0); PG8_MMA(0, 1, At, B1); PG8_BAR;
            PG8_LDA(At, 0, 1); PG8_STAGE(PG8_SA(0, 0), a2, voffA);
            PG8_BAR; PG8_WAIT_L(0); PG8_MMA(1, 0, At, B0); PG8_BAR; PG8_SCHED;
            PG8_STAGE(PG8_SB(0, 1), b2 + hstep, voffB);
            PG8_WAIT_V(6); PG8_BAR; PG8_MMA(1, 1, At, B1); PG8_BAR;
            PG8_LDB(B0, 1, 0); PG8_SCHED; PG8_LDA(At, 1, 0); PG8_STAGE(PG8_SA(0, 1), a2 + hstep, voffA);
            PG8_WAIT_L(8); PG8_BAR; PG8_WAIT_L(0); PG8_MMA(0, 0, At, B0); PG8_BAR; PG8_SCHED;
            PG8_LDB(B1, 1, 1); PG8_STAGE(PG8_SB(1, 0), b3, voffB);
            PG8_BAR; PG8_WAIT_L(0); PG8_MMA(0, 1, At, B1); PG8_BAR;
            PG8_LDA(At, 1, 1); PG8_STAGE(PG8_SA(1, 0), a3, voffA);
            PG8_BAR; PG8_WAIT_L(0); PG8_MMA(1, 0, At, B0); PG8_BAR; PG8_SCHED;
            PG8_STAGE(PG8_SB(1, 1), b3 + hstep, voffB);
            PG8_WAIT_V(6); PG8_BAR; PG8_MMA(1, 1, At, B1); PG8_BAR;
            }
        }
        if constexpr (ALIGN_EPI) { if (wr == 0) PG8_BAR; }
        if constexpr (!Epi::AFTER_DRAIN) { E(acc, cur, wr, wc, fr, fq); S.done(cur); }
        if (!has_next) break;
#pragma unroll
        for (int a = 0; a < 2; ++a)
#pragma unroll
            for (int b = 0; b < 2; ++b)
#pragma unroll
                for (int m = 0; m < 4; ++m)
#pragma unroll
                    for (int n = 0; n < 2; ++n) acc[a][b][m][n] = (f32x4){0.f, 0.f, 0.f, 0.f};
        cur = nxt; cA = nA; cB = nB; ++ui;
        if constexpr (ALIGN_EPI) { if (wr == 1) PG8_BAR; }
    }
    PG8_WAIT_V(0);
    if constexpr (!ALIGN_EPI) { if (wr == 0) PG8_BAR; }
    PG8_BAR;
    if constexpr (Epi::AFTER_DRAIN) { E.fused(acc, cur, wr, wc, fr, fq, lds, wid, lane); S.done(cur); }
#undef PG8_SA
#undef PG8_SB
#undef PG8_STAGE
#undef PG8_LDA
#undef PG8_LDB
#undef PG8_MMA
#undef PG8_WAIT_V
#undef PG8_WAIT_L
#undef PG8_BAR
#undef PG8_SCHED
}
}
namespace pg8 {
typedef int v4i_t __attribute__((ext_vector_type(4)));
typedef int v8i_t __attribute__((ext_vector_type(8)));
template <class Epi, class Sched, bool ALIGN_EPI = true>
__device__ __forceinline__ void gemm_phase_gather_fp8(PG8_LAS unsigned char* lds, const Gemm g, const Sched& S, const Epi& E, const PG8_LAS unsigned short* gidx, int rowbase, const int tid_in, const int scale_w_e8m0) {
    const int tid = tid_in, wid = __builtin_amdgcn_readfirstlane(tid >> 6), lane = tid & 63, wr = wid >> 2, wc = wid & 3, fr = lane & 15, fq = lane >> 4;
    const int K = g.K; int nt = K / BK; asm volatile("" : "+s"(nt));
    unsigned voffB[2]; int RA[2], CA[2];
#pragma unroll
    for (int i = 0; i < 2; ++i) { int R, C; stage_rc(tid * 16 + i * 8192, R, C); const int Rb = Epi::PERM ? ((R & ~31) + perm32(R & 31)) : R;
        RA[i] = R; CA[i] = C; voffB[i] = (unsigned)(Rb * K + C) * 2u; }
    const size_t kstep = (size_t)(BK * 2);
    const size_t hstep = (size_t)HALF * K * 2;
    const size_t tstep = 2 * hstep;
    const unsigned ldsw = (unsigned)wid * 1024u;
    const int aoff = lds_byte(wr * 64 + fr, fq * 8), boff = lds_byte(wc * 32 + fr, fq * 8);
#define PG8_SA(b, h) (((b) * 2 + (h)) * HTB)
#define PG8_SB(b, h) ((4 + (b) * 2 + (h)) * HTB)
#define PG8_STAGE(bufoff, gbase, voff) do { _Pragma("unroll") for (int _i = 0; _i < 2; ++_i) \
        __builtin_amdgcn_global_load_lds((const unsigned*)((const char*)(gbase) + (voff)[_i]), (PG8_LAS unsigned*)(lds + (bufoff) + ldsw + _i * 8192), 16, 0, 0); } while (0)
#define PG8_LDA(dst, b, h) do { _Pragma("unroll") for (int m = 0; m < 4; ++m) dst[m] = PG8_CAT(*(const PG8_LAS v4i_t*)(lds + PG8_SA(b, h) + aoff + m * 2048), *(const PG8_LAS v4i_t*)(lds + PG8_SA(b, h) + aoff + m * 2048 + 1024)); } while (0)
#define PG8_LDB(dst, b, h) do { _Pragma("unroll") for (int n = 0; n < 2; ++n) dst[n] = PG8_CAT(*(const PG8_LAS v4i_t*)(lds + PG8_SB(b, h) + boff + n * 2048), *(const PG8_LAS v4i_t*)(lds + PG8_SB(b, h) + boff + n * 2048 + 1024)); } while (0)
#define PG8_CAT(x0, x1) __builtin_shufflevector((x0), (x1), 0, 1, 2, 3, 4, 5, 6, 7)
#define PG8_MMA(ai, bj, At, Bt) do { __builtin_amdgcn_s_setprio(1); _Pragma("unroll") for (int m = 0; m < 4; ++m) _Pragma("unroll") for (int n = 0; n < 2; ++n) \
        asm volatile("v_mfma_scale_f32_16x16x128_f8f6f4 %0, %1, %2, %0, %3, %4 op_sel_hi:[0,0,0]" : "+v"(acc[ai][bj][m][n]) : "v"(Bt[n]), "v"(At[m]), "v"(sclw), "v"(scl)); __builtin_amdgcn_s_setprio(0); } while (0)
#define PG8_WAIT_V(n) asm volatile("s_waitcnt vmcnt(" #n ")" ::: "memory")
#define PG8_WAIT_L(n) asm volatile("s_waitcnt lgkmcnt(" #n ")" ::: "memory")
#define PG8_BAR __builtin_amdgcn_s_barrier()
#define PG8_SCHED __builtin_amdgcn_sched_barrier(0)
#define PG8_GOFF(dst, ui_) do { _Pragma("unroll") for (int _h = 0; _h < 2; ++_h) _Pragma("unroll") for (int _i = 0; _i < 2; ++_i) \
        dst[_h][_i] = (unsigned)((rowbase + (int)gidx[(ui_) * 256 + _h * HALF + RA[_i]]) * K + CA[_i]) * 2u; } while (0)
    Unit cur, nxt; int ui = 0;
    if (!S.next(0, cur)) return;
    f32x4 acc[2][2][4][2];
#pragma unroll
    for (int a = 0; a < 2; ++a)
#pragma unroll
        for (int b = 0; b < 2; ++b)
#pragma unroll
            for (int m = 0; m < 4; ++m)
#pragma unroll
                for (int n = 0; n < 2; ++n) acc[a][b][m][n] = (f32x4){0.f, 0.f, 0.f, 0.f};
    v8i_t At[4], B0[2], B1[2];
    int scl = 127, sclw = scale_w_e8m0; asm volatile("" : "+v"(scl), "+v"(sclw));
    unsigned gofC[2][2], g2[2][2];
    PG8_GOFF(gofC, 0);
#pragma unroll
    for (int _h = 0; _h < 2; ++_h)
#pragma unroll
        for (int _i = 0; _i < 2; ++_i) g2[_h][_i] = gofC[_h][_i];
    const char* A0 = (const char*)g.A;
    const char* cB = (const char*)g.Bt + (size_t)cur.pn * tstep;
    S.a_ready(cur);
    PG8_STAGE(PG8_SB(0, 0), cB, voffB); PG8_STAGE(PG8_SB(0, 1), cB + hstep, voffB); PG8_STAGE(PG8_SA(0, 0), A0, gofC[0]); PG8_STAGE(PG8_SA(0, 1), A0, gofC[1]);
    if (wr == 1) PG8_BAR;
    PG8_WAIT_V(2); PG8_BAR;
    PG8_STAGE(PG8_SB(1, 0), cB + kstep, voffB); PG8_STAGE(PG8_SA(1, 0), A0 + kstep, gofC[0]); PG8_STAGE(PG8_SB(1, 1), cB + hstep + kstep, voffB);
    PG8_WAIT_V(6); PG8_BAR;
    for (;;) {
        const bool has_next = S.next(ui + 1, nxt);
        const char* nB = has_next ? (const char*)g.Bt + (size_t)nxt.pn * tstep : cB;
#pragma unroll 1
        for (int t = 0; t < nt; t += 2) {
            const bool last = (t == nt - 2);
            const char* a1 = A0 + (size_t)(t + 1) * kstep;
            const char* a2 = last ? A0 : A0 + (size_t)(t + 2) * kstep; const char* b2 = last ? nB : cB + (size_t)(t + 2) * kstep;
            const char* a3 = a2 + kstep; const char* b3 = b2 + kstep;
            if (last && has_next) PG8_GOFF(g2, ui + 1);
            if (last && has_next) S.a_ready(nxt);
            PG8_LDB(B0, 0, 0); PG8_LDB(B1, 0, 1); PG8_SCHED; PG8_LDA(At, 0, 0); PG8_STAGE(PG8_SA(1, 1), a1, gofC[1]);
            PG8_WAIT_V(8); PG8_WAIT_L(0); PG8_BAR; PG8_MMA(0, 0, At, B0); PG8_MMA(0, 1, At, B1); PG8_BAR; PG8_SCHED;
            PG8_LDA(At, 0, 1); PG8_STAGE(PG8_SB(0, 0), b2, voffB); PG8_STAGE(PG8_SB(0, 1), b2 + hstep, voffB); PG8_STAGE(PG8_SA(0, 0), a2, g2[0]);
            PG8_WAIT_V(8); PG8_WAIT_L(0); PG8_BAR; PG8_MMA(1, 0, At, B0); PG8_MMA(1, 1, At, B1); PG8_BAR; PG8_SCHED;
            PG8_LDB(B0, 1, 0); PG8_LDB(B1, 1, 1); PG8_SCHED; PG8_LDA(At, 1, 0); PG8_STAGE(PG8_SA(0, 1), a2, g2[1]);
            PG8_WAIT_V(8); PG8_WAIT_L(0); PG8_BAR; PG8_MMA(0, 0, At, B0); PG8_MMA(0, 1, At, B1); PG8_BAR; PG8_SCHED;
            PG8_LDA(At, 1, 1); PG8_STAGE(PG8_SB(1, 0), b3, voffB); PG8_STAGE(PG8_SB(1, 1), b3 + hstep, voffB); PG8_STAGE(PG8_SA(1, 0), a3, g2[0]);
            PG8_WAIT_V(8); PG8_WAIT_L(0); PG8_BAR; PG8_MMA(1, 0, At, B0); PG8_MMA(1, 1, At, B1); PG8_BAR; PG8_SCHED;
        }
        if constexpr (ALIGN_EPI) { if (wr == 0) PG8_BAR; }
        asm volatile("s_nop 15\n\ts_nop 15" : "+v"(acc[0][0][0][0]), "+v"(acc[0][0][0][1]), "+v"(acc[0][0][1][0]), "+v"(acc[0][0][1][1]), "+v"(acc[0][0][2][0]), "+v"(acc[0][0][2][1]), "+v"(acc[0][0][3][0]), "+v"(acc[0][0][3][1]), "+v"(acc[0][1][0][0]), "+v"(acc[0][1][0][1]), "+v"(acc[0][1][1][0]), "+v"(acc[0][1][1][1]), "+v"(acc[0][1][2][0]), "+v"(acc[0][1][2][1]), "+v"(acc[0][1][3][0]), "+v"(acc[0][1][3][1]));
        asm volatile("" : "+v"(acc[1][0][0][0]), "+v"(acc[1][0][0][1]), "+v"(acc[1][0][1][0]), "+v"(acc[1][0][1][1]), "+v"(acc[1][0][2][0]), "+v"(acc[1][0][2][1]), "+v"(acc[1][0][3][0]), "+v"(acc[1][0][3][1]), "+v"(acc[1][1][0][0]), "+v"(acc[1][1][0][1]), "+v"(acc[1][1][1][0]), "+v"(acc[1][1][1][1]), "+v"(acc[1][1][2][0]), "+v"(acc[1][1][2][1]), "+v"(acc[1][1][3][0]), "+v"(acc[1][1][3][1]));
        E(acc, cur, wr, wc, fr, fq); S.done(cur);
        if (!has_next) break;
#pragma unroll
        for (int a = 0; a < 2; ++a)
#pragma unroll
            for (int b = 0; b < 2; ++b)
#pragma unroll
                for (int m = 0; m < 4; ++m)
#pragma unroll
                    for (int n = 0; n < 2; ++n) acc[a][b][m][n] = (f32x4){0.f, 0.f, 0.f, 0.f};
        cur = nxt; cB = nB; ++ui;
#pragma unroll
        for (int _h = 0; _h < 2; ++_h)
#pragma unroll
            for (int _i = 0; _i < 2; ++_i) gofC[_h][_i] = g2[_h][_i];
        if constexpr (ALIGN_EPI) { if (wr == 1) PG8_BAR; }
    }
    PG8_WAIT_V(0);
    if constexpr (!ALIGN_EPI) { if (wr == 0) PG8_BAR; }
    PG8_BAR;
#undef PG8_GOFF
#undef PG8_CAT
#undef PG8_SA
#undef PG8_SB
#undef PG8_STAGE
#undef PG8_LDA
#undef PG8_LDB
#undef PG8_MMA
#undef PG8_WAIT_V
#undef PG8_WAIT_L
#undef PG8_BAR
#undef PG8_SCHED
}
}
constexpr int NB = 8, SEQ = 4096, DM = 1024, MTOK = NB * SEQ;
constexpr int NPROJ = 3584;
constexpr int PCOLS_IN = 3600;
constexpr int NEXP = 16, CAP = 512, FFD = 2048, NSLOT = NEXP * NB * CAP;
constexpr float RMS_EPS = 1e-6f;
#ifndef N_LAUNCHES
#define N_LAUNCHES 1
#endif
constexpr int N_PHASES = 12;

constexpr size_t MiB = 1u << 20;
constexpr size_t WS_CTL = 0, CTL_ZERO_BYTES = 64 * 1024;
constexpr size_t WS_QHEAD = 32768;
constexpr size_t WS_MOD = 1 * MiB;
constexpr size_t WS_BIN2 = 1 * MiB + 512 * 1024;
constexpr size_t WS_HEXT = 2 * MiB;
constexpr size_t WS_W3EXT = 21 * MiB;
constexpr size_t WS_GATES = 4 * MiB;
constexpr size_t WS_AFF = 6 * MiB;
constexpr size_t WS_IDX = 8 * MiB, WS_GSEL = 8 * MiB + 256 * 1024;
constexpr size_t WS_INV = 9 * MiB;
constexpr size_t WS_WOUT = 12 * MiB;
constexpr size_t WS_WIN = 14 * MiB;
constexpr size_t WS_P = 24 * MiB;
constexpr size_t WS_H = 248 * MiB;
constexpr size_t WS_UT = 312 * MiB;
constexpr size_t WS_HM = 408 * MiB;
constexpr size_t WS_X1 = WS_HM;
constexpr size_t WS_ZT = 472 * MiB;
constexpr size_t WS_KSP = 504 * MiB;
constexpr size_t WS_WGU = 24 * MiB;
constexpr size_t WS_HID = 280 * MiB;
constexpr size_t WS_HF = 216 * MiB;
constexpr size_t WS_WD = 152 * MiB;
constexpr size_t WS_YS = 24 * MiB;
constexpr size_t WS_END = 536 * MiB;

constexpr int RING_BYTES = 131072;
constexpr int MISC_OFF = 147456 - 256;
constexpr int LDS_BYTES = 147456;

#define GAS __attribute__((address_space(1)))
#define LAS __attribute__((address_space(3)))
#define DI __device__ __forceinline__
typedef unsigned short bf16;
typedef unsigned v4u __attribute__((ext_vector_type(4)));
typedef unsigned v2u __attribute__((ext_vector_type(2)));
typedef float f32x4 __attribute__((ext_vector_type(4)));
typedef GAS unsigned gu32;
#define LDS_WAIT() asm volatile("s_waitcnt lgkmcnt(0)" ::: "memory")
DI float bf2f(unsigned b) { return __uint_as_float(b << 16); }
DI float bflo(unsigned w) { return __uint_as_float(w << 16); }
DI float bfhi(unsigned w) { return __uint_as_float(w & 0xffff0000u); }
DI unsigned f2bf(float f) { unsigned u = __float_as_uint(f); return (u + 0x7fffu + ((u >> 16) & 1u)) >> 16; }
DI unsigned pk2(float lo, float hi) { unsigned r; asm("v_cvt_pk_bf16_f32 %0, %1, %2" : "=v"(r) : "v"(lo), "v"(hi)); return r; }
#define DPP_XOR1 0xB1
#define DPP_XOR2 0x4E
#define DPP_HMIRROR 0x141
#define DPP_MIRROR 0x140
template <int CTRL> DI float dpp_mov(float v) { return __builtin_bit_cast(float, __builtin_amdgcn_update_dpp(0, __builtin_bit_cast(int, v), CTRL, 0xf, 0xf, true)); }
DI float row16_sum(float v) { v += dpp_mov<DPP_XOR1>(v); v += dpp_mov<DPP_XOR2>(v); v += dpp_mov<DPP_HMIRROR>(v); v += dpp_mov<DPP_MIRROR>(v); return v; }
DI float row16_max(float v) { v = fmaxf(v, dpp_mov<DPP_XOR1>(v)); v = fmaxf(v, dpp_mov<DPP_XOR2>(v)); v = fmaxf(v, dpp_mov<DPP_HMIRROR>(v)); v = fmaxf(v, dpp_mov<DPP_MIRROR>(v)); return v; }
DI float lane_bcast(float v, int l) { return __builtin_bit_cast(float, __builtin_amdgcn_readlane(__builtin_bit_cast(int, v), l)); }
DI float wave_sum(float v) { const float r = row16_sum(v); return (lane_bcast(r, 0) + lane_bcast(r, 16)) + (lane_bcast(r, 32) + lane_bcast(r, 48)); }
DI float sigmoidf_(float x) { return __builtin_amdgcn_rcpf(1.f + __expf(-x)); }

namespace pg8 {
struct MoeOrderA {
    int G, c;
    __device__ bool next(int i, Unit& u) const {
        const long L = (long)i * G + c; if (L >= 4096) return false;
        const int e = (int)(L >> 8), r = (int)(L & 255), x = r & 7, j = r >> 3;
        u.pm = e * 16 + 4 * (x >> 1) + (j >> 3); u.pn = e * 16 + 8 * (x & 1) + (j & 7); return true;
    }
    __device__ __forceinline__ void a_ready(const Unit&) const {}
    __device__ __forceinline__ void done(const Unit&) const {}
};
struct MoeOrderB {
    int G, c;
    __device__ bool next(int i, Unit& u) const {
        const long L = (long)i * G + c; if (L >= 1024) return false;
        const int r = (int)(L & 255), e = (int)(L >> 8) * 4 + ((r & 7) >> 1), idx = ((r & 1) << 5) | (r >> 3);
        u.pm = e * 16 + (idx >> 2); u.pn = e * 4 + (idx & 3); return true;
    }
    __device__ __forceinline__ void a_ready(const Unit&) const {}
    __device__ __forceinline__ void done(const Unit&) const {}
};
struct EpiSwiGLU {
    static constexpr bool PERM = true, AFTER_DRAIN = false;
    unsigned char* O;
    __device__ __forceinline__ void operator()(const f32x4 (&acc)[2][2][4][2], const Unit& u, int wr, int wc, int fr, int fq) const {
        const int row0 = u.pm * BM + wr * 64 + fr, col0 = (u.pn & 15) * 128 + wc * 32 + 8 * fq;
#pragma unroll
        for (int ai = 0; ai < 2; ++ai)
#pragma unroll
            for (int m = 0; m < 4; ++m) {
                unsigned char* rowp = O + (size_t)(row0 + ai * HALF + m * 16) * 2048 + col0;
                float h[8];
#pragma unroll
                for (int n = 0; n < 2; ++n)
#pragma unroll
                    for (int i = 0; i < 4; ++i) { const float g = acc[ai][0][m][n][i], up = acc[ai][1][m][n][i]; h[4 * n + i] = (g * up) * __builtin_amdgcn_rcpf(1.f + __builtin_amdgcn_exp2f(g * -1.4426950408889634f)); }
                int w0 = 0, w1 = 0;
                w0 = __builtin_amdgcn_cvt_pk_fp8_f32(h[0], h[1], w0, false); w0 = __builtin_amdgcn_cvt_pk_fp8_f32(h[2], h[3], w0, true);
                w1 = __builtin_amdgcn_cvt_pk_fp8_f32(h[4], h[5], w1, false); w1 = __builtin_amdgcn_cvt_pk_fp8_f32(h[6], h[7], w1, true);
                typedef unsigned u32x2e __attribute__((ext_vector_type(2)));
                *(u32x2e*)rowp = (u32x2e){(unsigned)w0, (unsigned)w1};
            }
    }
};
struct EpiYs {
    static constexpr bool PERM = true, AFTER_DRAIN = false;
    unsigned char* O;
    __device__ __forceinline__ void operator()(const f32x4 (&acc)[2][2][4][2], const Unit& u, int wr, int wc, int fr, int fq) const {
        const int row0 = u.pm * BM + wr * 64 + fr, col0 = (u.pn & 3) * BM + wc * 32 + 8 * fq;
#pragma unroll
        for (int ai = 0; ai < 2; ++ai)
#pragma unroll
            for (int m = 0; m < 4; ++m) {
                unsigned char* rowp = O + (size_t)(row0 + ai * HALF + m * 16) * 1024 + col0;
#pragma unroll
                for (int bj = 0; bj < 2; ++bj) { const f32x4 v0 = acc[ai][bj][m][0], v1 = acc[ai][bj][m][1];
                    int w0 = 0, w1 = 0;
                    w0 = __builtin_amdgcn_cvt_pk_fp8_f32(v0[0], v0[1], w0, false); w0 = __builtin_amdgcn_cvt_pk_fp8_f32(v0[2], v0[3], w0, true);
                    w1 = __builtin_amdgcn_cvt_pk_fp8_f32(v1[0], v1[1], w1, false); w1 = __builtin_amdgcn_cvt_pk_fp8_f32(v1[2], v1[3], w1, true);
                    typedef unsigned u32x2e __attribute__((ext_vector_type(2)));
                    *(u32x2e*)(rowp + bj * HALF) = (u32x2e){(unsigned)w0, (unsigned)w1}; }
            }
    }
};
struct EpiF32P {
    static constexpr bool PERM = false, AFTER_DRAIN = false;
    float* C; int ldc;
    __device__ __forceinline__ void operator()(const f32x4 (&acc)[2][2][4][2], const Unit& u, int wr, int wc, int fr, int fq) const {
        const int row0 = u.pm * BM + wr * 64 + fr, col0 = u.pn * BM + wc * 32 + 4 * fq;
#pragma unroll
        for (int ai = 0; ai < 2; ++ai)
#pragma unroll
            for (int m = 0; m < 4; ++m) { float* rowp = C + (size_t)(row0 + ai * HALF + m * 16) * ldc + col0;
#pragma unroll
                for (int bj = 0; bj < 2; ++bj)
#pragma unroll
                    for (int n = 0; n < 2; ++n) *(f32x4*)(rowp + bj * HALF + n * 16) = acc[ai][bj][m][n]; }
    }
};
struct EpiRes {
    static constexpr bool PERM = true, AFTER_DRAIN = false;
    const float* X; bf16_t* C; const float* mod;
    __device__ __forceinline__ void operator()(const f32x4 (&acc)[2][2][4][2], const Unit& u, int wr, int wc, int fr, int fq) const {
        const int row0 = u.pm * BM + wr * 64 + fr, col0 = u.pn * BM + wc * 32 + 8 * fq;
        const float* gp = mod + (size_t)((u.pm * BM) >> 12) * 6144 + 2048 + col0;
        f32x4 gv[2][2];
#pragma unroll
        for (int bj = 0; bj < 2; ++bj)
#pragma unroll
            for (int n = 0; n < 2; ++n) gv[bj][n] = *(const f32x4*)(gp + bj * HALF + 4 * n);
#pragma unroll
        for (int ai = 0; ai < 2; ++ai)
#pragma unroll
            for (int m = 0; m < 4; ++m) { const size_t off = (size_t)(row0 + ai * HALF + m * 16) * 1024 + col0;
#pragma unroll
                for (int bj = 0; bj < 2; ++bj) {
                    const f32x4 x0 = *(const f32x4*)(X + off + bj * HALF), x1 = *(const f32x4*)(X + off + bj * HALF + 4);
                    const f32x4 v0 = x0 + gv[bj][0] * acc[ai][bj][m][0], v1 = x1 + gv[bj][1] * acc[ai][bj][m][1];
                    u32x4 w; w.x = cvt_pk_bf16(v0[0], v0[1]); w.y = cvt_pk_bf16(v0[2], v0[3]); w.z = cvt_pk_bf16(v1[0], v1[1]); w.w = cvt_pk_bf16(v1[2], v1[3]);
                    *(u32x4*)(C + off + bj * HALF) = w; } }
    }
};
}
#define XB_TMO      128
#define XB_XCNT(j)  (256  + 64 * (j))
#define XB_XSUB(j)  (1280 + 64 * (j))
#define XB_XGEN(j)  (2304 + 64 * (j))
#define XB_TOP      3328
#define XB_TOPGEN   3392
#define XCD_BAR_WORDS 3456
#define XB_SPIN_CAP (1u << 18)

__device__ __forceinline__ unsigned xb_ld(unsigned* p)              { return __hip_atomic_load(p, __ATOMIC_RELAXED, __HIP_MEMORY_SCOPE_AGENT); }
__device__ __forceinline__ unsigned xb_add(unsigned* p, unsigned v) { return __hip_atomic_fetch_add(p, v, __ATOMIC_RELAXED, __HIP_MEMORY_SCOPE_AGENT); }
__device__ __forceinline__ unsigned xb_xcc_id() { return (unsigned)__builtin_amdgcn_s_getreg((3 << 11) | 20) & 0xFu; }
#define XB_SPIN(cond, bar) do { unsigned _sp = 0; while (cond) { __builtin_amdgcn_s_sleep(1); \
    if ((++_sp & 255u) == 0u) { if (xb_ld(&(bar)[XB_TMO])) break; if (_sp > XB_SPIN_CAP) { atomicAdd(&(bar)[XB_TMO], 1u); break; } } } } while (0)

struct XcdBarrier {
    unsigned* bar; unsigned x;
    volatile LAS unsigned* st;
};

__device__ __forceinline__ XcdBarrier xcd_barrier_post(unsigned* bar, volatile LAS unsigned* st, const bool leader) {
    XcdBarrier b; b.bar = bar; b.x = xb_xcc_id(); b.st = st;
    if (leader) (void)xb_add(&bar[XB_XCNT(b.x)], 1u);
    return b;
}
__device__ __forceinline__ void xcd_barrier_complete(unsigned* bar, unsigned x, unsigned& nloc, unsigned& nx) {
    const unsigned G = gridDim.x * gridDim.y * gridDim.z;
    unsigned sum, cnt, mine, sp = 0u;
    for (;;) {
        sum = 0u; cnt = 0u; mine = 0u;
#pragma unroll
        for (unsigned j = 0; j < 16; ++j) { const unsigned c = xb_ld(&bar[XB_XCNT(j)]); sum += c; cnt += (c > 0u) ? 1u : 0u; mine = (j == x) ? c : mine; }
        if (sum == G) break;
        __builtin_amdgcn_s_sleep(1);
        if ((++sp & 255u) == 0u) { if (xb_ld(&bar[XB_TMO])) break; if (sp > XB_SPIN_CAP) { atomicAdd(&bar[XB_TMO], 1u); break; } }
    }
    nloc = mine > 0u ? mine : 1u; nx = cnt > 0u ? cnt : 1u;
}

__device__ __forceinline__ void xcd_barrier(const XcdBarrier& b, const bool leader) {
    asm volatile("s_waitcnt vmcnt(0)" ::: "memory");
    __syncthreads();
    if (leader) {
        unsigned* bar = b.bar;
        __builtin_amdgcn_s_waitcnt(0);
        unsigned nloc = b.st[0], nx = b.st[1];
        if (nloc == 0u) { xcd_barrier_complete(bar, b.x, nloc, nx); b.st[0] = nloc; b.st[1] = nx; }
        const unsigned old = xb_add(&bar[XB_XSUB(b.x)], 1u);
        const unsigned gen = old / nloc;
        if (old + 1u == (gen + 1u) * nloc) {
            __builtin_amdgcn_fence(__ATOMIC_RELEASE, "agent");
            asm volatile("s_waitcnt vmcnt(0)" ::: "memory");
            const unsigned og = xb_add(&bar[XB_TOP], 1u);
            const unsigned tg = og / nx;
            if (og + 1u == (tg + 1u) * nx) xb_add(&bar[XB_TOPGEN], 1u);
            else XB_SPIN(xb_ld(&bar[XB_TOPGEN]) == tg, bar);
            __builtin_amdgcn_fence(__ATOMIC_ACQUIRE, "agent");
            xb_add(&bar[XB_XGEN(b.x)], 1u);
            asm volatile("s_waitcnt vmcnt(0)" ::: "memory");
        } else {
            XB_SPIN(xb_ld(&bar[XB_XGEN(b.x)]) == gen, bar);
            __builtin_amdgcn_fence(__ATOMIC_ACQUIRE, "agent");
            asm volatile("s_waitcnt vmcnt(0)" ::: "memory");
        }
    }
    __syncthreads();
}
#define HD __host__ __device__ __forceinline__
typedef float cf2 __attribute__((ext_vector_type(2)));
#define MK2(a, b) ((cf2){(a), (b)})
#define W16_C1 0.92387953251128674f
#define W16_S1 0.38268343236508977f
#define W16_H  0.70710678118654752f
HD cf2 w32_const(int k) {
    constexpr float C[16] = {1.f, 0.98078528040323043f, 0.92387953251128674f, 0.83146961230254524f, 0.70710678118654752f, 0.55557023301960218f, 0.38268343236508977f, 0.19509032201612825f,
                             0.f, -0.19509032201612825f, -0.38268343236508977f, -0.55557023301960218f, -0.70710678118654752f, -0.83146961230254524f, -0.92387953251128674f, -0.98078528040323043f};
    constexpr float S[16] = {0.f, 0.19509032201612825f, 0.38268343236508977f, 0.55557023301960218f, 0.70710678118654752f, 0.83146961230254524f, 0.92387953251128674f, 0.98078528040323043f,
                             1.f, 0.98078528040323043f, 0.92387953251128674f, 0.83146961230254524f, 0.70710678118654752f, 0.55557023301960218f, 0.38268343236508977f, 0.19509032201612825f};
    return MK2(C[k], -S[k]);
}
#ifndef DUPMASK
#define DUPMASK 0
#endif
#define DUP(k) ((DUPMASK >> (k)) & 1)
struct Args { const float* in[28]; float* out; unsigned char* ws; int ph_lo, ph_hi; };
struct Frame {
    LAS unsigned char* lds;
    int tid, lane, wave, G, blk;
    const struct Args* a;
};
#define REFRESH(F) do { int l_ = lane_id(); asm volatile("" : "+v"(l_)); (F).lane = l_; (F).tid = (F).wave * 64 + l_; } while (0)
#define IN_X 0
#define IN_C 1
#define IN_WADA 2
#define IN_BADA 3
#define IN_GMIX 4
#define IN_WIN 5
#define IN_BIN 6
#define IN_CQKW 7
#define IN_CQKB 8
#define IN_MNG 9
#define IN_CHYW 10
#define IN_CHYB 11
#define IN_HW1 12
#define IN_HB1 13
#define IN_HW2 14
#define IN_HB2 15
#define IN_HW3 16
#define IN_HFREQ 17
#define IN_HDELTA 18
#define IN_HBIAS 19
#define IN_HNG 20
#define IN_WOUT 21
#define IN_GFFN 22
#define IN_WROUTER 23
#define IN_WGATE 24
#define IN_WUP 25
#define IN_WDOWN 26
#define IN_GFINAL 27

DI void transpose_item(const float* src, int ldsrc, bf16* dst, int lddst, LAS float* scr, int lane) {
#pragma unroll 8
    for (int i = 0; i < 32; ++i) { const int kk = 2 * i + (lane >> 5); scr[kk * 33 + (lane & 31)] = src[(size_t)kk * ldsrc + (lane & 31)]; }
    LDS_WAIT(); asm volatile("" ::: "memory");
    const int c = lane & 7;
#pragma unroll
    for (int j = 0; j < 4; ++j) { const int n = (lane >> 3) + 8 * j; const LAS float* s = scr + (8 * c) * 33 + n;
        v4u o; o.x = pk2(s[0 * 33], s[1 * 33]); o.y = pk2(s[2 * 33], s[3 * 33]); o.z = pk2(s[4 * 33], s[5 * 33]); o.w = pk2(s[6 * 33], s[7 * 33]);
        *(v4u*)(dst + (size_t)n * lddst + 8 * c) = o; }
    LDS_WAIT(); asm volatile("" ::: "memory");
}
DI unsigned pk4_fp8(float a, float b, float c2, float d) { int w = 0; w = __builtin_amdgcn_cvt_pk_fp8_f32(a, b, w, false); w = __builtin_amdgcn_cvt_pk_fp8_f32(c2, d, w, true); return (unsigned)w; }
DI void transpose_item_fp8(const float* src, int ldsrc, unsigned char* dst, int lddst, float scale, LAS float* scr, int lane) {
#pragma unroll 8
    for (int i = 0; i < 32; ++i) { const int kk = 2 * i + (lane >> 5); scr[kk * 33 + (lane & 31)] = src[(size_t)kk * ldsrc + (lane & 31)]; }
    LDS_WAIT(); asm volatile("" ::: "memory");
    const int c = lane & 7;
#pragma unroll
    for (int j = 0; j < 4; ++j) { const int n = (lane >> 3) + 8 * j; const LAS float* s = scr + (8 * c) * 33 + n;
        v2u o; o.x = pk4_fp8(s[0 * 33] * scale, s[1 * 33] * scale, s[2 * 33] * scale, s[3 * 33] * scale); o.y = pk4_fp8(s[4 * 33] * scale, s[5 * 33] * scale, s[6 * 33] * scale, s[7 * 33] * scale);
        *(v2u*)(dst + (size_t)n * lddst + 8 * c) = o; }
    LDS_WAIT(); asm volatile("" ::: "memory");
}
DI float reduce16(const float (&acc)[16], int lane) {
    float r8[8], r4[4], r2[2], r1;
    { const bool up = (lane & 32) != 0;
#pragma unroll
      for (int i = 0; i < 8; ++i) { const float mine = up ? acc[8 + i] : acc[i], other = up ? acc[i] : acc[8 + i]; r8[i] = mine + __shfl_xor(other, 32); } }
    { const bool up = (lane & 16) != 0;
#pragma unroll
      for (int i = 0; i < 4; ++i) { const float mine = up ? r8[4 + i] : r8[i], other = up ? r8[i] : r8[4 + i]; r4[i] = mine + __shfl_xor(other, 16); } }
    { const bool up = (lane & 8) != 0;
#pragma unroll
      for (int i = 0; i < 2; ++i) { const float mine = up ? r4[2 + i] : r4[i], other = up ? r4[i] : r4[2 + i]; r2[i] = mine + __shfl_xor(other, 8); } }
    { const bool up = (lane & 4) != 0; const float mine = up ? r2[1] : r2[0], other = up ? r2[0] : r2[1]; r1 = mine + __shfl_xor(other, 4); }
    r1 += __shfl_xor(r1, 1); r1 += __shfl_xor(r1, 2);
    return r1;
}
DI int reduce16_index(int lane) { return ((lane >> 5) & 1) * 8 + ((lane >> 4) & 1) * 4 + ((lane >> 3) & 1) * 2 + ((lane >> 2) & 1); }

DI void p0_prologue(Frame& F) {
    unsigned char* ws = F.a->ws;
    LAS float* scr = (LAS float*)(F.lds + F.wave * 16384);
    const int gw = F.blk * 8 + F.wave, NGW = F.G * 8, lane = F.lane;
    bf16* WIN = (bf16*)(ws + WS_WIN); bf16* WOUT = (bf16*)(ws + WS_WOUT);
    for (int it = gw; it < 1792 + 512; it += NGW) {
        if (it < 1792) { const int kb = it / 112, nb = it % 112, n0 = 32 * nb, k0 = 64 * kb, sc = n0 + (n0 >= 2048 ? 16 : 0);
            transpose_item(F.a->in[IN_WIN] + (size_t)k0 * PCOLS_IN + sc, PCOLS_IN, WIN + (size_t)n0 * 1024 + k0, 1024, scr, lane); }
        else { const int r = it - 1792, kb = r / 32, nb = r % 32, n0 = 32 * nb, k0 = 64 * kb;
            transpose_item(F.a->in[IN_WOUT] + (size_t)k0 * 1024 + n0, 1024, WOUT + (size_t)n0 * 1024 + k0, 1024, scr, lane); }
    }
    {
        bf16* HEXT = (bf16*)(ws + WS_HEXT);
        const float* w1 = F.a->in[IN_HW1]; const float* w2 = F.a->in[IN_HW2];
        const float fr = F.a->in[IN_HFREQ][lane], b1 = F.a->in[IN_HB1][lane], b2 = F.a->in[IN_HB2][lane];
        for (int t = gw; t < SEQ; t += NGW) {
            float a1 = b1 + ((float)t * (1.f / 4095.f)) * w1[lane];
#pragma unroll 4
            for (int i = 0; i < 16; ++i) {
                const float band = 1e-4f + (float)i * ((15.f - 1e-4f) / 15.f);
                const float rev = band * (float)t * (1.f / 4096.f);
                const float fx = rev - floorf(rev);
                float sn, cs; sincospif(2.f * fx, &sn, &cs);
                a1 += cs * w1[(1 + i) * 64 + lane] - sn * w1[(17 + i) * 64 + lane];
            }
            const float h1 = sinf(fr * a1);
            float a2 = b2;
#pragma unroll 8
            for (int i = 0; i < 64; ++i) a2 += __shfl(h1, i) * w2[i * 64 + lane];
            const float h2 = sinf(fr * a2);
            const unsigned hi = f2bf(h2), lo = f2bf(h2 - bf2f(hi));
            bf16* hr = HEXT + (size_t)t * 256 + lane;
            hr[0] = (bf16)hi; hr[64] = (bf16)lo; hr[128] = (bf16)hi; hr[192] = 0;
        }
        bf16* W3EXT = (bf16*)(ws + WS_W3EXT); const float* w3 = F.a->in[IN_HW3];
        for (int i = F.blk * 512 + F.tid; i < 64 * 2048; i += F.G * 512) { const int j = i >> 11, col = i & 2047; const float w = w3[i];
            const unsigned hi = f2bf(w), lo = f2bf(w - bf2f(hi)); bf16* wr_ = W3EXT + (size_t)col * 256 + j;
            wr_[0] = (bf16)hi; wr_[64] = (bf16)hi; wr_[128] = (bf16)lo; wr_[192] = 0; }
    }
    { float* BIN2 = (float*)(ws + WS_BIN2); for (int n = F.blk * 512 + F.tid; n < NPROJ; n += F.G * 512) BIN2[n] = F.a->in[IN_BIN][n + (n >= 2048 ? 16 : 0)]; }
    __syncthreads();
    {
        LAS float* cs = (LAS float*)F.lds;
        LAS float* red = cs + 8192;
        float* MOD = (float*)(ws + WS_MOD); const float* wada = F.a->in[IN_WADA];
        for (int i = F.tid; i < 2048; i += 512) *(LAS f32x4*)(cs + 4 * i) = *(const f32x4*)(F.a->in[IN_C] + 4 * i);
        __syncthreads();
        const int ksl = F.tid >> 3, c4 = F.tid & 7;
        for (int it = F.blk; it < 192; it += F.G) {
            f32x4 w[16];
#pragma unroll
            for (int kk = 0; kk < 16; ++kk) w[kk] = *(const f32x4*)(wada + (size_t)(16 * ksl + kk) * 6144 + 32 * it + 4 * c4);
#pragma unroll
            for (int b = 0; b < 8; ++b) { f32x4 a = (f32x4){0.f, 0.f, 0.f, 0.f};
#pragma unroll
                for (int k4 = 0; k4 < 4; ++k4) { const f32x4 cv = *(const LAS f32x4*)(cs + b * 1024 + 16 * ksl + 4 * k4);
                    a += w[4 * k4] * cv.x + w[4 * k4 + 1] * cv.y + w[4 * k4 + 2] * cv.z + w[4 * k4 + 3] * cv.w; }
                *(LAS f32x4*)(red + (ksl * 8 + b) * 32 + 4 * c4) = a; }
            __syncthreads();
            if (F.tid < 256) { const int b = F.tid >> 5, col = F.tid & 31; float sacc = F.a->in[IN_BADA][32 * it + col];
#pragma unroll 8
                for (int k = 0; k < 64; ++k) sacc += red[(k * 8 + b) * 32 + col];
                MOD[b * 6144 + 32 * it + col] = sacc; }
            __syncthreads();
        }
    }
}

template <bool SECOND, int MODE = 0> DI void p_norm(Frame& F) {
    unsigned char* ws = F.a->ws; const int lane = F.lane;
    LAS float* Wt = (LAS float*)(F.lds + (MODE != 0 ? 8 * 8704 : 0));
    if (MODE == 0) {
    for (int i = F.tid; i < 16384; i += 512) { const int k = i >> 4, g = i & 15; Wt[g * 1024 + k] = SECOND ? F.a->in[IN_WROUTER][k * 16 + g] : F.a->in[IN_WIN][(size_t)k * PCOLS_IN + 2048 + g]; }
    __syncthreads();
    }
    const float* xin = F.a->in[IN_X]; const bf16* x1in = (const bf16*)(ws + WS_X1);
    const float* gvec = SECOND ? F.a->in[IN_GFFN] : F.a->in[IN_GMIX];
    const float* MOD = (const float*)(ws + WS_MOD);
    bf16* HO = (bf16*)(ws + WS_H); unsigned* HO8 = (unsigned*)(ws + WS_HF);
    const int gw = (MODE == 4) ? F.blk * 4 + (F.wave - 4) : F.blk * 8 + F.wave, NGW = (MODE == 4) ? F.G * 4 : F.G * 8;
    typedef typename std::conditional<SECOND, v2u, f32x4>::type raw_t;
    auto load_rows = [&](raw_t (&raw)[4][4], int rq) {
#pragma unroll
        for (int r = 0; r < 4; ++r) { const raw_t* xr = SECOND ? (const raw_t*)((const v2u*)(x1in + (size_t)(4 * rq + r) * 1024) + lane) : (const raw_t*)((const f32x4*)(xin + (size_t)(4 * rq + r) * 1024) + lane);
#pragma unroll
            for (int j = 0; j < 4; ++j) raw[r][j] = __builtin_nontemporal_load(xr + 64 * j); }
    };
    auto process = [&](const raw_t (&raw)[4][4], int rq) __attribute__((always_inline)) {
        const int row0 = 4 * rq, b = row0 >> 12;
        f32x4 v[4][4]; float ss[4];
#pragma unroll
        for (int r = 0; r < 4; ++r) { ss[r] = 0.f;
#pragma unroll
            for (int j = 0; j < 4; ++j) {
                if constexpr (SECOND) { const v2u w = raw[r][j]; v[r][j] = (f32x4){__builtin_bit_cast(float, w.x << 16), __builtin_bit_cast(float, w.x & 0xffff0000u), __builtin_bit_cast(float, w.y << 16), __builtin_bit_cast(float, w.y & 0xffff0000u)}; }
                else v[r][j] = raw[r][j];
                ss[r] += (v[r][j].x * v[r][j].x + v[r][j].y * v[r][j].y) + (v[r][j].z * v[r][j].z + v[r][j].w * v[r][j].w); } }
#pragma unroll
        for (int r = 0; r < 4; ++r) ss[r] = wave_sum(ss[r]);
        const float* mb = MOD + b * 6144 + (SECOND ? 3072 : 0);
#pragma unroll
        for (int j = 0; j < 4; ++j) { const int col = 256 * j + 4 * lane;
            const f32x4 g = *(const f32x4*)(gvec + col), sh = *(const f32x4*)(mb + col), sc = *(const f32x4*)(mb + 1024 + col);
            const f32x4 gs = g * (sc + 1.f);
#pragma unroll
            for (int r = 0; r < 4; ++r) v[r][j] = v[r][j] * (rsqrtf(ss[r] * (1.f / 1024.f) + RMS_EPS)) * gs + sh; }
#pragma unroll
        for (int r = 0; r < 4; ++r) {
            if (SECOND) { unsigned* o4 = HO8 + (size_t)(row0 + r) * 256 + lane;
#pragma unroll
                for (int j = 0; j < 4; ++j) o4[64 * j] = pk4_fp8(v[r][j].x, v[r][j].y, v[r][j].z, v[r][j].w); }
            else { unsigned long long* o8 = (unsigned long long*)(HO + (size_t)(row0 + r) * 1024) + lane;
#pragma unroll
                for (int j = 0; j < 4; ++j) o8[64 * j] = (unsigned long long)pk2(v[r][j].x, v[r][j].y) | ((unsigned long long)pk2(v[r][j].z, v[r][j].w) << 32); } }
        float b4[4][4];
#pragma unroll
        for (int q = 0; q < 4; ++q) {
            asm volatile("" ::: "memory");
            float t[4][4];
#pragma unroll
            for (int k = 0; k < 4; ++k) { const int g = q + 4 * k;
                f32x4 w[4];
#pragma unroll
                for (int j = 0; j < 4; ++j) w[j] = *(const LAS f32x4*)(Wt + g * 1024 + 256 * j + 4 * lane);
#pragma unroll
                for (int r = 0; r < 4; ++r) { float a = 0.f;
#pragma unroll
                    for (int j = 0; j < 4; ++j) a += (v[r][j].x * w[j].x + v[r][j].y * w[j].y) + (v[r][j].z * w[j].z + v[r][j].w * w[j].w);
                    t[k][r] = a; } }
            const bool up8 = (lane & 8) != 0, up4 = (lane & 4) != 0;
#pragma unroll
            for (int r = 0; r < 4; ++r) {
                const float u0 = (up8 ? t[2][r] : t[0][r]) + dpp_mov<DPP_MIRROR>(up8 ? t[0][r] : t[2][r]);
                const float u1 = (up8 ? t[3][r] : t[1][r]) + dpp_mov<DPP_MIRROR>(up8 ? t[1][r] : t[3][r]);
                b4[r][q] = (up4 ? u1 : u0) + dpp_mov<DPP_HMIRROR>(up4 ? u0 : u1); }
        }
        float a4[4], a2[2], val;
#pragma unroll
        for (int r = 0; r < 4; ++r) { float b2[2];
            { const bool up = (lane & 2) != 0;
#pragma unroll
              for (int q = 0; q < 2; ++q) { const float mine = up ? b4[r][q + 2] : b4[r][q], oth = up ? b4[r][q] : b4[r][q + 2]; b2[q] = mine + dpp_mov<DPP_XOR2>(oth); } }
            { const bool up = (lane & 1) != 0; const float mine = up ? b2[1] : b2[0], oth = up ? b2[0] : b2[1]; a4[r] = mine + dpp_mov<DPP_XOR1>(oth); }
        }
        { const bool up = (lane & 32) != 0;
#pragma unroll
          for (int q = 0; q < 2; ++q) { const float mine = up ? a4[q + 2] : a4[q], oth = up ? a4[q] : a4[q + 2]; a2[q] = mine + __shfl_xor(oth, 32); } }
        { const bool up = (lane & 16) != 0; const float mine = up ? a2[1] : a2[0], oth = up ? a2[0] : a2[1]; val = mine + __shfl_xor(oth, 16); }
        const int r_ = lane >> 4, g_ = lane & 15;
        if (!SECOND) ((float*)(ws + WS_GATES))[(size_t)row0 * 16 + lane] = val + F.a->in[IN_BIN][2048 + g_];
        else {
            const float mx = row16_max(val);
            const float ex = __expf(val - mx); const float sm = row16_sum(ex);
            ((float*)(ws + WS_AFF))[((size_t)b * 16 + g_) * SEQ + ((row0 + r_) & 4095)] = ex / sm;
        }
    };
    raw_t rawA[4][4], rawB[4][4];
    int rq = gw; bool hasA = rq < MTOK / 4;
    if (hasA) load_rows(rawA, rq);
#pragma unroll 1
    while (hasA) {
        const int rqB = rq + NGW; const bool hasB = rqB < MTOK / 4;
        if (hasB) load_rows(rawB, rqB);
        process(rawA, rq);
        if (!hasB) break;
        rq = rqB + NGW; hasA = rq < MTOK / 4;
        if (hasA) load_rows(rawA, rq);
        process(rawB, rqB);
    }
}

DI void p3_prep(Frame& F) {
    unsigned char* ws = F.a->ws;
    const bf16* P = (const bf16*)(ws + WS_P);
    {
        bf16* QK = (bf16*)(ws + WS_H);
        const float* cw = F.a->in[IN_CQKW]; const float* cb = F.a->in[IN_CQKB];
        const int nthr = F.G * 512;
        const int cg = F.tid & 127, c0 = 8 * cg;
        float wq0[8], wq1[8], wq2[8], bq[8];
#pragma unroll
        for (int e = 0; e < 8; ++e) { wq0[e] = cw[c0 + e]; wq1[e] = cw[1024 + c0 + e]; wq2[e] = cw[2048 + c0 + e]; bq[e] = cb[c0 + e]; }
        const float scale = (c0 >= 512) ? 0.08838834764831845f : 1.f;
        auto load_trip = [&](v4u (&cur)[4], v4u (&prv)[4], v4u (&nxt)[4], int i0) {
#pragma unroll
            for (int q = 0; q < 4; ++q) { const int token = (i0 + q * nthr) >> 7, t = token & 4095;
                const bf16* p0 = P + (size_t)token * NPROJ + c0;
                cur[q] = *(const v4u*)p0; prv[q] = (v4u){0u, 0u, 0u, 0u}; nxt[q] = (v4u){0u, 0u, 0u, 0u};
                if (t > 0) prv[q] = *(const v4u*)(p0 - NPROJ);
                if (t < SEQ - 1) nxt[q] = *(const v4u*)(p0 + NPROJ); }
        };
        auto process = [&](const v4u (&cur)[4], const v4u (&prv)[4], const v4u (&nxt)[4], int i0) __attribute__((always_inline)) {
#pragma unroll
            for (int q = 0; q < 4; ++q) { const int token = (i0 + q * nthr) >> 7;
                float o[8];
#pragma unroll
                for (int e = 0; e < 8; ++e) {
                    const unsigned wp = prv[q][e >> 1], wc = cur[q][e >> 1], wn = nxt[q][e >> 1];
                    const float xp = (e & 1) ? bfhi(wp) : bflo(wp), xc = (e & 1) ? bfhi(wc) : bflo(wc), xn = (e & 1) ? bfhi(wn) : bflo(wn);
                    const float val = bq[e] + wq0[e] * xp + wq1[e] * xc + wq2[e] * xn;
                    o[e] = val * sigmoidf_(val) * scale;
                }
                v4u w; w.x = pk2(o[0], o[1]); w.y = pk2(o[2], o[3]); w.z = pk2(o[4], o[5]); w.w = pk2(o[6], o[7]);
                *(v4u*)(QK + (size_t)token * 1024 + c0) = w; }
        };
        v4u cA[4], pA[4], nA[4], cB[4], pB[4], nB[4];
        int i0 = F.blk * 512 + F.tid; bool hasA = i0 < MTOK * 128;
        if (hasA) load_trip(cA, pA, nA, i0);
#pragma unroll 1
        while (hasA) {
            const int iB = i0 + 4 * nthr; const bool hasB = iB < MTOK * 128;
            if (hasB) load_trip(cB, pB, nB, iB);
            process(cA, pA, nA, i0);
            if (!hasB) break;
            i0 = iB + 4 * nthr; hasA = i0 < MTOK * 128;
            if (hasA) load_trip(cA, pA, nA, i0);
            process(cB, pB, nB, iB);
        }
    }
    {
        unsigned* UT = (unsigned*)(ws + WS_UT);
        LAS unsigned* tile = (LAS unsigned*)(F.lds + F.wave * 8704);
        const float* cw = F.a->in[IN_CHYW]; const float* cb = F.a->in[IN_CHYB];
        const int lane = F.lane, cg = lane & 7, tl = lane >> 3;
        const int gw = F.blk * 8 + F.wave, NGW = F.G * 8;
        __syncthreads();
#pragma unroll 1
        for (int u = gw; u < 4 * 128 * 24; u += NGW) {
            const int cgq = u % 24, tt = (u / 24) & 127, p = u / (24 * 128), hxc = cgq * 64 + cg * 8;
            float w0[8], w1[8], w2[8], bb[8];
#pragma unroll
            for (int e4 = 0; e4 < 2; ++e4) { const f32x4 a0 = *(const f32x4*)(cw + hxc + 4 * e4), a1 = *(const f32x4*)(cw + 1536 + hxc + 4 * e4), a2 = *(const f32x4*)(cw + 3072 + hxc + 4 * e4), a3 = *(const f32x4*)(cb + hxc + 4 * e4);
#pragma unroll
                for (int i = 0; i < 4; ++i) { w0[4 * e4 + i] = a0[i]; w1[4 * e4 + i] = a1[i]; w2[4 * e4 + i] = a2[i]; bb[4 * e4 + i] = a3[i]; } }
#pragma unroll
            for (int g = 0; g < 4; ++g) {
                const int t = tt * 32 + 8 * g + tl;
                unsigned short o[2][8];
#pragma unroll
                for (int bs = 0; bs < 2; ++bs) {
                    const bf16* p0 = P + (size_t)((2 * p + bs) * SEQ + t) * NPROJ + 2048 + hxc;
                    const v4u cur = *(const v4u*)p0;
                    v4u prv = (v4u){0u, 0u, 0u, 0u}, nxt = (v4u){0u, 0u, 0u, 0u};
                    if (t > 0) prv = *(const v4u*)(p0 - NPROJ);
                    if (t < SEQ - 1) nxt = *(const v4u*)(p0 + NPROJ);
#pragma unroll
                    for (int e = 0; e < 8; ++e) {
                        const unsigned wp = prv[e >> 1], wc = cur[e >> 1], wn = nxt[e >> 1];
                        const float xp = (e & 1) ? bfhi(wp) : bflo(wp), xc = (e & 1) ? bfhi(wc) : bflo(wc), xn = (e & 1) ? bfhi(wn) : bflo(wn);
                        o[bs][e] = (unsigned short)f2bf(bb[e] + w0[e] * xp + w1[e] * xc + w2[e] * xn);
                    }
                }
#pragma unroll
                for (int e = 0; e < 8; ++e) tile[(cg * 8 + e) * 33 + 8 * g + tl] = (unsigned)o[0][e] | ((unsigned)o[1][e] << 16);
            }
            LDS_WAIT(); asm volatile("" ::: "memory");
#pragma unroll 8
            for (int i = 0; i < 32; ++i) { const int cl = 2 * i + (lane >> 5), t5 = lane & 31, hx = cgq * 64 + cl, part = hx >> 9, ch = hx & 511;
                UT[(((size_t)part * 4 + p) * 512 + ch) * SEQ + tt * 32 + t5] = tile[cl * 33 + t5]; }
            LDS_WAIT(); asm volatile("" ::: "memory");
        }
    }
}

#define LAUNDER(x) asm volatile("" : "+v"(x))
#define LDS_BARRIER() do { asm volatile("s_waitcnt lgkmcnt(0)" ::: "memory"); __builtin_amdgcn_s_barrier(); asm volatile("" ::: "memory"); } while (0)

DI void p5_post(Frame& F) {
    unsigned char* ws = F.a->ws; const int lane = F.lane;
    bf16* Y = (bf16*)(ws + WS_H); const bf16* P = (const bf16*)(ws + WS_P); const bf16* HM = (const bf16*)(ws + WS_HM);
    {
        const int gw = F.blk * 8 + F.wave, NGW = F.G * 8;
        const f32x4 g0 = *(const f32x4*)(F.a->in[IN_MNG] + 8 * lane), g1 = *(const f32x4*)(F.a->in[IN_MNG] + 8 * lane + 4);
        for (int row = gw; row < MTOK; row += NGW) {
            const v4u a = *(const v4u*)(HM + (size_t)row * 512 + 8 * lane), bq = *(const v4u*)(HM + ((size_t)MTOK + row) * 512 + 8 * lane);
            const v4u ov = *(const v4u*)(P + (size_t)row * NPROJ + 1536 + 8 * lane);
            float hsum[8], og[8];
#pragma unroll
            for (int e = 0; e < 4; ++e) { hsum[2 * e] = bflo(a[e]) + bflo(bq[e]); hsum[2 * e + 1] = bfhi(a[e]) + bfhi(bq[e]); og[2 * e] = bflo(ov[e]); og[2 * e + 1] = bfhi(ov[e]); }
            float ss = 0.f;
#pragma unroll
            for (int e = 0; e < 8; ++e) ss += hsum[e] * hsum[e];
            ss = row16_sum(ss);
            const float rstd = rsqrtf(ss * (1.f / 128.f) + RMS_EPS);
            const float gg[8] = {g0.x, g0.y, g0.z, g0.w, g1.x, g1.y, g1.z, g1.w};
            float o[8];
#pragma unroll
            for (int e = 0; e < 8; ++e) o[e] = sigmoidf_(og[e]) * hsum[e] * rstd * gg[e];
            v4u w; w.x = pk2(o[0], o[1]); w.y = pk2(o[2], o[3]); w.z = pk2(o[4], o[5]); w.w = pk2(o[6], o[7]);
            *(v4u*)(Y + (size_t)row * 1024 + 8 * lane) = w;
        }
    }
    {
        const bf16* ZT = (const bf16*)(ws + WS_ZT);
        LAS bf16* tile = (LAS bf16*)F.lds;
        const f32x4 g0 = *(const f32x4*)(F.a->in[IN_HNG] + 8 * lane), g1 = *(const f32x4*)(F.a->in[IN_HNG] + 8 * lane + 4);
        const float gg[8] = {g0.x, g0.y, g0.z, g0.w, g1.x, g1.y, g1.z, g1.w};
        __syncthreads();
        for (int u = F.blk; u < 4 * 128; u += F.G) {
            const int p = u >> 7, tt = u & 127;
            for (int pc = F.tid; pc < 4096; pc += 512) {
                const int c = pc >> 3, q = pc & 7;
                const v4u v = *(const v4u*)(ZT + (((size_t)p * 512 + c) * SEQ + tt * 32) * 2 + q * 8);
#pragma unroll
                for (int i = 0; i < 4; ++i) { tile[((4 * q + i) * 2 + 0) * 520 + c] = (bf16)(v[i] & 0xffffu); tile[((4 * q + i) * 2 + 1) * 520 + c] = (bf16)(v[i] >> 16); }
            }
            __syncthreads();
#pragma unroll 2
            for (int rr = 0; rr < 8; ++rr) {
                const int row = F.wave * 8 + rr, t = row >> 1, bs = row & 1, token = (2 * p + bs) * SEQ + tt * 32 + t;
                const v4u v = *(const LAS v4u*)(tile + row * 520 + 8 * lane);
                float z[8];
#pragma unroll
                for (int e = 0; e < 4; ++e) { z[2 * e] = bflo(v[e]); z[2 * e + 1] = bfhi(v[e]); }
                float ss = 0.f;
#pragma unroll
                for (int e = 0; e < 8; ++e) ss += z[e] * z[e];
                ss = row16_sum(ss);
                const float rstd = rsqrtf(ss * (1.f / 128.f) + RMS_EPS);
                v4u w; w.x = pk2(z[0] * rstd * gg[0], z[1] * rstd * gg[1]); w.y = pk2(z[2] * rstd * gg[2], z[3] * rstd * gg[3]);
                w.z = pk2(z[4] * rstd * gg[4], z[5] * rstd * gg[5]); w.w = pk2(z[6] * rstd * gg[6], z[7] * rstd * gg[7]);
                *(v4u*)(Y + (size_t)token * 1024 + 512 + 8 * lane) = w;
            }
            __syncthreads();
        }
    }
}

template <int WSEL> DI void conv_experts(Frame& F) {
    LAS float* scr = (LAS float*)(F.lds + F.wave * 8704); unsigned char* WGU8 = F.a->ws + WS_WGU; unsigned char* WD8 = F.a->ws + WS_WD;
    const int gw = WSEL ? F.blk * 4 + F.wave : F.blk * 8 + F.wave, NGW = WSEL ? F.G * 4 : F.G * 8;
#pragma unroll 1
    for (int base = 4 * gw; base < 49152; base += 4 * NGW) {
#pragma unroll 1
        for (int q = 0; q < 4; ++q) {
            const int it = (int)base + q;
            if (it >= 16384) {
                const int i1 = it - 16384, nb = i1 & 127, kb = (i1 >> 7) & 15, e = i1 >> 11, n0 = 32 * nb, k0 = 64 * kb, j = n0 >> 8, r = n0 & 255, f0 = 128 * j + (r & 127);
                const float* W = (r < 128 ? F.a->in[IN_WGATE] : F.a->in[IN_WUP]) + (size_t)e * 1024 * 2048;
                transpose_item_fp8(W + (size_t)k0 * 2048 + f0, 2048, WGU8 + ((size_t)e * 4096 + n0) * 1024 + k0, 1024, 64.f, scr, F.lane);
            } else {
                const int nb = it & 31, kb = (it >> 5) & 31, e = it >> 10, n0 = 32 * nb, k0 = 64 * kb;
                transpose_item_fp8(F.a->in[IN_WDOWN] + (size_t)e * 2048 * 1024 + (size_t)k0 * 1024 + n0, 1024, WD8 + ((size_t)e * 1024 + n0) * 2048 + k0, 2048, 64.f, scr, F.lane);
            }
        }
    }
}

DI void p8_topk(Frame& F) {
    unsigned char* ws = F.a->ws; const int tid = F.tid, lane = F.lane, wave = F.wave;
    LAS unsigned* hist = (LAS unsigned*)F.lds;
    LAS unsigned* wtot = hist + 256;
    LAS unsigned* ctl = wtot + 8;
    const float* AFF = (const float*)(ws + WS_AFF);
    int* IDX = (int*)(ws + WS_IDX); float* GSEL = (float*)(ws + WS_GSEL); int* INV = (int*)(ws + WS_INV);
    for (int it = F.blk; it < NB * NEXP; it += F.G) {
        const int b = it >> 4, e = it & 15;
        unsigned k8[8];
        { const v4u a = *(const v4u*)(AFF + (size_t)it * SEQ + 8 * tid), c2 = *(const v4u*)(AFF + (size_t)it * SEQ + 8 * tid + 4);
          k8[0] = a.x; k8[1] = a.y; k8[2] = a.z; k8[3] = a.w; k8[4] = c2.x; k8[5] = c2.y; k8[6] = c2.z; k8[7] = c2.w; }
        unsigned prefix = 0u, need = CAP;
#pragma unroll 1
        for (int pass = 0; pass < 4; ++pass) {
            const int shift = 24 - 8 * pass; const unsigned mask = pass ? (0xffffffffu << (shift + 8)) : 0u;
            if (tid < 256) hist[tid] = 0u;
            __syncthreads();
#pragma unroll
            for (int i = 0; i < 8; ++i) if ((k8[i] & mask) == prefix) atomicAdd((unsigned*)(hist + ((k8[i] >> shift) & 255u)), 1u);
            __syncthreads();
            if (wave == 0) {
                const unsigned h0 = hist[4 * lane], h1 = hist[4 * lane + 1], h2 = hist[4 * lane + 2], h3 = hist[4 * lane + 3], s = h0 + h1 + h2 + h3;
                unsigned suf = s;
#pragma unroll
                for (int o = 1; o < 64; o <<= 1) { const unsigned t = __shfl_down(suf, o); if (lane + o < 64) suf += t; }
                const unsigned above = suf - s;
                if (above < need && need <= suf) {
                    unsigned rem = need - above; int bin;
                    if (h3 >= rem) bin = 3; else { rem -= h3; if (h2 >= rem) bin = 2; else { rem -= h2; if (h1 >= rem) bin = 1; else { rem -= h1; bin = 0; } } }
                    ctl[0] = prefix | ((unsigned)(4 * lane + bin) << shift); ctl[1] = rem;
                }
            }
            __syncthreads();
            prefix = ctl[0]; need = ctl[1];
        }
        const unsigned T = prefix;
        unsigned cg = 0u, ce = 0u;
#pragma unroll
        for (int i = 0; i < 8; ++i) { cg += (k8[i] > T) ? 1u : 0u; ce += (k8[i] == T) ? 1u : 0u; }
        const unsigned pack = cg | (ce << 16);
        unsigned inc = pack;
#pragma unroll
        for (int o = 1; o < 64; o <<= 1) { const unsigned t = __shfl_up(inc, o); if (lane >= o) inc += t; }
        if (lane == 63) wtot[wave] = inc;
        __syncthreads();
        unsigned woff = 0u;
#pragma unroll
        for (int w = 0; w < 8; ++w) woff += (w < wave) ? wtot[w] : 0u;
        const unsigned exc = woff + inc - pack;
        unsigned gtb = exc & 0xffffu, eqb = exc >> 16;
#pragma unroll
        for (int i = 0; i < 8; ++i) {
            const int idx = 8 * tid + i; const bool isgt = k8[i] > T, iseq = k8[i] == T, selc = isgt || (iseq && eqb < need);
            const int slot = (int)(gtb + (eqb < need ? eqb : need));
            if (selc) { IDX[it * CAP + slot] = idx; GSEL[it * CAP + slot] = __uint_as_float(k8[i]); }
            INV[((size_t)b * SEQ + idx) * 16 + e] = selc ? slot : -1;
            gtb += isgt ? 1u : 0u; eqb += iseq ? 1u : 0u;
        }
        __syncthreads();
    }
}

typedef float f32x2 __attribute__((ext_vector_type(2)));
template <bool DRY> DI void p12_final(Frame& F) {
    unsigned char* ws = F.a->ws; const int lane = F.lane;
    const int* INV = (const int*)(ws + WS_INV); const float* GSEL = (const float*)(ws + WS_GSEL); const unsigned char* YS = ws + WS_YS; const float* MOD = (const float*)(ws + WS_MOD);
    const int gw = F.blk * 8 + F.wave, NGW = F.G * 8;
    f32x4 gfin[4];
#pragma unroll
    for (int j = 0; j < 4; ++j) gfin[j] = *(const f32x4*)(F.a->in[IN_GFINAL] + 256 * j + 4 * lane);
#pragma unroll 1
    for (int rq = gw; rq < MTOK / 4; rq += NGW) {
        const int row0 = 4 * rq, b = row0 >> 12;
        const int myslot = INV[(size_t)row0 * 16 + lane];
        f32x4 v[4][4];
#pragma unroll
        for (int r = 0; r < 4; ++r) { const v2u* xb = (const v2u*)((const bf16*)(ws + WS_X1) + (size_t)(row0 + r) * 1024) + lane;
#pragma unroll
            for (int j = 0; j < 4; ++j) { const v2u w = xb[64 * j]; v[r][j] = (f32x4){__builtin_bit_cast(float, w.x << 16), __builtin_bit_cast(float, w.x & 0xffff0000u), __builtin_bit_cast(float, w.y << 16), __builtin_bit_cast(float, w.y & 0xffff0000u)}; } }
        const float mygate = (myslot >= 0) ? GSEL[((size_t)b * 16 + (lane & 15)) * CAP + myslot] : 0.f;
        const unsigned long long mask = __ballot(myslot >= 0);
        f32x4 gt[4];
#pragma unroll
        for (int j = 0; j < 4; ++j) gt[j] = *(const f32x4*)(MOD + b * 6144 + 5120 + 256 * j + 4 * lane);
        float ssq[4];
#pragma unroll
        for (int r = 0; r < 4; ++r) {
            unsigned m = (unsigned)(mask >> (16 * r)) & 0xffffu;
            unsigned y[4][4]; float gk[4];
#pragma unroll
            for (int k = 0; k < 4; ++k) {
                const bool has = (m != 0u); const int e = has ? __builtin_ctz(m) : 0; if (has) m &= m - 1u;
                const int s = has ? __builtin_amdgcn_readlane(myslot, 16 * r + e) : 0;
                gk[k] = has ? __builtin_bit_cast(float, __builtin_amdgcn_readlane(__builtin_bit_cast(int, mygate), 16 * r + e)) * (1.f / 16.f) : 0.f;
                const unsigned* yr = (const unsigned*)(YS + (((size_t)e * NB + b) * CAP + s) * 1024) + lane;
#pragma unroll
                for (int j = 0; j < 4; ++j) y[k][j] = yr[64 * j];
            }
            f32x4 acc[4];
#pragma unroll
            for (int j = 0; j < 4; ++j) { acc[j] = (f32x4){0.f, 0.f, 0.f, 0.f};
#pragma unroll
                for (int k = 0; k < 4; ++k) { const f32x2 lo2 = __builtin_amdgcn_cvt_pk_f32_fp8((int)y[k][j], false), hi2 = __builtin_amdgcn_cvt_pk_f32_fp8((int)y[k][j], true); acc[j] += (f32x4){lo2.x, lo2.y, hi2.x, hi2.y} * gk[k]; } }
            while (m != 0u) {
                const int e = __builtin_ctz(m); m &= m - 1u;
                const int s = __builtin_amdgcn_readlane(myslot, 16 * r + e);
                const float g = __builtin_bit_cast(float, __builtin_amdgcn_readlane(__builtin_bit_cast(int, mygate), 16 * r + e)) * (1.f / 16.f);
                const unsigned* yr = (const unsigned*)(YS + (((size_t)e * NB + b) * CAP + s) * 1024) + lane;
#pragma unroll
                for (int j = 0; j < 4; ++j) { const unsigned w = yr[64 * j]; const f32x2 lo2 = __builtin_amdgcn_cvt_pk_f32_fp8((int)w, false), hi2 = __builtin_amdgcn_cvt_pk_f32_fp8((int)w, true); acc[j] += (f32x4){lo2.x, lo2.y, hi2.x, hi2.y} * g; }
            }
            float ss = 0.f;
#pragma unroll
            for (int j = 0; j < 4; ++j) { v[r][j] = v[r][j] + gt[j] * acc[j]; ss += (v[r][j].x * v[r][j].x + v[r][j].y * v[r][j].y) + (v[r][j].z * v[r][j].z + v[r][j].w * v[r][j].w); }
            ssq[r] = ss;
        }
#pragma unroll
        for (int r = 0; r < 4; ++r) ssq[r] = wave_sum(ssq[r]);
#pragma unroll
        for (int r = 0; r < 4; ++r) { const float rstd = rsqrtf(ssq[r] * (1.f / 1024.f) + RMS_EPS); f32x4* xr = (f32x4*)((DRY ? (float*)(ws + WS_HID) : F.a->out) + (size_t)(row0 + r) * 1024) + lane;
#pragma unroll
            for (int j = 0; j < 4; ++j) xr[64 * j] = v[r][j] * rstd * gfin[j]; }
    }
}

typedef short bf16x8_t __attribute__((ext_vector_type(8)));
DI unsigned offb(unsigned row, unsigned ch) { return 256u * row + 16u * (ch ^ (((row & 3u) << 2) | ((row >> 2) & 3u))); }
DI bf16x8_t tr_read2(unsigned a0, unsigned a1) {
    v2u lo, hi;
    asm volatile("ds_read_b64_tr_b16 %0, %2\n\tds_read_b64_tr_b16 %1, %3\n\ts_waitcnt lgkmcnt(0)" : "=&v"(lo), "=&v"(hi) : "v"(a0), "v"(a1) : "memory");
    const v4u w = (v4u){lo.x, lo.y, hi.x, hi.y};
    return __builtin_bit_cast(bf16x8_t, w);
}
#define TR2(d0, d1, a, o0, o1) "ds_read_b64_tr_b16 %" #d0 ", %" #a " offset:" #o0 "\n\tds_read_b64_tr_b16 %" #d1 ", %" #a " offset:" #o1 "\n\t"
DI void tr_read_vt3(unsigned a, bf16x8_t (&f)[3]) {
    v2u l0, h0, l1, h1, l2, h2;
    asm volatile(TR2(0, 1, 6, 0, 2048) TR2(2, 3, 6, 32, 2080) TR2(4, 5, 6, 64, 2112) "s_waitcnt lgkmcnt(0)"
                 : "=&v"(l0), "=&v"(h0), "=&v"(l1), "=&v"(h1), "=&v"(l2), "=&v"(h2) : "v"(a) : "memory");
    f[0] = __builtin_bit_cast(bf16x8_t, (v4u){l0.x, l0.y, h0.x, h0.y}); f[1] = __builtin_bit_cast(bf16x8_t, (v4u){l1.x, l1.y, h1.x, h1.y}); f[2] = __builtin_bit_cast(bf16x8_t, (v4u){l2.x, l2.y, h2.x, h2.y});
}
DI void tr_read_ve6(unsigned a, bf16x8_t (&f)[2][3]) {
    v2u r[12];
    asm volatile(TR2(0, 1, 12, 0, 512) TR2(2, 3, 12, 32, 544) TR2(4, 5, 12, 64, 576) TR2(6, 7, 12, 4096, 4608) TR2(8, 9, 12, 4128, 4640) TR2(10, 11, 12, 4160, 4672) "s_waitcnt lgkmcnt(0)"
                 : "=&v"(r[0]), "=&v"(r[1]), "=&v"(r[2]), "=&v"(r[3]), "=&v"(r[4]), "=&v"(r[5]), "=&v"(r[6]), "=&v"(r[7]), "=&v"(r[8]), "=&v"(r[9]), "=&v"(r[10]), "=&v"(r[11]) : "v"(a) : "memory");
#pragma unroll
    for (int k = 0; k < 2; ++k)
#pragma unroll
        for (int vt = 0; vt < 3; ++vt) f[k][vt] = __builtin_bit_cast(bf16x8_t, (v4u){r[6 * k + 2 * vt].x, r[6 * k + 2 * vt].y, r[6 * k + 2 * vt + 1].x, r[6 * k + 2 * vt + 1].y});
}
DI void tr_read_kt4(unsigned a0, unsigned a1, bf16x8_t (&f)[4]) {
    v2u r[8];
    asm volatile("ds_read_b64_tr_b16 %0, %8\n\tds_read_b64_tr_b16 %1, %9\n\tds_read_b64_tr_b16 %2, %8 offset:8192\n\tds_read_b64_tr_b16 %3, %9 offset:8192\n\t"
                 "ds_read_b64_tr_b16 %4, %8 offset:16384\n\tds_read_b64_tr_b16 %5, %9 offset:16384\n\tds_read_b64_tr_b16 %6, %8 offset:24576\n\tds_read_b64_tr_b16 %7, %9 offset:24576\n\ts_waitcnt lgkmcnt(0)"
                 : "=&v"(r[0]), "=&v"(r[1]), "=&v"(r[2]), "=&v"(r[3]), "=&v"(r[4]), "=&v"(r[5]), "=&v"(r[6]), "=&v"(r[7]) : "v"(a0), "v"(a1) : "memory");
#pragma unroll
    for (int k = 0; k < 4; ++k) f[k] = __builtin_bit_cast(bf16x8_t, (v4u){r[2 * k].x, r[2 * k].y, r[2 * k + 1].x, r[2 * k + 1].y});
}
typedef __bf16 bf16pair_t __attribute__((ext_vector_type(2)));
DI unsigned cvtpk(float a, float b) { const bf16pair_t v = (bf16pair_t){(__bf16)a, (__bf16)b}; return __builtin_bit_cast(unsigned, v); }
DI bf16x8_t pack8(const f32x4& a, const f32x4& b) { v4u w; asm volatile("v_cvt_pk_bf16_f32 %0, %4, %5\n\tv_cvt_pk_bf16_f32 %1, %6, %7\n\tv_cvt_pk_bf16_f32 %2, %8, %9\n\tv_cvt_pk_bf16_f32 %3, %10, %11\n\ts_nop 1" : "=&v"(w.x), "=&v"(w.y), "=&v"(w.z), "=&v"(w.w) : "v"(a.x), "v"(a.y), "v"(a.z), "v"(a.w), "v"(b.x), "v"(b.y), "v"(b.z), "v"(b.w)); return __builtin_bit_cast(bf16x8_t, w); }
DI bf16x8_t lds_frag(const LAS unsigned char* p) { return *(const LAS bf16x8_t*)p; }
#define MFMA16(a, b, c) __builtin_amdgcn_mfma_f32_16x16x32_bf16((a), (b), (c), 0, 0, 0)
constexpr int ML_QT = 0, ML_KT = 32768, ML_VT = 65536, ML_VE = 81920, ML_CB = 98304, ML_OUT = 110592, ML_SC = 118784, ML_SCSZ = 2688;
DI void p4_mlstm_mfma(Frame& F) {
    unsigned char* ws = F.a->ws; LAS unsigned char* L = F.lds;
    const bf16* QK = (const bf16*)(ws + WS_H); const bf16* P = (const bf16*)(ws + WS_P); const float* GATES = (const float*)(ws + WS_GATES);
    bf16* HM = (bf16*)(ws + WS_HM);
    const int tid = F.tid, lane = F.lane, wave = F.wave, fr = lane & 15, fq = lane >> 4, q4 = fr >> 2, p4 = fr & 3;
    const int tb = (wave < 4) ? wave : 11 - wave;
    const unsigned ldsb = (unsigned)(uintptr_t)L;
    unsigned ro[4], cbw[4], tso[4];
#pragma unroll
    for (int k = 0; k < 4; ++k) { ro[k] = offb(fr, 4 * k + fq); cbw[k] = offb(4 * fq + k, 2 * wave + (fr >> 3)) + 2 * (fr & 7); tso[k] = offb((tid + 512 * k) >> 4, (tid + 512 * k) & 15); }
    for (int it0 = F.blk; it0 < 256; it0 += F.G) {
        const int it = (F.G == 256) ? (((it0 & 7) * 4 + (it0 >> 6)) * 8 + ((it0 >> 3) & 7)) : it0;
        const int vs = it & 3, dir = (it >> 2) & 1, h = (it >> 3) & 3, b = it >> 5;
        __syncthreads();
        for (int i = tid; i < 12288 / 16; i += 512) *(LAS v4u*)(L + ML_CB + 16 * i) = (v4u){0u, 0u, 0u, 0u};
        if (tid < 256) { const int row = tid >> 1, hf = tid & 1;
            *(LAS v4u*)(L + ML_VT + row * 128 + 64 + 16 * hf) = (v4u){hf ? 0u : 0x3F80u, 0u, 0u, 0u};
            *(LAS v4u*)(L + ML_VE + row * 128 + 64 + 16 * hf) = (v4u){0u, 0u, 0u, 0u}; }
        f32x4 Cacc[3];
#pragma unroll
        for (int vt = 0; vt < 3; ++vt) Cacc[vt] = (f32x4){0.f, 0.f, 0.f, 0.f};
        float m_in = -1e30f;
        float gpre[4] = {0.f, 0.f, 0.f, 0.f};
        v4u rqA[4], rkA[4], rvA, rqB[4], rkB[4], rvB;
        auto load_gates = [&](int cj) {
#pragma unroll
            for (int e = 0; e < 2; ++e) { const int tg = cj * 128 + 2 * lane + e, token = b * SEQ + (dir ? SEQ - 1 - tg : tg);
                gpre[2 * e] = GATES[(size_t)token * 16 + 8 * dir + h]; gpre[2 * e + 1] = GATES[(size_t)token * 16 + 8 * dir + 4 + h]; }
        };
        auto scan = [&](int cj) {
            LAS float* SC = (LAS float*)(L + ML_SC + (cj & 1) * ML_SCSZ);
            const float lf0 = fminf(gpre[1], 0.f) - log1pf(__expf(-fabsf(gpre[1]))), lf1 = fminf(gpre[3], 0.f) - log1pf(__expf(-fabsf(gpre[3])));
            float inc = lf0 + lf1;
#pragma unroll
            for (int o = 1; o < 64; o <<= 1) { const float t = __shfl_up(inc, o); if (lane >= o) inc += t; }
            const float b1 = inc, b0 = inc - lf1, u0 = gpre[0] - b0, u1 = gpre[2] - b1;
            float imx = fmaxf(u0, u1);
#pragma unroll
            for (int o = 1; o < 64; o <<= 1) { const float t = __shfl_up(imx, o); if (lane >= o) imx = fmaxf(imx, t); }
            float exm = __shfl_up(imx, 1); if (lane == 0) exm = -3.0e38f;
            const float M0 = fmaxf(m_in, fmaxf(exm, u0)), M1 = fmaxf(m_in, imx);
            const float g = __shfl(b1, 63), Ml = __shfl(M1, 63);
            SC[2 * lane] = u0; SC[2 * lane + 1] = u1;
            SC[128 + 2 * lane] = M0; SC[128 + 2 * lane + 1] = M1;
            SC[256 + 2 * lane] = __expf(m_in - M0); SC[256 + 2 * lane + 1] = __expf(m_in - M1);
            SC[384 + 2 * lane] = __expf(-(b0 + M0)); SC[384 + 2 * lane + 1] = __expf(-(b1 + M1));
            SC[512 + 2 * lane] = __expf(u0 - Ml); SC[512 + 2 * lane + 1] = __expf(u1 - Ml);
            if (lane == 0) SC[640] = __expf(m_in - Ml);
            m_in = g + Ml;
        };
        auto load_tiles = [&](int cj, v4u (&rq)[4], v4u (&rk)[4], v4u& rv) {
#pragma unroll
            for (int i = 0; i < 4; ++i) { const int id = tid + 512 * i, row = id >> 4, ch = id & 15, tg = cj * 128 + row, token = b * SEQ + (dir ? SEQ - 1 - tg : tg);
                rq[i] = *(const v4u*)(QK + (size_t)token * 1024 + h * 128 + 8 * ch); rk[i] = *(const v4u*)(QK + (size_t)token * 1024 + 512 + h * 128 + 8 * ch); }
            { const int row = tid >> 2, pc = tid & 3, tg = cj * 128 + row, token = b * SEQ + (dir ? SEQ - 1 - tg : tg);
              rv = *(const v4u*)(P + (size_t)token * NPROJ + 1024 + h * 128 + 32 * vs + 8 * pc); }
        };
        auto store_tiles = [&](int cj, const v4u (&rq)[4], const v4u (&rk)[4], const v4u& rv) {
            const LAS float* SC = (const LAS float*)(L + ML_SC + (cj & 1) * ML_SCSZ);
#pragma unroll
            for (int i = 0; i < 4; ++i) { *(LAS v4u*)(L + ML_QT + tso[i]) = rq[i]; *(LAS v4u*)(L + ML_KT + tso[i]) = rk[i]; }
            { const int row = tid >> 2, pc = tid & 3; const float e = SC[512 + row];
              *(LAS v4u*)(L + ML_VT + row * 128 + 16 * pc) = rv;
              v4u w; w.x = cvtpk(bflo(rv.x) * e, bfhi(rv.x) * e); w.y = cvtpk(bflo(rv.y) * e, bfhi(rv.y) * e); w.z = cvtpk(bflo(rv.z) * e, bfhi(rv.z) * e); w.w = cvtpk(bflo(rv.w) * e, bfhi(rv.w) * e);
              *(LAS v4u*)(L + ML_VE + row * 128 + 16 * pc) = w;
              if (pc == 0) *(LAS bf16*)(L + ML_VE + row * 128 + 64) = (bf16)f2bf(e); }
        };
        if (wave == 0) { load_gates(0); scan(0); load_gates(1); }
        load_tiles(0, rqA, rkA, rvA);
        __syncthreads();
        store_tiles(0, rqA, rkA, rvA);
        load_tiles(1, rqB, rkB, rvB); load_tiles(2, rqA, rkA, rvA);
        LDS_BARRIER();
#pragma unroll 1
        for (int cj2 = 0; cj2 < 32; cj2 += 2) {
#pragma unroll
          for (int par = 0; par < 2; ++par) {
            const int cj = cj2 + par;
            const LAS float* SC = (const LAS float*)(L + ML_SC + (cj & 1) * ML_SCSZ);
            if (cj + 1 < 32) { if (wave == 0) { scan(cj + 1); if (cj + 2 < 32) load_gates(cj + 2); } }
            bf16x8_t qf[4];
#pragma unroll
            for (int ks = 0; ks < 4; ++ks) qf[ks] = lds_frag(L + ML_QT + tb * 4096 + ro[ks]);
            f32x4 accO[3];
#pragma unroll
            for (int vt = 0; vt < 3; ++vt) { accO[vt] = (f32x4){0.f, 0.f, 0.f, 0.f};
#pragma unroll
                for (int ks = 0; ks < 4; ++ks) accO[vt] = MFMA16(qf[ks], lds_frag(L + ML_CB + vt * 4096 + ro[ks]), accO[vt]); }
            { const f32x4 ei = *(const LAS f32x4*)(SC + 256 + 16 * tb + 4 * fq);
#pragma unroll
              for (int vt = 0; vt < 3; ++vt) accO[vt] = accO[vt] * ei; }
            const float mrow_t = SC[128 + 16 * tb + fr];
            for (int ks2 = 0; ks2 <= (tb >> 1); ++ks2) {
                f32x4 st[2];
#pragma unroll
                for (int hh = 0; hh < 2; ++hh) {
                    const int sb = 2 * ks2 + hh;
                    st[hh] = (f32x4){0.f, 0.f, 0.f, 0.f};
                    if (sb <= tb) {
                        f32x4 acc = (f32x4){0.f, 0.f, 0.f, 0.f};
#pragma unroll
                        for (int kd = 0; kd < 4; ++kd) acc = MFMA16(lds_frag(L + ML_KT + sb * 4096 + ro[kd]), qf[kd], acc);
                        const f32x4 us = *(const LAS f32x4*)(SC + 16 * sb + 4 * fq);
#pragma unroll
                        for (int r = 0; r < 4; ++r) st[hh][r] = acc[r] * __expf(us[r] - mrow_t);
                        if (sb == tb) {
#pragma unroll
                            for (int r = 0; r < 4; ++r) st[hh][r] = (4 * fq + r <= fr) ? st[hh][r] : 0.f; }
                    }
                }
                const bf16x8_t sp = pack8(st[0], st[1]);
                bf16x8_t vf[3]; tr_read_vt3(ldsb + ML_VT + (32 * ks2 + 4 * fq + q4) * 128 + 8 * p4, vf);
#pragma unroll
                for (int vt = 0; vt < 3; ++vt) accO[vt] = MFMA16(sp, vf[vt], accO[vt]);
            }
            { const f32x4 enm = *(const LAS f32x4*)(SC + 384 + 16 * tb + 4 * fq);
#pragma unroll
              for (int r = 0; r < 4; ++r) { const float den = __shfl(accO[2][r], lane & 48), inv = 1.f / fmaxf(fabsf(den), enm[r]);
                  const int t = 16 * tb + 4 * fq + r;
                  const unsigned pr = cvtpk(accO[0][r] * inv, accO[1][r] * inv);
                  *(LAS bf16*)(L + ML_OUT + t * 64 + 2 * fr) = (bf16)(pr & 0xffffu); *(LAS bf16*)(L + ML_OUT + t * 64 + 32 + 2 * fr) = (bf16)(pr >> 16); } }
            { const float sp = SC[640];
#pragma unroll
              for (int vt = 0; vt < 3; ++vt) Cacc[vt] = Cacc[vt] * sp; }
            {
                const unsigned r0 = 8 * fq + q4;
                bf16x8_t kb[4]; tr_read_kt4(ldsb + ML_KT + offb(r0, 2 * wave + (p4 >> 1)) + 8 * (p4 & 1), ldsb + ML_KT + offb(r0 + 4, 2 * wave + (p4 >> 1)) + 8 * (p4 & 1), kb);
                const unsigned ea = ldsb + ML_VE + r0 * 128 + 8 * p4;
#pragma unroll
                for (int kp = 0; kp < 2; ++kp) {
                    bf16x8_t ve[2][3]; tr_read_ve6(ea + kp * 64 * 128, ve);
#pragma unroll
                    for (int k = 0; k < 2; ++k)
#pragma unroll
                        for (int vt = 0; vt < 3; ++vt) Cacc[vt] = MFMA16(ve[k][vt], kb[2 * kp + k], Cacc[vt]);
                }
            }
            LDS_BARRIER();
#pragma unroll
            for (int vt = 0; vt < 3; ++vt)
#pragma unroll
                for (int r = 0; r < 4; r += 2) { const unsigned pr = cvtpk(Cacc[vt][r], Cacc[vt][r + 1]);
                    *(LAS bf16*)(L + ML_CB + vt * 4096 + cbw[r]) = (bf16)(pr & 0xffffu); *(LAS bf16*)(L + ML_CB + vt * 4096 + cbw[r + 1]) = (bf16)(pr >> 16); }
            { const int row = tid >> 2, pc = tid & 3, tg = cj * 128 + row, token = b * SEQ + (dir ? SEQ - 1 - tg : tg);
              *(v4u*)(HM + ((size_t)dir * MTOK + token) * 512 + h * 128 + 32 * vs + 8 * pc) = *(const LAS v4u*)(L + ML_OUT + row * 64 + 16 * pc); }
            if (par == 0) { if (cj + 1 < 32) store_tiles(cj + 1, rqB, rkB, rvB); if (cj + 3 < 32) load_tiles(cj + 3, rqB, rkB, rvB); }
            else          { if (cj + 1 < 32) store_tiles(cj + 1, rqA, rkA, rvA); if (cj + 3 < 32) load_tiles(cj + 3, rqA, rkA, rvA); }
            LDS_BARRIER();
          }
        }
    }
}
HD unsigned pkc(float re, float im) {
#if defined(__HIP_DEVICE_COMPILE__)
    unsigned r; asm("v_cvt_pk_bf16_f32 %0, %1, %2" : "=v"(r) : "v"(re), "v"(im)); return r;
#else
    unsigned a = __builtin_bit_cast(unsigned, re), b = __builtin_bit_cast(unsigned, im);
    a = (a + 0x7fffu + ((a >> 16) & 1u)) >> 16; b = (b + 0x7fffu + ((b >> 16) & 1u)) >> 16; return a | (b << 16);
#endif
}
HD cf2 upk(unsigned w) { return MK2(__builtin_bit_cast(float, w << 16), __builtin_bit_cast(float, w & 0xffff0000u)); }
HD int wphys(int i) { return i + (i >> 4); }
HD cf2 p_mul(cf2 a, cf2 b) { return MK2(a.x * b.x - a.y * b.y, a.x * b.y + a.y * b.x); }
HD cf2 p_mulc(cf2 a, cf2 b) { return MK2(a.x * b.x + a.y * b.y, a.y * b.x - a.x * b.y); }
constexpr int FFT2_XWORDS = 8192 + 512;
HD float cos16(int j) {
#if defined(__HIP_DEVICE_COMPILE__)
    return cospif((float)(j & 15) * 0.125f);
#else
    constexpr float C[16] = {1.f, W16_C1, W16_H, W16_S1, 0.f, -W16_S1, -W16_H, -W16_C1, -1.f, -W16_C1, -W16_H, -W16_S1, 0.f, W16_S1, W16_H, W16_C1}; return C[j & 15];
#endif
}
HD float sin16(int j) { return cos16(j + 12); }
HD void dft_mat_frag(int lane, int s, bool inv, unsigned (&w)[4]) {
    const int r = lane & 31, h = lane >> 5, rr = r >> 1, rp = r & 1;
    float v[8];
#pragma unroll
    for (int j = 0; j < 8; ++j) {
        const int k = 16 * s + 8 * h + j, kk = k >> 1, kp = k & 1, a = (rr * kk) & 15;
        const float c = cos16(a), sn = inv ? -sin16(a) : sin16(a);
        v[j] = (rp == 0) ? (kp == 0 ? c : sn) : (kp == 0 ? -sn : c);
    }
#pragma unroll
    for (int j = 0; j < 4; ++j) w[j] = pkc(v[2 * j], v[2 * j + 1]);
}
HD cf2 tw8k(cf2 t8, int kbase, int h) { const cf2 w0 = w32_const(kbase), w1 = w32_const(kbase + 4); const cf2 w = h ? w1 : w0; return p_mul(t8, w); }
HD cf2 tw8k2(cf2 t8, int kbase, int h) { const cf2 w0 = w32_const(kbase), w1 = w32_const(kbase + 2); const cf2 w = h ? w1 : w0; return p_mul(t8, w); }

template <class TP> HD void f2_passA_fwd_tw(int wave, int lane, TP TW8, cf2 (&wl)[8]) {
    const int n = lane & 31, h = lane >> 5, lo = 32 * wave + n; const cf2 t8 = TW8[lo];
#pragma unroll
    for (int s = 0; s < 2; ++s)
#pragma unroll
        for (int i = 0; i < 4; ++i) wl[4 * s + i] = tw8k(t8, 8 * s + i, h);
}
template <bool BZ> HD void f2_passA_fwd_build(const unsigned (&a8)[8], const unsigned (&b8)[8], const cf2 (&wl)[8], unsigned (&B0)[2][4], unsigned (&B1)[2][4]) {
#pragma unroll
    for (int s = 0; s < 2; ++s)
#pragma unroll
        for (int i = 0; i < 4; ++i) {
            const cf2 a = upk(a8[4 * s + i]); cf2 d = a;
            if (BZ) B0[s][i] = a8[4 * s + i];
            else { const cf2 b = upk(b8[4 * s + i]); B0[s][i] = pkc(a.x + b.x, a.y + b.y); d = MK2(a.x - b.x, a.y - b.y); }
            const cf2 p = p_mul(d, wl[4 * s + i]); B1[s][i] = pkc(p.x, p.y);
        }
}
template <bool BZ, class TP> HD void f2_passA_fwd_load(int wave, int lane, const unsigned (&a8)[8], const unsigned (&b8)[8], TP TW8, unsigned (&B0)[2][4], unsigned (&B1)[2][4]) {
    cf2 wl[8]; f2_passA_fwd_tw(wave, lane, TW8, wl); f2_passA_fwd_build<BZ>(a8, b8, wl, B0, B1);
}
template <class TP> HD void f2_passA_fwd_twr(int wave, int lane, TP TWA, cf2 (&tw)[8]) {
    const int n = lane & 31, h = lane >> 5, lo = 32 * wave + n, t0 = 512 * h + lo;
#pragma unroll
    for (int g = 0; g < 4; ++g)
#pragma unroll
        for (int e = 0; e < 2; ++e) tw[2 * g + e] = TWA[(4 * g + e) * 256 + t0];
}
template <class XP> HD void f2_passA_fwd_st(int wave, int lane, int q, const float (&acc)[16], XP X, const cf2 (&tw)[8]) {
    const int n = lane & 31, h = lane >> 5, lo = 32 * wave + n, p0 = wphys(q * 4096 + lo) + 544 * h;
#pragma unroll
    for (int g = 0; g < 4; ++g)
#pragma unroll
        for (int e = 0; e < 2; ++e) {
            const cf2 o = p_mul(MK2(acc[4 * g + 2 * e], acc[4 * g + 2 * e + 1]), tw[2 * g + e]);
            X[p0 + 272 * (4 * g + e)] = pkc(o.x, o.y);
        }
}
template <class XP, class TP> HD void f2_passA_fwd_store(int wave, int lane, int q, const float (&acc)[16], XP X, TP TWA) { cf2 tw[8]; f2_passA_fwd_twr(wave, lane, TWA, tw); f2_passA_fwd_st(wave, lane, q, acc, X, tw); }
template <class XP> HD void f2_passB_load(int wave, int lane, int q, XP X, unsigned (&B)[2][4]) {
    const int n = lane & 31, h = lane >> 5, bb = 32 * wave + n, p0 = wphys(q * 4096 + (bb >> 4) * 256 + (bb & 15));
#pragma unroll
    for (int s = 0; s < 2; ++s)
#pragma unroll
        for (int i = 0; i < 4; ++i) B[s][i] = X[p0 + 17 * (8 * s + 4 * h + i)];
}
template <class TP> HD void f2_passB_fwd_twr(int wave, int lane, TP TWB, cf2 (&tw)[8]) {
    const int n = lane & 31, h = lane >> 5, bb = 32 * wave + n, lo16 = bb & 15, t0 = 32 * h + lo16;
#pragma unroll
    for (int g = 0; g < 4; ++g)
#pragma unroll
        for (int e = 0; e < 2; ++e) tw[2 * g + e] = TWB[(4 * g + e) * 16 + t0];
}
template <class XP> HD void f2_passB_fwd_st(int wave, int lane, int q, const float (&acc)[16], XP X, const cf2 (&tw)[8]) {
    const int n = lane & 31, h = lane >> 5, bb = 32 * wave + n, lo16 = bb & 15, p0 = wphys(q * 4096 + (bb >> 4) * 256 + lo16) + 34 * h;
#pragma unroll
    for (int g = 0; g < 4; ++g)
#pragma unroll
        for (int e = 0; e < 2; ++e) {
            const cf2 o = p_mul(MK2(acc[4 * g + 2 * e], acc[4 * g + 2 * e + 1]), tw[2 * g + e]);
            X[p0 + 17 * (4 * g + e)] = pkc(o.x, o.y);
        }
}
template <class XP, class TP> HD void f2_passB_fwd_store(int wave, int lane, int q, const float (&acc)[16], XP X, TP TWB) { cf2 tw[8]; f2_passB_fwd_twr(wave, lane, TWB, tw); f2_passB_fwd_st(wave, lane, q, acc, X, tw); }
template <class TP> HD void f2_passB_inv_twr(int wave, int lane, TP TWA, cf2 (&tw)[8]) {
    const int n = lane & 31, h = lane >> 5, bb = 32 * wave + n, hi = bb >> 4, lo16 = bb & 15, t0 = hi * 256 + 32 * h + lo16;
#pragma unroll
    for (int g = 0; g < 4; ++g)
#pragma unroll
        for (int e = 0; e < 2; ++e) tw[2 * g + e] = TWA[t0 + 16 * (4 * g + e)];
}
template <class XP> HD void f2_passB_inv_st(int wave, int lane, int q, const float (&acc)[16], XP X, const cf2 (&tw)[8]) {
    const int n = lane & 31, h = lane >> 5, bb = 32 * wave + n, hi = bb >> 4, lo16 = bb & 15, p0 = wphys(q * 4096 + hi * 256 + lo16) + 34 * h;
#pragma unroll
    for (int g = 0; g < 4; ++g)
#pragma unroll
        for (int e = 0; e < 2; ++e) {
            const cf2 o = p_mulc(MK2(acc[4 * g + 2 * e], acc[4 * g + 2 * e + 1]), tw[2 * g + e]);
            X[p0 + 17 * (4 * g + e)] = pkc(o.x, o.y);
        }
}
template <class XP, class TP> HD void f2_passB_inv_store(int wave, int lane, int q, const float (&acc)[16], XP X, TP TWA) { cf2 tw[8]; f2_passB_inv_twr(wave, lane, TWA, tw); f2_passB_inv_st(wave, lane, q, acc, X, tw); }
template <class XP> HD void f2_passC_load(int wave, int lane, int q, XP X, unsigned (&B)[2][4]) {
    const int n = lane & 31, h = lane >> 5, p0 = 17 * (q * 256 + 32 * wave + n);
#pragma unroll
    for (int s = 0; s < 2; ++s)
#pragma unroll
        for (int i = 0; i < 4; ++i) B[s][i] = X[p0 + 8 * s + 4 * h + i];
}
template <class XP> HD void f2_passC_fwd_store(int wave, int lane, int q, const float (&acc)[16], const cf2 (&kv)[8], XP X) {
    const int n = lane & 31, h = lane >> 5, p0 = 17 * (q * 256 + 32 * wave + n);
#pragma unroll
    for (int g = 0; g < 4; ++g)
#pragma unroll
        for (int e = 0; e < 2; ++e) {
            const cf2 o = p_mul(MK2(acc[4 * g + 2 * e], acc[4 * g + 2 * e + 1]), kv[2 * g + e]);
            X[p0 + 4 * g + e + 2 * h] = pkc(o.x, o.y);
        }
}
template <class TP> HD void f2_passC_inv_twr(int wave, int lane, TP TWB, cf2 (&tw)[8]) {
    const int n = lane & 31, h = lane >> 5, bb = 32 * wave + n, rB = bb & 15, t0 = rB * 16 + 2 * h;
#pragma unroll
    for (int g = 0; g < 4; ++g)
#pragma unroll
        for (int e = 0; e < 2; ++e) tw[2 * g + e] = TWB[t0 + 4 * g + e];
}
template <class XP> HD void f2_passC_inv_st(int wave, int lane, int q, const float (&acc)[16], XP X, const cf2 (&tw)[8]) {
    const int n = lane & 31, h = lane >> 5, bb = 32 * wave + n, p0 = 17 * (q * 256 + bb) + 2 * h;
#pragma unroll
    for (int g = 0; g < 4; ++g)
#pragma unroll
        for (int e = 0; e < 2; ++e) {
            const cf2 o = p_mulc(MK2(acc[4 * g + 2 * e], acc[4 * g + 2 * e + 1]), tw[2 * g + e]);
            X[p0 + 4 * g + e] = pkc(o.x, o.y);
        }
}
template <class XP, class TP> HD void f2_passC_inv_store(int wave, int lane, int q, const float (&acc)[16], XP X, TP TWB) { cf2 tw[8]; f2_passC_inv_twr(wave, lane, TWB, tw); f2_passC_inv_st(wave, lane, q, acc, X, tw); }
template <class XP> HD void f2_passA_inv_load(int wave, int lane, int q, XP X, unsigned (&B)[2][4]) {
    const int n = lane & 31, h = lane >> 5, p0 = wphys(q * 4096 + 32 * wave + n);
#pragma unroll
    for (int s = 0; s < 2; ++s)
#pragma unroll
        for (int i = 0; i < 4; ++i) B[s][i] = X[p0 + 272 * (8 * s + 4 * h + i)];
}
template <class TP> HD void f2_passA_inv_tw(int wave, int lane, TP TW8, cf2 (&wc)[8]) {
    const int n = lane & 31, h = lane >> 5, lo = 32 * wave + n; const cf2 t8 = TW8[lo];
#pragma unroll
    for (int g = 0; g < 4; ++g)
#pragma unroll
        for (int e = 0; e < 2; ++e) wc[2 * g + e] = tw8k2(t8, 4 * g + e, h);
}
HD void f2_passA_inv_comb(const float (&acc0)[16], const float (&acc1)[16], const cf2 (&wc)[8], cf2 (&y)[8]) {
#pragma unroll
    for (int g = 0; g < 4; ++g)
#pragma unroll
        for (int e = 0; e < 2; ++e) {
            const cf2 u0 = MK2(acc0[4 * g + 2 * e], acc0[4 * g + 2 * e + 1]), u1 = MK2(acc1[4 * g + 2 * e], acc1[4 * g + 2 * e + 1]);
            const cf2 p = p_mulc(u1, wc[2 * g + e]);
            y[2 * g + e] = MK2(u0.x + p.x, u0.y + p.y);
        }
}
template <class TP> HD void f2_passA_inv_combine(int wave, int lane, const float (&acc0)[16], const float (&acc1)[16], TP TW8, cf2 (&y)[8]) { cf2 wc[8]; f2_passA_inv_tw(wave, lane, TW8, wc); f2_passA_inv_comb(acc0, acc1, wc, y); }
typedef float f32x16 __attribute__((ext_vector_type(16)));
#define MFMA32(a, b, c) __builtin_amdgcn_mfma_f32_32x32x16_bf16(__builtin_bit_cast(bf16x8_t, (a)), __builtin_bit_cast(bf16x8_t, (b)), (c), 0, 0, 0)
constexpr int H3_X = 0, H3_XQ = 34816, H3_Z1 = 69632, H3_ZQ = 16384, H3_TWA = 102400, H3_TWB = 135168, H3_TW8 = 137216, H3_TS = 34816;
struct DftMats { v4u f[2], i[2]; };
DI void h3_mm2(const DftMats& M, bool inv, const unsigned (&B0)[2][4], const unsigned (&B1)[2][4], float (&out0)[16], float (&out1)[16]) {
    f32x16 acc0, acc1;
#pragma unroll
    for (int i = 0; i < 16; ++i) { acc0[i] = 0.f; acc1[i] = 0.f; }
    const v4u b00 = (v4u){B0[0][0], B0[0][1], B0[0][2], B0[0][3]}, b01 = (v4u){B0[1][0], B0[1][1], B0[1][2], B0[1][3]};
    const v4u b10 = (v4u){B1[0][0], B1[0][1], B1[0][2], B1[0][3]}, b11 = (v4u){B1[1][0], B1[1][1], B1[1][2], B1[1][3]};
    acc0 = MFMA32(inv ? M.i[0] : M.f[0], b00, acc0); acc1 = MFMA32(inv ? M.i[0] : M.f[0], b10, acc1);
    acc0 = MFMA32(inv ? M.i[1] : M.f[1], b01, acc0); acc1 = MFMA32(inv ? M.i[1] : M.f[1], b11, acc1);
#pragma unroll
    for (int i = 0; i < 16; ++i) { out0[i] = acc0[i]; out1[i] = acc1[i]; }
}
DI void mfma_ready(unsigned (&B)[2][4]) {
    asm volatile("s_nop 1" : "+v"(B[0][0]), "+v"(B[0][1]), "+v"(B[0][2]), "+v"(B[0][3]), "+v"(B[1][0]), "+v"(B[1][1]), "+v"(B[1][2]), "+v"(B[1][3]));
}
template <int O> DI void hy3_conv2(int wave, int lane0, const DftMats& M, const unsigned (&vinA)[8], const unsigned (&vinB)[8], LAS unsigned* X0, LAS unsigned* Z10, const LAS cf2* TWA, const LAS cf2* TWB, const LAS cf2* TW8,
                                   const cf2* kg, const unsigned* UzA, const unsigned* UxA, unsigned* ztA, const unsigned* UzB, const unsigned* UxB, unsigned* ztB, float bias) {
    const unsigned zero8[8] = {0u, 0u, 0u, 0u, 0u, 0u, 0u, 0u};
    LAS unsigned* X1 = X0 + H3_XQ / 4; LAS unsigned* Z11 = Z10 + H3_ZQ / 4;
    { int lane = lane0; LAUNDER(lane); const int n = lane & 31, h = lane >> 5, lo = 32 * wave + n;
      cf2 wl[8], tw[8]; f2_passA_fwd_tw(wave, lane, TW8, wl); f2_passA_fwd_twr(wave, lane, TWA, tw);
      unsigned a8[8], b8[8];
#pragma unroll
      for (int s = 0; s < 2; ++s)
#pragma unroll
          for (int i = 0; i < 4; ++i) { a8[4 * s + i] = (O == 0) ? vinA[4 * s + i] : Z10[(8 * s + 4 * h + i) * 256 + lo]; b8[4 * s + i] = (O == 0) ? vinB[4 * s + i] : Z11[(8 * s + 4 * h + i) * 256 + lo]; }
      unsigned B0[2][4], B1[2][4], C0[2][4], C1[2][4];
      f2_passA_fwd_build<true>(a8, zero8, wl, B0, B1); f2_passA_fwd_build<true>(b8, zero8, wl, C0, C1);
      mfma_ready(B0); mfma_ready(B1); mfma_ready(C0); mfma_ready(C1);
      float a0[16], a1[16], c0[16], c1[16]; h3_mm2(M, false, B0, B1, a0, a1); h3_mm2(M, false, C0, C1, c0, c1);
      f2_passA_fwd_st(wave, lane, 0, a0, X0, tw); f2_passA_fwd_st(wave, lane, 1, a1, X0, tw); f2_passA_fwd_st(wave, lane, 0, c0, X1, tw); f2_passA_fwd_st(wave, lane, 1, c1, X1, tw); }
    LDS_BARRIER();
    cf2 kv0[8], kv1[8];
    { int lane = lane0; LAUNDER(lane);
#pragma unroll
      for (int p = 0; p < 8; ++p) { kv0[p] = kg[((0 * 8 + wave) * 8 + p) * 64 + lane]; kv1[p] = kg[((1 * 8 + wave) * 8 + p) * 64 + lane]; }
      cf2 tw[8]; f2_passB_fwd_twr(wave, lane, TWB, tw);
      unsigned B0[2][4], B1[2][4], C0[2][4], C1[2][4];
      f2_passB_load(wave, lane, 0, X0, B0); f2_passB_load(wave, lane, 1, X0, B1); f2_passB_load(wave, lane, 0, X1, C0); f2_passB_load(wave, lane, 1, X1, C1);
      float a0[16], a1[16], c0[16], c1[16]; h3_mm2(M, false, B0, B1, a0, a1); h3_mm2(M, false, C0, C1, c0, c1);
      f2_passB_fwd_st(wave, lane, 0, a0, X0, tw); f2_passB_fwd_st(wave, lane, 1, a1, X0, tw); f2_passB_fwd_st(wave, lane, 0, c0, X1, tw); f2_passB_fwd_st(wave, lane, 1, c1, X1, tw); }
    LDS_WAIT(); asm volatile("" ::: "memory");
    { int lane = lane0; LAUNDER(lane);
      cf2 tw[8]; f2_passC_inv_twr(wave, lane, TWB, tw);
      unsigned B0[2][4], B1[2][4], C0[2][4], C1[2][4];
      f2_passC_load(wave, lane, 0, X0, B0); f2_passC_load(wave, lane, 1, X0, B1); f2_passC_load(wave, lane, 0, X1, C0); f2_passC_load(wave, lane, 1, X1, C1);
      float a0[16], a1[16], c0[16], c1[16]; h3_mm2(M, false, B0, B1, a0, a1); h3_mm2(M, false, C0, C1, c0, c1);
      f2_passC_fwd_store(wave, lane, 0, a0, kv0, X0); f2_passC_fwd_store(wave, lane, 1, a1, kv1, X0); f2_passC_fwd_store(wave, lane, 0, c0, kv0, X1); f2_passC_fwd_store(wave, lane, 1, c1, kv1, X1);
      asm volatile("" ::: "memory");
      f2_passC_load(wave, lane, 0, X0, B0); f2_passC_load(wave, lane, 1, X0, B1); f2_passC_load(wave, lane, 0, X1, C0); f2_passC_load(wave, lane, 1, X1, C1);
      h3_mm2(M, true, B0, B1, a0, a1); h3_mm2(M, true, C0, C1, c0, c1);
      f2_passC_inv_st(wave, lane, 0, a0, X0, tw); f2_passC_inv_st(wave, lane, 1, a1, X0, tw); f2_passC_inv_st(wave, lane, 0, c0, X1, tw); f2_passC_inv_st(wave, lane, 1, c1, X1, tw); }
    LDS_WAIT(); asm volatile("" ::: "memory");
    unsigned fxA[8], fzA[8], fxB[8], fzB[8];
    { int lane = lane0; LAUNDER(lane);
      { const int n = lane & 31, h = lane >> 5, lo = 32 * wave + n;
#pragma unroll
        for (int g = 0; g < 4; ++g)
#pragma unroll
            for (int e = 0; e < 2; ++e) { const int t = (4 * g + 2 * h + e) * 256 + lo; fxA[2 * g + e] = UxA[t]; fzA[2 * g + e] = (O == 0) ? UzA[t] : 0u; fxB[2 * g + e] = UxB[t]; fzB[2 * g + e] = (O == 0) ? UzB[t] : 0u; } }
      cf2 tw[8]; f2_passB_inv_twr(wave, lane, TWA, tw);
      unsigned B0[2][4], B1[2][4], C0[2][4], C1[2][4];
      f2_passB_load(wave, lane, 0, X0, B0); f2_passB_load(wave, lane, 1, X0, B1); f2_passB_load(wave, lane, 0, X1, C0); f2_passB_load(wave, lane, 1, X1, C1);
      float a0[16], a1[16], c0[16], c1[16]; h3_mm2(M, true, B0, B1, a0, a1); h3_mm2(M, true, C0, C1, c0, c1);
      f2_passB_inv_st(wave, lane, 0, a0, X0, tw); f2_passB_inv_st(wave, lane, 1, a1, X0, tw); f2_passB_inv_st(wave, lane, 0, c0, X1, tw); f2_passB_inv_st(wave, lane, 1, c1, X1, tw); }
    LDS_BARRIER();
    { int lane = lane0; LAUNDER(lane); const int n = lane & 31, h = lane >> 5, lo = 32 * wave + n;
      cf2 wc[8]; f2_passA_inv_tw(wave, lane, TW8, wc);
      unsigned B0[2][4], B1[2][4], C0[2][4], C1[2][4];
      f2_passA_inv_load(wave, lane, 0, X0, B0); f2_passA_inv_load(wave, lane, 1, X0, B1); f2_passA_inv_load(wave, lane, 0, X1, C0); f2_passA_inv_load(wave, lane, 1, X1, C1);
      unsigned zq[2][8];
#pragma unroll
      for (int p = 0; p < 8; ++p) { const int t = (4 * (p >> 1) + 2 * h + (p & 1)) * 256 + lo; zq[0][p] = (O == 1) ? Z10[t] : 0u; zq[1][p] = (O == 1) ? Z11[t] : 0u; }
      float a0[16], a1[16], c0[16], c1[16]; h3_mm2(M, true, B0, B1, a0, a1); h3_mm2(M, true, C0, C1, c0, c1);
#pragma unroll
      for (int q = 0; q < 2; ++q) { LAS unsigned* Z1 = q ? Z11 : Z10; unsigned* zt = q ? ztB : ztA;
          cf2 y[8]; if (q == 0) f2_passA_inv_comb(a0, a1, wc, y); else f2_passA_inv_comb(c0, c1, wc, y);
#pragma unroll
          for (int g = 0; g < 4; ++g)
#pragma unroll
              for (int e = 0; e < 2; ++e) { const int p = 2 * g + e, t = (4 * g + 2 * h + e) * 256 + lo; const unsigned fx = q ? fxB[p] : fxA[p], fz = q ? fzB[p] : fzA[p];
                  if (O == 0) Z1[t] = pkc(bflo(fx) * (y[p].x + bias * bflo(fz)), bfhi(fx) * (y[p].y + bias * bfhi(fz)));
                  else { const cf2 z1 = upk(zq[q][p]); zt[t] = pkc(bflo(fx) * (y[p].x + bias * z1.x), bfhi(fx) * (y[p].y + bias * z1.y)); } } } }
    LDS_BARRIER();
}
DI void p4_hyena3(Frame& F) {
    unsigned char* ws = F.a->ws; const int tid = F.tid, wave = F.wave;
    LAS unsigned* X = (LAS unsigned*)(F.lds + H3_X); LAS unsigned* Z1 = (LAS unsigned*)(F.lds + H3_Z1);
    LAS cf2* TWA = (LAS cf2*)(F.lds + H3_TWA); LAS cf2* TWB = (LAS cf2*)(F.lds + H3_TWB); LAS cf2* TW8 = (LAS cf2*)(F.lds + H3_TW8);
    LAS float* TS = (LAS float*)(F.lds + H3_TS);
    const float* FILT = (const float*)F.a->out;
    cf2* KG = (cf2*)(ws + WS_KSP) + (size_t)F.blk * 16384;
    const unsigned* UT = (const unsigned*)(ws + WS_UT); unsigned* ZT = (unsigned*)(ws + WS_ZT);
#pragma unroll 1
    for (int i = tid; i < 4096; i += 512) { const int r = i >> 8, lo = i & 255; float sn, cs; sincospif((float)(r * lo) * (1.f / 2048.f), &sn, &cs); TWA[i] = MK2(cs, -sn); }
    if (tid < 256) { float sn, cs; const int r = tid >> 4, lo = tid & 15; sincospif((float)(r * lo) * (1.f / 128.f), &sn, &cs); TWB[tid] = MK2(cs, -sn);
        sincospif((float)tid * (1.f / 4096.f), &sn, &cs); TW8[tid] = MK2(cs, -sn); }
    DftMats M;
    { unsigned w[4];
      dft_mat_frag(F.lane, 0, false, w); M.f[0] = (v4u){w[0], w[1], w[2], w[3]}; dft_mat_frag(F.lane, 1, false, w); M.f[1] = (v4u){w[0], w[1], w[2], w[3]};
      dft_mat_frag(F.lane, 0, true, w); M.i[0] = (v4u){w[0], w[1], w[2], w[3]}; dft_mat_frag(F.lane, 1, true, w); M.i[1] = (v4u){w[0], w[1], w[2], w[3]}; }
    __syncthreads();
    for (int c = F.blk; c < 512; c += F.G) {
        for (int o2 = 0; o2 < (DUP(15) ? 4 : 2); ++o2) { const int o = o2 & 1;
            const float adf = fabsf(F.a->in[IN_HDELTA][(o * 2) * 512 + c]), adb = fabsf(F.a->in[IN_HDELTA][(o * 2 + 1) * 512 + c]);
            {
                const float* Ff = FILT + (size_t)((o * 2) * 512 + c) * SEQ; const float* Fb = FILT + (size_t)((o * 2 + 1) * 512 + c) * SEQ;
                if (tid == 0) TS[SEQ] = 0.f;
#pragma unroll
                for (int i = 0; i < 8; i += 2) {
                    const int t0 = tid + 512 * i, t1 = t0 + 512; const float f0 = Ff[t0], b0 = Fb[t0], f1 = Ff[t1], b1 = Fb[t1];
                    const float tt0 = (float)t0 * (1.f / 4095.f), tt1 = (float)t1 * (1.f / 4095.f);
                    const float hf0 = f0 * (__expf(-tt0 * adf) + 0.05f), hb0 = b0 * (__expf(-tt0 * adb) + 0.05f), hf1 = f1 * (__expf(-tt1 * adf) + 0.05f), hb1 = b1 * (__expf(-tt1 * adb) + 0.05f);
                    if (t0 == 0) TS[0] = hf0 + hb0; else { TS[t0] = hf0; TS[2 * SEQ - t0] = hb0; }
                    TS[t1] = hf1; TS[2 * SEQ - t1] = hb1; }
            }
            __syncthreads();
            { int lane = F.lane; LAUNDER(lane); const int n = lane & 31, h = lane >> 5, lo = 32 * wave + n;
              unsigned B0[2][4], B1[2][4]; const cf2 t8 = TW8[lo];
#pragma unroll
              for (int s = 0; s < 2; ++s)
#pragma unroll
                  for (int i = 0; i < 4; ++i) { const int t = (8 * s + 4 * h + i) * 256 + lo; const float a = TS[t], b = TS[SEQ + t], d = a - b; const cf2 w = tw8k(t8, 8 * s + i, h);
                      B0[s][i] = pkc(a + b, 0.f); B1[s][i] = pkc(d * w.x, d * w.y); }
              mfma_ready(B0); mfma_ready(B1);
              float a0[16], a1[16]; h3_mm2(M, false, B0, B1, a0, a1);
              f2_passA_fwd_store(wave, lane, 0, a0, X, TWA); f2_passA_fwd_store(wave, lane, 1, a1, X, TWA); }
            __syncthreads();
            { int lane = F.lane; LAUNDER(lane);
              unsigned B0[2][4], B1[2][4]; f2_passB_load(wave, lane, 0, X, B0); f2_passB_load(wave, lane, 1, X, B1);
              float a0[16], a1[16]; h3_mm2(M, false, B0, B1, a0, a1);
              f2_passB_fwd_store(wave, lane, 0, a0, X, TWB); f2_passB_fwd_store(wave, lane, 1, a1, X, TWB); }
            LDS_WAIT(); asm volatile("" ::: "memory");
            { int lane = F.lane; LAUNDER(lane);
              unsigned B0[2][4], B1[2][4]; f2_passC_load(wave, lane, 0, X, B0); f2_passC_load(wave, lane, 1, X, B1);
              float a0[16], a1[16]; h3_mm2(M, false, B0, B1, a0, a1);
              cf2* kg = KG + o * 8192;
#pragma unroll
              for (int p = 0; p < 8; ++p) { const int g = p >> 1, e = p & 1;
                  kg[((0 * 8 + wave) * 8 + p) * 64 + lane] = MK2(a0[4 * g + 2 * e] * (1.f / 8192.f), a0[4 * g + 2 * e + 1] * (1.f / 8192.f));
                  kg[((1 * 8 + wave) * 8 + p) * 64 + lane] = MK2(a1[4 * g + 2 * e] * (1.f / 8192.f), a1[4 * g + 2 * e + 1] * (1.f / 8192.f)); } }
            __syncthreads();
        }
        const float bias0 = F.a->in[IN_HBIAS][c], bias1 = F.a->in[IN_HBIAS][512 + c];
        unsigned vinA[8], vinB[8];
        { const int n = F.lane & 31, h = F.lane >> 5, lo = 32 * wave + n; const unsigned* Uz = UT + (((size_t)2 * 4 + 0) * 512 + c) * SEQ + lo;
#pragma unroll
          for (int s = 0; s < 2; ++s)
#pragma unroll
              for (int i = 0; i < 4; ++i) { vinA[4 * s + i] = Uz[(8 * s + 4 * h + i) * 256]; vinB[4 * s + i] = Uz[(size_t)512 * SEQ + (8 * s + 4 * h + i) * 256]; } }
#pragma unroll 1
        for (int p2 = 0; p2 < (DUP(16) ? 4 : 2); ++p2) { const int p = 2 * (p2 & 1);
            const unsigned* Ux1 = UT + (((size_t)0 * 4 + p) * 512 + c) * SEQ; const unsigned* Ux2 = UT + (((size_t)1 * 4 + p) * 512 + c) * SEQ; const unsigned* Uz = UT + (((size_t)2 * 4 + p) * 512 + c) * SEQ;
            unsigned* zt = ZT + ((size_t)p * 512 + c) * SEQ; const size_t PQ = (size_t)512 * SEQ;
            hy3_conv2<0>(wave, F.lane, M, vinA, vinB, X, Z1, TWA, TWB, TW8, KG, Uz, Ux1, zt, Uz + PQ, Ux1 + PQ, zt + PQ, bias0);
            if (DUP(16) || p < 2) { const int n = F.lane & 31, h = F.lane >> 5, lo = 32 * wave + n; const unsigned* Un = UT + (((size_t)2 * 4 + ((p + 2) & 3)) * 512 + c) * SEQ + lo;
#pragma unroll
                for (int s = 0; s < 2; ++s)
#pragma unroll
                    for (int i = 0; i < 4; ++i) { vinA[4 * s + i] = Un[(8 * s + 4 * h + i) * 256]; vinB[4 * s + i] = Un[PQ + (8 * s + 4 * h + i) * 256]; } }
            hy3_conv2<1>(wave, F.lane, M, vinA, vinB, X, Z1, TWA, TWB, TW8, KG + 8192, Uz, Ux2, zt, Uz + PQ, Ux2 + PQ, zt + PQ, bias1);
        }
    }
}
__global__ void __launch_bounds__(512, 2) fwd_kernel(Args args) {
    extern __shared__ __attribute__((aligned(16))) unsigned char lds[];
    Frame F;
    F.lds = (LAS unsigned char*)lds;
    F.wave = __builtin_amdgcn_readfirstlane((int)threadIdx.x >> 6); F.lane = lane_id(); F.tid = F.wave * 64 + F.lane;
    F.G = gridDim.x; F.blk = blockIdx.x;
    F.a = &args;
    volatile LAS unsigned* MISC = (volatile LAS unsigned*)(F.lds + MISC_OFF);
    if (F.tid < 64) MISC[F.tid] = 0u;
    __syncthreads();
    if (N_LAUNCHES == 1) (void)xcd_barrier_post((unsigned*)(F.a->ws + WS_CTL), MISC + 8, F.tid == 0);
    const int lo = args.ph_lo, hi = args.ph_hi;
#define IN(k) (lo <= (k) && (k) < hi)

#define SEAM(k) do { if (IN(k) && IN((k) + 1)) { XcdBarrier b_; b_.bar = (unsigned*)(F.a->ws + WS_CTL); b_.x = xb_xcc_id(); b_.st = MISC + 8; xcd_barrier(b_, F.wave == 0 && lane_id() == 0); } } while (0)
    unsigned char* ws = F.a->ws;
    if (IN(0)) { REFRESH(F); p0_prologue(F); if (DUP(0)) { __syncthreads(); p0_prologue(F); } } SEAM(0);
    if (DUP(17) && IN(0) && IN(1)) { for (int q = 0; q < 8; ++q) { XcdBarrier b_; b_.bar = (unsigned*)(F.a->ws + WS_CTL); b_.x = xb_xcc_id(); b_.st = MISC + 8; xcd_barrier(b_, F.wave == 0 && lane_id() == 0); } }
    if (IN(1)) { REFRESH(F);
        {
            pg8::Gemm g{(const pg8::bf16_t*)(ws + WS_W3EXT), (const pg8::bf16_t*)(ws + WS_HEXT), 2048, SEQ, 256}; pg8::StaticOrder S; S.init(2048, SEQ, F.G, F.blk);
            pg8::EpiF32P E{F.a->out, SEQ};
            pg8::gemm_phase<pg8::EpiF32P, pg8::StaticOrder, true, true>(F.lds, g, S, E, F.tid);
        }
        __syncthreads();
        p_norm<false>(F); if (DUP(1)) { __syncthreads(); p_norm<false>(F); } } SEAM(1);
    if (IN(2)) { REFRESH(F);
        pg8::Gemm g{(const pg8::bf16_t*)(ws + WS_H), (const pg8::bf16_t*)(ws + WS_WIN), MTOK, NPROJ, DM}; pg8::StaticOrder S; S.init(MTOK, NPROJ, F.G, F.blk);
        pg8::EpiBf16<0> E{(pg8::bf16_t*)(ws + WS_P), NPROJ, (const float*)(ws + WS_BIN2), 0, 0, 1.f};
        pg8::gemm_phase<pg8::EpiBf16<0>, pg8::StaticOrder, true, true>(F.lds, g, S, E, F.tid);
        if (DUP(2)) { __syncthreads(); pg8::gemm_phase<pg8::EpiBf16<0>, pg8::StaticOrder, true, true>(F.lds, g, S, E, F.tid); }
    } SEAM(2);
    if (IN(3)) { REFRESH(F); p3_prep(F); if (DUP(3)) { __syncthreads(); p3_prep(F); } } SEAM(3);
    if (IN(4)) { REFRESH(F); p4_hyena3(F); if (DUP(4)) { __syncthreads(); p4_hyena3(F); } __syncthreads(); p4_mlstm_mfma(F); if (DUP(13)) { __syncthreads(); p4_mlstm_mfma(F); } } SEAM(4);
    if (IN(5)) { REFRESH(F); p5_post(F); if (DUP(5)) { __syncthreads(); p5_post(F); } } SEAM(5);
    if (IN(6)) { REFRESH(F);
        pg8::Gemm g{(const pg8::bf16_t*)(ws + WS_H), (const pg8::bf16_t*)(ws + WS_WOUT), MTOK, DM, DM}; pg8::StaticOrder S; S.init(MTOK, DM, F.G, F.blk);
        pg8::EpiRes E{F.a->in[IN_X], (pg8::bf16_t*)(ws + WS_X1), (const float*)(ws + WS_MOD)};
        pg8::gemm_phase<pg8::EpiRes, pg8::StaticOrder, true, true>(F.lds, g, S, E, F.tid);
        if (DUP(6)) { __syncthreads(); pg8::gemm_phase<pg8::EpiRes, pg8::StaticOrder, true, true>(F.lds, g, S, E, F.tid); }
    } SEAM(6);
    if (IN(7)) { REFRESH(F);
        { LAS float* Wt = (LAS float*)(F.lds + 8 * 8704); for (int i = F.tid; i < 16384; i += 512) { const int k = i >> 4, g = i & 15; Wt[g * 1024 + k] = F.a->in[IN_WROUTER][k * 16 + g]; } }
        __syncthreads();
        if (F.wave < 4) conv_experts<1>(F); else p_norm<true, 4>(F);
    } SEAM(7);
    if (IN(8)) { REFRESH(F); p8_topk(F); } SEAM(8);
    if (IN(9)) { REFRESH(F);
        pg8::Gemm g{(const pg8::bf16_t*)(ws + WS_HF), (const pg8::bf16_t*)(ws + WS_WGU), NSLOT, NEXP * 4096, DM / 2}; pg8::MoeOrderA S{F.G, F.blk};
        LAS unsigned short* gidx = (LAS unsigned short*)(F.lds + RING_BYTES);
        { const int* IDX = (const int*)(ws + WS_IDX);
          for (int q = F.tid; q < 4096; q += 512) { pg8::Unit u; const int i = q >> 8, r = q & 255;
              if (S.next(i, u)) { const int e = u.pm >> 4, pml = u.pm & 15, b = pml >> 1, s0 = (pml & 1) * 256; gidx[q] = (unsigned short)(b * SEQ + IDX[(b * 16 + e) * CAP + s0 + r]); } } }
        __syncthreads();
        pg8::EpiSwiGLU E{ws + WS_HID};
        pg8::gemm_phase_gather_fp8<pg8::EpiSwiGLU, pg8::MoeOrderA>(F.lds, g, S, E, gidx, 0, F.tid, 121);
        if (DUP(9)) { __syncthreads(); pg8::gemm_phase_gather_fp8<pg8::EpiSwiGLU, pg8::MoeOrderA>(F.lds, g, S, E, gidx, 0, F.tid, 121); }
    } SEAM(9);
    if (IN(10)) { REFRESH(F);
        pg8::Gemm g{(const pg8::bf16_t*)(ws + WS_HID), (const pg8::bf16_t*)(ws + WS_WD), NSLOT, NEXP * 1024, FFD / 2}; pg8::MoeOrderB S{F.G, F.blk};
        LAS unsigned short* gidx = (LAS unsigned short*)(F.lds + RING_BYTES);
        for (int q = F.tid; q < 4096; q += 512) { pg8::Unit u; const int i = q >> 8, r = q & 255; if (S.next(i, u)) gidx[q] = (unsigned short)(u.pm * 256 + r); }
        __syncthreads();
        pg8::EpiYs E{ws + WS_YS};
        pg8::gemm_phase_gather_fp8<pg8::EpiYs, pg8::MoeOrderB>(F.lds, g, S, E, gidx, 0, F.tid, 125);
        if (DUP(10)) { __syncthreads(); pg8::gemm_phase_gather_fp8<pg8::EpiYs, pg8::MoeOrderB>(F.lds, g, S, E, gidx, 0, F.tid, 125); }
    } SEAM(10);
    if (IN(11)) { REFRESH(F); if (DUP(11)) { p12_final<true>(F); __syncthreads(); } p12_final<false>(F); }
#undef IN
#undef SEAM
}

extern "C" void kernel_launch(void* const* d_in, const int* in_sizes, int n_in, void* d_out, int out_size, void* d_ws, size_t ws_size, hipStream_t stream) {
    static int grid = 0;
    if (grid == 0) {
        if (n_in != 28 || out_size != MTOK * DM || ws_size < WS_END) { fprintf(stderr, "kernel_launch: unexpected shapes (n_in %d, out %d, ws %zu < %zu)\n", n_in, out_size, ws_size, (size_t)WS_END); grid = -1; return; }
        int dev = 0, cus = 0;
        if (hipGetDevice(&dev) != hipSuccess || hipDeviceGetAttribute(&cus, hipDeviceAttributeMultiprocessorCount, dev) != hipSuccess) { grid = -1; return; }
        if (hipFuncSetAttribute((const void*)fwd_kernel, hipFuncAttributeMaxDynamicSharedMemorySize, LDS_BYTES) != hipSuccess) { fprintf(stderr, "kernel_launch: hipFuncSetAttribute failed\n"); grid = -1; return; }
        int per_cu = 0;
        if (hipOccupancyMaxActiveBlocksPerMultiprocessor(&per_cu, (const void*)fwd_kernel, 512, LDS_BYTES) != hipSuccess || per_cu < 1) fprintf(stderr, "kernel_launch: occupancy query reports %d\n", per_cu);
        (void)hipGetLastError();
        grid = cus > 256 ? 256 : cus;
    }
    if (grid < 0) return;
    (void)hipMemsetAsync((char*)d_ws + WS_CTL, 0, CTL_ZERO_BYTES, stream);
    Args a{};
    for (int i = 0; i < 28; ++i) a.in[i] = (const float*)d_in[i];
    a.out = (float*)d_out; a.ws = (unsigned char*)d_ws;
    if (N_LAUNCHES == 1) { a.ph_lo = 0; a.ph_hi = N_PHASES; hipLaunchKernelGGL(fwd_kernel, dim3(grid), dim3(512), LDS_BYTES, stream, a); }
    else for (int p = 0; p < N_PHASES; ++p) { a.ph_lo = p; a.ph_hi = p + 1; hipLaunchKernelGGL(fwd_kernel, dim3(grid), dim3(512), LDS_BYTES, stream, a); }
}
```

```cpp
#include <hip/hip_runtime.h>
#include <cstdio>
#include <cstdint>
#include <type_traits>
#define N_LAUNCHES 1
#define DUPMASK 0
__device__ __forceinline__ int lane_id() { return (int)__builtin_amdgcn_mbcnt_hi(~0u, __builtin_amdgcn_mbcnt_lo(~0u, 0u)); }
namespace pg8 {
#define PG8_LAS __attribute__((address_space(3)))
typedef unsigned short bf16_t;
typedef short bf16x8 __attribute__((ext_vector_type(8)));
typedef float f32x4 __attribute__((ext_vector_type(4)));
typedef unsigned u32x4 __attribute__((ext_vector_type(4)));
constexpr int BM = 256, BK = 64, HALF = 128, HTB = HALF * BK * 2  , STAGE_BYTES = 8 * HTB, NXCD = 8, WGM = 8;

__host__ __device__ __forceinline__ int lds_byte(int r, int c) { const int st = (r >> 4) * 2 + (c >> 5), rr = r & 15, cc = c & 31, ob = rr * 64 + cc * 2; return st * 1024 + (ob ^ (((ob >> 9) & 1) << 5)); }
__host__ __device__ __forceinline__ void stage_rc(int b, int& R, int& C) { const int st = b / 1024, sb = b % 1024, swz = sb ^ (((sb >> 9) & 1) << 5); R = (st >> 1) * 16 + swz / 64; C = (st & 1) * 32 + (swz % 64) / 2; }
__host__ __device__ __forceinline__ int perm32(int rho) { const int n = rho >> 4, i = rho & 15; return 8 * (i >> 2) + 4 * n + (i & 3); }

struct Unit { int pm, pn; };
struct Gemm { const bf16_t* A; const bf16_t* Bt; int M, N, K; };

struct StaticOrder {
    int nM, nN, nwg, G, c;
    __host__ __device__ void init(int M, int N, int G_, int c_) { nM = M / BM; nN = N / BM; nwg = nM * nN; G = G_; c = c_; }
    __host__ __device__ bool next(int i, Unit& u) const {
        const long L = (long)i * G + c; if (L >= nwg) return false;
        int wgid = (int)L; { const int q = nwg / NXCD, r = nwg % NXCD, xcd = wgid % NXCD, off = wgid / NXCD; wgid = (xcd < r ? xcd * (q + 1) : r * (q + 1) + (xcd - r) * q) + off; }
        const int nig = WGM * nN, gid = wgid / nig, fm = gid * WGM, gsz = (nM - fm) < WGM ? (nM - fm) : WGM;
        u.pm = fm + ((wgid % nig) % gsz); u.pn = (wgid % nig) / gsz; return true;
    }
    __device__ __forceinline__ void a_ready(const Unit&) const {}
    __device__ __forceinline__ void done(const Unit&) const {}
};

__device__ __forceinline__ unsigned cvt_pk_bf16(float lo, float hi) { unsigned r; asm volatile("v_cvt_pk_bf16_f32 %0, %1, %2" : "=v"(r) : "v"(lo), "v"(hi)); return r; }
typedef float f32x2 __attribute__((ext_vector_type(2)));
__device__ __forceinline__ f32x2 gelu_pk(f32x2 v) {
    const f32x2 av = __builtin_elementwise_abs(v), d = av * 0.2316418882f + 1.0f;
    f32x2 t; t.x = __builtin_amdgcn_rcpf(d.x); t.y = __builtin_amdgcn_rcpf(d.y);
    f32x2 q = t * 0.5307027145f + (-0.7265760135f); q = q * t + 0.7107068705f; q = q * t + (-0.142248368f); q = q * t + 0.127414796f; q = q * t;
    const f32x2 s = (v * v) * (-0.72134752044f);
    f32x2 e; e.x = __builtin_amdgcn_exp2f(s.x); e.y = __builtin_amdgcn_exp2f(s.y);
    const f32x2 m = v * (q * e), r = v - m;
    f32x2 o; o.x = v.x < 0.f ? m.x : r.x; o.y = v.y < 0.f ? m.y : r.y; return o;
}

template <int ACT  > struct EpiBf16 {
    static constexpr bool PERM = true, AFTER_DRAIN = false; static_assert(ACT == 0 || ACT == 1, "EpiBf16: ACT is 0 (none) or 1 (gelu_pk)");
    bf16_t* O; int ldc; const float* bias; int split_cols; size_t split_stride; float scale0;
    __device__ __forceinline__ void operator()(const f32x4 (&acc)[2][2][4][2], const Unit& u, int wr, int wc, int fr, int fq) const {
        const int row0 = u.pm * BM + wr * 64 + fr; int colt = u.pn * BM; bf16_t* base = O;
        float sc = 1.f; if (split_cols) { const int t = colt / split_cols; base += (size_t)t * split_stride; colt -= t * split_cols; if (t == 0) sc = scale0; }
        const int col0 = colt + wc * 32 + 8 * fq, bcol0 = u.pn * BM + wc * 32 + 8 * fq;
        f32x4 bv[2][2];
#pragma unroll
        for (int bj = 0; bj < 2; ++bj)
#pragma unroll
            for (int n = 0; n < 2; ++n) bv[bj][n] = bias ? *(const f32x4*)(bias + bcol0 + bj * HALF + 4 * n) : (f32x4){0.f, 0.f, 0.f, 0.f};
#pragma unroll
        for (int ai = 0; ai < 2; ++ai)
#pragma unroll
            for (int m = 0; m < 4; ++m) { bf16_t* rowp = base + (size_t)(row0 + ai * HALF + m * 16) * ldc + col0;
#pragma unroll
                for (int bj = 0; bj < 2; ++bj) { f32x4 v0 = acc[ai][bj][m][0] + bv[bj][0], v1 = acc[ai][bj][m][1] + bv[bj][1];
                    if (ACT == 1) { f32x2 a = gelu_pk((f32x2){v0[0], v0[1]}), b = gelu_pk((f32x2){v0[2], v0[3]}), c = gelu_pk((f32x2){v1[0], v1[1]}), d = gelu_pk((f32x2){v1[2], v1[3]});
                        v0 = (f32x4){a.x, a.y, b.x, b.y}; v1 = (f32x4){c.x, c.y, d.x, d.y}; }
                    v0 = v0 * sc; v1 = v1 * sc; u32x4 w; w.x = cvt_pk_bf16(v0[0], v0[1]); w.y = cvt_pk_bf16(v0[2], v0[3]); w.z = cvt_pk_bf16(v1[0], v1[1]); w.w = cvt_pk_bf16(v1[2], v1[3]);
                    *(u32x4*)(rowp + bj * HALF) = w; } }
    }
};


template <class Epi, class Sched, bool ALIGN_EPI = false, bool SP2 = false>
__device__ __forceinline__ void gemm_phase(PG8_LAS unsigned char* lds, const Gemm g, const Sched& S, const Epi& E, const int tid_in) {
    const int tid = tid_in, wid = __builtin_amdgcn_readfirstlane(tid >> 6), lane = tid & 63, wr = wid >> 2, wc = wid & 3, fr = lane & 15, fq = lane >> 4;
    const int K = g.K, nt = K / BK;
    unsigned voffA[2], voffB[2];
#pragma unroll
    for (int i = 0; i < 2; ++i) { int R, C; stage_rc(tid * 16 + i * 8192, R, C); const int Rb = Epi::PERM ? ((R & ~31) + perm32(R & 31)) : R;
        voffA[i] = (unsigned)(R * K + C) * 2u; voffB[i] = (unsigned)(Rb * K + C) * 2u; }
    const size_t kstep = (size_t)(BK * 2);
    const size_t hstep = (size_t)HALF * K * 2;
    const size_t tstep = 2 * hstep;
    const unsigned ldsw = (unsigned)wid * 1024u;
    const int aoff = lds_byte(wr * 64 + fr, fq * 8), boff = lds_byte(wc * 32 + fr, fq * 8);
#define PG8_SA(b, h) (((b) * 2 + (h)) * HTB)
#define PG8_SB(b, h) ((4 + (b) * 2 + (h)) * HTB)
#define PG8_STAGE(bufoff, gbase, voff) do { _Pragma("unroll") for (int _i = 0; _i < 2; ++_i) \
        __builtin_amdgcn_global_load_lds((const unsigned*)((const char*)(gbase) + (voff)[_i]), (PG8_LAS unsigned*)(lds + (bufoff) + ldsw + _i * 8192), 16, 0, 0); } while (0)
#define PG8_LDA(dst, b, h) do { _Pragma("unroll") for (int m = 0; m < 4; ++m) _Pragma("unroll") for (int k = 0; k < 2; ++k) dst[m][k] = *(const PG8_LAS bf16x8*)(lds + PG8_SA(b, h) + aoff + m * 2048 + k * 1024); } while (0)
#define PG8_LDB(dst, b, h) do { _Pragma("unroll") for (int n = 0; n < 2; ++n) _Pragma("unroll") for (int k = 0; k < 2; ++k) dst[n][k] = *(const PG8_LAS bf16x8*)(lds + PG8_SB(b, h) + boff + n * 2048 + k * 1024); } while (0)
#define PG8_MMA(ai, bj, At, Bt) do { __builtin_amdgcn_s_setprio(1); _Pragma("unroll") for (int m = 0; m < 4; ++m) _Pragma("unroll") for (int n = 0; n < 2; ++n) _Pragma("unroll") for (int k = 0; k < 2; ++k) \
        acc[ai][bj][m][n] = __builtin_amdgcn_mfma_f32_16x16x32_bf16(Bt[n][k], At[m][k], acc[ai][bj][m][n], 0, 0, 0); __builtin_amdgcn_s_setprio(0); } while (0)
#define PG8_WAIT_V(n) asm volatile("s_waitcnt vmcnt(" #n ")" ::: "memory")
#define PG8_WAIT_L(n) asm volatile("s_waitcnt lgkmcnt(" #n ")" ::: "memory")
#define PG8_BAR __builtin_amdgcn_s_barrier()
#define PG8_SCHED __builtin_amdgcn_sched_barrier(0)
    Unit cur, nxt; int ui = 0;
    if (!S.next(0, cur)) return;
    f32x4 acc[2][2][4][2];
#pragma unroll
    for (int a = 0; a < 2; ++a)
#pragma unroll
        for (int b = 0; b < 2; ++b)
#pragma unroll
            for (int m = 0; m < 4; ++m)
#pragma unroll
                for (int n = 0; n < 2; ++n) acc[a][b][m][n] = (f32x4){0.f, 0.f, 0.f, 0.f};
    bf16x8 At[4][2], B0[2][2], B1[2][2];
    const char* cA = (const char*)g.A + (size_t)cur.pm * tstep; const char* cB = (const char*)g.Bt + (size_t)cur.pn * tstep;
    S.a_ready(cur);
    if constexpr (SP2) {
        PG8_STAGE(PG8_SB(0, 0), cB, voffB); PG8_STAGE(PG8_SB(0, 1), cB + hstep, voffB); PG8_STAGE(PG8_SA(0, 0), cA, voffA); PG8_STAGE(PG8_SA(0, 1), cA + hstep, voffA);
        if (wr == 1) PG8_BAR;
        PG8_WAIT_V(2); PG8_BAR;
        PG8_STAGE(PG8_SB(1, 0), cB + kstep, voffB); PG8_STAGE(PG8_SA(1, 0), cA + kstep, voffA); PG8_STAGE(PG8_SB(1, 1), cB + hstep + kstep, voffB);
        PG8_WAIT_V(6); PG8_BAR;
    } else {
        PG8_STAGE(PG8_SB(0, 0), cB, voffB); PG8_STAGE(PG8_SA(0, 0), cA, voffA); PG8_STAGE(PG8_SB(0, 1), cB + hstep, voffB); PG8_STAGE(PG8_SA(0, 1), cA + hstep, voffA);
        if (wr == 1) PG8_BAR;
        PG8_WAIT_V(4); PG8_BAR;
        PG8_STAGE(PG8_SB(1, 0), cB + kstep, voffB); PG8_STAGE(PG8_SA(1, 0), cA + kstep, voffA); PG8_STAGE(PG8_SB(1, 1), cB + hstep + kstep, voffB);
        PG8_WAIT_V(6); PG8_BAR;
    }
    for (;;) {
        const bool has_next = S.next(ui + 1, nxt);
        const char* nA = has_next ? (const char*)g.A + (size_t)nxt.pm * tstep : cA; const char* nB = has_next ? (const char*)g.Bt + (size_t)nxt.pn * tstep : cB;
        for (int t = 0; t < nt; t += 2) {
            const bool last = (t == nt - 2);
            const char* a1 = cA + (size_t)(t + 1) * kstep;
            const char* a2 = last ? nA : cA + (size_t)(t + 2) * kstep; const char* b2 = last ? nB : cB + (size_t)(t + 2) * kstep;
            const char* a3 = a2 + kstep; const char* b3 = b2 + kstep;
            if (last && has_next) S.a_ready(nxt);
            if constexpr (SP2) {
            PG8_LDB(B0, 0, 0); PG8_LDB(B1, 0, 1); PG8_SCHED; PG8_LDA(At, 0, 0); PG8_STAGE(PG8_SA(1, 1), a1 + hstep, voffA);
            PG8_WAIT_V(8); PG8_WAIT_L(0); PG8_BAR; PG8_MMA(0, 0, At, B0); PG8_MMA(0, 1, At, B1); PG8_BAR; PG8_SCHED;
            PG8_LDA(At, 0, 1); PG8_STAGE(PG8_SB(0, 0), b2, voffB); PG8_STAGE(PG8_SB(0, 1), b2 + hstep, voffB); PG8_STAGE(PG8_SA(0, 0), a2, voffA);
            PG8_WAIT_V(8); PG8_WAIT_L(0); PG8_BAR; PG8_MMA(1, 0, At, B0); PG8_MMA(1, 1, At, B1); PG8_BAR; PG8_SCHED;
            PG8_LDB(B0, 1, 0); PG8_LDB(B1, 1, 1); PG8_SCHED; PG8_LDA(At, 1, 0); PG8_STAGE(PG8_SA(0, 1), a2 + hstep, voffA);
            PG8_WAIT_V(8); PG8_WAIT_L(0); PG8_BAR; PG8_MMA(0, 0, At, B0); PG8_MMA(0, 1, At, B1); PG8_BAR; PG8_SCHED;
            PG8_LDA(At, 1, 1); PG8_STAGE(PG8_SB(1, 0), b3, voffB); PG8_STAGE(PG8_SB(1, 1), b3 + hstep, voffB); PG8_STAGE(PG8_SA(1, 0), a3, voffA);
            PG8_WAIT_V(8); PG8_WAIT_L(0); PG8_BAR; PG8_MMA(1, 0, At, B0); PG8_MMA(1, 1, At, B1); PG8_BAR; PG8_SCHED;
            } else {
            PG8_LDB(B0, 0, 0); PG8_SCHED; PG8_LDA(At, 0, 0); PG8_STAGE(PG8_SA(1, 1), a1 + hstep, voffA);
            PG8_WAIT_L(8); PG8_BAR; PG8_WAIT_L(0); PG8_MMA(0, 0, At, B0); PG8_BAR; PG8_SCHED;
            PG8_LDB(B1, 0, 1); PG8_STAGE(PG8_SB(0, 0), b2, voffB);
            PG8_BAR; PG8_WAIT_L(0); PG8_MMA(0, 1, At, B1); PG8_BAR;
            PG8_LDA(At, 0, 1); PG8_STAGE(PG8_SA(0, 0), a2, voffA);
            PG8_BAR; PG8_WAIT_L(0); PG8_MMA(1, 0, At, B0); PG8_BAR; PG8_SCHED;
            PG8_STAGE(PG8_SB(0, 1), b2 + hstep, voffB);
            PG8_WAIT_V(6); PG8_BAR; PG8_MMA(1, 1, At, B1); PG8_BAR;
            PG8_LDB(B0, 1, 0); PG8_SCHED; PG8_LDA(At, 1, 0); PG8_STAGE(PG8_SA(0, 1), a2 + hstep, voffA);
            PG8_WAIT_L(8); PG8_BAR; PG8_WAIT_L(0); PG8_MMA(0, 0, At, B0); PG8_BAR; PG8_SCHED;
            PG8_LDB(B1, 1, 1); PG8_STAGE(PG8_SB(1, 0), b3, voffB);
            PG8_BAR; PG8_WAIT_L(0); PG8_MMA(0, 1, At, B1); PG8_BAR;
            PG8_LDA(At, 1, 1); PG8_STAGE(PG8_SA(1, 0), a3, voffA);
            PG8_BAR; PG8_WAIT_L(0); PG8_MMA(1, 0, At, B0); PG8_BAR; PG8_SCHED;
            PG8_STAGE(PG8_SB(1, 1), b3 + hstep, voffB);
            PG8_WAIT_V(6); PG8_BAR; PG8_MMA(1, 1, At, B1); PG8_BAR;
            }
        }
        if constexpr (ALIGN_EPI) { if (wr == 0) PG8_BAR; }
        if constexpr (!Epi::AFTER_DRAIN) { E(acc, cur, wr, wc, fr, fq); S.done(cur); }
        if (!has_next) break;
#pragma unroll
        for (int a = 0; a < 2; ++a)
#pragma unroll
            for (int b = 0; b < 2; ++b)
#pragma unroll
                for (int m = 0; m < 4; ++m)
#pragma unroll
                    for (int n = 0; n < 2; ++n) acc[a][b][m][n] = (f32x4){0.f, 0.f, 0.f, 0.f};
        cur = nxt; cA = nA; cB = nB; ++ui;
        if constexpr (ALIGN_EPI) { if (wr == 1) PG8_BAR; }
    }
    PG8_WAIT_V(0);
    if constexpr (!ALIGN_EPI) { if (wr == 0) PG8_BAR; }
    PG8_BAR;
    if constexpr (Epi::AFTER_DRAIN) { E.fused(acc, cur, wr, wc, fr, fq, lds, wid, lane); S.done(cur); }
#undef PG8_SA
#undef PG8_SB
#undef PG8_STAGE
#undef PG8_LDA
#undef PG8_LDB
#undef PG8_MMA
#undef PG8_WAIT_V
#undef PG8_WAIT_L
#undef PG8_BAR
#undef PG8_SCHED
}
}
namespace pg8 {
typedef int v4i_t __attribute__((ext_vector_type(4)));
typedef int v8i_t __attribute__((ext_vector_type(8)));
template <class Epi, class Sched, bool ALIGN_EPI = true>
__device__ __forceinline__ void gemm_phase_gather_fp8(PG8_LAS unsigned char* lds, const Gemm g, const Sched& S, const Epi& E, const PG8_LAS unsigned short* gidx, int rowbase, const int tid_in, const int scale_w_e8m0) {
    const int tid = tid_in, wid = __builtin_amdgcn_readfirstlane(tid >> 6), lane = tid & 63, wr = wid >> 2, wc = wid & 3, fr = lane & 15, fq = lane >> 4;
    const int K = g.K; int nt = K / BK; asm volatile("" : "+s"(nt));
    unsigned voffB[2]; int RA[2], CA[2];
#pragma unroll
    for (int i = 0; i < 2; ++i) { int R, C; stage_rc(tid * 16 + i * 8192, R, C); const int Rb = Epi::PERM ? ((R & ~31) + perm32(R & 31)) : R;
        RA[i] = R; CA[i] = C; voffB[i] = (unsigned)(Rb * K + C) * 2u; }
    const size_t kstep = (size_t)(BK * 2);
    const size_t hstep = (size_t)HALF * K * 2;
    const size_t tstep = 2 * hstep;
    const unsigned ldsw = (unsigned)wid * 1024u;
    const int aoff = lds_byte(wr * 64 + fr, fq * 8), boff = lds_byte(wc * 32 + fr, fq * 8);
#define PG8_SA(b, h) (((b) * 2 + (h)) * HTB)
#define PG8_SB(b, h) ((4 + (b) * 2 + (h)) * HTB)
#define PG8_STAGE(bufoff, gbase, voff) do { _Pragma("unroll") for (int _i = 0; _i < 2; ++_i) \
        __builtin_amdgcn_global_load_lds((const unsigned*)((const char*)(gbase) + (voff)[_i]), (PG8_LAS unsigned*)(lds + (bufoff) + ldsw + _i * 8192), 16, 0, 0); } while (0)
#define PG8_LDA(dst, b, h) do { _Pragma("unroll") for (int m = 0; m < 4; ++m) dst[m] = PG8_CAT(*(const PG8_LAS v4i_t*)(lds + PG8_SA(b, h) + aoff + m * 2048), *(const PG8_LAS v4i_t*)(lds + PG8_SA(b, h) + aoff + m * 2048 + 1024)); } while (0)
#define PG8_LDB(dst, b, h) do { _Pragma("unroll") for (int n = 0; n < 2; ++n) dst[n] = PG8_CAT(*(const PG8_LAS v4i_t*)(lds + PG8_SB(b, h) + boff + n * 2048), *(const PG8_LAS v4i_t*)(lds + PG8_SB(b, h) + boff + n * 2048 + 1024)); } while (0)
#define PG8_CAT(x0, x1) __builtin_shufflevector((x0), (x1), 0, 1, 2, 3, 4, 5, 6, 7)
#define PG8_MMA(ai, bj, At, Bt) do { __builtin_amdgcn_s_setprio(1); _Pragma("unroll") for (int m = 0; m < 4; ++m) _Pragma("unroll") for (int n = 0; n < 2; ++n) \
        asm volatile("v_mfma_scale_f32_16x16x128_f8f6f4 %0, %1, %2, %0, %3, %4 op_sel_hi:[0,0,0]" : "+v"(acc[ai][bj][m][n]) : "v"(Bt[n]), "v"(At[m]), "v"(sclw), "v"(scl)); __builtin_amdgcn_s_setprio(0); } while (0)
#define PG8_WAIT_V(n) asm volatile("s_waitcnt vmcnt(" #n ")" ::: "memory")
#define PG8_WAIT_L(n) asm volatile("s_waitcnt lgkmcnt(" #n ")" ::: "memory")
#define PG8_BAR __builtin_amdgcn_s_barrier()
#define PG8_SCHED __builtin_amdgcn_sched_barrier(0)
#define PG8_GOFF(dst, ui_) do { _Pragma("unroll") for (int _h = 0; _h < 2; ++_h) _Pragma("unroll") for (int _i = 0; _i < 2; ++_i) \
        dst[_h][_i] = (unsigned)((rowbase + (int)gidx[(ui_) * 256 + _h * HALF + RA[_i]]) * K + CA[_i]) * 2u; } while (0)
    Unit cur, nxt; int ui = 0;
    if (!S.next(0, cur)) return;
    f32x4 acc[2][2][4][2];
#pragma unroll
    for (int a = 0; a < 2; ++a)
#pragma unroll
        for (int b = 0; b < 2; ++b)
#pragma unroll
            for (int m = 0; m < 4; ++m)
#pragma unroll
                for (int n = 0; n < 2; ++n) acc[a][b][m][n] = (f32x4){0.f, 0.f, 0.f, 0.f};
    v8i_t At[4], B0[2], B1[2];
    int scl = 127, sclw = scale_w_e8m0; asm volatile("" : "+v"(scl), "+v"(sclw));
    unsigned gofC[2][2], g2[2][2];
    PG8_GOFF(gofC, 0);
#pragma unroll
    for (int _h = 0; _h < 2; ++_h)
#pragma unroll
        for (int _i = 0; _i < 2; ++_i) g2[_h][_i] = gofC[_h][_i];
    const char* A0 = (const char*)g.A;
    const char* cB = (const char*)g.Bt + (size_t)cur.pn * tstep;
    S.a_ready(cur);
    PG8_STAGE(PG8_SB(0, 0), cB, voffB); PG8_STAGE(PG8_SB(0, 1), cB + hstep, voffB); PG8_STAGE(PG8_SA(0, 0), A0, gofC[0]); PG8_STAGE(PG8_SA(0, 1), A0, gofC[1]);
    if (wr == 1) PG8_BAR;
    PG8_WAIT_V(2); PG8_BAR;
    PG8_STAGE(PG8_SB(1, 0), cB + kstep, voffB); PG8_STAGE(PG8_SA(1, 0), A0 + kstep, gofC[0]); PG8_STAGE(PG8_SB(1, 1), cB + hstep + kstep, voffB);
    PG8_WAIT_V(6); PG8_BAR;
    for (;;) {
        const bool has_next = S.next(ui + 1, nxt);
        const char* nB = has_next ? (const char*)g.Bt + (size_t)nxt.pn * tstep : cB;
#pragma unroll 1
        for (int t = 0; t < nt; t += 2) {
            const bool last = (t == nt - 2);
            const char* a1 = A0 + (size_t)(t + 1) * kstep;
            const char* a2 = last ? A0 : A0 + (size_t)(t + 2) * kstep; const char* b2 = last ? nB : cB + (size_t)(t + 2) * kstep;
            const char* a3 = a2 + kstep; const char* b3 = b2 + kstep;
            if (last && has_next) PG8_GOFF(g2, ui + 1);
            if (last && has_next) S.a_ready(nxt);
            PG8_LDB(B0, 0, 0); PG8_LDB(B1, 0, 1); PG8_SCHED; PG8_LDA(At, 0, 0); PG8_STAGE(PG8_SA(1, 1), a1, gofC[1]);
            PG8_WAIT_V(8); PG8_WAIT_L(0); PG8_BAR; PG8_MMA(0, 0, At, B0); PG8_MMA(0, 1, At, B1); PG8_BAR; PG8_SCHED;
            PG8_LDA(At, 0, 1); PG8_STAGE(PG8_SB(0, 0), b2, voffB); PG8_STAGE(PG8_SB(0, 1), b2 + hstep, voffB); PG8_STAGE(PG8_SA(0, 0), a2, g2[0]);
            PG8_WAIT_V(8); PG8_WAIT_L(0); PG8_BAR; PG8_MMA(1, 0, At, B0); PG8_MMA(1, 1, At, B1); PG8_BAR; PG8_SCHED;
            PG8_LDB(B0, 1, 0); PG8_LDB(B1, 1, 1); PG8_SCHED; PG8_LDA(At, 1, 0); PG8_STAGE(PG8_SA(0, 1), a2, g2[1]);
            PG8_WAIT_V(8); PG8_WAIT_L(0); PG8_BAR; PG8_MMA(0, 0, At, B0); PG8_MMA(0, 1, At, B1); PG8_BAR; PG8_SCHED;
            PG8_LDA(At, 1, 1); PG8_STAGE(PG8_SB(1, 0), b3, voffB); PG8_STAGE(PG8_SB(1, 1), b3 + hstep, voffB); PG8_STAGE(PG8_SA(1, 0), a3, g2[0]);
            PG8_WAIT_V(8); PG8_WAIT_L(0); PG8_BAR; PG8_MMA(1, 0, At, B0); PG8_MMA(1, 1, At, B1); PG8_BAR; PG8_SCHED;
        }
        if constexpr (ALIGN_EPI) { if (wr == 0) PG8_BAR; }
        asm volatile("s_nop 15\n\ts_nop 15" : "+v"(acc[0][0][0][0]), "+v"(acc[0][0][0][1]), "+v"(acc[0][0][1][0]), "+v"(acc[0][0][1][1]), "+v"(acc[0][0][2][0]), "+v"(acc[0][0][2][1]), "+v"(acc[0][0][3][0]), "+v"(acc[0][0][3][1]), "+v"(acc[0][1][0][0]), "+v"(acc[0][1][0][1]), "+v"(acc[0][1][1][0]), "+v"(acc[0][1][1][1]), "+v"(acc[0][1][2][0]), "+v"(acc[0][1][2][1]), "+v"(acc[0][1][3][0]), "+v"(acc[0][1][3][1]));
        asm volatile("" : "+v"(acc[1][0][0][0]), "+v"(acc[1][0][0][1]), "+v"(acc[1][0][1][0]), "+v"(acc[1][0][1][1]), "+v"(acc[1][0][2][0]), "+v"(acc[1][0][2][1]), "+v"(acc[1][0][3][0]), "+v"(acc[1][0][3][1]), "+v"(acc[1][1][0][0]), "+v"(acc[1][1][0][1]), "+v"(acc[1][1][1][0]), "+v"(acc[1][1][1][1]), "+v"(acc[1][1][2][0]), "+v"(acc[1][1][2][1]), "+v"(acc[1][1][3][0]), "+v"(acc[1][1][3][1]));
        E(acc, cur, wr, wc, fr, fq); S.done(cur);
        if (!has_next) break;
#pragma unroll
        for (int a = 0; a < 2; ++a)
#pragma unroll
            for (int b = 0; b < 2; ++b)
#pragma unroll
                for (int m = 0; m < 4; ++m)
#pragma unroll
                    for (int n = 0; n < 2; ++n) acc[a][b][m][n] = (f32x4){0.f, 0.f, 0.f, 0.f};
        cur = nxt; cB = nB; ++ui;
#pragma unroll
        for (int _h = 0; _h < 2; ++_h)
#pragma unroll
            for (int _i = 0; _i < 2; ++_i) gofC[_h][_i] = g2[_h][_i];
        if constexpr (ALIGN_EPI) { if (wr == 1) PG8_BAR; }
    }
    PG8_WAIT_V(0);
    if constexpr (!ALIGN_EPI) { if (wr == 0) PG8_BAR; }
    PG8_BAR;
#undef PG8_GOFF
#undef PG8_CAT
#undef PG8_SA
#undef PG8_SB
#undef PG8_STAGE
#undef PG8_LDA
#undef PG8_LDB
#undef PG8_MMA
#undef PG8_WAIT_V
#undef PG8_WAIT_L
#undef PG8_BAR
#undef PG8_SCHED
}
}
constexpr int NB = 8, SEQ = 4096, DM = 1024, MTOK = NB * SEQ;
constexpr int NPROJ = 3584;
constexpr int PCOLS_IN = 3600;
constexpr int NEXP = 16, CAP = 512, FFD = 2048, NSLOT = NEXP * NB * CAP;
constexpr float RMS_EPS = 1e-6f;
#ifndef N_LAUNCHES
#define N_LAUNCHES 1
#endif
constexpr int N_PHASES = 12;

constexpr size_t MiB = 1u << 20;
constexpr size_t WS_CTL = 0, CTL_ZERO_BYTES = 64 * 1024;
constexpr size_t WS_QHEAD = 32768;
constexpr size_t WS_MOD = 1 * MiB;
constexpr size_t WS_BIN2 = 1 * MiB + 512 * 1024;
constexpr size_t WS_HEXT = 2 * MiB;
constexpr size_t WS_W3EXT = 21 * MiB;
constexpr size_t WS_GATES = 4 * MiB;
constexpr size_t WS_AFF = 6 * MiB;
constexpr size_t WS_IDX = 8 * MiB, WS_GSEL = 8 * MiB + 256 * 1024;
constexpr size_t WS_INV = 9 * MiB;
constexpr size_t WS_WOUT = 12 * MiB;
constexpr size_t WS_WIN = 14 * MiB;
constexpr size_t WS_P = 24 * MiB;
constexpr size_t WS_H = 248 * MiB;
constexpr size_t WS_UT = 312 * MiB;
constexpr size_t WS_HM = 408 * MiB;
constexpr size_t WS_X1 = WS_HM;
constexpr size_t WS_ZT = 472 * MiB;
constexpr size_t WS_KSP = 504 * MiB;
constexpr size_t WS_WGU = 24 * MiB;
constexpr size_t WS_HID = 280 * MiB;
constexpr size_t WS_HF = 216 * MiB;
constexpr size_t WS_WD = 152 * MiB;
constexpr size_t WS_YS = 24 * MiB;
constexpr size_t WS_END = 536 * MiB;

constexpr int RING_BYTES = 131072;
constexpr int MISC_OFF = 147456 - 256;
constexpr int LDS_BYTES = 147456;

#define GAS __attribute__((address_space(1)))
#define LAS __attribute__((address_space(3)))
#define DI __device__ __forceinline__
typedef unsigned short bf16;
typedef unsigned v4u __attribute__((ext_vector_type(4)));
typedef unsigned v2u __attribute__((ext_vector_type(2)));
typedef float f32x4 __attribute__((ext_vector_type(4)));
typedef GAS unsigned gu32;
#define LDS_WAIT() asm volatile("s_waitcnt lgkmcnt(0)" ::: "memory")
DI float bf2f(unsigned b) { return __uint_as_float(b << 16); }
DI float bflo(unsigned w) { return __uint_as_float(w << 16); }
DI float bfhi(unsigned w) { return __uint_as_float(w & 0xffff0000u); }
DI unsigned f2bf(float f) { unsigned u = __float_as_uint(f); return (u + 0x7fffu + ((u >> 16) & 1u)) >> 16; }
DI unsigned pk2(float lo, float hi) { unsigned r; asm("v_cvt_pk_bf16_f32 %0, %1, %2" : "=v"(r) : "v"(lo), "v"(hi)); return r; }
#define DPP_XOR1 0xB1
#define DPP_XOR2 0x4E
#define DPP_HMIRROR 0x141
#define DPP_MIRROR 0x140
template <int CTRL> DI float dpp_mov(float v) { return __builtin_bit_cast(float, __builtin_amdgcn_update_dpp(0, __builtin_bit_cast(int, v), CTRL, 0xf, 0xf, true)); }
DI float row16_sum(float v) { v += dpp_mov<DPP_XOR1>(v); v += dpp_mov<DPP_XOR2>(v); v += dpp_mov<DPP_HMIRROR>(v); v += dpp_mov<DPP_MIRROR>(v); return v; }
DI float row16_max(float v) { v = fmaxf(v, dpp_mov<DPP_XOR1>(v)); v = fmaxf(v, dpp_mov<DPP_XOR2>(v)); v = fmaxf(v, dpp_mov<DPP_HMIRROR>(v)); v = fmaxf(v, dpp_mov<DPP_MIRROR>(v)); return v; }
DI float lane_bcast(float v, int l) { return __builtin_bit_cast(float, __builtin_amdgcn_readlane(__builtin_bit_cast(int, v), l)); }
DI float wave_sum(float v) { const float r = row16_sum(v); return (lane_bcast(r, 0) + lane_bcast(r, 16)) + (lane_bcast(r, 32) + lane_bcast(r, 48)); }
DI float sigmoidf_(float x) { return __builtin_amdgcn_rcpf(1.f + __expf(-x)); }

namespace pg8 {
struct MoeOrderA {
    int G, c;
    __device__ bool next(int i, Unit& u) const {
        const long L = (long)i * G + c; if (L >= 4096) return false;
        const int e = (int)(L >> 8), r = (int)(L & 255), x = r & 7, j = r >> 3;
        u.pm = e * 16 + 4 * (x >> 1) + (j >> 3); u.pn = e * 16 + 8 * (x & 1) + (j & 7); return true;
    }
    __device__ __forceinline__ void a_ready(const Unit&) const {}
    __device__ __forceinline__ void done(const Unit&) const {}
};
struct MoeOrderB {
    int G, c;
    __device__ bool next(int i, Unit& u) const {
        const long L = (long)i * G + c; if (L >= 1024) return false;
        const int r = (int)(L & 255), e = (int)(L >> 8) * 4 + ((r & 7) >> 1), idx = ((r & 1) << 5) | (r >> 3);
        u.pm = e * 16 + (idx >> 2); u.pn = e * 4 + (idx & 3); return true;
    }
    __device__ __forceinline__ void a_ready(const Unit&) const {}
    __device__ __forceinline__ void done(const Unit&) const {}
};
struct EpiSwiGLU {
    static constexpr bool PERM = true, AFTER_DRAIN = false;
    unsigned char* O;
    __device__ __forceinline__ void operator()(const f32x4 (&acc)[2][2][4][2], const Unit& u, int wr, int wc, int fr, int fq) const {
        const int row0 = u.pm * BM + wr * 64 + fr, col0 = (u.pn & 15) * 128 + wc * 32 + 8 * fq;
#pragma unroll
        for (int ai = 0; ai < 2; ++ai)
#pragma unroll
            for (int m = 0; m < 4; ++m) {
                unsigned char* rowp = O + (size_t)(row0 + ai * HALF + m * 16) * 2048 + col0;
                float h[8];
#pragma unroll
                for (int n = 0; n < 2; ++n)
#pragma unroll
                    for (int i = 0; i < 4; ++i) { const float g = acc[ai][0][m][n][i], up = acc[ai][1][m][n][i]; h[4 * n + i] = (g * up) * __builtin_amdgcn_rcpf(1.f + __builtin_amdgcn_exp2f(g * -1.4426950408889634f)); }
                int w0 = 0, w1 = 0;
                w0 = __builtin_amdgcn_cvt_pk_fp8_f32(h[0], h[1], w0, false); w0 = __builtin_amdgcn_cvt_pk_fp8_f32(h[2], h[3], w0, true);
                w1 = __builtin_amdgcn_cvt_pk_fp8_f32(h[4], h[5], w1, false); w1 = __builtin_amdgcn_cvt_pk_fp8_f32(h[6], h[7], w1, true);
                typedef unsigned u32x2e __attribute__((ext_vector_type(2)));
                *(u32x2e*)rowp = (u32x2e){(unsigned)w0, (unsigned)w1};
            }
    }
};
struct EpiYs {
    static constexpr bool PERM = true, AFTER_DRAIN = false;
    unsigned char* O;
    __device__ __forceinline__ void operator()(const f32x4 (&acc)[2][2][4][2], const Unit& u, int wr, int wc, int fr, int fq) const {
        const int row0 = u.pm * BM + wr * 64 + fr, col0 = (u.pn & 3) * BM + wc * 32 + 8 * fq;
#pragma unroll
        for (int ai = 0; ai < 2; ++ai)
#pragma unroll
            for (int m = 0; m < 4; ++m) {
                unsigned char* rowp = O + (size_t)(row0 + ai * HALF + m * 16) * 1024 + col0;
#pragma unroll
                for (int bj = 0; bj < 2; ++bj) { const f32x4 v0 = acc[ai][bj][m][0], v1 = acc[ai][bj][m][1];
                    int w0 = 0, w1 = 0;
                    w0 = __builtin_amdgcn_cvt_pk_fp8_f32(v0[0], v0[1], w0, false); w0 = __builtin_amdgcn_cvt_pk_fp8_f32(v0[2], v0[3], w0, true);
                    w1 = __builtin_amdgcn_cvt_pk_fp8_f32(v1[0], v1[1], w1, false); w1 = __builtin_amdgcn_cvt_pk_fp8_f32(v1[2], v1[3], w1, true);
                    typedef unsigned u32x2e __attribute__((ext_vector_type(2)));
                    *(u32x2e*)(rowp + bj * HALF) = (u32x2e){(unsigned)w0, (unsigned)w1}; }
            }
    }
};
struct EpiF32P {
    static constexpr bool PERM = false, AFTER_DRAIN = false;
    float* C; int ldc;
    __device__ __forceinline__ void operator()(const f32x4 (&acc)[2][2][4][2], const Unit& u, int wr, int wc, int fr, int fq) const {
        const int row0 = u.pm * BM + wr * 64 + fr, col0 = u.pn * BM + wc * 32 + 4 * fq;
#pragma unroll
        for (int ai = 0; ai < 2; ++ai)
#pragma unroll
            for (int m = 0; m < 4; ++m) { float* rowp = C + (size_t)(row0 + ai * HALF + m * 16) * ldc + col0;
#pragma unroll
                for (int bj = 0; bj < 2; ++bj)
#pragma unroll
                    for (int n = 0; n < 2; ++n) *(f32x4*)(rowp + bj * HALF + n * 16) = acc[ai][bj][m][n]; }
    }
};
struct EpiRes {
    static constexpr bool PERM = true, AFTER_DRAIN = false;
    const float* X; bf16_t* C; const float* mod;
    __device__ __forceinline__ void operator()(const f32x4 (&acc)[2][2][4][2], const Unit& u, int wr, int wc, int fr, int fq) const {
        const int row0 = u.pm * BM + wr * 64 + fr, col0 = u.pn * BM + wc * 32 + 8 * fq;
        const float* gp = mod + (size_t)((u.pm * BM) >> 12) * 6144 + 2048 + col0;
        f32x4 gv[2][2];
#pragma unroll
        for (int bj = 0; bj < 2; ++bj)
#pragma unroll
            for (int n = 0; n < 2; ++n) gv[bj][n] = *(const f32x4*)(gp + bj * HALF + 4 * n);
#pragma unroll
        for (int ai = 0; ai < 2; ++ai)
#pragma unroll
            for (int m = 0; m < 4; ++m) { const size_t off = (size_t)(row0 + ai * HALF + m * 16) * 1024 + col0;
#pragma unroll
                for (int bj = 0; bj < 2; ++bj) {
                    const f32x4 x0 = *(const f32x4*)(X + off + bj * HALF), x1 = *(const f32x4*)(X + off + bj * HALF + 4);
                    const f32x4 v0 = x0 + gv[bj][0] * acc[ai][bj][m][0], v1 = x1 + gv[bj][1] * acc[ai][bj][m][1];
                    u32x4 w; w.x = cvt_pk_bf16(v0[0], v0[1]); w.y = cvt_pk_bf16(v0[2], v0[3]); w.z = cvt_pk_bf16(v1[0], v1[1]); w.w = cvt_pk_bf16(v1[2], v1[3]);
                    *(u32x4*)(C + off + bj * HALF) = w; } }
    }
};
}
#define XB_TMO      128
#define XB_XCNT(j)  (256  + 64 * (j))
#define XB_XSUB(j)  (1280 + 64 * (j))
#define XB_XGEN(j)  (2304 + 64 * (j))
#define XB_TOP      3328
#define XB_TOPGEN   3392
#define XCD_BAR_WORDS 3456
#define XB_SPIN_CAP (1u << 18)

__device__ __forceinline__ unsigned xb_ld(unsigned* p)              { return __hip_atomic_load(p, __ATOMIC_RELAXED, __HIP_MEMORY_SCOPE_AGENT); }
__device__ __forceinline__ unsigned xb_add(unsigned* p, unsigned v) { return __hip_atomic_fetch_add(p, v, __ATOMIC_RELAXED, __HIP_MEMORY_SCOPE_AGENT); }
__device__ __forceinline__ unsigned xb_xcc_id() { return (unsigned)__builtin_amdgcn_s_getreg((3 << 11) | 20) & 0xFu; }
#define XB_SPIN(cond, bar) do { unsigned _sp = 0; while (cond) { __builtin_amdgcn_s_sleep(1); \
    if ((++_sp & 255u) == 0u) { if (xb_ld(&(bar)[XB_TMO])) break; if (_sp > XB_SPIN_CAP) { atomicAdd(&(bar)[XB_TMO], 1u); break; } } } } while (0)

struct XcdBarrier {
    unsigned* bar; unsigned x;
    volatile LAS unsigned* st;
};

__device__ __forceinline__ XcdBarrier xcd_barrier_post(unsigned* bar, volatile LAS unsigned* st, const bool leader) {
    XcdBarrier b; b.bar = bar; b.x = xb_xcc_id(); b.st = st;
    if (leader) (void)xb_add(&bar[XB_XCNT(b.x)], 1u);
    return b;
}
__device__ __forceinline__ void xcd_barrier_complete(unsigned* bar, unsigned x, unsigned& nloc, unsigned& nx) {
    const unsigned G = gridDim.x * gridDim.y * gridDim.z;
    unsigned sum, cnt, mine, sp = 0u;
    for (;;) {
        sum = 0u; cnt = 0u; mine = 0u;
#pragma unroll
        for (unsigned j = 0; j < 16; ++j) { const unsigned c = xb_ld(&bar[XB_XCNT(j)]); sum += c; cnt += (c > 0u) ? 1u : 0u; mine = (j == x) ? c : mine; }
        if (sum == G) break;
        __builtin_amdgcn_s_sleep(1);
        if ((++sp & 255u) == 0u) { if (xb_ld(&bar[XB_TMO])) break; if (sp > XB_SPIN_CAP) { atomicAdd(&bar[XB_TMO], 1u); break; } }
    }
    nloc = mine > 0u ? mine : 1u; nx = cnt > 0u ? cnt : 1u;
}

__device__ __forceinline__ void xcd_barrier(const XcdBarrier& b, const bool leader) {
    asm volatile("s_waitcnt vmcnt(0)" ::: "memory");
    __syncthreads();
    if (leader) {
        unsigned* bar = b.bar;
        __builtin_amdgcn_s_waitcnt(0);
        unsigned nloc = b.st[0], nx = b.st[1];
        if (nloc == 0u) { xcd_barrier_complete(bar, b.x, nloc, nx); b.st[0] = nloc; b.st[1] = nx; }
        const unsigned old = xb_add(&bar[XB_XSUB(b.x)], 1u);
        const unsigned gen = old / nloc;
        if (old + 1u == (gen + 1u) * nloc) {
            __builtin_amdgcn_fence(__ATOMIC_RELEASE, "agent");
            asm volatile("s_waitcnt vmcnt(0)" ::: "memory");
            const unsigned og = xb_add(&bar[XB_TOP], 1u);
            const unsigned tg = og / nx;
            if (og + 1u == (tg + 1u) * nx) xb_add(&bar[XB_TOPGEN], 1u);
            else XB_SPIN(xb_ld(&bar[XB_TOPGEN]) == tg, bar);
            __builtin_amdgcn_fence(__ATOMIC_ACQUIRE, "agent");
            xb_add(&bar[XB_XGEN(b.x)], 1u);
            asm volatile("s_waitcnt vmcnt(0)" ::: "memory");
        } else {
            XB_SPIN(xb_ld(&bar[XB_XGEN(b.x)]) == gen, bar);
            __builtin_amdgcn_fence(__ATOMIC_ACQUIRE, "agent");
            asm volatile("s_waitcnt vmcnt(0)" ::: "memory");
        }
    }
    __syncthreads();
}
#define HD __host__ __device__ __forceinline__
typedef float cf2 __attribute__((ext_vector_type(2)));
#define MK2(a, b) ((cf2){(a), (b)})
#define W16_C1 0.92387953251128674f
#define W16_S1 0.38268343236508977f
#define W16_H  0.70710678118654752f
HD cf2 w32_const(int k) {
    constexpr float C[16] = {1.f, 0.98078528040323043f, 0.92387953251128674f, 0.83146961230254524f, 0.70710678118654752f, 0.55557023301960218f, 0.38268343236508977f, 0.19509032201612825f,
                             0.f, -0.19509032201612825f, -0.38268343236508977f, -0.55557023301960218f, -0.70710678118654752f, -0.83146961230254524f, -0.92387953251128674f, -0.98078528040323043f};
    constexpr float S[16] = {0.f, 0.19509032201612825f, 0.38268343236508977f, 0.55557023301960218f, 0.70710678118654752f, 0.83146961230254524f, 0.92387953251128674f, 0.98078528040323043f,
                             1.f, 0.98078528040323043f, 0.92387953251128674f, 0.83146961230254524f, 0.70710678118654752f, 0.55557023301960218f, 0.38268343236508977f, 0.19509032201612825f};
    return MK2(C[k], -S[k]);
}
#ifndef DUPMASK
#define DUPMASK 0
#endif
#define DUP(k) ((DUPMASK >> (k)) & 1)
struct Args { const float* in[28]; float* out; unsigned char* ws; int ph_lo, ph_hi; };
struct Frame {
    LAS unsigned char* lds;
    int tid, lane, wave, G, blk;
    const struct Args* a;
};
#define REFRESH(F) do { int l_ = lane_id(); asm volatile("" : "+v"(l_)); (F).lane = l_; (F).tid = (F).wave * 64 + l_; } while (0)
#define IN_X 0
#define IN_C 1
#define IN_WADA 2
#define IN_BADA 3
#define IN_GMIX 4
#define IN_WIN 5
#define IN_BIN 6
#define IN_CQKW 7
#define IN_CQKB 8
#define IN_MNG 9
#define IN_CHYW 10
#define IN_CHYB 11
#define IN_HW1 12
#define IN_HB1 13
#define IN_HW2 14
#define IN_HB2 15
#define IN_HW3 16
#define IN_HFREQ 17
#define IN_HDELTA 18
#define IN_HBIAS 19
#define IN_HNG 20
#define IN_WOUT 21
#define IN_GFFN 22
#define IN_WROUTER 23
#define IN_WGATE 24
#define IN_WUP 25
#define IN_WDOWN 26
#define IN_GFINAL 27

DI void transpose_item(const float* src, int ldsrc, bf16* dst, int lddst, LAS float* scr, int lane) {
#pragma unroll 8
    for (int i = 0; i < 32; ++i) { const int kk = 2 * i + (lane >> 5); scr[kk * 33 + (lane & 31)] = src[(size_t)kk * ldsrc + (lane & 31)]; }
    LDS_WAIT(); asm volatile("" ::: "memory");
    const int c = lane & 7;
#pragma unroll
    for (int j = 0; j < 4; ++j) { const int n = (lane >> 3) + 8 * j; const LAS float* s = scr + (8 * c) * 33 + n;
        v4u o; o.x = pk2(s[0 * 33], s[1 * 33]); o.y = pk2(s[2 * 33], s[3 * 33]); o.z = pk2(s[4 * 33], s[5 * 33]); o.w = pk2(s[6 * 33], s[7 * 33]);
        *(v4u*)(dst + (size_t)n * lddst + 8 * c) = o; }
    LDS_WAIT(); asm volatile("" ::: "memory");
}
DI unsigned pk4_fp8(float a, float b, float c2, float d) { int w = 0; w = __builtin_amdgcn_cvt_pk_fp8_f32(a, b, w, false); w = __builtin_amdgcn_cvt_pk_fp8_f32(c2, d, w, true); return (unsigned)w; }
DI void transpose_item_fp8(const float* src, int ldsrc, unsigned char* dst, int lddst, float scale, LAS float* scr, int lane) {
#pragma unroll 8
    for (int i = 0; i < 32; ++i) { const int kk = 2 * i + (lane >> 5); scr[kk * 33 + (lane & 31)] = src[(size_t)kk * ldsrc + (lane & 31)]; }
    LDS_WAIT(); asm volatile("" ::: "memory");
    const int c = lane & 7;
#pragma unroll
    for (int j = 0; j < 4; ++j) { const int n = (lane >> 3) + 8 * j; const LAS float* s = scr + (8 * c) * 33 + n;
        v2u o; o.x = pk4_fp8(s[0 * 33] * scale, s[1 * 33] * scale, s[2 * 33] * scale, s[3 * 33] * scale); o.y = pk4_fp8(s[4 * 33] * scale, s[5 * 33] * scale, s[6 * 33] * scale, s[7 * 33] * scale);
        *(v2u*)(dst + (size_t)n * lddst + 8 * c) = o; }
    LDS_WAIT(); asm volatile("" ::: "memory");
}
DI float reduce16(const float (&acc)[16], int lane) {
    float r8[8], r4[4], r2[2], r1;
    { const bool up = (lane & 32) != 0;
#pragma unroll
      for (int i = 0; i < 8; ++i) { const float mine = up ? acc[8 + i] : acc[i], other = up ? acc[i] : acc[8 + i]; r8[i] = mine + __shfl_xor(other, 32); } }
    { const bool up = (lane & 16) != 0;
#pragma unroll
      for (int i = 0; i < 4; ++i) { const float mine = up ? r8[4 + i] : r8[i], other = up ? r8[i] : r8[4 + i]; r4[i] = mine + __shfl_xor(other, 16); } }
    { const bool up = (lane & 8) != 0;
#pragma unroll
      for (int i = 0; i < 2; ++i) { const float mine = up ? r4[2 + i] : r4[i], other = up ? r4[i] : r4[2 + i]; r2[i] = mine + __shfl_xor(other, 8); } }
    { const bool up = (lane & 4) != 0; const float mine = up ? r2[1] : r2[0], other = up ? r2[0] : r2[1]; r1 = mine + __shfl_xor(other, 4); }
    r1 += __shfl_xor(r1, 1); r1 += __shfl_xor(r1, 2);
    return r1;
}
DI int reduce16_index(int lane) { return ((lane >> 5) & 1) * 8 + ((lane >> 4) & 1) * 4 + ((lane >> 3) & 1) * 2 + ((lane >> 2) & 1); }

DI void p0_prologue(Frame& F) {
    unsigned char* ws = F.a->ws;
    LAS float* scr = (LAS float*)(F.lds + F.wave * 16384);
    const int gw = F.blk * 8 + F.wave, NGW = F.G * 8, lane = F.lane;
    bf16* WIN = (bf16*)(ws + WS_WIN); bf16* WOUT = (bf16*)(ws + WS_WOUT);
    for (int it = gw; it < 1792 + 512; it += NGW) {
        if (it < 1792) { const int kb = it / 112, nb = it % 112, n0 = 32 * nb, k0 = 64 * kb, sc = n0 + (n0 >= 2048 ? 16 : 0);
            transpose_item(F.a->in[IN_WIN] + (size_t)k0 * PCOLS_IN + sc, PCOLS_IN, WIN + (size_t)n0 * 1024 + k0, 1024, scr, lane); }
        else { const int r = it - 1792, kb = r / 32, nb = r % 32, n0 = 32 * nb, k0 = 64 * kb;
            transpose_item(F.a->in[IN_WOUT] + (size_t)k0 * 1024 + n0, 1024, WOUT + (size_t)n0 * 1024 + k0, 1024, scr, lane); }
    }
    {
        bf16* HEXT = (bf16*)(ws + WS_HEXT);
        const float* w1 = F.a->in[IN_HW1]; const float* w2 = F.a->in[IN_HW2];
        const float fr = F.a->in[IN_HFREQ][lane], b1 = F.a->in[IN_HB1][lane], b2 = F.a->in[IN_HB2][lane];
        for (int t = gw; t < SEQ; t += NGW) {
            float a1 = b1 + ((float)t * (1.f / 4095.f)) * w1[lane];
#pragma unroll 4
            for (int i = 0; i < 16; ++i) {
                const float band = 1e-4f + (float)i * ((15.f - 1e-4f) / 15.f);
                const float rev = band * (float)t * (1.f / 4096.f);
                const float fx = rev - floorf(rev);
                float sn, cs; sincospif(2.f * fx, &sn, &cs);
                a1 += cs * w1[(1 + i) * 64 + lane] - sn * w1[(17 + i) * 64 + lane];
            }
            const float h1 = sinf(fr * a1);
            float a2 = b2;
#pragma unroll 8
            for (int i = 0; i < 64; ++i) a2 += __shfl(h1, i) * w2[i * 64 + lane];
            const float h2 = sinf(fr * a2);
            const unsigned hi = f2bf(h2), lo = f2bf(h2 - bf2f(hi));
            bf16* hr = HEXT + (size_t)t * 256 + lane;
            hr[0] = (bf16)hi; hr[64] = (bf16)lo; hr[128] = (bf16)hi; hr[192] = 0;
        }
        bf16* W3EXT = (bf16*)(ws + WS_W3EXT); const float* w3 = F.a->in[IN_HW3];
        for (int i = F.blk * 512 + F.tid; i < 64 * 2048; i += F.G * 512) { const int j = i >> 11, col = i & 2047; const float w = w3[i];
            const unsigned hi = f2bf(w), lo = f2bf(w - bf2f(hi)); bf16* wr_ = W3EXT + (size_t)col * 256 + j;
            wr_[0] = (bf16)hi; wr_[64] = (bf16)hi; wr_[128] = (bf16)lo; wr_[192] = 0; }
    }
    { float* BIN2 = (float*)(ws + WS_BIN2); for (int n = F.blk * 512 + F.tid; n < NPROJ; n += F.G * 512) BIN2[n] = F.a->in[IN_BIN][n + (n >= 2048 ? 16 : 0)]; }
    __syncthreads();
    {
        LAS float* cs = (LAS float*)F.lds;
        LAS float* red = cs + 8192;
        float* MOD = (float*)(ws + WS_MOD); const float* wada = F.a->in[IN_WADA];
        for (int i = F.tid; i < 2048; i += 512) *(LAS f32x4*)(cs + 4 * i) = *(const f32x4*)(F.a->in[IN_C] + 4 * i);
        __syncthreads();
        const int ksl = F.tid >> 3, c4 = F.tid & 7;
        for (int it = F.blk; it < 192; it += F.G) {
            f32x4 w[16];
#pragma unroll
            for (int kk = 0; kk < 16; ++kk) w[kk] = *(const f32x4*)(wada + (size_t)(16 * ksl + kk) * 6144 + 32 * it + 4 * c4);
#pragma unroll
            for (int b = 0; b < 8; ++b) { f32x4 a = (f32x4){0.f, 0.f, 0.f, 0.f};
#pragma unroll
                for (int k4 = 0; k4 < 4; ++k4) { const f32x4 cv = *(const LAS f32x4*)(cs + b * 1024 + 16 * ksl + 4 * k4);
                    a += w[4 * k4] * cv.x + w[4 * k4 + 1] * cv.y + w[4 * k4 + 2] * cv.z + w[4 * k4 + 3] * cv.w; }
                *(LAS f32x4*)(red + (ksl * 8 + b) * 32 + 4 * c4) = a; }
            __syncthreads();
            if (F.tid < 256) { const int b = F.tid >> 5, col = F.tid & 31; float sacc = F.a->in[IN_BADA][32 * it + col];
#pragma unroll 8
                for (int k = 0; k < 64; ++k) sacc += red[(k * 8 + b) * 32 + col];
                MOD[b * 6144 + 32 * it + col] = sacc; }
            __syncthreads();
        }
    }
}

template <bool SECOND, int MODE = 0> DI void p_norm(Frame& F) {
    unsigned char* ws = F.a->ws; const int lane = F.lane;
    LAS float* Wt = (LAS float*)(F.lds + (MODE != 0 ? 8 * 8704 : 0));
    if (MODE == 0) {
    for (int i = F.tid; i < 16384; i += 512) { const int k = i >> 4, g = i & 15; Wt[g * 1024 + k] = SECOND ? F.a->in[IN_WROUTER][k * 16 + g] : F.a->in[IN_WIN][(size_t)k * PCOLS_IN + 2048 + g]; }
    __syncthreads();
    }
    const float* xin = F.a->in[IN_X]; const bf16* x1in = (const bf16*)(ws + WS_X1);
    const float* gvec = SECOND ? F.a->in[IN_GFFN] : F.a->in[IN_GMIX];
    const float* MOD = (const float*)(ws + WS_MOD);
    bf16* HO = (bf16*)(ws + WS_H); unsigned* HO8 = (unsigned*)(ws + WS_HF);
    const int gw = (MODE == 4) ? F.blk * 4 + (F.wave - 4) : F.blk * 8 + F.wave, NGW = (MODE == 4) ? F.G * 4 : F.G * 8;
    typedef typename std::conditional<SECOND, v2u, f32x4>::type raw_t;
    auto load_rows = [&](raw_t (&raw)[4][4], int rq) {
#pragma unroll
        for (int r = 0; r < 4; ++r) { const raw_t* xr = SECOND ? (const raw_t*)((const v2u*)(x1in + (size_t)(4 * rq + r) * 1024) + lane) : (const raw_t*)((const f32x4*)(xin + (size_t)(4 * rq + r) * 1024) + lane);
#pragma unroll
            for (int j = 0; j < 4; ++j) raw[r][j] = __builtin_nontemporal_load(xr + 64 * j); }
    };
    f32x4 mg[4], msh[4], msc[4];
    auto load_mod = [&](int rq) {
        const float* mb = MOD + ((4 * rq) >> 12) * 6144 + (SECOND ? 3072 : 0);
#pragma unroll
        for (int j = 0; j < 4; ++j) { const int col = 256 * j + 4 * lane; mg[j] = *(const f32x4*)(gvec + col); msh[j] = *(const f32x4*)(mb + col); msc[j] = *(const f32x4*)(mb + 1024 + col); }
    };
    auto process = [&](const raw_t (&raw)[4][4], int rq) __attribute__((always_inline)) {
        const int row0 = 4 * rq, b = row0 >> 12;
        f32x4 v[4][4]; float ss[4];
#pragma unroll
        for (int r = 0; r < 4; ++r) { ss[r] = 0.f;
#pragma unroll
            for (int j = 0; j < 4; ++j) {
                if constexpr (SECOND) { const v2u w = raw[r][j]; v[r][j] = (f32x4){__builtin_bit_cast(float, w.x << 16), __builtin_bit_cast(float, w.x & 0xffff0000u), __builtin_bit_cast(float, w.y << 16), __builtin_bit_cast(float, w.y & 0xffff0000u)}; }
                else v[r][j] = raw[r][j];
                ss[r] += (v[r][j].x * v[r][j].x + v[r][j].y * v[r][j].y) + (v[r][j].z * v[r][j].z + v[r][j].w * v[r][j].w); } }
#pragma unroll
        for (int r = 0; r < 4; ++r) ss[r] = wave_sum(ss[r]);
#pragma unroll
        for (int j = 0; j < 4; ++j) {
            const f32x4 g = mg[j], sh = msh[j], sc = msc[j];
            const f32x4 gs = g * (sc + 1.f);
#pragma unroll
            for (int r = 0; r < 4; ++r) v[r][j] = v[r][j] * (rsqrtf(ss[r] * (1.f / 1024.f) + RMS_EPS)) * gs + sh; }
#pragma unroll
        for (int r = 0; r < 4; ++r) {
            if (SECOND) { unsigned* o4 = HO8 + (size_t)(row0 + r) * 256 + lane;
#pragma unroll
                for (int j = 0; j < 4; ++j) o4[64 * j] = pk4_fp8(v[r][j].x, v[r][j].y, v[r][j].z, v[r][j].w); }
            else { unsigned long long* o8 = (unsigned long long*)(HO + (size_t)(row0 + r) * 1024) + lane;
#pragma unroll
                for (int j = 0; j < 4; ++j) o8[64 * j] = (unsigned long long)pk2(v[r][j].x, v[r][j].y) | ((unsigned long long)pk2(v[r][j].z, v[r][j].w) << 32); } }
        float b4[4][4];
#pragma unroll
        for (int q = 0; q < 4; ++q) {
            asm volatile("" ::: "memory");
            float t[4][4];
#pragma unroll
            for (int k = 0; k < 4; ++k) { const int g = q + 4 * k;
                f32x4 w[4];
#pragma unroll
                for (int j = 0; j < 4; ++j) w[j] = *(const LAS f32x4*)(Wt + g * 1024 + 256 * j + 4 * lane);
#pragma unroll
                for (int r = 0; r < 4; ++r) { float a = 0.f;
#pragma unroll
                    for (int j = 0; j < 4; ++j) a += (v[r][j].x * w[j].x + v[r][j].y * w[j].y) + (v[r][j].z * w[j].z + v[r][j].w * w[j].w);
                    t[k][r] = a; } }
            const bool up8 = (lane & 8) != 0, up4 = (lane & 4) != 0;
#pragma unroll
            for (int r = 0; r < 4; ++r) {
                const float u0 = (up8 ? t[2][r] : t[0][r]) + dpp_mov<DPP_MIRROR>(up8 ? t[0][r] : t[2][r]);
                const float u1 = (up8 ? t[3][r] : t[1][r]) + dpp_mov<DPP_MIRROR>(up8 ? t[1][r] : t[3][r]);
                b4[r][q] = (up4 ? u1 : u0) + dpp_mov<DPP_HMIRROR>(up4 ? u0 : u1); }
        }
        float a4[4], a2[2], val;
#pragma unroll
        for (int r = 0; r < 4; ++r) { float b2[2];
            { const bool up = (lane & 2) != 0;
#pragma unroll
              for (int q = 0; q < 2; ++q) { const float mine = up ? b4[r][q + 2] : b4[r][q], oth = up ? b4[r][q] : b4[r][q + 2]; b2[q] = mine + dpp_mov<DPP_XOR2>(oth); } }
            { const bool up = (lane & 1) != 0; const float mine = up ? b2[1] : b2[0], oth = up ? b2[0] : b2[1]; a4[r] = mine + dpp_mov<DPP_XOR1>(oth); }
        }
        { const bool up = (lane & 32) != 0;
#pragma unroll
          for (int q = 0; q < 2; ++q) { const float mine = up ? a4[q + 2] : a4[q], oth = up ? a4[q] : a4[q + 2]; a2[q] = mine + __shfl_xor(oth, 32); } }
        { const bool up = (lane & 16) != 0; const float mine = up ? a2[1] : a2[0], oth = up ? a2[0] : a2[1]; val = mine + __shfl_xor(oth, 16); }
        const int r_ = lane >> 4, g_ = lane & 15;
        if (!SECOND) ((float*)(ws + WS_GATES))[(size_t)row0 * 16 + lane] = val + F.a->in[IN_BIN][2048 + g_];
        else {
            const float mx = row16_max(val);
            const float ex = __expf(val - mx); const float sm = row16_sum(ex);
            ((float*)(ws + WS_AFF))[((size_t)b * 16 + g_) * SEQ + ((row0 + r_) & 4095)] = ex / sm;
        }
    };
    raw_t rawA[4][4], rawB[4][4];
    int rq = gw; bool hasA = rq < MTOK / 4;
    if (hasA) load_rows(rawA, rq);
#pragma unroll 1
    while (hasA) {
        const int rqB = rq + NGW; const bool hasB = rqB < MTOK / 4;
        load_mod(rq);
        if (hasB) load_rows(rawB, rqB);
        process(rawA, rq);
        if (!hasB) break;
        rq = rqB + NGW; hasA = rq < MTOK / 4;
        load_mod(rqB);
        if (hasA) load_rows(rawA, rq);
        process(rawB, rqB);
    }
}

DI void p3_prep(Frame& F) {
    unsigned char* ws = F.a->ws;
    const bf16* P = (const bf16*)(ws + WS_P);
    {
        bf16* QK = (bf16*)(ws + WS_H);
        const float* cw = F.a->in[IN_CQKW]; const float* cb = F.a->in[IN_CQKB];
        const int nthr = F.G * 512;
        const int cg = F.tid & 127, c0 = 8 * cg;
        float wq0[8], wq1[8], wq2[8], bq[8];
#pragma unroll
        for (int e = 0; e < 8; ++e) { wq0[e] = cw[c0 + e]; wq1[e] = cw[1024 + c0 + e]; wq2[e] = cw[2048 + c0 + e]; bq[e] = cb[c0 + e]; }
        const float scale = (c0 >= 512) ? 0.08838834764831845f : 1.f;
        auto load_trip = [&](v4u (&cur)[4], v4u (&prv)[4], v4u (&nxt)[4], int i0) {
#pragma unroll
            for (int q = 0; q < 4; ++q) { const int token = (i0 + q * nthr) >> 7, t = token & 4095;
                const bf16* p0 = P + (size_t)token * NPROJ + c0;
                cur[q] = *(const v4u*)p0; prv[q] = (v4u){0u, 0u, 0u, 0u}; nxt[q] = (v4u){0u, 0u, 0u, 0u};
                if (t > 0) prv[q] = *(const v4u*)(p0 - NPROJ);
                if (t < SEQ - 1) nxt[q] = *(const v4u*)(p0 + NPROJ); }
        };
        auto process = [&](const v4u (&cur)[4], const v4u (&prv)[4], const v4u (&nxt)[4], int i0) __attribute__((always_inline)) {
#pragma unroll
            for (int q = 0; q < 4; ++q) { const int token = (i0 + q * nthr) >> 7;
                float o[8];
#pragma unroll
                for (int e = 0; e < 8; ++e) {
                    const unsigned wp = prv[q][e >> 1], wc = cur[q][e >> 1], wn = nxt[q][e >> 1];
                    const float xp = (e & 1) ? bfhi(wp) : bflo(wp), xc = (e & 1) ? bfhi(wc) : bflo(wc), xn = (e & 1) ? bfhi(wn) : bflo(wn);
                    const float val = bq[e] + wq0[e] * xp + wq1[e] * xc + wq2[e] * xn;
                    o[e] = val * sigmoidf_(val) * scale;
                }
                v4u w; w.x = pk2(o[0], o[1]); w.y = pk2(o[2], o[3]); w.z = pk2(o[4], o[5]); w.w = pk2(o[6], o[7]);
                *(v4u*)(QK + (size_t)token * 1024 + c0) = w; }
        };
        v4u cA[4], pA[4], nA[4], cB[4], pB[4], nB[4];
        int i0 = F.blk * 512 + F.tid; bool hasA = i0 < MTOK * 128;
        if (hasA) load_trip(cA, pA, nA, i0);
#pragma unroll 1
        while (hasA) {
            const int iB = i0 + 4 * nthr; const bool hasB = iB < MTOK * 128;
            if (hasB) load_trip(cB, pB, nB, iB);
            process(cA, pA, nA, i0);
            if (!hasB) break;
            i0 = iB + 4 * nthr; hasA = i0 < MTOK * 128;
            if (hasA) load_trip(cA, pA, nA, i0);
            process(cB, pB, nB, iB);
        }
    }
    {
        unsigned* UT = (unsigned*)(ws + WS_UT);
        LAS unsigned* tile = (LAS unsigned*)(F.lds + F.wave * 8704);
        const float* cw = F.a->in[IN_CHYW]; const float* cb = F.a->in[IN_CHYB];
        const int lane = F.lane, cg = lane & 7, tl = lane >> 3;
        const int gw = F.blk * 8 + F.wave, NGW = F.G * 8;
        __syncthreads();
#pragma unroll 1
        for (int u = gw; u < 4 * 128 * 24; u += NGW) {
            const int cgq = u % 24, tt = (u / 24) & 127, p = u / (24 * 128), hxc = cgq * 64 + cg * 8;
            float w0[8], w1[8], w2[8], bb[8];
#pragma unroll
            for (int e4 = 0; e4 < 2; ++e4) { const f32x4 a0 = *(const f32x4*)(cw + hxc + 4 * e4), a1 = *(const f32x4*)(cw + 1536 + hxc + 4 * e4), a2 = *(const f32x4*)(cw + 3072 + hxc + 4 * e4), a3 = *(const f32x4*)(cb + hxc + 4 * e4);
#pragma unroll
                for (int i = 0; i < 4; ++i) { w0[4 * e4 + i] = a0[i]; w1[4 * e4 + i] = a1[i]; w2[4 * e4 + i] = a2[i]; bb[4 * e4 + i] = a3[i]; } }
#pragma unroll
            for (int g = 0; g < 4; ++g) {
                const int t = tt * 32 + 8 * g + tl;
                unsigned short o[2][8];
#pragma unroll
                for (int bs = 0; bs < 2; ++bs) {
                    const bf16* p0 = P + (size_t)((2 * p + bs) * SEQ + t) * NPROJ + 2048 + hxc;
                    const v4u cur = *(const v4u*)p0;
                    v4u prv = (v4u){0u, 0u, 0u, 0u}, nxt = (v4u){0u, 0u, 0u, 0u};
                    if (t > 0) prv = *(const v4u*)(p0 - NPROJ);
                    if (t < SEQ - 1) nxt = *(const v4u*)(p0 + NPROJ);
#pragma unroll
                    for (int e = 0; e < 8; ++e) {
                        const unsigned wp = prv[e >> 1], wc = cur[e >> 1], wn = nxt[e >> 1];
                        const float xp = (e & 1) ? bfhi(wp) : bflo(wp), xc = (e & 1) ? bfhi(wc) : bflo(wc), xn = (e & 1) ? bfhi(wn) : bflo(wn);
                        o[bs][e] = (unsigned short)f2bf(bb[e] + w0[e] * xp + w1[e] * xc + w2[e] * xn);
                    }
                }
#pragma unroll
                for (int e = 0; e < 8; ++e) tile[(cg * 8 + e) * 33 + 8 * g + tl] = (unsigned)o[0][e] | ((unsigned)o[1][e] << 16);
            }
            LDS_WAIT(); asm volatile("" ::: "memory");
#pragma unroll 8
            for (int i = 0; i < 32; ++i) { const int cl = 2 * i + (lane >> 5), t5 = lane & 31, hx = cgq * 64 + cl, part = hx >> 9, ch = hx & 511;
                UT[(((size_t)part * 4 + p) * 512 + ch) * SEQ + tt * 32 + t5] = tile[cl * 33 + t5]; }
            LDS_WAIT(); asm volatile("" ::: "memory");
        }
    }
}

#define LAUNDER(x) asm volatile("" : "+v"(x))
#define LDS_BARRIER() do { asm volatile("s_waitcnt lgkmcnt(0)" ::: "memory"); __builtin_amdgcn_s_barrier(); asm volatile("" ::: "memory"); } while (0)

DI void p5_post(Frame& F) {
    unsigned char* ws = F.a->ws; const int lane = F.lane;
    bf16* Y = (bf16*)(ws + WS_H); const bf16* P = (const bf16*)(ws + WS_P); const bf16* HM = (const bf16*)(ws + WS_HM);
    {
        const int gw = F.blk * 8 + F.wave, NGW = F.G * 8;
        const f32x4 g0 = *(const f32x4*)(F.a->in[IN_MNG] + 8 * lane), g1 = *(const f32x4*)(F.a->in[IN_MNG] + 8 * lane + 4);
        for (int row = gw; row < MTOK; row += NGW) {
            const v4u a = *(const v4u*)(HM + (size_t)row * 512 + 8 * lane), bq = *(const v4u*)(HM + ((size_t)MTOK + row) * 512 + 8 * lane);
            const v4u ov = *(const v4u*)(P + (size_t)row * NPROJ + 1536 + 8 * lane);
            float hsum[8], og[8];
#pragma unroll
            for (int e = 0; e < 4; ++e) { hsum[2 * e] = bflo(a[e]) + bflo(bq[e]); hsum[2 * e + 1] = bfhi(a[e]) + bfhi(bq[e]); og[2 * e] = bflo(ov[e]); og[2 * e + 1] = bfhi(ov[e]); }
            float ss = 0.f;
#pragma unroll
            for (int e = 0; e < 8; ++e) ss += hsum[e] * hsum[e];
            ss = row16_sum(ss);
            const float rstd = rsqrtf(ss * (1.f / 128.f) + RMS_EPS);
            const float gg[8] = {g0.x, g0.y, g0.z, g0.w, g1.x, g1.y, g1.z, g1.w};
            float o[8];
#pragma unroll
            for (int e = 0; e < 8; ++e) o[e] = sigmoidf_(og[e]) * hsum[e] * rstd * gg[e];
            v4u w; w.x = pk2(o[0], o[1]); w.y = pk2(o[2], o[3]); w.z = pk2(o[4], o[5]); w.w = pk2(o[6], o[7]);
            *(v4u*)(Y + (size_t)row * 1024 + 8 * lane) = w;
        }
    }
    {
        const bf16* ZT = (const bf16*)(ws + WS_ZT);
        LAS bf16* tile = (LAS bf16*)F.lds;
        const f32x4 g0 = *(const f32x4*)(F.a->in[IN_HNG] + 8 * lane), g1 = *(const f32x4*)(F.a->in[IN_HNG] + 8 * lane + 4);
        const float gg[8] = {g0.x, g0.y, g0.z, g0.w, g1.x, g1.y, g1.z, g1.w};
        __syncthreads();
        for (int u = F.blk; u < 4 * 128; u += F.G) {
            const int p = u >> 7, tt = u & 127;
            for (int pc = F.tid; pc < 4096; pc += 512) {
                const int c = pc >> 3, q = pc & 7;
                const v4u v = *(const v4u*)(ZT + (((size_t)p * 512 + c) * SEQ + tt * 32) * 2 + q * 8);
#pragma unroll
                for (int i = 0; i < 4; ++i) { tile[((4 * q + i) * 2 + 0) * 520 + c] = (bf16)(v[i] & 0xffffu); tile[((4 * q + i) * 2 + 1) * 520 + c] = (bf16)(v[i] >> 16); }
            }
            __syncthreads();
#pragma unroll 2
            for (int rr = 0; rr < 8; ++rr) {
                const int row = F.wave * 8 + rr, t = row >> 1, bs = row & 1, token = (2 * p + bs) * SEQ + tt * 32 + t;
                const v4u v = *(const LAS v4u*)(tile + row * 520 + 8 * lane);
                float z[8];
#pragma unroll
                for (int e = 0; e < 4; ++e) { z[2 * e] = bflo(v[e]); z[2 * e + 1] = bfhi(v[e]); }
                float ss = 0.f;
#pragma unroll
                for (int e = 0; e < 8; ++e) ss += z[e] * z[e];
                ss = row16_sum(ss);
                const float rstd = rsqrtf(ss * (1.f / 128.f) + RMS_EPS);
                v4u w; w.x = pk2(z[0] * rstd * gg[0], z[1] * rstd * gg[1]); w.y = pk2(z[2] * rstd * gg[2], z[3] * rstd * gg[3]);
                w.z = pk2(z[4] * rstd * gg[4], z[5] * rstd * gg[5]); w.w = pk2(z[6] * rstd * gg[6], z[7] * rstd * gg[7]);
                *(v4u*)(Y + (size_t)token * 1024 + 512 + 8 * lane) = w;
            }
            __syncthreads();
        }
    }
}

template <int WSEL> DI void conv_experts(Frame& F) {
    LAS float* scr = (LAS float*)(F.lds + F.wave * 8704); unsigned char* WGU8 = F.a->ws + WS_WGU; unsigned char* WD8 = F.a->ws + WS_WD;
    const int gw = WSEL ? F.blk * 4 + F.wave : F.blk * 8 + F.wave, NGW = WSEL ? F.G * 4 : F.G * 8;
#pragma unroll 1
    for (int base = 4 * gw; base < 49152; base += 4 * NGW) {
#pragma unroll 1
        for (int q = 0; q < 4; ++q) {
            const int it = (int)base + q;
            if (it >= 16384) {
                const int i1 = it - 16384, nb = i1 & 127, kb = (i1 >> 7) & 15, e = i1 >> 11, n0 = 32 * nb, k0 = 64 * kb, j = n0 >> 8, r = n0 & 255, f0 = 128 * j + (r & 127);
                const float* W = (r < 128 ? F.a->in[IN_WGATE] : F.a->in[IN_WUP]) + (size_t)e * 1024 * 2048;
                transpose_item_fp8(W + (size_t)k0 * 2048 + f0, 2048, WGU8 + ((size_t)e * 4096 + n0) * 1024 + k0, 1024, 64.f, scr, F.lane);
            } else {
                const int nb = it & 31, kb = (it >> 5) & 31, e = it >> 10, n0 = 32 * nb, k0 = 64 * kb;
                transpose_item_fp8(F.a->in[IN_WDOWN] + (size_t)e * 2048 * 1024 + (size_t)k0 * 1024 + n0, 1024, WD8 + ((size_t)e * 1024 + n0) * 2048 + k0, 2048, 64.f, scr, F.lane);
            }
        }
    }
}

DI void p8_topk(Frame& F) {
    unsigned char* ws = F.a->ws; const int tid = F.tid, lane = F.lane, wave = F.wave;
    LAS unsigned* hist = (LAS unsigned*)F.lds;
    LAS unsigned* wtot = hist + 256;
    LAS unsigned* ctl = wtot + 8;
    const float* AFF = (const float*)(ws + WS_AFF);
    int* IDX = (int*)(ws + WS_IDX); float* GSEL = (float*)(ws + WS_GSEL); int* INV = (int*)(ws + WS_INV);
    for (int it = F.blk; it < NB * NEXP; it += F.G) {
        const int b = it >> 4, e = it & 15;
        unsigned k8[8];
        { const v4u a = *(const v4u*)(AFF + (size_t)it * SEQ + 8 * tid), c2 = *(const v4u*)(AFF + (size_t)it * SEQ + 8 * tid + 4);
          k8[0] = a.x; k8[1] = a.y; k8[2] = a.z; k8[3] = a.w; k8[4] = c2.x; k8[5] = c2.y; k8[6] = c2.z; k8[7] = c2.w; }
        unsigned prefix = 0u, need = CAP;
#pragma unroll 1
        for (int pass = 0; pass < 4; ++pass) {
            const int shift = 24 - 8 * pass; const unsigned mask = pass ? (0xffffffffu << (shift + 8)) : 0u;
            if (tid < 256) hist[tid] = 0u;
            __syncthreads();
#pragma unroll
            for (int i = 0; i < 8; ++i) if ((k8[i] & mask) == prefix) atomicAdd((unsigned*)(hist + ((k8[i] >> shift) & 255u)), 1u);
            __syncthreads();
            if (wave == 0) {
                const unsigned h0 = hist[4 * lane], h1 = hist[4 * lane + 1], h2 = hist[4 * lane + 2], h3 = hist[4 * lane + 3], s = h0 + h1 + h2 + h3;
                unsigned suf = s;
#pragma unroll
                for (int o = 1; o < 64; o <<= 1) { const unsigned t = __shfl_down(suf, o); if (lane + o < 64) suf += t; }
                const unsigned above = suf - s;
                if (above < need && need <= suf) {
                    unsigned rem = need - above; int bin;
                    if (h3 >= rem) bin = 3; else { rem -= h3; if (h2 >= rem) bin = 2; else { rem -= h2; if (h1 >= rem) bin = 1; else { rem -= h1; bin = 0; } } }
                    ctl[0] = prefix | ((unsigned)(4 * lane + bin) << shift); ctl[1] = rem;
                }
            }
            __syncthreads();
            prefix = ctl[0]; need = ctl[1];
        }
        const unsigned T = prefix;
        unsigned cg = 0u, ce = 0u;
#pragma unroll
        for (int i = 0; i < 8; ++i) { cg += (k8[i] > T) ? 1u : 0u; ce += (k8[i] == T) ? 1u : 0u; }
        const unsigned pack = cg | (ce << 16);
        unsigned inc = pack;
#pragma unroll
        for (int o = 1; o < 64; o <<= 1) { const unsigned t = __shfl_up(inc, o); if (lane >= o) inc += t; }
        if (lane == 63) wtot[wave] = inc;
        __syncthreads();
        unsigned woff = 0u;
#pragma unroll
        for (int w = 0; w < 8; ++w) woff += (w < wave) ? wtot[w] : 0u;
        const unsigned exc = woff + inc - pack;
        unsigned gtb = exc & 0xffffu, eqb = exc >> 16;
#pragma unroll
        for (int i = 0; i < 8; ++i) {
            const int idx = 8 * tid + i; const bool isgt = k8[i] > T, iseq = k8[i] == T, selc = isgt || (iseq && eqb < need);
            const int slot = (int)(gtb + (eqb < need ? eqb : need));
            if (selc) { IDX[it * CAP + slot] = idx; GSEL[it * CAP + slot] = __uint_as_float(k8[i]); }
            INV[((size_t)b * SEQ + idx) * 16 + e] = selc ? slot : -1;
            gtb += isgt ? 1u : 0u; eqb += iseq ? 1u : 0u;
        }
        __syncthreads();
    }
}

typedef float f32x2 __attribute__((ext_vector_type(2)));
template <bool DRY> DI void p12_final(Frame& F) {
    unsigned char* ws = F.a->ws; const int lane = F.lane;
    const int* INV = (const int*)(ws + WS_INV); const float* GSEL = (const float*)(ws + WS_GSEL); const unsigned char* YS = ws + WS_YS; const float* MOD = (const float*)(ws + WS_MOD);
    const int gw = F.blk * 8 + F.wave, NGW = F.G * 8;
    f32x4 gfin[4];
#pragma unroll
    for (int j = 0; j < 4; ++j) gfin[j] = *(const f32x4*)(F.a->in[IN_GFINAL] + 256 * j + 4 * lane);
#pragma unroll 1
    for (int rq = gw; rq < MTOK / 4; rq += NGW) {
        const int row0 = 4 * rq, b = row0 >> 12;
        const int myslot = INV[(size_t)row0 * 16 + lane];
        f32x4 v[4][4];
#pragma unroll
        for (int r = 0; r < 4; ++r) { const v2u* xb = (const v2u*)((const bf16*)(ws + WS_X1) + (size_t)(row0 + r) * 1024) + lane;
#pragma unroll
            for (int j = 0; j < 4; ++j) { const v2u w = xb[64 * j]; v[r][j] = (f32x4){__builtin_bit_cast(float, w.x << 16), __builtin_bit_cast(float, w.x & 0xffff0000u), __builtin_bit_cast(float, w.y << 16), __builtin_bit_cast(float, w.y & 0xffff0000u)}; } }
        const float mygate = (myslot >= 0) ? GSEL[((size_t)b * 16 + (lane & 15)) * CAP + myslot] : 0.f;
        const unsigned long long mask = __ballot(myslot >= 0);
        f32x4 gt[4];
#pragma unroll
        for (int j = 0; j < 4; ++j) gt[j] = *(const f32x4*)(MOD + b * 6144 + 5120 + 256 * j + 4 * lane);
        float ssq[4];
#pragma unroll
        for (int r = 0; r < 4; ++r) {
            unsigned m = (unsigned)(mask >> (16 * r)) & 0xffffu;
            unsigned y[4][4]; float gk[4];
#pragma unroll
            for (int k = 0; k < 4; ++k) {
                const bool has = (m != 0u); const int e = has ? __builtin_ctz(m) : 0; if (has) m &= m - 1u;
                const int s = has ? __builtin_amdgcn_readlane(myslot, 16 * r + e) : 0;
                gk[k] = has ? __builtin_bit_cast(float, __builtin_amdgcn_readlane(__builtin_bit_cast(int, mygate), 16 * r + e)) * (1.f / 16.f) : 0.f;
                const unsigned* yr = (const unsigned*)(YS + (((size_t)e * NB + b) * CAP + s) * 1024) + lane;
#pragma unroll
                for (int j = 0; j < 4; ++j) y[k][j] = yr[64 * j];
            }
            f32x4 acc[4];
#pragma unroll
            for (int j = 0; j < 4; ++j) { acc[j] = (f32x4){0.f, 0.f, 0.f, 0.f};
#pragma unroll
                for (int k = 0; k < 4; ++k) { const f32x2 lo2 = __builtin_amdgcn_cvt_pk_f32_fp8((int)y[k][j], false), hi2 = __builtin_amdgcn_cvt_pk_f32_fp8((int)y[k][j], true); acc[j] += (f32x4){lo2.x, lo2.y, hi2.x, hi2.y} * gk[k]; } }
            while (m != 0u) {
                const int e = __builtin_ctz(m); m &= m - 1u;
                const int s = __builtin_amdgcn_readlane(myslot, 16 * r + e);
                const float g = __builtin_bit_cast(float, __builtin_amdgcn_readlane(__builtin_bit_cast(int, mygate), 16 * r + e)) * (1.f / 16.f);
                const unsigned* yr = (const unsigned*)(YS + (((size_t)e * NB + b) * CAP + s) * 1024) + lane;
#pragma unroll
                for (int j = 0; j < 4; ++j) { const unsigned w = yr[64 * j]; const f32x2 lo2 = __builtin_amdgcn_cvt_pk_f32_fp8((int)w, false), hi2 = __builtin_amdgcn_cvt_pk_f32_fp8((int)w, true); acc[j] += (f32x4){lo2.x, lo2.y, hi2.x, hi2.y} * g; }
            }
            float ss = 0.f;
#pragma unroll
            for (int j = 0; j < 4; ++j) { v[r][j] = v[r][j] + gt[j] * acc[j]; ss += (v[r][j].x * v[r][j].x + v[r][j].y * v[r][j].y) + (v[r][j].z * v[r][j].z + v[r][j].w * v[r][j].w); }
            ssq[r] = ss;
        }
#pragma unroll
        for (int r = 0; r < 4; ++r) ssq[r] = wave_sum(ssq[r]);
#pragma unroll
        for (int r = 0; r < 4; ++r) { const float rstd = rsqrtf(ssq[r] * (1.f / 1024.f) + RMS_EPS); f32x4* xr = (f32x4*)((DRY ? (float*)(ws + WS_HID) : F.a->out) + (size_t)(row0 + r) * 1024) + lane;
#pragma unroll
            for (int j = 0; j < 4; ++j) xr[64 * j] = v[r][j] * rstd * gfin[j]; }
    }
}

typedef short bf16x8_t __attribute__((ext_vector_type(8)));
DI unsigned offb(unsigned row, unsigned ch) { return 256u * row + 16u * (ch ^ (((row & 3u) << 2) | ((row >> 2) & 3u))); }
DI bf16x8_t tr_read2(unsigned a0, unsigned a1) {
    v2u lo, hi;
    asm volatile("ds_read_b64_tr_b16 %0, %2\n\tds_read_b64_tr_b16 %1, %3\n\ts_waitcnt lgkmcnt(0)" : "=&v"(lo), "=&v"(hi) : "v"(a0), "v"(a1) : "memory");
    const v4u w = (v4u){lo.x, lo.y, hi.x, hi.y};
    return __builtin_bit_cast(bf16x8_t, w);
}
#define TR2(d0, d1, a, o0, o1) "ds_read_b64_tr_b16 %" #d0 ", %" #a " offset:" #o0 "\n\tds_read_b64_tr_b16 %" #d1 ", %" #a " offset:" #o1 "\n\t"
DI void tr_read_vt3(unsigned a, bf16x8_t (&f)[3]) {
    v2u l0, h0, l1, h1, l2, h2;
    asm volatile(TR2(0, 1, 6, 0, 2048) TR2(2, 3, 6, 32, 2080) TR2(4, 5, 6, 64, 2112) "s_waitcnt lgkmcnt(0)"
                 : "=&v"(l0), "=&v"(h0), "=&v"(l1), "=&v"(h1), "=&v"(l2), "=&v"(h2) : "v"(a) : "memory");
    f[0] = __builtin_bit_cast(bf16x8_t, (v4u){l0.x, l0.y, h0.x, h0.y}); f[1] = __builtin_bit_cast(bf16x8_t, (v4u){l1.x, l1.y, h1.x, h1.y}); f[2] = __builtin_bit_cast(bf16x8_t, (v4u){l2.x, l2.y, h2.x, h2.y});
}
DI void tr_read_ve6(unsigned a, bf16x8_t (&f)[2][3]) {
    v2u r[12];
    asm volatile(TR2(0, 1, 12, 0, 512) TR2(2, 3, 12, 32, 544) TR2(4, 5, 12, 64, 576) TR2(6, 7, 12, 4096, 4608) TR2(8, 9, 12, 4128, 4640) TR2(10, 11, 12, 4160, 4672) "s_waitcnt lgkmcnt(0)"
                 : "=&v"(r[0]), "=&v"(r[1]), "=&v"(r[2]), "=&v"(r[3]), "=&v"(r[4]), "=&v"(r[5]), "=&v"(r[6]), "=&v"(r[7]), "=&v"(r[8]), "=&v"(r[9]), "=&v"(r[10]), "=&v"(r[11]) : "v"(a) : "memory");
#pragma unroll
    for (int k = 0; k < 2; ++k)
#pragma unroll
        for (int vt = 0; vt < 3; ++vt) f[k][vt] = __builtin_bit_cast(bf16x8_t, (v4u){r[6 * k + 2 * vt].x, r[6 * k + 2 * vt].y, r[6 * k + 2 * vt + 1].x, r[6 * k + 2 * vt + 1].y});
}
DI void tr_read_kt4(unsigned a0, unsigned a1, bf16x8_t (&f)[4]) {
    v2u r[8];
    asm volatile("ds_read_b64_tr_b16 %0, %8\n\tds_read_b64_tr_b16 %1, %9\n\tds_read_b64_tr_b16 %2, %8 offset:8192\n\tds_read_b64_tr_b16 %3, %9 offset:8192\n\t"
                 "ds_read_b64_tr_b16 %4, %8 offset:16384\n\tds_read_b64_tr_b16 %5, %9 offset:16384\n\tds_read_b64_tr_b16 %6, %8 offset:24576\n\tds_read_b64_tr_b16 %7, %9 offset:24576\n\ts_waitcnt lgkmcnt(0)"
                 : "=&v"(r[0]), "=&v"(r[1]), "=&v"(r[2]), "=&v"(r[3]), "=&v"(r[4]), "=&v"(r[5]), "=&v"(r[6]), "=&v"(r[7]) : "v"(a0), "v"(a1) : "memory");
#pragma unroll
    for (int k = 0; k < 4; ++k) f[k] = __builtin_bit_cast(bf16x8_t, (v4u){r[2 * k].x, r[2 * k].y, r[2 * k + 1].x, r[2 * k + 1].y});
}
typedef __bf16 bf16pair_t __attribute__((ext_vector_type(2)));
DI unsigned cvtpk(float a, float b) { const bf16pair_t v = (bf16pair_t){(__bf16)a, (__bf16)b}; return __builtin_bit_cast(unsigned, v); }
DI bf16x8_t pack8(const f32x4& a, const f32x4& b) { v4u w; asm volatile("v_cvt_pk_bf16_f32 %0, %4, %5\n\tv_cvt_pk_bf16_f32 %1, %6, %7\n\tv_cvt_pk_bf16_f32 %2, %8, %9\n\tv_cvt_pk_bf16_f32 %3, %10, %11\n\ts_nop 1" : "=&v"(w.x), "=&v"(w.y), "=&v"(w.z), "=&v"(w.w) : "v"(a.x), "v"(a.y), "v"(a.z), "v"(a.w), "v"(b.x), "v"(b.y), "v"(b.z), "v"(b.w)); return __builtin_bit_cast(bf16x8_t, w); }
DI bf16x8_t lds_frag(const LAS unsigned char* p) { return *(const LAS bf16x8_t*)p; }
#define MFMA16(a, b, c) __builtin_amdgcn_mfma_f32_16x16x32_bf16((a), (b), (c), 0, 0, 0)
constexpr int ML_QT = 0, ML_KT = 32768, ML_VT = 65536, ML_VE = 81920, ML_CB = 98304, ML_OUT = 110592, ML_SC = 118784, ML_SCSZ = 2688;
DI void p4_mlstm_mfma(Frame& F) {
    unsigned char* ws = F.a->ws; LAS unsigned char* L = F.lds;
    const bf16* QK = (const bf16*)(ws + WS_H); const bf16* P = (const bf16*)(ws + WS_P); const float* GATES = (const float*)(ws + WS_GATES);
    bf16* HM = (bf16*)(ws + WS_HM);
    const int tid = F.tid, lane = F.lane, wave = F.wave, fr = lane & 15, fq = lane >> 4, q4 = fr >> 2, p4 = fr & 3;
    const int tb = (wave < 4) ? wave : 11 - wave;
    const unsigned ldsb = (unsigned)(uintptr_t)L;
    unsigned ro[4], cbw[4], tso[4];
#pragma unroll
    for (int k = 0; k < 4; ++k) { ro[k] = offb(fr, 4 * k + fq); cbw[k] = offb(4 * fq + k, 2 * wave + (fr >> 3)) + 2 * (fr & 7); tso[k] = offb((tid + 512 * k) >> 4, (tid + 512 * k) & 15); }
    for (int it0 = F.blk; it0 < 256; it0 += F.G) {
        const int it = (F.G == 256) ? (((it0 & 7) * 4 + (it0 >> 6)) * 8 + ((it0 >> 3) & 7)) : it0;
        const int vs = it & 3, dir = (it >> 2) & 1, h = (it >> 3) & 3, b = it >> 5;
        __syncthreads();
        for (int i = tid; i < 12288 / 16; i += 512) *(LAS v4u*)(L + ML_CB + 16 * i) = (v4u){0u, 0u, 0u, 0u};
        if (tid < 256) { const int row = tid >> 1, hf = tid & 1;
            *(LAS v4u*)(L + ML_VT + row * 128 + 64 + 16 * hf) = (v4u){hf ? 0u : 0x3F80u, 0u, 0u, 0u};
            *(LAS v4u*)(L + ML_VE + row * 128 + 64 + 16 * hf) = (v4u){0u, 0u, 0u, 0u}; }
        f32x4 Cacc[3];
#pragma unroll
        for (int vt = 0; vt < 3; ++vt) Cacc[vt] = (f32x4){0.f, 0.f, 0.f, 0.f};
        float m_in = -1e30f;
        float gpre[4] = {0.f, 0.f, 0.f, 0.f};
        v4u rqA[4], rkA[4], rvA, rqB[4], rkB[4], rvB;
        auto load_gates = [&](int cj) {
#pragma unroll
            for (int e = 0; e < 2; ++e) { const int tg = cj * 128 + 2 * lane + e, token = b * SEQ + (dir ? SEQ - 1 - tg : tg);
                gpre[2 * e] = GATES[(size_t)token * 16 + 8 * dir + h]; gpre[2 * e + 1] = GATES[(size_t)token * 16 + 8 * dir + 4 + h]; }
        };
        auto scan = [&](int cj) {
            LAS float* SC = (LAS float*)(L + ML_SC + (cj & 1) * ML_SCSZ);
            const float lf0 = fminf(gpre[1], 0.f) - log1pf(__expf(-fabsf(gpre[1]))), lf1 = fminf(gpre[3], 0.f) - log1pf(__expf(-fabsf(gpre[3])));
            float inc = lf0 + lf1;
#pragma unroll
            for (int o = 1; o < 64; o <<= 1) { const float t = __shfl_up(inc, o); if (lane >= o) inc += t; }
            const float b1 = inc, b0 = inc - lf1, u0 = gpre[0] - b0, u1 = gpre[2] - b1;
            float imx = fmaxf(u0, u1);
#pragma unroll
            for (int o = 1; o < 64; o <<= 1) { const float t = __shfl_up(imx, o); if (lane >= o) imx = fmaxf(imx, t); }
            float exm = __shfl_up(imx, 1); if (lane == 0) exm = -3.0e38f;
            const float M0 = fmaxf(m_in, fmaxf(exm, u0)), M1 = fmaxf(m_in, imx);
            const float g = __shfl(b1, 63), Ml = __shfl(M1, 63);
            SC[2 * lane] = u0; SC[2 * lane + 1] = u1;
            SC[128 + 2 * lane] = M0; SC[128 + 2 * lane + 1] = M1;
            SC[256 + 2 * lane] = __expf(m_in - M0); SC[256 + 2 * lane + 1] = __expf(m_in - M1);
            SC[384 + 2 * lane] = __expf(-(b0 + M0)); SC[384 + 2 * lane + 1] = __expf(-(b1 + M1));
            SC[512 + 2 * lane] = __expf(u0 - Ml); SC[512 + 2 * lane + 1] = __expf(u1 - Ml);
            if (lane == 0) SC[640] = __expf(m_in - Ml);
            m_in = g + Ml;
        };
        auto load_tiles = [&](int cj, v4u (&rq)[4], v4u (&rk)[4], v4u& rv) {
#pragma unroll
            for (int i = 0; i < 4; ++i) { const int id = tid + 512 * i, row = id >> 4, ch = id & 15, tg = cj * 128 + row, token = b * SEQ + (dir ? SEQ - 1 - tg : tg);
                rq[i] = *(const v4u*)(QK + (size_t)token * 1024 + h * 128 + 8 * ch); rk[i] = *(const v4u*)(QK + (size_t)token * 1024 + 512 + h * 128 + 8 * ch); }
            { const int row = tid >> 2, pc = tid & 3, tg = cj * 128 + row, token = b * SEQ + (dir ? SEQ - 1 - tg : tg);
              rv = *(const v4u*)(P + (size_t)token * NPROJ + 1024 + h * 128 + 32 * vs + 8 * pc); }
        };
        auto store_tiles = [&](int cj, const v4u (&rq)[4], const v4u (&rk)[4], const v4u& rv) {
            const LAS float* SC = (const LAS float*)(L + ML_SC + (cj & 1) * ML_SCSZ);
#pragma unroll
            for (int i = 0; i < 4; ++i) { *(LAS v4u*)(L + ML_QT + tso[i]) = rq[i]; *(LAS v4u*)(L + ML_KT + tso[i]) = rk[i]; }
            { const int row = tid >> 2, pc = tid & 3; const float e = SC[512 + row];
              *(LAS v4u*)(L + ML_VT + row * 128 + 16 * pc) = rv;
              v4u w; w.x = cvtpk(bflo(rv.x) * e, bfhi(rv.x) * e); w.y = cvtpk(bflo(rv.y) * e, bfhi(rv.y) * e); w.z = cvtpk(bflo(rv.z) * e, bfhi(rv.z) * e); w.w = cvtpk(bflo(rv.w) * e, bfhi(rv.w) * e);
              *(LAS v4u*)(L + ML_VE + row * 128 + 16 * pc) = w;
              if (pc == 0) *(LAS bf16*)(L + ML_VE + row * 128 + 64) = (bf16)f2bf(e); }
        };
        if (wave == 0) { load_gates(0); scan(0); load_gates(1); }
        load_tiles(0, rqA, rkA, rvA);
        __syncthreads();
        store_tiles(0, rqA, rkA, rvA);
        load_tiles(1, rqB, rkB, rvB); load_tiles(2, rqA, rkA, rvA);
        LDS_BARRIER();
#pragma unroll 1
        for (int cj2 = 0; cj2 < 32; cj2 += 2) {
#pragma unroll
          for (int par = 0; par < 2; ++par) {
            const int cj = cj2 + par;
            const LAS float* SC = (const LAS float*)(L + ML_SC + (cj & 1) * ML_SCSZ);
            if (cj + 1 < 32) { if (wave == 0) { scan(cj + 1); if (cj + 2 < 32) load_gates(cj + 2); } }
            bf16x8_t qf[4];
#pragma unroll
            for (int ks = 0; ks < 4; ++ks) qf[ks] = lds_frag(L + ML_QT + tb * 4096 + ro[ks]);
            f32x4 accO[3];
#pragma unroll
            for (int vt = 0; vt < 3; ++vt) { accO[vt] = (f32x4){0.f, 0.f, 0.f, 0.f};
#pragma unroll
                for (int ks = 0; ks < 4; ++ks) accO[vt] = MFMA16(qf[ks], lds_frag(L + ML_CB + vt * 4096 + ro[ks]), accO[vt]); }
            { const f32x4 ei = *(const LAS f32x4*)(SC + 256 + 16 * tb + 4 * fq);
#pragma unroll
              for (int vt = 0; vt < 3; ++vt) accO[vt] = accO[vt] * ei; }
            const float mrow_t = SC[128 + 16 * tb + fr];
            for (int ks2 = 0; ks2 <= (tb >> 1); ++ks2) {
                f32x4 st[2];
#pragma unroll
                for (int hh = 0; hh < 2; ++hh) {
                    const int sb = 2 * ks2 + hh;
                    st[hh] = (f32x4){0.f, 0.f, 0.f, 0.f};
                    if (sb <= tb) {
                        f32x4 acc = (f32x4){0.f, 0.f, 0.f, 0.f};
#pragma unroll
                        for (int kd = 0; kd < 4; ++kd) acc = MFMA16(lds_frag(L + ML_KT + sb * 4096 + ro[kd]), qf[kd], acc);
                        const f32x4 us = *(const LAS f32x4*)(SC + 16 * sb + 4 * fq);
#pragma unroll
                        for (int r = 0; r < 4; ++r) st[hh][r] = acc[r] * __expf(us[r] - mrow_t);
                        if (sb == tb) {
#pragma unroll
                            for (int r = 0; r < 4; ++r) st[hh][r] = (4 * fq + r <= fr) ? st[hh][r] : 0.f; }
                    }
                }
                const bf16x8_t sp = pack8(st[0], st[1]);
                bf16x8_t vf[3]; tr_read_vt3(ldsb + ML_VT + (32 * ks2 + 4 * fq + q4) * 128 + 8 * p4, vf);
#pragma unroll
                for (int vt = 0; vt < 3; ++vt) accO[vt] = MFMA16(sp, vf[vt], accO[vt]);
            }
            { const f32x4 enm = *(const LAS f32x4*)(SC + 384 + 16 * tb + 4 * fq);
#pragma unroll
              for (int r = 0; r < 4; ++r) { const float den = __shfl(accO[2][r], lane & 48), inv = 1.f / fmaxf(fabsf(den), enm[r]);
                  const int t = 16 * tb + 4 * fq + r;
                  const unsigned pr = cvtpk(accO[0][r] * inv, accO[1][r] * inv);
                  *(LAS bf16*)(L + ML_OUT + t * 64 + 2 * fr) = (bf16)(pr & 0xffffu); *(LAS bf16*)(L + ML_OUT + t * 64 + 32 + 2 * fr) = (bf16)(pr >> 16); } }
            { const float sp = SC[640];
#pragma unroll
              for (int vt = 0; vt < 3; ++vt) Cacc[vt] = Cacc[vt] * sp; }
            {
                const unsigned r0 = 8 * fq + q4;
                bf16x8_t kb[4]; tr_read_kt4(ldsb + ML_KT + offb(r0, 2 * wave + (p4 >> 1)) + 8 * (p4 & 1), ldsb + ML_KT + offb(r0 + 4, 2 * wave + (p4 >> 1)) + 8 * (p4 & 1), kb);
                const unsigned ea = ldsb + ML_VE + r0 * 128 + 8 * p4;
#pragma unroll
                for (int kp = 0; kp < 2; ++kp) {
                    bf16x8_t ve[2][3]; tr_read_ve6(ea + kp * 64 * 128, ve);
#pragma unroll
                    for (int k = 0; k < 2; ++k)
#pragma unroll
                        for (int vt = 0; vt < 3; ++vt) Cacc[vt] = MFMA16(ve[k][vt], kb[2 * kp + k], Cacc[vt]);
                }
            }
            LDS_BARRIER();
#pragma unroll
            for (int vt = 0; vt < 3; ++vt)
#pragma unroll
                for (int r = 0; r < 4; r += 2) { const unsigned pr = cvtpk(Cacc[vt][r], Cacc[vt][r + 1]);
                    *(LAS bf16*)(L + ML_CB + vt * 4096 + cbw[r]) = (bf16)(pr & 0xffffu); *(LAS bf16*)(L + ML_CB + vt * 4096 + cbw[r + 1]) = (bf16)(pr >> 16); }
            { const int row = tid >> 2, pc = tid & 3, tg = cj * 128 + row, token = b * SEQ + (dir ? SEQ - 1 - tg : tg);
              *(v4u*)(HM + ((size_t)dir * MTOK + token) * 512 + h * 128 + 32 * vs + 8 * pc) = *(const LAS v4u*)(L + ML_OUT + row * 64 + 16 * pc); }
            if (par == 0) { if (cj + 1 < 32) store_tiles(cj + 1, rqB, rkB, rvB); if (cj + 3 < 32) load_tiles(cj + 3, rqB, rkB, rvB); }
            else          { if (cj + 1 < 32) store_tiles(cj + 1, rqA, rkA, rvA); if (cj + 3 < 32) load_tiles(cj + 3, rqA, rkA, rvA); }
            LDS_BARRIER();
          }
        }
    }
}
HD unsigned pkc(float re, float im) {
#if defined(__HIP_DEVICE_COMPILE__)
    unsigned r; asm("v_cvt_pk_bf16_f32 %0, %1, %2" : "=v"(r) : "v"(re), "v"(im)); return r;
#else
    unsigned a = __builtin_bit_cast(unsigned, re), b = __builtin_bit_cast(unsigned, im);
    a = (a + 0x7fffu + ((a >> 16) & 1u)) >> 16; b = (b + 0x7fffu + ((b >> 16) & 1u)) >> 16; return a | (b << 16);
#endif
}
HD cf2 upk(unsigned w) { return MK2(__builtin_bit_cast(float, w << 16), __builtin_bit_cast(float, w & 0xffff0000u)); }
HD int wphys(int i) { return i + (i >> 4); }
HD cf2 p_mul(cf2 a, cf2 b) { return MK2(a.x * b.x - a.y * b.y, a.x * b.y + a.y * b.x); }
HD cf2 p_mulc(cf2 a, cf2 b) { return MK2(a.x * b.x + a.y * b.y, a.y * b.x - a.x * b.y); }
constexpr int FFT2_XWORDS = 8192 + 512;
HD float cos16(int j) {
#if defined(__HIP_DEVICE_COMPILE__)
    return cospif((float)(j & 15) * 0.125f);
#else
    constexpr float C[16] = {1.f, W16_C1, W16_H, W16_S1, 0.f, -W16_S1, -W16_H, -W16_C1, -1.f, -W16_C1, -W16_H, -W16_S1, 0.f, W16_S1, W16_H, W16_C1}; return C[j & 15];
#endif
}
HD float sin16(int j) { return cos16(j + 12); }
HD void dft_mat_frag(int lane, int s, bool inv, unsigned (&w)[4]) {
    const int r = lane & 31, h = lane >> 5, rr = r >> 1, rp = r & 1;
    float v[8];
#pragma unroll
    for (int j = 0; j < 8; ++j) {
        const int k = 16 * s + 8 * h + j, kk = k >> 1, kp = k & 1, a = (rr * kk) & 15;
        const float c = cos16(a), sn = inv ? -sin16(a) : sin16(a);
        v[j] = (rp == 0) ? (kp == 0 ? c : sn) : (kp == 0 ? -sn : c);
    }
#pragma unroll
    for (int j = 0; j < 4; ++j) w[j] = pkc(v[2 * j], v[2 * j + 1]);
}
HD cf2 tw8k(cf2 t8, int kbase, int h) { const cf2 w0 = w32_const(kbase), w1 = w32_const(kbase + 4); const cf2 w = h ? w1 : w0; return p_mul(t8, w); }
HD cf2 tw8k2(cf2 t8, int kbase, int h) { const cf2 w0 = w32_const(kbase), w1 = w32_const(kbase + 2); const cf2 w = h ? w1 : w0; return p_mul(t8, w); }

template <class TP> HD void f2_passA_fwd_tw(int wave, int lane, TP TW8, cf2 (&wl)[8]) {
    const int n = lane & 31, h = lane >> 5, lo = 32 * wave + n; const cf2 t8 = TW8[lo];
#pragma unroll
    for (int s = 0; s < 2; ++s)
#pragma unroll
        for (int i = 0; i < 4; ++i) wl[4 * s + i] = tw8k(t8, 8 * s + i, h);
}
template <bool BZ> HD void f2_passA_fwd_build(const unsigned (&a8)[8], const unsigned (&b8)[8], const cf2 (&wl)[8], unsigned (&B0)[2][4], unsigned (&B1)[2][4]) {
#pragma unroll
    for (int s = 0; s < 2; ++s)
#pragma unroll
        for (int i = 0; i < 4; ++i) {
            const cf2 a = upk(a8[4 * s + i]); cf2 d = a;
            if (BZ) B0[s][i] = a8[4 * s + i];
            else { const cf2 b = upk(b8[4 * s + i]); B0[s][i] = pkc(a.x + b.x, a.y + b.y); d = MK2(a.x - b.x, a.y - b.y); }
            const cf2 p = p_mul(d, wl[4 * s + i]); B1[s][i] = pkc(p.x, p.y);
        }
}
template <bool BZ, class TP> HD void f2_passA_fwd_load(int wave, int lane, const unsigned (&a8)[8], const unsigned (&b8)[8], TP TW8, unsigned (&B0)[2][4], unsigned (&B1)[2][4]) {
    cf2 wl[8]; f2_passA_fwd_tw(wave, lane, TW8, wl); f2_passA_fwd_build<BZ>(a8, b8, wl, B0, B1);
}
template <class TP> HD void f2_passA_fwd_twr(int wave, int lane, TP TWA, cf2 (&tw)[8]) {
    const int n = lane & 31, h = lane >> 5, lo = 32 * wave + n, t0 = 512 * h + lo;
#pragma unroll
    for (int g = 0; g < 4; ++g)
#pragma unroll
        for (int e = 0; e < 2; ++e) tw[2 * g + e] = TWA[(4 * g + e) * 256 + t0];
}
template <class XP> HD void f2_passA_fwd_st(int wave, int lane, int q, const float (&acc)[16], XP X, const cf2 (&tw)[8]) {
    const int n = lane & 31, h = lane >> 5, lo = 32 * wave + n, p0 = wphys(q * 4096 + lo) + 544 * h;
#pragma unroll
    for (int g = 0; g < 4; ++g)
#pragma unroll
        for (int e = 0; e < 2; ++e) {
            const cf2 o = p_mul(MK2(acc[4 * g + 2 * e], acc[4 * g + 2 * e + 1]), tw[2 * g + e]);
            X[p0 + 272 * (4 * g + e)] = pkc(o.x, o.y);
        }
}
template <class XP, class TP> HD void f2_passA_fwd_store(int wave, int lane, int q, const float (&acc)[16], XP X, TP TWA) { cf2 tw[8]; f2_passA_fwd_twr(wave, lane, TWA, tw); f2_passA_fwd_st(wave, lane, q, acc, X, tw); }
template <class XP> HD void f2_passB_load(int wave, int lane, int q, XP X, unsigned (&B)[2][4]) {
    const int n = lane & 31, h = lane >> 5, bb = 32 * wave + n, p0 = wphys(q * 4096 + (bb >> 4) * 256 + (bb & 15));
#pragma unroll
    for (int s = 0; s < 2; ++s)
#pragma unroll
        for (int i = 0; i < 4; ++i) B[s][i] = X[p0 + 17 * (8 * s + 4 * h + i)];
}
template <class TP> HD void f2_passB_fwd_twr(int wave, int lane, TP TWB, cf2 (&tw)[8]) {
    const int n = lane & 31, h = lane >> 5, bb = 32 * wave + n, lo16 = bb & 15, t0 = 32 * h + lo16;
#pragma unroll
    for (int g = 0; g < 4; ++g)
#pragma unroll
        for (int e = 0; e < 2; ++e) tw[2 * g + e] = TWB[(4 * g + e) * 16 + t0];
}
template <class XP> HD void f2_passB_fwd_st(int wave, int lane, int q, const float (&acc)[16], XP X, const cf2 (&tw)[8]) {
    const int n = lane & 31, h = lane >> 5, bb = 32 * wave + n, lo16 = bb & 15, p0 = wphys(q * 4096 + (bb >> 4) * 256 + lo16) + 34 * h;
#pragma unroll
    for (int g = 0; g < 4; ++g)
#pragma unroll
        for (int e = 0; e < 2; ++e) {
            const cf2 o = p_mul(MK2(acc[4 * g + 2 * e], acc[4 * g + 2 * e + 1]), tw[2 * g + e]);
            X[p0 + 17 * (4 * g + e)] = pkc(o.x, o.y);
        }
}
template <class XP, class TP> HD void f2_passB_fwd_store(int wave, int lane, int q, const float (&acc)[16], XP X, TP TWB) { cf2 tw[8]; f2_passB_fwd_twr(wave, lane, TWB, tw); f2_passB_fwd_st(wave, lane, q, acc, X, tw); }
template <class TP> HD void f2_passB_inv_twr(int wave, int lane, TP TWA, cf2 (&tw)[8]) {
    const int n = lane & 31, h = lane >> 5, bb = 32 * wave + n, hi = bb >> 4, lo16 = bb & 15, t0 = hi * 256 + 32 * h + lo16;
#pragma unroll
    for (int g = 0; g < 4; ++g)
#pragma unroll
        for (int e = 0; e < 2; ++e) tw[2 * g + e] = TWA[t0 + 16 * (4 * g + e)];
}
template <class XP> HD void f2_passB_inv_st(int wave, int lane, int q, const float (&acc)[16], XP X, const cf2 (&tw)[8]) {
    const int n = lane & 31, h = lane >> 5, bb = 32 * wave + n, hi = bb >> 4, lo16 = bb & 15, p0 = wphys(q * 4096 + hi * 256 + lo16) + 34 * h;
#pragma unroll
    for (int g = 0; g < 4; ++g)
#pragma unroll
        for (int e = 0; e < 2; ++e) {
            const cf2 o = p_mulc(MK2(acc[4 * g + 2 * e], acc[4 * g + 2 * e + 1]), tw[2 * g + e]);
            X[p0 + 17 * (4 * g + e)] = pkc(o.x, o.y);
        }
}
template <class XP, class TP> HD void f2_passB_inv_store(int wave, int lane, int q, const float (&acc)[16], XP X, TP TWA) { cf2 tw[8]; f2_passB_inv_twr(wave, lane, TWA, tw); f2_passB_inv_st(wave, lane, q, acc, X, tw); }
template <class XP> HD void f2_passC_load(int wave, int lane, int q, XP X, unsigned (&B)[2][4]) {
    const int n = lane & 31, h = lane >> 5, p0 = 17 * (q * 256 + 32 * wave + n);
#pragma unroll
    for (int s = 0; s < 2; ++s)
#pragma unroll
        for (int i = 0; i < 4; ++i) B[s][i] = X[p0 + 8 * s + 4 * h + i];
}
template <class XP> HD void f2_passC_fwd_store(int wave, int lane, int q, const float (&acc)[16], const cf2 (&kv)[8], XP X) {
    const int n = lane & 31, h = lane >> 5, p0 = 17 * (q * 256 + 32 * wave + n);
#pragma unroll
    for (int g = 0; g < 4; ++g)
#pragma unroll
        for (int e = 0; e < 2; ++e) {
            const cf2 o = p_mul(MK2(acc[4 * g + 2 * e], acc[4 * g + 2 * e + 1]), kv[2 * g + e]);
            X[p0 + 4 * g + e + 2 * h] = pkc(o.x, o.y);
        }
}
template <class TP> HD void f2_passC_inv_twr(int wave, int lane, TP TWB, cf2 (&tw)[8]) {
    const int n = lane & 31, h = lane >> 5, bb = 32 * wave + n, rB = bb & 15, t0 = rB * 16 + 2 * h;
#pragma unroll
    for (int g = 0; g < 4; ++g)
#pragma unroll
        for (int e = 0; e < 2; ++e) tw[2 * g + e] = TWB[t0 + 4 * g + e];
}
template <class XP> HD void f2_passC_inv_st(int wave, int lane, int q, const float (&acc)[16], XP X, const cf2 (&tw)[8]) {
    const int n = lane & 31, h = lane >> 5, bb = 32 * wave + n, p0 = 17 * (q * 256 + bb) + 2 * h;
#pragma unroll
    for (int g = 0; g < 4; ++g)
#pragma unroll
        for (int e = 0; e < 2; ++e) {
            const cf2 o = p_mulc(MK2(acc[4 * g + 2 * e], acc[4 * g + 2 * e + 1]), tw[2 * g + e]);
            X[p0 + 4 * g + e] = pkc(o.x, o.y);
        }
}
template <class XP, class TP> HD void f2_passC_inv_store(int wave, int lane, int q, const float (&acc)[16], XP X, TP TWB) { cf2 tw[8]; f2_passC_inv_twr(wave, lane, TWB, tw); f2_passC_inv_st(wave, lane, q, acc, X, tw); }
template <class XP> HD void f2_passA_inv_load(int wave, int lane, int q, XP X, unsigned (&B)[2][4]) {
    const int n = lane & 31, h = lane >> 5, p0 = wphys(q * 4096 + 32 * wave + n);
#pragma unroll
    for (int s = 0; s < 2; ++s)
#pragma unroll
        for (int i = 0; i < 4; ++i) B[s][i] = X[p0 + 272 * (8 * s + 4 * h + i)];
}
template <class TP> HD void f2_passA_inv_tw(int wave, int lane, TP TW8, cf2 (&wc)[8]) {
    const int n = lane & 31, h = lane >> 5, lo = 32 * wave + n; const cf2 t8 = TW8[lo];
#pragma unroll
    for (int g = 0; g < 4; ++g)
#pragma unroll
        for (int e = 0; e < 2; ++e) wc[2 * g + e] = tw8k2(t8, 4 * g + e, h);
}
HD void f2_passA_inv_comb(const float (&acc0)[16], const float (&acc1)[16], const cf2 (&wc)[8], cf2 (&y)[8]) {
#pragma unroll
    for (int g = 0; g < 4; ++g)
#pragma unroll
        for (int e = 0; e < 2; ++e) {
            const cf2 u0 = MK2(acc0[4 * g + 2 * e], acc0[4 * g + 2 * e + 1]), u1 = MK2(acc1[4 * g + 2 * e], acc1[4 * g + 2 * e + 1]);
            const cf2 p = p_mulc(u1, wc[2 * g + e]);
            y[2 * g + e] = MK2(u0.x + p.x, u0.y + p.y);
        }
}
template <class TP> HD void f2_passA_inv_combine(int wave, int lane, const float (&acc0)[16], const float (&acc1)[16], TP TW8, cf2 (&y)[8]) { cf2 wc[8]; f2_passA_inv_tw(wave, lane, TW8, wc); f2_passA_inv_comb(acc0, acc1, wc, y); }
typedef float f32x16 __attribute__((ext_vector_type(16)));
#define MFMA32(a, b, c) __builtin_amdgcn_mfma_f32_32x32x16_bf16(__builtin_bit_cast(bf16x8_t, (a)), __builtin_bit_cast(bf16x8_t, (b)), (c), 0, 0, 0)
constexpr int H3_X = 0, H3_XQ = 34816, H3_Z1 = 69632, H3_ZQ = 16384, H3_TWA = 102400, H3_TWB = 135168, H3_TW8 = 137216, H3_TS = 34816;
struct DftMats { v4u f[2], i[2]; };
DI void h3_mm2(const DftMats& M, bool inv, const unsigned (&B0)[2][4], const unsigned (&B1)[2][4], float (&out0)[16], float (&out1)[16]) {
    f32x16 acc0, acc1;
#pragma unroll
    for (int i = 0; i < 16; ++i) { acc0[i] = 0.f; acc1[i] = 0.f; }
    const v4u b00 = (v4u){B0[0][0], B0[0][1], B0[0][2], B0[0][3]}, b01 = (v4u){B0[1][0], B0[1][1], B0[1][2], B0[1][3]};
    const v4u b10 = (v4u){B1[0][0], B1[0][1], B1[0][2], B1[0][3]}, b11 = (v4u){B1[1][0], B1[1][1], B1[1][2], B1[1][3]};
    acc0 = MFMA32(inv ? M.i[0] : M.f[0], b00, acc0); acc1 = MFMA32(inv ? M.i[0] : M.f[0], b10, acc1);
    acc0 = MFMA32(inv ? M.i[1] : M.f[1], b01, acc0); acc1 = MFMA32(inv ? M.i[1] : M.f[1], b11, acc1);
#pragma unroll
    for (int i = 0; i < 16; ++i) { out0[i] = acc0[i]; out1[i] = acc1[i]; }
}
DI void mfma_ready(unsigned (&B)[2][4]) {
    asm volatile("s_nop 1" : "+v"(B[0][0]), "+v"(B[0][1]), "+v"(B[0][2]), "+v"(B[0][3]), "+v"(B[1][0]), "+v"(B[1][1]), "+v"(B[1][2]), "+v"(B[1][3]));
}
template <int O> DI void hy3_conv2(int wave, int lane0, const DftMats& M, const unsigned (&vinA)[8], const unsigned (&vinB)[8], LAS unsigned* X0, LAS unsigned* Z10, const LAS cf2* TWA, const LAS cf2* TWB, const LAS cf2* TW8,
                                   const cf2* kg, const unsigned* UzA, const unsigned* UxA, unsigned* ztA, const unsigned* UzB, const unsigned* UxB, unsigned* ztB, float bias) {
    const unsigned zero8[8] = {0u, 0u, 0u, 0u, 0u, 0u, 0u, 0u};
    LAS unsigned* X1 = X0 + H3_XQ / 4; LAS unsigned* Z11 = Z10 + H3_ZQ / 4;
    { int lane = lane0; LAUNDER(lane); const int n = lane & 31, h = lane >> 5, lo = 32 * wave + n;
      cf2 wl[8], tw[8]; f2_passA_fwd_tw(wave, lane, TW8, wl); f2_passA_fwd_twr(wave, lane, TWA, tw);
      unsigned a8[8], b8[8];
#pragma unroll
      for (int s = 0; s < 2; ++s)
#pragma unroll
          for (int i = 0; i < 4; ++i) { a8[4 * s + i] = (O == 0) ? vinA[4 * s + i] : Z10[(8 * s + 4 * h + i) * 256 + lo]; b8[4 * s + i] = (O == 0) ? vinB[4 * s + i] : Z11[(8 * s + 4 * h + i) * 256 + lo]; }
      unsigned B0[2][4], B1[2][4], C0[2][4], C1[2][4];
      f2_passA_fwd_build<true>(a8, zero8, wl, B0, B1); f2_passA_fwd_build<true>(b8, zero8, wl, C0, C1);
      mfma_ready(B0); mfma_ready(B1); mfma_ready(C0); mfma_ready(C1);
      float a0[16], a1[16], c0[16], c1[16]; h3_mm2(M, false, B0, B1, a0, a1); h3_mm2(M, false, C0, C1, c0, c1);
      f2_passA_fwd_st(wave, lane, 0, a0, X0, tw); f2_passA_fwd_st(wave, lane, 1, a1, X0, tw); f2_passA_fwd_st(wave, lane, 0, c0, X1, tw); f2_passA_fwd_st(wave, lane, 1, c1, X1, tw); }
    LDS_BARRIER();
    cf2 kv0[8], kv1[8];
    { int lane = lane0; LAUNDER(lane);
#pragma unroll
      for (int p = 0; p < 8; ++p) { kv0[p] = kg[((0 * 8 + wave) * 8 + p) * 64 + lane]; kv1[p] = kg[((1 * 8 + wave) * 8 + p) * 64 + lane]; }
      cf2 tw[8]; f2_passB_fwd_twr(wave, lane, TWB, tw);
      unsigned B0[2][4], B1[2][4], C0[2][4], C1[2][4];
      f2_passB_load(wave, lane, 0, X0, B0); f2_passB_load(wave, lane, 1, X0, B1); f2_passB_load(wave, lane, 0, X1, C0); f2_passB_load(wave, lane, 1, X1, C1);
      float a0[16], a1[16], c0[16], c1[16]; h3_mm2(M, false, B0, B1, a0, a1); h3_mm2(M, false, C0, C1, c0, c1);
      f2_passB_fwd_st(wave, lane, 0, a0, X0, tw); f2_passB_fwd_st(wave, lane, 1, a1, X0, tw); f2_passB_fwd_st(wave, lane, 0, c0, X1, tw); f2_passB_fwd_st(wave, lane, 1, c1, X1, tw); }
    LDS_WAIT(); asm volatile("" ::: "memory");
    { int lane = lane0; LAUNDER(lane);
      cf2 tw[8]; f2_passC_inv_twr(wave, lane, TWB, tw);
      unsigned B0[2][4], B1[2][4], C0[2][4], C1[2][4];
      f2_passC_load(wave, lane, 0, X0, B0); f2_passC_load(wave, lane, 1, X0, B1); f2_passC_load(wave, lane, 0, X1, C0); f2_passC_load(wave, lane, 1, X1, C1);
      float a0[16], a1[16], c0[16], c1[16]; h3_mm2(M, false, B0, B1, a0, a1); h3_mm2(M, false, C0, C1, c0, c1);
      f2_passC_fwd_store(wave, lane, 0, a0, kv0, X0); f2_passC_fwd_store(wave, lane, 1, a1, kv1, X0); f2_passC_fwd_store(wave, lane, 0, c0, kv0, X1); f2_passC_fwd_store(wave, lane, 1, c1, kv1, X1);
      asm volatile("" ::: "memory");
      f2_passC_load(wave, lane, 0, X0, B0); f2_passC_load(wave, lane, 1, X0, B1); f2_passC_load(wave, lane, 0, X1, C0); f2_passC_load(wave, lane, 1, X1, C1);
      h3_mm2(M, true, B0, B1, a0, a1); h3_mm2(M, true, C0, C1, c0, c1);
      f2_passC_inv_st(wave, lane, 0, a0, X0, tw); f2_passC_inv_st(wave, lane, 1, a1, X0, tw); f2_passC_inv_st(wave, lane, 0, c0, X1, tw); f2_passC_inv_st(wave, lane, 1, c1, X1, tw); }
    LDS_WAIT(); asm volatile("" ::: "memory");
    unsigned fxA[8], fzA[8], fxB[8], fzB[8];
    { int lane = lane0; LAUNDER(lane);
      { const int n = lane & 31, h = lane >> 5, lo = 32 * wave + n;
#pragma unroll
        for (int g = 0; g < 4; ++g)
#pragma unroll
            for (int e = 0; e < 2; ++e) { const int t = (4 * g + 2 * h + e) * 256 + lo; fxA[2 * g + e] = UxA[t]; fzA[2 * g + e] = (O == 0) ? UzA[t] : 0u; fxB[2 * g + e] = UxB[t]; fzB[2 * g + e] = (O == 0) ? UzB[t] : 0u; } }
      cf2 tw[8]; f2_passB_inv_twr(wave, lane, TWA, tw);
      unsigned B0[2][4], B1[2][4], C0[2][4], C1[2][4];
      f2_passB_load(wave, lane, 0, X0, B0); f2_passB_load(wave, lane, 1, X0, B1); f2_passB_load(wave, lane, 0, X1, C0); f2_passB_load(wave, lane, 1, X1, C1);
      float a0[16], a1[16], c0[16], c1[16]; h3_mm2(M, true, B0, B1, a0, a1); h3_mm2(M, true, C0, C1, c0, c1);
      f2_passB_inv_st(wave, lane, 0, a0, X0, tw); f2_passB_inv_st(wave, lane, 1, a1, X0, tw); f2_passB_inv_st(wave, lane, 0, c0, X1, tw); f2_passB_inv_st(wave, lane, 1, c1, X1, tw); }
    LDS_BARRIER();
    { int lane = lane0; LAUNDER(lane); const int n = lane & 31, h = lane >> 5, lo = 32 * wave + n;
      cf2 wc[8]; f2_passA_inv_tw(wave, lane, TW8, wc);
      unsigned B0[2][4], B1[2][4], C0[2][4], C1[2][4];
      f2_passA_inv_load(wave, lane, 0, X0, B0); f2_passA_inv_load(wave, lane, 1, X0, B1); f2_passA_inv_load(wave, lane, 0, X1, C0); f2_passA_inv_load(wave, lane, 1, X1, C1);
      unsigned zq[2][8];
#pragma unroll
      for (int p = 0; p < 8; ++p) { const int t = (4 * (p >> 1) + 2 * h + (p & 1)) * 256 + lo; zq[0][p] = (O == 1) ? Z10[t] : 0u; zq[1][p] = (O == 1) ? Z11[t] : 0u; }
      float a0[16], a1[16], c0[16], c1[16]; h3_mm2(M, true, B0, B1, a0, a1); h3_mm2(M, true, C0, C1, c0, c1);
#pragma unroll
      for (int q = 0; q < 2; ++q) { LAS unsigned* Z1 = q ? Z11 : Z10; unsigned* zt = q ? ztB : ztA;
          cf2 y[8]; if (q == 0) f2_passA_inv_comb(a0, a1, wc, y); else f2_passA_inv_comb(c0, c1, wc, y);
#pragma unroll
          for (int g = 0; g < 4; ++g)
#pragma unroll
              for (int e = 0; e < 2; ++e) { const int p = 2 * g + e, t = (4 * g + 2 * h + e) * 256 + lo; const unsigned fx = q ? fxB[p] : fxA[p], fz = q ? fzB[p] : fzA[p];
                  if (O == 0) Z1[t] = pkc(bflo(fx) * (y[p].x + bias * bflo(fz)), bfhi(fx) * (y[p].y + bias * bfhi(fz)));
                  else { const cf2 z1 = upk(zq[q][p]); zt[t] = pkc(bflo(fx) * (y[p].x + bias * z1.x), bfhi(fx) * (y[p].y + bias * z1.y)); } } } }
    LDS_BARRIER();
}
DI void p4_hyena3(Frame& F) {
    unsigned char* ws = F.a->ws; const int tid = F.tid, wave = F.wave;
    LAS unsigned* X = (LAS unsigned*)(F.lds + H3_X); LAS unsigned* Z1 = (LAS unsigned*)(F.lds + H3_Z1);
    LAS cf2* TWA = (LAS cf2*)(F.lds + H3_TWA); LAS cf2* TWB = (LAS cf2*)(F.lds + H3_TWB); LAS cf2* TW8 = (LAS cf2*)(F.lds + H3_TW8);
    LAS float* TS = (LAS float*)(F.lds + H3_TS);
    const float* FILT = (const float*)F.a->out;
    cf2* KG = (cf2*)(ws + WS_KSP) + (size_t)F.blk * 16384;
    const unsigned* UT = (const unsigned*)(ws + WS_UT); unsigned* ZT = (unsigned*)(ws + WS_ZT);
#pragma unroll 1
    for (int i = tid; i < 4096; i += 512) { const int r = i >> 8, lo = i & 255; float sn, cs; sincospif((float)(r * lo) * (1.f / 2048.f), &sn, &cs); TWA[i] = MK2(cs, -sn); }
    if (tid < 256) { float sn, cs; const int r = tid >> 4, lo = tid & 15; sincospif((float)(r * lo) * (1.f / 128.f), &sn, &cs); TWB[tid] = MK2(cs, -sn);
        sincospif((float)tid * (1.f / 4096.f), &sn, &cs); TW8[tid] = MK2(cs, -sn); }
    DftMats M;
    { unsigned w[4];
      dft_mat_frag(F.lane, 0, false, w); M.f[0] = (v4u){w[0], w[1], w[2], w[3]}; dft_mat_frag(F.lane, 1, false, w); M.f[1] = (v4u){w[0], w[1], w[2], w[3]};
      dft_mat_frag(F.lane, 0, true, w); M.i[0] = (v4u){w[0], w[1], w[2], w[3]}; dft_mat_frag(F.lane, 1, true, w); M.i[1] = (v4u){w[0], w[1], w[2], w[3]}; }
    __syncthreads();
    for (int c = F.blk; c < 512; c += F.G) {
        for (int o2 = 0; o2 < (DUP(15) ? 4 : 2); ++o2) { const int o = o2 & 1;
            const float adf = fabsf(F.a->in[IN_HDELTA][(o * 2) * 512 + c]), adb = fabsf(F.a->in[IN_HDELTA][(o * 2 + 1) * 512 + c]);
            {
                const float* Ff = FILT + (size_t)((o * 2) * 512 + c) * SEQ; const float* Fb = FILT + (size_t)((o * 2 + 1) * 512 + c) * SEQ;
                if (tid == 0) TS[SEQ] = 0.f;
#pragma unroll
                for (int i = 0; i < 8; i += 2) {
                    const int t0 = tid + 512 * i, t1 = t0 + 512; const float f0 = Ff[t0], b0 = Fb[t0], f1 = Ff[t1], b1 = Fb[t1];
                    const float tt0 = (float)t0 * (1.f / 4095.f), tt1 = (float)t1 * (1.f / 4095.f);
                    const float hf0 = f0 * (__expf(-tt0 * adf) + 0.05f), hb0 = b0 * (__expf(-tt0 * adb) + 0.05f), hf1 = f1 * (__expf(-tt1 * adf) + 0.05f), hb1 = b1 * (__expf(-tt1 * adb) + 0.05f);
                    if (t0 == 0) TS[0] = hf0 + hb0; else { TS[t0] = hf0; TS[2 * SEQ - t0] = hb0; }
                    TS[t1] = hf1; TS[2 * SEQ - t1] = hb1; }
            }
            __syncthreads();
            { int lane = F.lane; LAUNDER(lane); const int n = lane & 31, h = lane >> 5, lo = 32 * wave + n;
              unsigned B0[2][4], B1[2][4]; const cf2 t8 = TW8[lo];
#pragma unroll
              for (int s = 0; s < 2; ++s)
#pragma unroll
                  for (int i = 0; i < 4; ++i) { const int t = (8 * s + 4 * h + i) * 256 + lo; const float a = TS[t], b = TS[SEQ + t], d = a - b; const cf2 w = tw8k(t8, 8 * s + i, h);
                      B0[s][i] = pkc(a + b, 0.f); B1[s][i] = pkc(d * w.x, d * w.y); }
              mfma_ready(B0); mfma_ready(B1);
              float a0[16], a1[16]; h3_mm2(M, false, B0, B1, a0, a1);
              f2_passA_fwd_store(wave, lane, 0, a0, X, TWA); f2_passA_fwd_store(wave, lane, 1, a1, X, TWA); }
            __syncthreads();
            { int lane = F.lane; LAUNDER(lane);
              unsigned B0[2][4], B1[2][4]; f2_passB_load(wave, lane, 0, X, B0); f2_passB_load(wave, lane, 1, X, B1);
              float a0[16], a1[16]; h3_mm2(M, false, B0, B1, a0, a1);
              f2_passB_fwd_store(wave, lane, 0, a0, X, TWB); f2_passB_fwd_store(wave, lane, 1, a1, X, TWB); }
            LDS_WAIT(); asm volatile("" ::: "memory");
            { int lane = F.lane; LAUNDER(lane);
              unsigned B0[2][4], B1[2][4]; f2_passC_load(wave, lane, 0, X, B0); f2_passC_load(wave, lane, 1, X, B1);
              float a0[16], a1[16]; h3_mm2(M, false, B0, B1, a0, a1);
              cf2* kg = KG + o * 8192;
#pragma unroll
              for (int p = 0; p < 8; ++p) { const int g = p >> 1, e = p & 1;
                  kg[((0 * 8 + wave) * 8 + p) * 64 + lane] = MK2(a0[4 * g + 2 * e] * (1.f / 8192.f), a0[4 * g + 2 * e + 1] * (1.f / 8192.f));
                  kg[((1 * 8 + wave) * 8 + p) * 64 + lane] = MK2(a1[4 * g + 2 * e] * (1.f / 8192.f), a1[4 * g + 2 * e + 1] * (1.f / 8192.f)); } }
            __syncthreads();
        }
        const float bias0 = F.a->in[IN_HBIAS][c], bias1 = F.a->in[IN_HBIAS][512 + c];
        unsigned vinA[8], vinB[8];
        { const int n = F.lane & 31, h = F.lane >> 5, lo = 32 * wave + n; const unsigned* Uz = UT + (((size_t)2 * 4 + 0) * 512 + c) * SEQ + lo;
#pragma unroll
          for (int s = 0; s < 2; ++s)
#pragma unroll
              for (int i = 0; i < 4; ++i) { vinA[4 * s + i] = Uz[(8 * s + 4 * h + i) * 256]; vinB[4 * s + i] = Uz[(size_t)512 * SEQ + (8 * s + 4 * h + i) * 256]; } }
#pragma unroll 1
        for (int p2 = 0; p2 < (DUP(16) ? 4 : 2); ++p2) { const int p = 2 * (p2 & 1);
            const unsigned* Ux1 = UT + (((size_t)0 * 4 + p) * 512 + c) * SEQ; const unsigned* Ux2 = UT + (((size_t)1 * 4 + p) * 512 + c) * SEQ; const unsigned* Uz = UT + (((size_t)2 * 4 + p) * 512 + c) * SEQ;
            unsigned* zt = ZT + ((size_t)p * 512 + c) * SEQ; const size_t PQ = (size_t)512 * SEQ;
            hy3_conv2<0>(wave, F.lane, M, vinA, vinB, X, Z1, TWA, TWB, TW8, KG, Uz, Ux1, zt, Uz + PQ, Ux1 + PQ, zt + PQ, bias0);
            if (DUP(16) || p < 2) { const int n = F.lane & 31, h = F.lane >> 5, lo = 32 * wave + n; const unsigned* Un = UT + (((size_t)2 * 4 + ((p + 2) & 3)) * 512 + c) * SEQ + lo;
#pragma unroll
                for (int s = 0; s < 2; ++s)
#pragma unroll
                    for (int i = 0; i < 4; ++i) { vinA[4 * s + i] = Un[(8 * s + 4 * h + i) * 256]; vinB[4 * s + i] = Un[PQ + (8 * s + 4 * h + i) * 256]; } }
            hy3_conv2<1>(wave, F.lane, M, vinA, vinB, X, Z1, TWA, TWB, TW8, KG + 8192, Uz, Ux2, zt, Uz + PQ, Ux2 + PQ, zt + PQ, bias1);
        }
    }
}
__global__ void __launch_bounds__(512, 2) fwd_kernel(Args args) {
    extern __shared__ __attribute__((aligned(16))) unsigned char lds[];
    Frame F;
    F.lds = (LAS unsigned char*)lds;
    F.wave = __builtin_amdgcn_readfirstlane((int)threadIdx.x >> 6); F.lane = lane_id(); F.tid = F.wave * 64 + F.lane;
    F.G = gridDim.x; F.blk = blockIdx.x;
    F.a = &args;
    volatile LAS unsigned* MISC = (volatile LAS unsigned*)(F.lds + MISC_OFF);
    if (F.tid < 64) MISC[F.tid] = 0u;
    __syncthreads();
    if (N_LAUNCHES == 1) (void)xcd_barrier_post((unsigned*)(F.a->ws + WS_CTL), MISC + 8, F.tid == 0);
    const int lo = args.ph_lo, hi = args.ph_hi;
#define IN(k) (lo <= (k) && (k) < hi)

#define SEAM(k) do { if (IN(k) && IN((k) + 1)) { XcdBarrier b_; b_.bar = (unsigned*)(F.a->ws + WS_CTL); b_.x = xb_xcc_id(); b_.st = MISC + 8; xcd_barrier(b_, F.wave == 0 && lane_id() == 0); } } while (0)
    unsigned char* ws = F.a->ws;
    if (IN(0)) { REFRESH(F); p0_prologue(F); if (DUP(0)) { __syncthreads(); p0_prologue(F); } } SEAM(0);
    if (DUP(17) && IN(0) && IN(1)) { for (int q = 0; q < 8; ++q) { XcdBarrier b_; b_.bar = (unsigned*)(F.a->ws + WS_CTL); b_.x = xb_xcc_id(); b_.st = MISC + 8; xcd_barrier(b_, F.wave == 0 && lane_id() == 0); } }
    if (IN(1)) { REFRESH(F);
        {
            pg8::Gemm g{(const pg8::bf16_t*)(ws + WS_W3EXT), (const pg8::bf16_t*)(ws + WS_HEXT), 2048, SEQ, 256}; pg8::StaticOrder S; S.init(2048, SEQ, F.G, F.blk);
            pg8::EpiF32P E{F.a->out, SEQ};
            pg8::gemm_phase<pg8::EpiF32P, pg8::StaticOrder, true, true>(F.lds, g, S, E, F.tid);
        }
        __syncthreads();
        p_norm<false>(F); if (DUP(1)) { __syncthreads(); p_norm<false>(F); } } SEAM(1);
    if (IN(2)) { REFRESH(F);
        pg8::Gemm g{(const pg8::bf16_t*)(ws + WS_H), (const pg8::bf16_t*)(ws + WS_WIN), MTOK, NPROJ, DM}; pg8::StaticOrder S; S.init(MTOK, NPROJ, F.G, F.blk);
        pg8::EpiBf16<0> E{(pg8::bf16_t*)(ws + WS_P), NPROJ, (const float*)(ws + WS_BIN2), 0, 0, 1.f};
        pg8::gemm_phase<pg8::EpiBf16<0>, pg8::StaticOrder, true, true>(F.lds, g, S, E, F.tid);
        if (DUP(2)) { __syncthreads(); pg8::gemm_phase<pg8::EpiBf16<0>, pg8::StaticOrder, true, true>(F.lds, g, S, E, F.tid); }
    } SEAM(2);
    if (IN(3)) { REFRESH(F); p3_prep(F); if (DUP(3)) { __syncthreads(); p3_prep(F); } } SEAM(3);
    if (IN(4)) { REFRESH(F); p4_hyena3(F); if (DUP(4)) { __syncthreads(); p4_hyena3(F); } __syncthreads(); p4_mlstm_mfma(F); if (DUP(13)) { __syncthreads(); p4_mlstm_mfma(F); } } SEAM(4);
    if (IN(5)) { REFRESH(F); p5_post(F); if (DUP(5)) { __syncthreads(); p5_post(F); } } SEAM(5);
    if (IN(6)) { REFRESH(F);
        pg8::Gemm g{(const pg8::bf16_t*)(ws + WS_H), (const pg8::bf16_t*)(ws + WS_WOUT), MTOK, DM, DM}; pg8::StaticOrder S; S.init(MTOK, DM, F.G, F.blk);
        pg8::EpiRes E{F.a->in[IN_X], (pg8::bf16_t*)(ws + WS_X1), (const float*)(ws + WS_MOD)};
        pg8::gemm_phase<pg8::EpiRes, pg8::StaticOrder, true, true>(F.lds, g, S, E, F.tid);
        if (DUP(6)) { __syncthreads(); pg8::gemm_phase<pg8::EpiRes, pg8::StaticOrder, true, true>(F.lds, g, S, E, F.tid); }
    } SEAM(6);
    if (IN(7)) { REFRESH(F);
        { LAS float* Wt = (LAS float*)(F.lds + 8 * 8704); for (int i = F.tid; i < 16384; i += 512) { const int k = i >> 4, g = i & 15; Wt[g * 1024 + k] = F.a->in[IN_WROUTER][k * 16 + g]; } }
        __syncthreads();
        if (F.wave < 4) conv_experts<1>(F); else p_norm<true, 4>(F);
    } SEAM(7);
    if (IN(8)) { REFRESH(F); p8_topk(F); } SEAM(8);
    if (IN(9)) { REFRESH(F);
        pg8::Gemm g{(const pg8::bf16_t*)(ws + WS_HF), (const pg8::bf16_t*)(ws + WS_WGU), NSLOT, NEXP * 4096, DM / 2}; pg8::MoeOrderA S{F.G, F.blk};
        LAS unsigned short* gidx = (LAS unsigned short*)(F.lds + RING_BYTES);
        { const int* IDX = (const int*)(ws + WS_IDX);
          for (int q = F.tid; q < 4096; q += 512) { pg8::Unit u; const int i = q >> 8, r = q & 255;
              if (S.next(i, u)) { const int e = u.pm >> 4, pml = u.pm & 15, b = pml >> 1, s0 = (pml & 1) * 256; gidx[q] = (unsigned short)(b * SEQ + IDX[(b * 16 + e) * CAP + s0 + r]); } } }
        __syncthreads();
        pg8::EpiSwiGLU E{ws + WS_HID};
        pg8::gemm_phase_gather_fp8<pg8::EpiSwiGLU, pg8::MoeOrderA>(F.lds, g, S, E, gidx, 0, F.tid, 121);
        if (DUP(9)) { __syncthreads(); pg8::gemm_phase_gather_fp8<pg8::EpiSwiGLU, pg8::MoeOrderA>(F.lds, g, S, E, gidx, 0, F.tid, 121); }
    } SEAM(9);
    if (IN(10)) { REFRESH(F);
        pg8::Gemm g{(const pg8::bf16_t*)(ws + WS_HID), (const pg8::bf16_t*)(ws + WS_WD), NSLOT, NEXP * 1024, FFD / 2}; pg8::MoeOrderB S{F.G, F.blk};
        LAS unsigned short* gidx = (LAS unsigned short*)(F.lds + RING_BYTES);
        for (int q = F.tid; q < 4096; q += 512) { pg8::Unit u; const int i = q >> 8, r = q & 255; if (S.next(i, u)) gidx[q] = (unsigned short)(u.pm * 256 + r); }
        __syncthreads();
        pg8::EpiYs E{ws + WS_YS};
        pg8::gemm_phase_gather_fp8<pg8::EpiYs, pg8::MoeOrderB>(F.lds, g, S, E, gidx, 0, F.tid, 125);
        if (DUP(10)) { __syncthreads(); pg8::gemm_phase_gather_fp8<pg8::EpiYs, pg8::MoeOrderB>(F.lds, g, S, E, gidx, 0, F.tid, 125); }
    } SEAM(10);
    if (IN(11)) { REFRESH(F); if (DUP(11)) { p12_final<true>(F); __syncthreads(); } p12_final<false>(F); }
#undef IN
#undef SEAM
}

extern "C" void kernel_launch(void* const* d_in, const int* in_sizes, int n_in, void* d_out, int out_size, void* d_ws, size_t ws_size, hipStream_t stream) {
    static int grid = 0;
    if (grid == 0) {
        if (n_in != 28 || out_size != MTOK * DM || ws_size < WS_END) { fprintf(stderr, "kernel_launch: unexpected shapes (n_in %d, out %d, ws %zu < %zu)\n", n_in, out_size, ws_size, (size_t)WS_END); grid = -1; return; }
        int dev = 0, cus = 0;
        if (hipGetDevice(&dev) != hipSuccess || hipDeviceGetAttribute(&cus, hipDeviceAttributeMultiprocessorCount, dev) != hipSuccess) { grid = -1; return; }
        if (hipFuncSetAttribute((const void*)fwd_kernel, hipFuncAttributeMaxDynamicSharedMemorySize, LDS_BYTES) != hipSuccess) { fprintf(stderr, "kernel_launch: hipFuncSetAttribute failed\n"); grid = -1; return; }
        int per_cu = 0;
        if (hipOccupancyMaxActiveBlocksPerMultiprocessor(&per_cu, (const void*)fwd_kernel, 512, LDS_BYTES) != hipSuccess || per_cu < 1) fprintf(stderr, "kernel_launch: occupancy query reports %d\n", per_cu);
        (void)hipGetLastError();
        grid = cus > 256 ? 256 : cus;
    }
    if (grid < 0) return;
    (void)hipMemsetAsync((char*)d_ws + WS_CTL, 0, CTL_ZERO_BYTES, stream);
    Args a{};
    for (int i = 0; i < 28; ++i) a.in[i] = (const float*)d_in[i];
    a.out = (float*)d_out; a.ws = (unsigned char*)d_ws;
    if (N_LAUNCHES == 1) { a.ph_lo = 0; a.ph_hi = N_PHASES; hipLaunchKernelGGL(fwd_kernel, dim3(grid), dim3(512), LDS_BYTES, stream, a); }
    else for (int p = 0; p < N_PHASES; ++p) { a.ph_lo = p; a.ph_hi = p + 1; hipLaunchKernelGGL(fwd_kernel, dim3(grid), dim3(512), LDS_BYTES, stream, a); }
}
```
